# Optimizing an MI355X kernel written in HIP

```python
import jax
import jax.numpy as jnp
from jax import lax
import numpy as np

D_MODEL = 1024
BATCH = 8
SEQ = 2048
DEPTH = 1

GRID_W = 64
CTX_LEN = 256
ATT_HEADS = 16
ATT_KV_HEADS = 4
ATT_HEAD_DIM = 64
ATT_GROUP = ATT_HEADS // ATT_KV_HEADS
WINDOW = 128
ATT_BLOCK = 128
ROPE_BASE = 10000.0
ATT_SCALE = ATT_HEAD_DIM ** -0.5
ML_HEADS = 4
ML_QK_DIM = 128
ML_V_DIM = 256
ML_CHUNK = 128
D_FF = 2816
CONV_W = 3
EPS = 1e-6
NEG_INF = -1e30

ATT_Q_W = ATT_HEADS * ATT_HEAD_DIM
ATT_KV_W = ATT_KV_HEADS * ATT_HEAD_DIM
ML_QK_W = ML_HEADS * ML_QK_DIM
ML_V_W = ML_HEADS * ML_V_DIM
ML_GATE_W = 2 * 2 * ML_HEADS
IN_SPLITS = (ATT_Q_W, ATT_KV_W, ATT_KV_W, ML_QK_W, ML_QK_W, ML_V_W, ML_V_W, ML_GATE_W, D_MODEL, D_MODEL)
IN_W = ATT_Q_W + 2 * ATT_KV_W + 2 * ML_QK_W + 2 * ML_V_W + ML_GATE_W + 2 * D_MODEL

kernel_name = "hybrid_mlstm_swa_dit_layer"


def rms_norm(x, w):
    xf = x.astype(jnp.float32)
    y = xf * lax.rsqrt(jnp.mean(xf * xf, axis=-1, keepdims=True) + EPS)
    return (y * w.astype(jnp.float32)).astype(x.dtype)


def modulate(h, shift, scale):
    return h * (1 + scale[:, None, :]) + shift[:, None, :]


def heads(a, n_heads, head_dim):
    return a.reshape(a.shape[0], a.shape[1], n_heads, head_dim)


def split_in_proj(p):
    parts, start = [], 0
    for width in IN_SPLITS:
        parts.append(p[..., start:start + width])
        start += width
    return parts


def axial_rope(rows):
    row = jnp.repeat(jnp.arange(rows, dtype=jnp.float32), GRID_W)
    col = jnp.tile(jnp.arange(GRID_W, dtype=jnp.float32), rows)
    n_freq = ATT_HEAD_DIM // 4
    inv_freq = ROPE_BASE ** (-jnp.arange(n_freq, dtype=jnp.float32) / n_freq)
    ang = jnp.concatenate([row[:, None] * inv_freq, col[:, None] * inv_freq], axis=-1)
    return jnp.cos(ang)[:, None, :], jnp.sin(ang)[:, None, :]


def apply_rope(x, cos, sin):
    xf = x.astype(jnp.float32)
    half = x.shape[-1] // 2
    x1, x2 = xf[..., :half], xf[..., half:]
    return jnp.concatenate([x1 * cos - x2 * sin, x1 * sin + x2 * cos], axis=-1).astype(x.dtype)


def windowed_gqa(q, k, v, k_ctx, v_ctx, sink):
    B, L, H, dh = q.shape
    T = ATT_BLOCK
    nb = L // T
    C = k_ctx.shape[1]
    qb = q.reshape(B, nb, T, ATT_KV_HEADS, ATT_GROUP, dh).swapaxes(0, 1)

    def band(a):
        ap = jnp.pad(a, ((0, 0), (T, T), (0, 0), (0, 0))).reshape(B, nb + 2, T, ATT_KV_HEADS, dh)
        w = jnp.concatenate([ap[:, :-2], ap[:, 1:-1], ap[:, 2:]], axis=2)
        return w.swapaxes(0, 1)

    kb, vb = band(k), band(v)
    sink_b = jnp.broadcast_to(sink.astype(jnp.float32).reshape(1, ATT_KV_HEADS, ATT_GROUP, 1, 1),
                              (B, ATT_KV_HEADS, ATT_GROUP, T, 1))
    key_off = jnp.arange(3 * T) - T
    rel = key_off[None, :] - jnp.arange(T)[:, None]

    def one_block(args):
        blk, qblk, kblk, vblk = args
        k_abs = blk * T + key_off
        valid = (jnp.abs(rel) <= WINDOW) & ((k_abs >= 0) & (k_abs < L))[None, :]
        s_lat = jnp.einsum('btkgd,bskd->bkgts', qblk, kblk).astype(jnp.float32) * ATT_SCALE
        s_lat = jnp.where(valid, s_lat, NEG_INF)
        s_ctx = jnp.einsum('btkgd,bskd->bkgts', qblk, k_ctx).astype(jnp.float32) * ATT_SCALE
        p = jax.nn.softmax(jnp.concatenate([s_lat, s_ctx, sink_b], axis=-1), axis=-1).astype(v.dtype)
        return (jnp.einsum('bkgts,bskd->btkgd', p[..., :3 * T], vblk)
                + jnp.einsum('bkgts,bskd->btkgd', p[..., 3 * T:3 * T + C], v_ctx))

    o = lax.map(one_block, (jnp.arange(nb), qb, kb, vb))
    return o.swapaxes(0, 1).reshape(B, L, H * dh)


def context_gqa(q_ctx, k_ctx, v_ctx, sink):
    B, C, H, dh = q_ctx.shape
    qg = q_ctx.reshape(B, C, ATT_KV_HEADS, ATT_GROUP, dh)
    s = jnp.einsum('btkgd,bskd->bkgts', qg, k_ctx).astype(jnp.float32) * ATT_SCALE
    sink_b = jnp.broadcast_to(sink.astype(jnp.float32).reshape(1, ATT_KV_HEADS, ATT_GROUP, 1, 1),
                              (B, ATT_KV_HEADS, ATT_GROUP, C, 1))
    p = jax.nn.softmax(jnp.concatenate([s, sink_b], axis=-1), axis=-1).astype(v_ctx.dtype)
    return jnp.einsum('bkgts,bskd->btkgd', p[..., :C], v_ctx).reshape(B, C, H * dh)


def mlstm_chunkwise(q, k, v, i_pre, f_pre, state):
    B, L, H, dqk = q.shape
    dv = v.shape[-1]
    T = ML_CHUNK
    nc = L // T

    def chunks(a):
        return a.astype(jnp.float32).reshape(B, nc, T, *a.shape[2:]).swapaxes(0, 1)

    qs, vs = chunks(q), chunks(v)
    ks = chunks(k) * (dqk ** -0.5)
    i_s = chunks(i_pre)
    lf_s = jax.nn.log_sigmoid(chunks(f_pre))
    tril = jnp.tril(jnp.ones((T, T), dtype=bool))

    def step(carry, xs):
        Cm, n, m = carry
        qc, kc, vc, ic, lfc = xs
        b = jnp.cumsum(lfc, axis=1).transpose(0, 2, 1)
        ih = ic.transpose(0, 2, 1)
        dmat = jnp.where(tril, b[..., :, None] - b[..., None, :] + ih[..., None, :], -jnp.inf)
        inter = b + m[..., None]
        m_t = jnp.maximum(inter, dmat.max(axis=-1))
        s = jnp.einsum('bthd,bshd->bhts', qc, kc) * jnp.exp(dmat - m_t[..., None])
        w_inter = jnp.exp(inter - m_t)
        num = (jnp.einsum('bhts,bshv->bthv', s, vc)
               + jnp.einsum('bthd,bhdv->bthv', qc, Cm) * w_inter.transpose(0, 2, 1)[..., None])
        nq = s.sum(axis=-1) + w_inter * jnp.einsum('bthd,bhd->bht', qc, n)
        den = jnp.maximum(jnp.abs(nq), jnp.exp(-m_t))
        h = num / den.transpose(0, 2, 1)[..., None]
        b_last = b[..., -1]
        a = b_last[..., None] - b + ih
        m_new = jnp.maximum(b_last + m, a.max(axis=-1))
        wk = jnp.exp(a - m_new[..., None]).transpose(0, 2, 1)[..., None]
        decay = jnp.exp(b_last + m - m_new)
        C_new = decay[..., None, None] * Cm + jnp.einsum('bshd,bshv->bhdv', kc * wk, vc)
        n_new = decay[..., None] * n + jnp.einsum('bshd->bhd', kc * wk)
        return (C_new, n_new, m_new), h

    state, hs = lax.scan(step, state, (qs, ks, vs, i_s, lf_s))
    return hs.swapaxes(0, 1).reshape(B, L, H, dv), state


def mlstm_bidirectional(q, k, v, g, q_c, k_c, v_c, g_c):
    B = q.shape[0]
    init = (jnp.zeros((B, ML_HEADS, ML_QK_DIM, ML_V_DIM), jnp.float32),
            jnp.zeros((B, ML_HEADS, ML_QK_DIM), jnp.float32),
            jnp.zeros((B, ML_HEADS), jnp.float32))

    def fl(a):
        return jnp.flip(a, axis=1)

    hc_f, st_f = mlstm_chunkwise(q_c, k_c, v_c, g_c[:, :, 0, 0], g_c[:, :, 0, 1], init)
    hc_b, st_b = mlstm_chunkwise(fl(q_c), fl(k_c), fl(v_c), fl(g_c[:, :, 1, 0]), fl(g_c[:, :, 1, 1]), init)
    h_f, _ = mlstm_chunkwise(q, k, v, g[:, :, 0, 0], g[:, :, 0, 1], st_f)
    h_b, _ = mlstm_chunkwise(fl(q), fl(k), fl(v), fl(g[:, :, 1, 0]), fl(g[:, :, 1, 1]), st_b)
    return h_f + fl(h_b), hc_f + fl(hc_b)


def mlstm_readout(h_tilde, o_pre, norm_w):
    B, L = h_tilde.shape[:2]
    hn = rms_norm(h_tilde, norm_w.reshape(ML_HEADS, ML_V_DIM)).reshape(B, L, ML_V_W)
    return hn.astype(o_pre.dtype) * jax.nn.sigmoid(o_pre)


def merge_branches(att, ml, ga_pre, gm_pre, w_branch_att, w_branch_ml, w_out):
    y = jax.nn.sigmoid(ga_pre) * (att @ w_branch_att) + jax.nn.sigmoid(gm_pre) * (ml @ w_branch_ml)
    return y @ w_out


def conv_ffn(h, w_up, conv_w, conv_b, w_down):
    L = h.shape[1]
    u = h @ w_up
    r = CONV_W // 2
    up = jnp.pad(u, ((0, 0), (r, r), (0, 0)))
    acc = conv_b
    for j in range(CONV_W):
        acc = acc + up[:, j:j + L] * conv_w[j]
    a, g = jnp.split(acc, 2, axis=-1)
    return (jax.nn.silu(g) * a) @ w_down


def setup_inputs(seed: int = 0) -> dict:
    key = jax.random.key(seed)
    ks = jax.random.split(key, 24)
    f32 = jnp.float32

    def nrm(k, shape, scale):
        return jax.random.normal(k, shape, f32) * scale

    gate_offset = jnp.array([0.0, 3.0], f32).reshape(1, 1, 2, 1)
    return {
        "x": nrm(ks[0], (BATCH, SEQ, D_MODEL), 1.0),
        "c": nrm(ks[1], (BATCH, D_MODEL), 1.0),
        "ctx": nrm(ks[2], (BATCH, CTX_LEN, D_MODEL), 1.0),
        "c_ctx": nrm(ks[3], (D_MODEL,), 1.0),
        "w_mod": nrm(ks[4], (DEPTH, D_MODEL, 6 * D_MODEL), 0.5 * D_MODEL ** -0.5),
        "b_mod": nrm(ks[5], (DEPTH, 6 * D_MODEL), 0.02),
        "norm1_w": 1.0 + nrm(ks[6], (DEPTH, D_MODEL), 0.02),
        "w_in": nrm(ks[7], (DEPTH, D_MODEL, IN_W), D_MODEL ** -0.5),
        "q_norm_w": 1.0 + nrm(ks[8], (DEPTH, ATT_HEAD_DIM), 0.02),
        "k_norm_w": 1.0 + nrm(ks[9], (DEPTH, ATT_HEAD_DIM), 0.02),
        "attn_sink": nrm(ks[10], (DEPTH, ATT_HEADS), 0.5),
        "ml_gate_b": gate_offset + nrm(ks[11], (DEPTH, 2, 2, ML_HEADS), 0.3),
        "ml_norm_w": 1.0 + nrm(ks[12], (DEPTH, ML_V_W), 0.02),
        "w_branch_att": nrm(ks[13], (DEPTH, ATT_Q_W, D_MODEL), ATT_Q_W ** -0.5),
        "w_branch_ml": nrm(ks[14], (DEPTH, ML_V_W, D_MODEL), ML_V_W ** -0.5),
        "w_out": nrm(ks[15], (DEPTH, D_MODEL, D_MODEL), D_MODEL ** -0.5),
        "norm2_w": 1.0 + nrm(ks[16], (DEPTH, D_MODEL), 0.02),
        "w_up": nrm(ks[17], (DEPTH, D_MODEL, 2 * D_FF), D_MODEL ** -0.5),
        "conv_w": nrm(ks[18], (DEPTH, CONV_W, 2 * D_FF), CONV_W ** -0.5),
        "conv_b": nrm(ks[19], (DEPTH, 2 * D_FF), 0.02),
        "w_down": nrm(ks[20], (DEPTH, D_FF, D_MODEL), D_FF ** -0.5),
    }


def reference(x, c, ctx, c_ctx, w_mod, b_mod, norm1_w, w_in, q_norm_w, k_norm_w, attn_sink,
              ml_gate_b, ml_norm_w, w_branch_att, w_branch_ml, w_out, norm2_w, w_up, conv_w, conv_b, w_down):
    B, L, _ = x.shape
    C = ctx.shape[1]
    rows = L // GRID_W
    cos, sin = axial_rope(rows)
    for l in range(DEPTH):
        mod = jax.nn.silu(c) @ w_mod[l] + b_mod[l]
        mod_c = jax.nn.silu(c_ctx)[None, :] @ w_mod[l] + b_mod[l]
        sh1, sc1, g1, sh2, sc2, g2 = jnp.split(mod, 6, axis=-1)
        sh1c, sc1c, g1c, sh2c, sc2c, g2c = jnp.split(mod_c, 6, axis=-1)

        h = modulate(rms_norm(x, norm1_w[l]), sh1, sc1)
        hc = modulate(rms_norm(ctx, norm1_w[l]), sh1c, sc1c)
        aq, ak, av, mq, mk, mv, mo, mg, ga, gm = split_in_proj(h @ w_in[l])
        aqc, akc, avc, mqc, mkc, mvc, moc, mgc, gac, gmc = split_in_proj(hc @ w_in[l])

        q = apply_rope(rms_norm(heads(aq, ATT_HEADS, ATT_HEAD_DIM), q_norm_w[l]), cos, sin)
        k = apply_rope(rms_norm(heads(ak, ATT_KV_HEADS, ATT_HEAD_DIM), k_norm_w[l]), cos, sin)
        v = heads(av, ATT_KV_HEADS, ATT_HEAD_DIM)
        k_ctx = rms_norm(heads(akc, ATT_KV_HEADS, ATT_HEAD_DIM), k_norm_w[l])
        v_ctx = heads(avc, ATT_KV_HEADS, ATT_HEAD_DIM)
        att = windowed_gqa(q, k, v, k_ctx, v_ctx, attn_sink[l])

        gates = mg.reshape(B, L, 2, 2, ML_HEADS) + ml_gate_b[l]
        gates_c = mgc.reshape(B, C, 2, 2, ML_HEADS) + ml_gate_b[l]
        ht, ht_c = mlstm_bidirectional(
            heads(mq, ML_HEADS, ML_QK_DIM), heads(mk, ML_HEADS, ML_QK_DIM), heads(mv, ML_HEADS, ML_V_DIM), gates,
            heads(mqc, ML_HEADS, ML_QK_DIM), heads(mkc, ML_HEADS, ML_QK_DIM), heads(mvc, ML_HEADS, ML_V_DIM), gates_c)
        ml = mlstm_readout(ht, mo, ml_norm_w[l])

        y = merge_branches(att, ml, ga, gm, w_branch_att[l], w_branch_ml[l], w_out[l])
        x_mid = x + g1[:, None, :] * y

        if l < DEPTH - 1:
            q_c = rms_norm(heads(aqc, ATT_HEADS, ATT_HEAD_DIM), q_norm_w[l])
            att_c = context_gqa(q_c, k_ctx, v_ctx, attn_sink[l])
            ml_c = mlstm_readout(ht_c, moc, ml_norm_w[l])
            y_c = merge_branches(att_c, ml_c, gac, gmc, w_branch_att[l], w_branch_ml[l], w_out[l])
            ctx = ctx + g1c[:, None, :] * y_c
            ctx = ctx + g2c[:, None, :] * conv_ffn(modulate(rms_norm(ctx, norm2_w[l]), sh2c, sc2c),
                                                   w_up[l], conv_w[l], conv_b[l], w_down[l])

        x = x_mid + g2[:, None, :] * conv_ffn(modulate(rms_norm(x_mid, norm2_w[l]), sh2, sc2),
                                              w_up[l], conv_w[l], conv_b[l], w_down[l])
    return x
```

```cpp
#include <hip/hip_runtime.h>
#include <hip/hip_cooperative_groups.h>
#include <cstdio>
#include <cstdint>
namespace cg = cooperative_groups;

#ifndef RPT_MASK
#define RPT_MASK 0
#endif
#ifndef ONE_LAUNCH
#define ONE_LAUNCH 1
#endif

#define LAS __attribute__((address_space(3)))
typedef unsigned short bf16_t;
typedef short bf16x8 __attribute__((ext_vector_type(8)));
typedef float f32x4 __attribute__((ext_vector_type(4)));
typedef unsigned u32x4 __attribute__((ext_vector_type(4)));
typedef unsigned u32x2 __attribute__((ext_vector_type(2)));

constexpr int D = 1024, NB = 8, SEQ = 2048, CTX = 256;
constexpr int ML = NB * SEQ;
constexpr int MC = NB * CTX;
constexpr int MT = ML + MC;
constexpr int DFF = 2816, NUP = 2 * DFF, INW = 6672;
constexpr float EPS = 1e-6f;
constexpr size_t MiB = 1u << 20;
constexpr size_t WS_ZERO = 0;
constexpr size_t WS_MOD = 0, WS_FB = 256 * 1024, WS_RSQ = 512 * 1024;
constexpr size_t WS_MODP = 236 * MiB + 12 * MiB;
constexpr size_t WS_RSQP = 252 * MiB;
constexpr size_t DO_FBP = 60 * MiB;
constexpr size_t WS_ROPE = 1 * MiB;
constexpr size_t WS_GATES = 2 * MiB;
constexpr size_t WS_WBA = 4 * MiB, WS_WBM = 6 * MiB, WS_WO = 8 * MiB, WS_WUP = 10 * MiB, WS_WDN = 21 * MiB;
constexpr size_t WS_AQ = 27 * MiB;
constexpr size_t WS_MQ = 59 * MiB, WS_MK = 75 * MiB  , WS_MO = 93 * MiB, WS_GA = 125 * MiB, WS_GM = 157 * MiB, WS_XT = 189 * MiB  ;
constexpr size_t WS_T1 = 59 * MiB, WS_Y = 189 * MiB;
constexpr size_t WS_U = 59 * MiB;
constexpr size_t WS_HALO = 236 * MiB;
constexpr size_t WS_END = 256 * MiB;
constexpr size_t DO_H = 0, DO_W1T = 36 * MiB, DO_W2T = 47 * MiB, DO_AK = 51 * MiB;
constexpr size_t DO_HF = 0, DO_HB = 32 * MiB;
constexpr int LDS_BYTES = 157696;

typedef float f32x2_t __attribute__((ext_vector_type(2))); typedef __bf16 bf16x2_t __attribute__((ext_vector_type(2)));
__device__ __forceinline__ unsigned cvt_pk_bf16(float lo, float hi) { f32x2_t v = {lo, hi}; bf16x2_t b = __builtin_convertvector(v, bf16x2_t); return __builtin_bit_cast(unsigned, b); }
__device__ __forceinline__ float bf2f(unsigned short v) { return __uint_as_float((unsigned)v << 16); }
__device__ __forceinline__ bf16_t f2bf(float f) { return (bf16_t)(cvt_pk_bf16(f, 0.f) & 0xffffu); }
__device__ __forceinline__ u32x4 pack8(f32x4 a, f32x4 b) { u32x4 w; w.x = cvt_pk_bf16(a[0], a[1]); w.y = cvt_pk_bf16(a[2], a[3]); w.z = cvt_pk_bf16(b[0], b[1]); w.w = cvt_pk_bf16(b[2], b[3]); return w; }
__device__ __forceinline__ float sigmoidf_(float x) { return 1.f / (1.f + __expf(-x)); }
__device__ __forceinline__ float wave_sum(float v) {
#pragma unroll
    for (int o = 1; o < 64; o <<= 1) v += __shfl_xor(v, o);
    return v;
}

namespace pg8 {
constexpr int BM = 256, BK = 64, HALF = 128, HTB = HALF * BK * 2, STAGE_BYTES = 8 * HTB, NXCD = 8, WGM = 8;
__host__ __device__ __forceinline__ int lds_byte(int r, int c) { const int st = (r >> 4) * 2 + (c >> 5), rr = r & 15, cc = c & 31, ob = rr * 64 + cc * 2; return st * 1024 + (ob ^ (((ob >> 9) & 1) << 5)); }
__host__ __device__ __forceinline__ void stage_rc(int b, int& R, int& C) { const int st = b / 1024, sb = b % 1024, swz = sb ^ (((sb >> 9) & 1) << 5); R = (st >> 1) * 16 + swz / 64; C = (st & 1) * 32 + (swz % 64) / 2; }
__host__ __device__ __forceinline__ int perm32(int rho) { const int n = rho >> 4, i = rho & 15; return 8 * (i >> 2) + 4 * n + (i & 3); }

struct Unit { int pm, pn; };
struct Gemm { const bf16_t* A; const bf16_t* Bt; int lda, ldb, K; const bf16_t* A2 = nullptr; const bf16_t* Bt2 = nullptr; };

struct Order {
    int nM, nN, nwg, G, c, extra;
    __device__ __forceinline__ void init(int nM_, int nN_, int G_, int c_, int extra_) { nM = nM_; nN = nN_; nwg = nM_ * nN_; G = G_; c = c_; extra = extra_; }
    __device__ __forceinline__ bool next(int i, Unit& u) const {
        const long Lq = (long)i * G + c; if (Lq >= nwg + extra) return false;
        if (Lq >= nwg) { const int e = (int)(Lq - nwg); u.pm = nM + e / 3; u.pn = e % 3; return true; }
        int wgid = (int)Lq; { const int q = nwg / NXCD, r = nwg % NXCD, xcd = wgid % NXCD, off = wgid / NXCD; wgid = (xcd < r ? xcd * (q + 1) : r * (q + 1) + (xcd - r) * q) + off; }
        const int nig = WGM * nN, gid = wgid / nig, fm = gid * WGM, gsz = (nM - fm) < WGM ? (nM - fm) : WGM;
        u.pm = fm + ((wgid % nig) % gsz); u.pn = (wgid % nig) / gsz; return true;
    }
};

template <class Epi, class Sched, bool ALIGN_EPI, bool DUAL = false>
__device__ __forceinline__ void gemm_phase(LAS unsigned char* lds, const Gemm g, const Sched& S, const Epi& E) {
    int tid_ = threadIdx.x; asm volatile("" : "+v"(tid_));
    const int tid = tid_, wid = __builtin_amdgcn_readfirstlane(tid >> 6), lane = tid & 63, wr = wid >> 2, wc = wid & 3, fr = lane & 15, fq = lane >> 4;
    const int K = g.K, nt1 = K / BK, nt = DUAL ? 2 * nt1 : nt1;
    unsigned voffA[2], voffB[2];
#pragma unroll
    for (int i = 0; i < 2; ++i) { int R, C; stage_rc(tid * 16 + i * 8192, R, C); const int Rb = ((R & ~31) + perm32(R & 31));
        voffA[i] = (unsigned)(R * g.lda + C) * 2u; voffB[i] = (unsigned)(Rb * g.ldb + C) * 2u; }
    const size_t kstep = (size_t)(BK * 2);
    const size_t hstepA = (size_t)HALF * g.lda * 2, hstepB = (size_t)HALF * g.ldb * 2;
    const size_t tstepA = 2 * hstepA, tstepB = 2 * hstepB;
    const unsigned ldsw = (unsigned)wid * 1024u;
    const int aoff = lds_byte(wr * 64 + fr, fq * 8), boff = lds_byte(wc * 32 + fr, fq * 8);
#define PG8_SA(b, h) (((b) * 2 + (h)) * HTB)
#define PG8_SB(b, h) ((4 + (b) * 2 + (h)) * HTB)
#define PG8_STAGE(bufoff, gbase, voff) do { _Pragma("unroll") for (int _i = 0; _i < 2; ++_i) \
        __builtin_amdgcn_global_load_lds((const unsigned*)((const char*)(gbase) + (voff)[_i]), (LAS unsigned*)(lds + (bufoff) + ldsw + _i * 8192), 16, 0, 0); } while (0)
#define PG8_LDA(dst, b, h) do { _Pragma("unroll") for (int m = 0; m < 4; ++m) _Pragma("unroll") for (int k = 0; k < 2; ++k) dst[m][k] = *(const LAS bf16x8*)(lds + PG8_SA(b, h) + aoff + m * 2048 + k * 1024); } while (0)
#define PG8_LDB(dst, b, h) do { _Pragma("unroll") for (int n = 0; n < 2; ++n) _Pragma("unroll") for (int k = 0; k < 2; ++k) dst[n][k] = *(const LAS bf16x8*)(lds + PG8_SB(b, h) + boff + n * 2048 + k * 1024); } while (0)
#define PG8_MMA(ai, bj, At, Bt) do { __builtin_amdgcn_s_setprio(1); _Pragma("unroll") for (int m = 0; m < 4; ++m) _Pragma("unroll") for (int n = 0; n < 2; ++n) _Pragma("unroll") for (int k = 0; k < 2; ++k) \
        acc[ai][bj][m][n] = __builtin_amdgcn_mfma_f32_16x16x32_bf16(Bt[n][k], At[m][k], acc[ai][bj][m][n], 0, 0, 0); __builtin_amdgcn_s_setprio(0); } while (0)
#define PG8_WAIT_V(n) asm volatile("s_waitcnt vmcnt(" #n ")" ::: "memory")
#define PG8_WAIT_L(n) asm volatile("s_waitcnt lgkmcnt(" #n ")" ::: "memory")
#define PG8_BAR __builtin_amdgcn_s_barrier()
#define PG8_SCHED __builtin_amdgcn_sched_barrier(0)
    Unit cur, nxt; int ui = 0;
    if (!S.next(0, cur)) return;
    f32x4 acc[2][2][4][2];
#pragma unroll
    for (int a = 0; a < 2; ++a)
#pragma unroll
        for (int b = 0; b < 2; ++b)
#pragma unroll
            for (int m = 0; m < 4; ++m)
#pragma unroll
                for (int n = 0; n < 2; ++n) acc[a][b][m][n] = (f32x4){0.f, 0.f, 0.f, 0.f};
    bf16x8 At[4][2], B0[2][2], B1[2][2];
    const char* cA = (const char*)g.A + (size_t)cur.pm * tstepA; const char* cB = (const char*)g.Bt + (size_t)cur.pn * tstepB;
    const char* cA2 = DUAL ? (const char*)g.A2 + (size_t)cur.pm * tstepA : cA; const char* cB2 = DUAL ? (const char*)g.Bt2 + (size_t)cur.pn * tstepB : cB;
    PG8_STAGE(PG8_SB(0, 0), cB, voffB); PG8_STAGE(PG8_SB(0, 1), cB + hstepB, voffB); PG8_STAGE(PG8_SA(0, 0), cA, voffA); PG8_STAGE(PG8_SA(0, 1), cA + hstepA, voffA);
    if (wr == 1) PG8_BAR;
    PG8_WAIT_V(2); PG8_BAR;
    PG8_STAGE(PG8_SB(1, 0), cB + kstep, voffB); PG8_STAGE(PG8_SA(1, 0), cA + kstep, voffA); PG8_STAGE(PG8_SB(1, 1), cB + hstepB + kstep, voffB);
    PG8_WAIT_V(6); PG8_BAR;
    for (;;) {
        const bool has_next = S.next(ui + 1, nxt);
        const char* nA = has_next ? (const char*)g.A + (size_t)nxt.pm * tstepA : cA; const char* nB = has_next ? (const char*)g.Bt + (size_t)nxt.pn * tstepB : cB;
        for (int t = 0; t < nt; t += 2) {
            const bool last = (t == nt - 2);
            const bool seg2 = DUAL && t >= nt1, seg2n = DUAL && t + 2 >= nt1;
            const char* a1 = seg2 ? cA2 + (size_t)(t + 1 - nt1) * kstep : cA + (size_t)(t + 1) * kstep;
            const char* a2 = last ? nA : (seg2n ? cA2 + (size_t)(t + 2 - nt1) * kstep : cA + (size_t)(t + 2) * kstep);
            const char* b2 = last ? nB : (seg2n ? cB2 + (size_t)(t + 2 - nt1) * kstep : cB + (size_t)(t + 2) * kstep);
            if constexpr (DUAL) { if (t == nt1) E.mid(acc, cur, wr, wc, fr, fq); }
            const char* a3 = a2 + kstep; const char* b3 = b2 + kstep;
            PG8_LDB(B0, 0, 0); PG8_LDB(B1, 0, 1); PG8_SCHED; PG8_LDA(At, 0, 0); PG8_STAGE(PG8_SA(1, 1), a1 + hstepA, voffA);
            PG8_WAIT_V(8); PG8_WAIT_L(0); PG8_BAR; PG8_MMA(0, 0, At, B0); PG8_MMA(0, 1, At, B1); PG8_BAR; PG8_SCHED;
            PG8_LDA(At, 0, 1); PG8_STAGE(PG8_SB(0, 0), b2, voffB); PG8_STAGE(PG8_SB(0, 1), b2 + hstepB, voffB); PG8_STAGE(PG8_SA(0, 0), a2, voffA);
            PG8_WAIT_V(8); PG8_WAIT_L(0); PG8_BAR; PG8_MMA(1, 0, At, B0); PG8_MMA(1, 1, At, B1); PG8_BAR; PG8_SCHED;
            PG8_LDB(B0, 1, 0); PG8_LDB(B1, 1, 1); PG8_SCHED; PG8_LDA(At, 1, 0); PG8_STAGE(PG8_SA(0, 1), a2 + hstepA, voffA);
            PG8_WAIT_V(8); PG8_WAIT_L(0); PG8_BAR; PG8_MMA(0, 0, At, B0); PG8_MMA(0, 1, At, B1); PG8_BAR; PG8_SCHED;
            PG8_LDA(At, 1, 1); PG8_STAGE(PG8_SB(1, 0), b3, voffB); PG8_STAGE(PG8_SB(1, 1), b3 + hstepB, voffB); PG8_STAGE(PG8_SA(1, 0), a3, voffA);
            PG8_WAIT_V(8); PG8_WAIT_L(0); PG8_BAR; PG8_MMA(1, 0, At, B0); PG8_MMA(1, 1, At, B1); PG8_BAR; PG8_SCHED;
        }
        if constexpr (ALIGN_EPI) { if (wr == 0) PG8_BAR; }
        E(acc, cur, wr, wc, fr, fq);
        if (!has_next) break;
#pragma unroll
        for (int a = 0; a < 2; ++a)
#pragma unroll
            for (int b = 0; b < 2; ++b)
#pragma unroll
                for (int m = 0; m < 4; ++m)
#pragma unroll
                    for (int n = 0; n < 2; ++n) acc[a][b][m][n] = (f32x4){0.f, 0.f, 0.f, 0.f};
        cur = nxt; cA = nA; cB = nB; ++ui;
        if constexpr (DUAL) { cA2 = (const char*)g.A2 + (size_t)cur.pm * tstepA; cB2 = (const char*)g.Bt2 + (size_t)cur.pn * tstepB; }
        if constexpr (ALIGN_EPI) { if (wr == 1) PG8_BAR; }
    }
    PG8_WAIT_V(0);
    if constexpr (!ALIGN_EPI) { if (wr == 0) PG8_BAR; }
    PG8_BAR;
#undef PG8_SA
#undef PG8_SB
#undef PG8_STAGE
#undef PG8_LDA
#undef PG8_LDB
#undef PG8_MMA
#undef PG8_WAIT_V
#undef PG8_WAIT_L
#undef PG8_BAR
#undef PG8_SCHED
}
}
using pg8::Unit;
typedef const f32x4 (&AccRef)[2][2][4][2];

struct EpiIn {
    bf16_t *AK_, *MK_, *AQ_, *MQ_, *MO_, *GA_, *GM_; const float *qnw, *knw, *cosT_, *sinT_;
    __device__ __forceinline__ void head_path(AccRef acc, const Unit& u, int wr, int wc, int fr, int fq_in, bf16_t* base, int ld, int coff, const float* nw) const {
        int fq = fq_in; asm volatile("" : "+v"(fq));
        const int row0 = u.pm * 256 + wr * 64 + fr;
        const bool rope = u.pm < 64;
#pragma unroll
        for (int ai = 0; ai < 2; ++ai)
#pragma unroll
            for (int m = 0; m < 4; ++m) {
                const int row = row0 + ai * 128 + m * 16;
                f32x4 v00 = acc[ai][0][m][0], v01 = acc[ai][0][m][1], v10 = acc[ai][1][m][0], v11 = acc[ai][1][m][1];
                f32x4 q = v00 * v00 + v01 * v01 + v10 * v10 + v11 * v11;
                float ss = (q[0] + q[1]) + (q[2] + q[3]);
                ss += __shfl_xor(ss, 16); ss += __shfl_xor(ss, 32);
                const float rs = rsqrtf(ss * (1.f / 64.f) + EPS);
                v00 = v00 * rs * *(const f32x4*)(nw + 8 * fq); v01 = v01 * rs * *(const f32x4*)(nw + 8 * fq + 4); v10 = v10 * rs * *(const f32x4*)(nw + 32 + 8 * fq); v11 = v11 * rs * *(const f32x4*)(nw + 32 + 8 * fq + 4);
                f32x4 o00 = v00, o01 = v01, o10 = v10, o11 = v11;
                if (rope) {
                    const int t = row & 2047;
                    const f32x4 c0 = *(const f32x4*)(cosT_ + t * 32 + 8 * fq), c1 = *(const f32x4*)(cosT_ + t * 32 + 8 * fq + 4);
                    const f32x4 s0 = *(const f32x4*)(sinT_ + t * 32 + 8 * fq), s1 = *(const f32x4*)(sinT_ + t * 32 + 8 * fq + 4);
                    o00 = v00 * c0 - v10 * s0; o01 = v01 * c1 - v11 * s1; o10 = v00 * s0 + v10 * c0; o11 = v01 * s1 + v11 * c1;
                }
                bf16_t* p = base + (size_t)row * ld + coff + wc * 64 + 8 * fq;
                *(u32x4*)p = pack8(o00, o01); *(u32x4*)(p + 32) = pack8(o10, o11);
                asm volatile("" ::: "memory");
            }
    }
    template <bool SIG> __device__ __forceinline__ void plain_path(AccRef acc, const Unit& u, int wr, int wc, int fr, int fq, bf16_t* base, int ld, int coff) const {
        const int row0 = u.pm * 256 + wr * 64 + fr;
#pragma unroll
        for (int ai = 0; ai < 2; ++ai)
#pragma unroll
            for (int m = 0; m < 4; ++m) {
                bf16_t* p = base + (size_t)(row0 + ai * 128 + m * 16) * ld + coff + wc * 32 + 8 * fq;
#pragma unroll
                for (int bj = 0; bj < 2; ++bj) { f32x4 v0 = acc[ai][bj][m][0], v1 = acc[ai][bj][m][1];
                    if (SIG) {
#pragma unroll
                        for (int e = 0; e < 4; ++e) { v0[e] = sigmoidf_(v0[e]); v1[e] = sigmoidf_(v1[e]); } }
                    *(u32x4*)(p + bj * 128) = pack8(v0, v1); }
            }
    }
    __device__ __forceinline__ void operator()(AccRef acc, const Unit& u, int wr, int wc, int fr, int fq) const {
        const int pn = u.pn;
        if (pn == 0) head_path(acc, u, wr, wc, fr, fq, AK_, 256, 0, knw);
        else if (pn <= 2) plain_path<false>(acc, u, wr, wc, fr, fq, MK_, 512, (pn - 1) * 256);
        else if (pn <= 6) head_path(acc, u, wr, wc, fr, fq, AQ_, 1024, (pn - 3) * 256, qnw);
        else if (pn <= 8) plain_path<false>(acc, u, wr, wc, fr, fq, MQ_, 512, (pn - 7) * 256);
        else if (pn <= 12) plain_path<false>(acc, u, wr, wc, fr, fq, MO_, 1024, (pn - 9) * 256);
        else if (pn <= 16) plain_path<true>(acc, u, wr, wc, fr, fq, GA_, 1024, (pn - 13) * 256);
        else plain_path<true>(acc, u, wr, wc, fr, fq, GM_, 1024, (pn - 17) * 256);
    }
};
struct EpiPlain {
    bf16_t* O; int ldc;
    __device__ __forceinline__ void operator()(AccRef acc, const Unit& u, int wr, int wc, int fr, int fq) const {
        const int row0 = u.pm * 256 + wr * 64 + fr;
#pragma unroll
        for (int ai = 0; ai < 2; ++ai)
#pragma unroll
            for (int m = 0; m < 4; ++m) {
                bf16_t* p = O + (size_t)(row0 + ai * 128 + m * 16) * ldc + u.pn * 256 + wc * 32 + 8 * fq;
#pragma unroll
                for (int bj = 0; bj < 2; ++bj) *(u32x4*)(p + bj * 128) = pack8(acc[ai][bj][m][0], acc[ai][bj][m][1]);
            }
    }
};
template <bool ADD> struct EpiGate {
    const bf16_t* Gt; const bf16_t* T; bf16_t* O;
    __device__ __forceinline__ void operator()(AccRef acc, const Unit& u, int wr, int wc, int fr, int fq) const {
        const int row0 = u.pm * 256 + wr * 64 + fr;
        const size_t off0 = (size_t)row0 * 1024 + u.pn * 256 + wc * 32 + 8 * fq;
        u32x4 gv[2][2], tv[2][2];
#pragma unroll
        for (int bj = 0; bj < 2; ++bj) { gv[0][bj] = *(const u32x4*)(Gt + off0 + bj * 128); tv[0][bj] = (u32x4){0u, 0u, 0u, 0u}; if (ADD) tv[0][bj] = *(const u32x4*)(T + off0 + bj * 128); }
#pragma unroll
        for (int it = 0; it < 8; ++it) {
            const int ai = it >> 2, m = it & 3, cur = it & 1, nx = cur ^ 1;
            const size_t off = off0 + (size_t)(ai * 128 + m * 16) * 1024;
            if (it < 7) { const size_t offn = off0 + (size_t)(((it + 1) >> 2) * 128 + ((it + 1) & 3) * 16) * 1024;
#pragma unroll
                for (int bj = 0; bj < 2; ++bj) { gv[nx][bj] = *(const u32x4*)(Gt + offn + bj * 128); tv[nx][bj] = (u32x4){0u, 0u, 0u, 0u}; if (ADD) tv[nx][bj] = *(const u32x4*)(T + offn + bj * 128); } }
#pragma unroll
            for (int bj = 0; bj < 2; ++bj) {
                float r[8];
#pragma unroll
                for (int e = 0; e < 8; ++e) {
                    const unsigned gw = gv[cur][bj][e >> 1], tw = tv[cur][bj][e >> 1];
                    const float gg = (e & 1) ? __uint_as_float(gw & 0xffff0000u) : __uint_as_float(gw << 16);
                    const float tt = (e & 1) ? __uint_as_float(tw & 0xffff0000u) : __uint_as_float(tw << 16);
                    r[e] = tt + sigmoidf_(gg) * acc[ai][bj][m][e >> 2][e & 3];
                }
                u32x4 w; w.x = cvt_pk_bf16(r[0], r[1]); w.y = cvt_pk_bf16(r[2], r[3]); w.z = cvt_pk_bf16(r[4], r[5]); w.w = cvt_pk_bf16(r[6], r[7]);
                *(u32x4*)(O + off + bj * 128) = w;
            }
        }
    }
};
struct EpiMerge {
    const bf16_t* Sa; const bf16_t* Sm; bf16_t* O;
    __device__ __forceinline__ void mid(f32x4 (&acc)[2][2][4][2], const Unit& u, int wr, int wc, int fr, int fq) const {
        const size_t off0 = (size_t)(u.pm * 256 + wr * 64 + fr) * 1024 + u.pn * 256 + wc * 32 + 8 * fq;
        u32x4 av[2][2], mv[2][2];
#pragma unroll
        for (int bj = 0; bj < 2; ++bj) { av[0][bj] = *(const u32x4*)(Sa + off0 + bj * 128); mv[0][bj] = *(const u32x4*)(Sm + off0 + bj * 128); }
#pragma unroll
        for (int it = 0; it < 8; ++it) {
            const int ai = it >> 2, m = it & 3, cur = it & 1, nx = cur ^ 1;
            if (it < 7) { const size_t offn = off0 + (size_t)(((it + 1) >> 2) * 128 + ((it + 1) & 3) * 16) * 1024;
#pragma unroll
                for (int bj = 0; bj < 2; ++bj) { av[nx][bj] = *(const u32x4*)(Sa + offn + bj * 128); mv[nx][bj] = *(const u32x4*)(Sm + offn + bj * 128); } }
#pragma unroll
            for (int bj = 0; bj < 2; ++bj)
#pragma unroll
                for (int e = 0; e < 8; ++e) {
                    const unsigned aw = av[cur][bj][e >> 1], mw = mv[cur][bj][e >> 1];
                    const float sa = (e & 1) ? __uint_as_float(aw & 0xffff0000u) : __uint_as_float(aw << 16);
                    const float sm = (e & 1) ? __uint_as_float(mw & 0xffff0000u) : __uint_as_float(mw << 16);
                    acc[ai][bj][m][e >> 2][e & 3] *= sa * __builtin_amdgcn_rcpf(fmaxf(sm, 1e-30f));
                }
        }
    }
    __device__ __forceinline__ void operator()(AccRef acc, const Unit& u, int wr, int wc, int fr, int fq) const {
        const size_t off0 = (size_t)(u.pm * 256 + wr * 64 + fr) * 1024 + u.pn * 256 + wc * 32 + 8 * fq;
        u32x4 mv[2][2];
#pragma unroll
        for (int bj = 0; bj < 2; ++bj) mv[0][bj] = *(const u32x4*)(Sm + off0 + bj * 128);
#pragma unroll
        for (int it = 0; it < 8; ++it) {
            const int ai = it >> 2, m = it & 3, cur = it & 1, nx = cur ^ 1;
            const size_t off = off0 + (size_t)(ai * 128 + m * 16) * 1024;
            if (it < 7) { const size_t offn = off0 + (size_t)(((it + 1) >> 2) * 128 + ((it + 1) & 3) * 16) * 1024;
#pragma unroll
                for (int bj = 0; bj < 2; ++bj) mv[nx][bj] = *(const u32x4*)(Sm + offn + bj * 128); }
#pragma unroll
            for (int bj = 0; bj < 2; ++bj) { float r[8];
#pragma unroll
                for (int e = 0; e < 8; ++e) { const unsigned mw = mv[cur][bj][e >> 1];
                    const float sm = (e & 1) ? __uint_as_float(mw & 0xffff0000u) : __uint_as_float(mw << 16);
                    r[e] = fmaxf(sm, 1e-30f) * acc[ai][bj][m][e >> 2][e & 3]; }
                u32x4 w; w.x = cvt_pk_bf16(r[0], r[1]); w.y = cvt_pk_bf16(r[2], r[3]); w.z = cvt_pk_bf16(r[4], r[5]); w.w = cvt_pk_bf16(r[6], r[7]);
                *(u32x4*)(O + off + bj * 128) = w; }
        }
    }
};
struct EpiOut {
    const float* x; const float* mod; const float* nw2; float* xmid; bf16_t* AP; float* rowsq;
    __device__ __forceinline__ void operator()(AccRef acc, const Unit& u, int wr, int wc, int fr, int fq) const {
        const int b = u.pm >> 3; const float* mb = mod + b * 6144;
        const int row0 = u.pm * 256 + wr * 64 + fr, col0 = u.pn * 256 + wc * 32 + 8 * fq;
        f32x4 g1[2][2], sw[2][2];
#pragma unroll
        for (int bj = 0; bj < 2; ++bj)
#pragma unroll
            for (int n = 0; n < 2; ++n) { const int c = col0 + bj * 128 + 4 * n; g1[bj][n] = *(const f32x4*)(mb + 2048 + c);
                sw[bj][n] = *(const f32x4*)(nw2 + c) * (*(const f32x4*)(mb + 4096 + c) + 1.f); }
        f32x4 xv[2][2][2];
#pragma unroll
        for (int bj = 0; bj < 2; ++bj)
#pragma unroll
            for (int n = 0; n < 2; ++n) xv[0][bj][n] = *(const f32x4*)(x + (size_t)row0 * 1024 + col0 + bj * 128 + 4 * n);
#pragma unroll
        for (int it = 0; it < 8; ++it) {
            const int ai = it >> 2, m = it & 3, cur = it & 1, nx = cur ^ 1;
            const int row = row0 + ai * 128 + m * 16; const size_t off = (size_t)row * 1024 + col0; float ss = 0.f;
            if (it < 7) { const size_t offn = (size_t)(row0 + ((it + 1) >> 2) * 128 + ((it + 1) & 3) * 16) * 1024 + col0;
#pragma unroll
                for (int bj = 0; bj < 2; ++bj)
#pragma unroll
                    for (int n = 0; n < 2; ++n) xv[nx][bj][n] = *(const f32x4*)(x + offn + bj * 128 + 4 * n); }
#pragma unroll
            for (int bj = 0; bj < 2; ++bj) {
                f32x4 v[2];
#pragma unroll
                for (int n = 0; n < 2; ++n) { v[n] = xv[cur][bj][n] + g1[bj][n] * acc[ai][bj][m][n];
                    const f32x4 q = v[n] * v[n]; ss += (q[0] + q[1]) + (q[2] + q[3]); }
                *(u32x4*)(AP + off + bj * 128) = pack8(v[0] * sw[bj][0], v[1] * sw[bj][1]);
            }
            ss += __shfl_xor(ss, 16); ss += __shfl_xor(ss, 32);
            if (fq == 0) rowsq[(size_t)row * 16 + u.pn * 4 + wc] = ss;
        }
    }
};
struct EpiUp {
    const float* rowsq; const float* fb; bf16_t* U; bf16_t* HALO;
    __device__ __forceinline__ void operator()(AccRef acc, const Unit& u, int wr, int wc, int fr, int fq) const {
        const int b = u.pm >> 3; const int row0 = u.pm * 256 + wr * 64 + fr, col0 = u.pn * 256 + wc * 32 + 8 * fq;
        f32x4 bias[2][2];
#pragma unroll
        for (int bj = 0; bj < 2; ++bj)
#pragma unroll
            for (int n = 0; n < 2; ++n) bias[bj][n] = *(const f32x4*)(fb + b * NUP + col0 + bj * 128 + 4 * n);
#pragma unroll
        for (int ai = 0; ai < 2; ++ai)
#pragma unroll
            for (int m = 0; m < 4; ++m) {
                const int row = row0 + ai * 128 + m * 16; const f32x4 q0 = *(const f32x4*)(rowsq + (size_t)row * 16), q1 = *(const f32x4*)(rowsq + (size_t)row * 16 + 4), q2 = *(const f32x4*)(rowsq + (size_t)row * 16 + 8), q3 = *(const f32x4*)(rowsq + (size_t)row * 16 + 12);
                const f32x4 qs = (q0 + q1) + (q2 + q3); const float rstd = rsqrtf(((qs[0] + qs[1]) + (qs[2] + qs[3])) * (1.f / 1024.f) + EPS);
                const int r31 = row & 31; const bool halo = (r31 == 0) || (r31 == 31);
#pragma unroll
                for (int bj = 0; bj < 2; ++bj) {
                    const u32x4 w = pack8(acc[ai][bj][m][0] * rstd + bias[bj][0], acc[ai][bj][m][1] * rstd + bias[bj][1]);
                    *(u32x4*)(U + (size_t)row * NUP + col0 + bj * 128) = w;
                    if (halo) *(u32x4*)(HALO + ((size_t)(row >> 5) * 2 + (r31 ? 1 : 0)) * NUP + col0 + bj * 128) = w;
                }
            }
    }
};
struct EpiDown {
    float* out; const float* mod; const bf16_t* AP; const float* nw2;
    __device__ __forceinline__ void operator()(AccRef acc, const Unit& u, int wr, int wc, int fr, int fq) const {
        const int b = u.pm >> 3; const float* mb = mod + b * 6144;
        const int row0 = u.pm * 256 + wr * 64 + fr, col0 = u.pn * 256 + wc * 32 + 8 * fq;
        f32x4 g2[2][2], rsw[2][2];
#pragma unroll
        for (int bj = 0; bj < 2; ++bj)
#pragma unroll
            for (int n = 0; n < 2; ++n) { const int c = col0 + bj * 128 + 4 * n; g2[bj][n] = *(const f32x4*)(mb + 5120 + c);
                const f32x4 sw = *(const f32x4*)(nw2 + c) * (*(const f32x4*)(mb + 4096 + c) + 1.f);
#pragma unroll
                for (int e = 0; e < 4; ++e) rsw[bj][n][e] = 1.f / sw[e]; }
        u32x4 av[2][2];
#pragma unroll
        for (int bj = 0; bj < 2; ++bj) av[0][bj] = *(const u32x4*)(AP + (size_t)row0 * 1024 + col0 + bj * 128);
#pragma unroll
        for (int it = 0; it < 8; ++it) {
            const int ai = it >> 2, m = it & 3, cur = it & 1, nx = cur ^ 1;
            const size_t off = (size_t)(row0 + ai * 128 + m * 16) * 1024 + col0;
            if (it < 7) { const size_t offn = (size_t)(row0 + ((it + 1) >> 2) * 128 + ((it + 1) & 3) * 16) * 1024 + col0;
#pragma unroll
                for (int bj = 0; bj < 2; ++bj) av[nx][bj] = *(const u32x4*)(AP + offn + bj * 128); }
#pragma unroll
            for (int bj = 0; bj < 2; ++bj)
#pragma unroll
                for (int n = 0; n < 2; ++n) { const unsigned w0 = av[cur][bj][2 * n], w1 = av[cur][bj][2 * n + 1];
                    const f32x4 ap = (f32x4){__uint_as_float(w0 << 16), __uint_as_float(w0 & 0xffff0000u), __uint_as_float(w1 << 16), __uint_as_float(w1 & 0xffff0000u)};
                    *(f32x4*)(out + off + bj * 128 + 4 * n) = ap * rsw[bj][n] + g2[bj][n] * acc[ai][bj][m][n]; }
        }
    }
};

__device__ __forceinline__ f32x4 mfma16(bf16x8 a, bf16x8 b, f32x4 c) { return __builtin_amdgcn_mfma_f32_16x16x32_bf16(a, b, c, 0, 0, 0); }

__device__ __forceinline__ void transpose_item(const float* W, int ldw, int col, int k0, bf16_t* WT, int dst_row, int dld, LAS float* scr, int lane) {
#pragma unroll 8
    for (int i = 0; i < 32; ++i) { const int kk = 2 * i + (lane >> 5); scr[kk * 33 + (lane & 31)] = W[(size_t)(k0 + kk) * ldw + col + (lane & 31)]; }
    asm volatile("s_waitcnt lgkmcnt(0)" ::: "memory");
    const int c = lane & 7;
#pragma unroll
    for (int j = 0; j < 4; ++j) { const int n = (lane >> 3) + 8 * j; const LAS float* s = scr + (8 * c) * 33 + n;
        u32x4 o; o.x = cvt_pk_bf16(s[0 * 33], s[1 * 33]); o.y = cvt_pk_bf16(s[2 * 33], s[3 * 33]); o.z = cvt_pk_bf16(s[4 * 33], s[5 * 33]); o.w = cvt_pk_bf16(s[6 * 33], s[7 * 33]);
        *(u32x4*)(WT + (size_t)(dst_row + n) * dld + k0 + 8 * c) = o; }
    asm volatile("s_waitcnt lgkmcnt(0)" ::: "memory");
}
__device__ __forceinline__ int headperm(int n0) { const int tile = n0 >> 8, l = n0 & 255; return tile * 256 + 128 * ((l >> 5) & 1) + 32 * (l >> 6); }

struct Args {
    const float *x, *c, *ctx, *c_ctx, *w_mod, *b_mod, *norm1_w, *w_in, *q_norm_w, *k_norm_w, *attn_sink, *ml_gate_b, *ml_norm_w,
        *w_branch_att, *w_branch_ml, *w_out, *norm2_w, *w_up, *conv_w, *conv_b, *w_down;
    float* out; unsigned char* ws; int ph_lo, ph_hi;
};

template <int NV, int KS, bool ATOMIC> __device__ __forceinline__ void gemv_task(const float* W, int ldw, int n0, int k0, const LAS float* svec, float* out, int ldo) {
    const int n = n0 + threadIdx.x; float a[NV];
#pragma unroll
    for (int v = 0; v < NV; ++v) a[v] = 0.f;
#pragma unroll 16
    for (int k = 0; k < KS; ++k) { const float w = W[(size_t)(k0 + k) * ldw + n];
#pragma unroll
        for (int v = 0; v < NV; ++v) a[v] += svec[v * KS + k] * w; }
#pragma unroll
    for (int v = 0; v < NV; ++v) { if (ATOMIC) atomicAdd(out + (size_t)v * ldo + n, a[v]); else out[(size_t)v * ldo + n] = a[v]; }
}

#define mod   ((float*)(wsb + WS_MOD))
#define modp  ((float*)(wsb + WS_MODP))
#define fbias ((float*)(wsb + WS_FB))
#define rowsq ((float*)(wsb + WS_RSQP))
#define fbp ((float*)(dob + DO_FBP))
#define cosT  ((float*)(wsb + WS_ROPE))
#define sinT  ((float*)(wsb + WS_ROPE) + 2048 * 32)
#define gates ((float*)(wsb + WS_GATES))
#define WBA ((bf16_t*)(wsb + WS_WBA))
#define WBM ((bf16_t*)(wsb + WS_WBM))
#define WO  ((bf16_t*)(wsb + WS_WO))
#define WUP ((bf16_t*)(wsb + WS_WUP))
#define WDN ((bf16_t*)(wsb + WS_WDN))
#define AQ  ((bf16_t*)(wsb + WS_AQ))
#ifdef DBG_ATTO
#define ATTO GA
#else
#define ATTO AQ
#endif
#define MQ  ((bf16_t*)(wsb + WS_MQ))
#define MK  ((bf16_t*)(wsb + WS_MK))
#define MO  ((bf16_t*)(wsb + WS_MO))
#define GA  ((bf16_t*)(wsb + WS_GA))
#define GM  ((bf16_t*)(wsb + WS_GM))
#define XT  ((bf16_t*)(wsb + WS_XT))
#define T1  ((bf16_t*)(wsb + WS_T1))
#define Y   ((bf16_t*)(wsb + WS_Y))
#define U   ((bf16_t*)(wsb + WS_U))
#define HALO ((bf16_t*)(wsb + WS_HALO))
#define H   ((bf16_t*)(dob + DO_H))
#define W1T ((bf16_t*)(dob + DO_W1T))
#define W2T ((bf16_t*)(dob + DO_W2T))
#define AK  ((bf16_t*)(dob + DO_AK))
#define HF  ((bf16_t*)(dob + DO_HF))
#define HB  ((bf16_t*)(dob + DO_HB))

#define XB_TMO      128
#define XB_XCNT(j)  (256  + 64 * (j))
#define XB_XSUB(j)  (1280 + 64 * (j))
#define XB_XGEN(j)  (2304 + 64 * (j))
#define XB_TOP      3328
#define XB_TOPGEN   3392
#define XCD_BAR_WORDS 3456
#define XB_SPIN_CAP (1u << 18)
__device__ __forceinline__ unsigned xb_ld(unsigned* p)              { return __hip_atomic_load(p, __ATOMIC_RELAXED, __HIP_MEMORY_SCOPE_AGENT); }
__device__ __forceinline__ unsigned xb_add(unsigned* p, unsigned v) { return __hip_atomic_fetch_add(p, v, __ATOMIC_RELAXED, __HIP_MEMORY_SCOPE_AGENT); }
__device__ __forceinline__ unsigned xb_xcc_id() { return (unsigned)__builtin_amdgcn_s_getreg((3 << 11) | 20) & 0xFu; }
#define XB_SPIN(cond, bar) do { unsigned _sp = 0; while (cond) { __builtin_amdgcn_s_sleep(1); \
    if ((++_sp & 255u) == 0u) { if (xb_ld(&(bar)[XB_TMO])) break; if (_sp > XB_SPIN_CAP) { atomicAdd(&(bar)[XB_TMO], 1u); break; } } } } while (0)
struct XcdBarrier { unsigned* bar; unsigned x; volatile LAS unsigned* st; };
__device__ __forceinline__ XcdBarrier xcd_barrier_post(unsigned* bar, volatile LAS unsigned* st) {
    XcdBarrier b; b.bar = bar; b.x = xb_xcc_id(); b.st = st;
    if (threadIdx.x == 0) (void)xb_add(&bar[XB_XCNT(b.x)], 1u);
    return b;
}
__device__ __forceinline__ void xcd_barrier_complete(unsigned* bar, unsigned x, unsigned& nloc, unsigned& nx) {
    const unsigned G = gridDim.x * gridDim.y * gridDim.z;
    unsigned sum, cnt, mine, sp = 0u;
    for (;;) {
        sum = 0u; cnt = 0u; mine = 0u;
#pragma unroll
        for (unsigned j = 0; j < 16; ++j) { const unsigned c = xb_ld(&bar[XB_XCNT(j)]); sum += c; cnt += (c > 0u) ? 1u : 0u; mine = (j == x) ? c : mine; }
        if (sum == G) break;
        __builtin_amdgcn_s_sleep(1);
        if ((++sp & 255u) == 0u) { if (xb_ld(&bar[XB_TMO])) break; if (sp > XB_SPIN_CAP) { atomicAdd(&bar[XB_TMO], 1u); break; } }
    }
    nloc = mine > 0u ? mine : 1u; nx = cnt > 0u ? cnt : 1u;
}
__device__ __forceinline__ void xcd_barrier(const XcdBarrier& b) {
    asm volatile("s_waitcnt vmcnt(0)" ::: "memory");
    __syncthreads();
    if (threadIdx.x == 0) {
        unsigned* bar = b.bar;
        __builtin_amdgcn_s_waitcnt(0);
        unsigned nloc = b.st[0], nx = b.st[1];
        if (nloc == 0u) { xcd_barrier_complete(bar, b.x, nloc, nx); b.st[0] = nloc; b.st[1] = nx; }
        const unsigned old = xb_add(&bar[XB_XSUB(b.x)], 1u);
        const unsigned gen = old / nloc;
        if (old + 1u == (gen + 1u) * nloc) {
            __builtin_amdgcn_fence(__ATOMIC_RELEASE, "agent");
            asm volatile("s_waitcnt vmcnt(0)" ::: "memory");
            const unsigned og = xb_add(&bar[XB_TOP], 1u);
            const unsigned tg = og / nx;
            if (og + 1u == (tg + 1u) * nx) xb_add(&bar[XB_TOPGEN], 1u);
            else XB_SPIN(xb_ld(&bar[XB_TOPGEN]) == tg, bar);
            __builtin_amdgcn_fence(__ATOMIC_ACQUIRE, "agent");
            xb_add(&bar[XB_XGEN(b.x)], 1u);
            asm volatile("s_waitcnt vmcnt(0)" ::: "memory");
        } else {
            XB_SPIN(xb_ld(&bar[XB_XGEN(b.x)]) == gen, bar);
            __builtin_amdgcn_fence(__ATOMIC_ACQUIRE, "agent");
            asm volatile("s_waitcnt vmcnt(0)" ::: "memory");
        }
    }
    __syncthreads();
}
constexpr size_t WS_BAR = 253 * MiB;
constexpr int LDS_ST_OFF = LDS_BYTES - 16;
#define A (*(const volatile __attribute__((address_space(4))) Args*)__builtin_amdgcn_kernarg_segment_ptr())
__global__ void __launch_bounds__(512, 2) fwd_kernel(Args Aparam) {
    extern __shared__ __attribute__((aligned(16))) unsigned char lds_raw[];
    LAS unsigned char* lds = (LAS unsigned char*)lds_raw;
    const int tid = threadIdx.x, lane = tid & 63, wave = __builtin_amdgcn_readfirstlane(tid >> 6);
    const int G = gridDim.x, bx = blockIdx.x;
    const int gw = bx * 8 + wave, NGW = G * 8;
    const int lo = A.ph_lo, hi = A.ph_hi; (void)lo; (void)hi;
#ifndef PHMASK
#define PHMASK 0x1fff
#endif
#if ONE_LAUNCH
#define IN(k) (((PHMASK >> (k)) & 1) && (k) < 11)
#else
#define IN(k) (((PHMASK >> (k)) & 1) && lo <= (k) && (k) < hi)
#endif
#if ONE_LAUNCH
    XcdBarrier xbar; xbar.bar = nullptr; xbar.x = 0; xbar.st = (volatile LAS unsigned*)(lds + LDS_ST_OFF);
#define SEAM(k) do { xcd_barrier(xbar); } while (0)
    {
        unsigned* const barw = (unsigned*)(A.ws + WS_BAR);
        if (tid < 4) ((LAS unsigned*)(lds + LDS_ST_OFF))[tid] = 0u;
        if (bx == 0) for (int i = tid; i < XCD_BAR_WORDS; i += 512) barw[i] = 0u;
        cg::this_grid().sync();
        xbar = xcd_barrier_post(barw, (volatile LAS unsigned*)(lds + LDS_ST_OFF));
    }
#else
#define SEAM(k) do { } while (0)
#endif

    for (int rep_ = 0; rep_ < (((RPT_MASK >> 0) & 1) ? 2 : 1); ++rep_) { if (rep_) { if (0 == 0) cg::this_grid().sync(); else xcd_barrier(xbar); }
    if (IN(0)) {
        unsigned char* const wsb = A.ws; unsigned char* const dob = (unsigned char*)A.out; (void)wsb; (void)dob;
        int tid_ph = threadIdx.x; asm volatile("" : "+v"(tid_ph)); const int tid = tid_ph; (void)tid;
        LAS float* svec = (LAS float*)(lds + 131072);
        for (int task = bx; task < 192; task += G) {
            const int cb = task % 12, ks = task / 12, k0 = ks * 64;
            __syncthreads();
            for (int i = tid; i < 576; i += 512) { const int v = i >> 6, k = i & 63; const float cv = v < 8 ? A.c[v * 1024 + k0 + k] : A.c_ctx[k0 + k]; svec[i] = cv / (1.f + __expf(-cv)); }
            __syncthreads();
            gemv_task<9, 64, false>(A.w_mod, 6144, cb * 512, k0, svec, modp + (size_t)ks * 9 * 6144, 6144);
        }
        LAS float* scr = (LAS float*)(lds + wave * 16384);
        constexpr int NITEMS = 9088;
        for (int it = gw; it < NITEMS; it += NGW) {
            int r = it; const float* W; int ldw, col0, ncols, K; bf16_t* dst; int hp = 0;
            if (r < 512) { W = A.w_in; ldw = INW; col0 = 0; ncols = 1024; K = 1024; dst = W1T + (size_t)3 * 256 * 1024; hp = 1; }
            else if ((r -= 512) < 128) { W = A.w_in; ldw = INW; col0 = 1024; ncols = 256; K = 1024; dst = W1T; hp = 1; }
            else if ((r -= 128) < 128) { W = A.w_in; ldw = INW; col0 = 1280; ncols = 256; K = 1024; dst = W2T; }
            else if ((r -= 128) < 256) { W = A.w_in; ldw = INW; col0 = 1536; ncols = 512; K = 1024; dst = W1T + (size_t)7 * 256 * 1024; }
            else if ((r -= 256) < 256) { W = A.w_in; ldw = INW; col0 = 2048; ncols = 512; K = 1024; dst = W1T + (size_t)1 * 256 * 1024; }
            else if ((r -= 256) < 512) { W = A.w_in; ldw = INW; col0 = 2560; ncols = 1024; K = 1024; dst = W2T + (size_t)256 * 1024; }
            else if ((r -= 512) < 512) { W = A.w_in; ldw = INW; col0 = 3584; ncols = 1024; K = 1024; dst = W1T + (size_t)9 * 256 * 1024; }
            else if ((r -= 512) < 512) { W = A.w_in; ldw = INW; col0 = 4624; ncols = 1024; K = 1024; dst = W1T + (size_t)13 * 256 * 1024; }
            else if ((r -= 512) < 512) { W = A.w_in; ldw = INW; col0 = 5648; ncols = 1024; K = 1024; dst = W1T + (size_t)17 * 256 * 1024; }
            else if ((r -= 512) < 512) { W = A.w_branch_att; ldw = 1024; col0 = 0; ncols = 1024; K = 1024; dst = WBA; }
            else if ((r -= 512) < 512) { W = A.w_branch_ml; ldw = 1024; col0 = 0; ncols = 1024; K = 1024; dst = WBM; }
            else if ((r -= 512) < 512) { W = A.w_out; ldw = 1024; col0 = 0; ncols = 1024; K = 1024; dst = WO; }
            else if ((r -= 512) < 2816) { W = A.w_up; ldw = NUP; col0 = 0; ncols = NUP; K = 1024; dst = WUP; }
            else { r -= 2816; W = A.w_down; ldw = 1024; col0 = 0; ncols = 1024; K = DFF; dst = WDN; }
            const int nblk = ncols / 32, kb = r / nblk, nb = r % nblk, n0 = nb * 32;
            transpose_item(W, ldw, col0 + n0, kb * 64, dst, hp ? headperm(n0) : n0, K, scr, lane);
        }
        for (int i = bx * 512 + tid; i < 2048 * 32; i += G * 512) {
            const int t = i >> 5, j = i & 31; const float pos = (j < 16) ? (float)(t >> 6) : (float)(t & 63);
            const float invf = exp2f(-(float)(j & 15) * (13.287712379549449f / 16.f)); const float ang = pos * invf;
            cosT[i] = cosf(ang); sinT[i] = sinf(ang);
        }
    }
    }
    SEAM(0);

    for (int rep_ = 0; rep_ < (((RPT_MASK >> 1) & 1) ? 2 : 1); ++rep_) { if (rep_) { if (1 == 0) cg::this_grid().sync(); else xcd_barrier(xbar); }
    if (IN(1)) {
        unsigned char* const wsb = A.ws; unsigned char* const dob = (unsigned char*)A.out; (void)wsb; (void)dob;
        int tid_ph = threadIdx.x; asm volatile("" : "+v"(tid_ph)); const int tid = tid_ph; (void)tid;
        constexpr int GP = 1028;
        LAS float* sWg = (LAS float*)lds;
        LAS float* hT = (LAS float*)(lds + 65792);
        LAS float* svm = (LAS float*)(lds + 131584);
        LAS float* part = (LAS float*)(lds + 147968);
        LAS float* svec = part;
        for (int k = tid; k < 1024; k += 512) { const float* src = A.w_in + (size_t)k * INW + 4608;
#pragma unroll
            for (int q = 0; q < 4; ++q) { const f32x4 v = *(const f32x4*)(src + 4 * q); sWg[(4 * q + 0) * GP + k] = v[0]; sWg[(4 * q + 1) * GP + k] = v[1]; sWg[(4 * q + 2) * GP + k] = v[2]; sWg[(4 * q + 3) * GP + k] = v[3]; } }
        const int rpb = (MT + G - 1) / G, rbeg = bx * rpb, rend = (rbeg + rpb < MT) ? rbeg + rpb : MT;
        const int vlo = rbeg < ML ? (rbeg >> 11) : 8;
        for (int i = tid; i < 4096; i += 512) { const int slot = i >> 11, k = i & 2047; int v = vlo + slot; if (v > 8) v = 8; float a = A.b_mod[k];
#pragma unroll
            for (int ks = 0; ks < 16; ++ks) a += modp[((size_t)ks * 9 + v) * 6144 + k];
            svm[i] = a; }
        for (int i = bx * 512 + tid; i < 9 * 6144; i += G * 512) { float a = A.b_mod[i % 6144];
#pragma unroll
            for (int ks = 0; ks < 16; ++ks) a += modp[(size_t)ks * 9 * 6144 + i];
            mod[i] = a; }
        __syncthreads();
        {
            const float* xin = A.x; const float* cin = A.ctx; const float* n1w = A.norm1_w; const float* gbias = A.ml_gate_b;
            const int r16 = lane & 15, quad = lane >> 4;
            const int ntile = (rend - rbeg + 15) >> 4;
            f32x4 xn[2][4];
#pragma unroll
            for (int t = 0; t < 2; ++t) { const int row = rbeg + wave + 8 * t; if (row < rend) { const float* xr = row < ML ? xin + (size_t)row * 1024 : cin + (size_t)(row - ML) * 1024;
#pragma unroll
                for (int j = 0; j < 4; ++j) xn[t][j] = *(const f32x4*)(xr + 4 * lane + 256 * j); } }
            for (int tile = 0; tile < ntile; ++tile) {
                const int trow = rbeg + 16 * tile;
#pragma unroll
                for (int t = 0; t < 2; ++t) {
                    const int r = wave + 8 * t, row = trow + r;
                    f32x4 hv[4]; float ss = 0.f;
#pragma unroll
                    for (int j = 0; j < 4; ++j) { hv[j] = xn[t][j]; const f32x4 q = hv[j] * hv[j]; ss += (q[0] + q[1]) + (q[2] + q[3]); }
                    { const int rn = row + 16; if (rn < rend) { const float* xr = rn < ML ? xin + (size_t)rn * 1024 : cin + (size_t)(rn - ML) * 1024;
#pragma unroll
                        for (int j = 0; j < 4; ++j) xn[t][j] = *(const f32x4*)(xr + 4 * lane + 256 * j); } }
                    if (row < rend) {
                        const int v = row < ML ? (row >> 11) : 8;
                        const LAS float* sh = svm + (v - vlo) * 2048; const LAS float* sc = sh + 1024;
                        const float rstd = rsqrtf(wave_sum(ss) * (1.f / 1024.f) + EPS);
                        bf16_t* ho = H + (size_t)row * 1024;
#pragma unroll
                        for (int j = 0; j < 4; ++j) { const int k = 4 * lane + 256 * j;
                            hv[j] = hv[j] * rstd * (*(const f32x4*)(n1w + k)) * (*(const LAS f32x4*)(sc + k) + 1.f) + *(const LAS f32x4*)(sh + k);
                            u32x2 w; w.x = cvt_pk_bf16(hv[j][0], hv[j][1]); w.y = cvt_pk_bf16(hv[j][2], hv[j][3]); *(u32x2*)(ho + k) = w;
                            *(LAS f32x4*)(hT + r * GP + k) = hv[j]; }
                    }
                }
                __syncthreads();
                { f32x4 acc = (f32x4){0.f, 0.f, 0.f, 0.f};
#pragma unroll
                  for (int kk = 0; kk < 8; ++kk) { const f32x4 a4 = *(const LAS f32x4*)(hT + r16 * GP + wave * 128 + kk * 16 + quad * 4), b4 = *(const LAS f32x4*)(sWg + r16 * GP + wave * 128 + kk * 16 + quad * 4);
#pragma unroll
                    for (int i = 0; i < 4; ++i) acc = __builtin_amdgcn_mfma_f32_16x16x4f32(a4[i], b4[i], acc, 0, 0, 0); }
#pragma unroll
                  for (int j = 0; j < 4; ++j) part[wave * 256 + (quad * 4 + j) * 16 + r16] = acc[j]; }
                __syncthreads();
                if (tid < 256) { const int r = tid >> 4, gidx = tid & 15, row = trow + r; float gv = gbias[gidx];
#pragma unroll
                    for (int w = 0; w < 8; ++w) gv += part[w * 256 + tid];
                    if (gidx & 4) gv = fminf(gv, 0.f) - log1pf(expf(-fabsf(gv)));
                    if (row < rend) gates[(size_t)row * 16 + gidx] = gv; }
            }
        }
        for (int task = bx; task < 176; task += G) {
            const int cb = task % 11, ks = task / 11, k0 = ks * 64;
            __syncthreads();
            { const int v = tid >> 6, k = 3072 + k0 + (tid & 63); float a = A.b_mod[k];
#pragma unroll
                for (int q = 0; q < 16; ++q) a += modp[((size_t)q * 9 + v) * 6144 + k];
                svec[tid] = a; }
            __syncthreads();
            gemv_task<8, 64, false>(A.w_up, NUP, cb * 512, k0, svec, fbp + (size_t)ks * 8 * NUP, NUP);
        }
    }
    }
    SEAM(1);

    for (int rep_ = 0; rep_ < (((RPT_MASK >> 2) & 1) ? 2 : 1); ++rep_) { if (rep_) { if (2 == 0) cg::this_grid().sync(); else xcd_barrier(xbar); }
    if (IN(2)) {
        unsigned char* const wsb = A.ws; unsigned char* const dob = (unsigned char*)A.out; (void)wsb; (void)dob;
        int tid_ph = threadIdx.x; asm volatile("" : "+v"(tid_ph)); const int tid = tid_ph; (void)tid;
        { pg8::Gemm g{H, W1T, 1024, 1024, 1024}; pg8::Order S; S.init(64, 21, G, bx, 24);
          EpiIn E{AK, MK, AQ, MQ, MO, GA, GM, A.q_norm_w, A.k_norm_w, cosT, sinT};
          pg8::gemm_phase<EpiIn, pg8::Order, true>(lds, g, S, E); }
        { pg8::Gemm g{W2T, H, 1024, 1024, 1024}; pg8::Order S; S.init(5, 72, G, (bx + G - (1368 % G)) % G, 0);
          EpiPlain E{XT, MT};
          pg8::gemm_phase<EpiPlain, pg8::Order, true>(lds, g, S, E); }
    }
    }
    SEAM(2);

    if (IN(3)) {
        unsigned char* const wsb = A.ws; unsigned char* const dob = (unsigned char*)A.out; (void)wsb; (void)dob;
        int tid_ph = threadIdx.x; asm volatile("" : "+v"(tid_ph)); const int tid = tid_ph; (void)tid;
        for (int i = bx * 512 + tid; i < 8 * NUP; i += G * 512) { float a = 0.f;
#pragma unroll
            for (int ks = 0; ks < 16; ++ks) a += fbp[(size_t)ks * 8 * NUP + i];
            fbias[i] = a; }
        const int r16 = lane & 15, quad = lane >> 4;
        const int rt = wave & 3, hp = wave >> 2;
        LAS bf16_t* sK = (LAS bf16_t*)lds;
        LAS bf16_t* sVT = sK + 64 * 72;
        bf16x8 qn[2][2];
#define AT_QLOAD(un_) do { const int qb_ = (un_) & 31, kvh_ = ((un_) >> 5) & 3, b_ = (un_) >> 7; \
            _Pragma("unroll") for (int g = 0; g < 2; ++g) _Pragma("unroll") for (int ks = 0; ks < 2; ++ks) \
                qn[g][ks] = *(const bf16x8*)(AQ + (size_t)(b_ * SEQ + qb_ * 64 + rt * 16 + r16) * 1024 + (kvh_ * 4 + hp * 2 + g) * 64 + ks * 32 + quad * 8); } while (0)
        if (bx < 1024) AT_QLOAD(bx);
        for (int unit = bx; unit < 1024; unit += G) {
            const int qb = unit & 31, kvh = (unit >> 5) & 3, b = unit >> 7;
            const int rowbase = b * SEQ, t0 = qb * 64;
            bf16x8 qf[2][2];
#pragma unroll
            for (int g = 0; g < 2; ++g)
#pragma unroll
                for (int ks = 0; ks < 2; ++ks) qf[g][ks] = qn[g][ks];
            if (unit + G < 1024) AT_QLOAD(unit + G);
            f32x4 o[2][4]; float mrow[2], lrow[2];
#pragma unroll
            for (int g = 0; g < 2; ++g) { mrow[g] = A.attn_sink[kvh * 4 + hp * 2 + g] * 1.4426950408889634f; lrow[g] = 1.f;
#pragma unroll
                for (int dt = 0; dt < 4; ++dt) o[g][dt] = (f32x4){0.f, 0.f, 0.f, 0.f}; }
            const int kb_lo = (qb < 2) ? 2 - qb : 0, kb_hi = (qb > 29) ? 33 - qb : 4;
            const bf16_t* const ak_ = AK; const bf16_t* const xt_ = XT; int tid3 = threadIdx.x; asm volatile("" : "+v"(tid3)); const int lr = tid3 >> 3, lc = tid3 & 7;
#define AT_KROW0(kb_) (((kb_) < 5) ? rowbase + (qb + (kb_) - 2) * 64 : ML + b * CTX + ((kb_) - 5) * 64)
            u32x4 pk, pv;
            { const int kr = AT_KROW0(kb_lo); pk = *(const u32x4*)(ak_ + (size_t)(kr + lr) * 256 + kvh * 64 + lc * 8); pv = *(const u32x4*)(xt_ + (size_t)(kvh * 64 + lr) * MT + kr + lc * 8); }
            for (int kb = kb_lo; kb < 9; kb = (kb == kb_hi) ? 5 : kb + 1) {
                const int mtype = (kb == 0) ? 1 : (kb == 4) ? 2 : 0;
                const int mlo = (mtype == 1) ? 0 : -4096, mhi = (mtype == 2) ? 0 : 4096, dl = quad * 4 - rt * 16 - r16;
                __syncthreads();
                *(LAS u32x4*)(sK + lr * 72 + lc * 8) = pk; *(LAS u32x4*)(sVT + lr * 72 + lc * 8) = pv;
                { const int kn = (kb == kb_hi) ? 5 : kb + 1;
                  if (kn < 9) { const int kr = AT_KROW0(kn); pk = *(const u32x4*)(ak_ + (size_t)(kr + lr) * 256 + kvh * 64 + lc * 8); pv = *(const u32x4*)(xt_ + (size_t)(kvh * 64 + lr) * MT + kr + lc * 8); } }
                __syncthreads();
                bf16x8 kf[4][2], vf[2][4];
#pragma unroll
                for (int tile = 0; tile < 4; ++tile)
#pragma unroll
                    for (int ks = 0; ks < 2; ++ks) kf[tile][ks] = *(const LAS bf16x8*)(sK + (tile * 16 + r16) * 72 + ks * 32 + quad * 8);
#pragma unroll
                for (int ks = 0; ks < 2; ++ks)
#pragma unroll
                    for (int dt = 0; dt < 4; ++dt) { const u32x2 lo = *(const LAS u32x2*)(sVT + (dt * 16 + r16) * 72 + ks * 32 + quad * 4), hi = *(const LAS u32x2*)(sVT + (dt * 16 + r16) * 72 + ks * 32 + 16 + quad * 4);
                        const u32x4 w = (u32x4){lo.x, lo.y, hi.x, hi.y}; vf[ks][dt] = __builtin_bit_cast(bf16x8, w); }
#define AT_HEAD(g, MASKED) do { \
                    f32x4 s[4]; \
                    _Pragma("unroll") for (int tile = 0; tile < 4; ++tile) { s[tile] = (f32x4){0.f, 0.f, 0.f, 0.f}; \
                        _Pragma("unroll") for (int ks = 0; ks < 2; ++ks) s[tile] = mfma16(kf[tile][ks], qf[g][ks], s[tile]); } \
                    float mx = -1e30f; \
                    _Pragma("unroll") for (int tile = 0; tile < 4; ++tile) _Pragma("unroll") for (int j = 0; j < 4; ++j) { float v = s[tile][j] * 0.18033688011112042f; \
                            if (MASKED) { const int dd = dl + (tile * 16 + j); const int bad = ((dd - mlo) | (mhi - dd)) >> 31; v += __int_as_float(bad & (int)0xF149F2CAu); } \
                            s[tile][j] = v; mx = fmaxf(mx, v); } \
                    mx = fmaxf(mx, __shfl_xor(mx, 16)); mx = fmaxf(mx, __shfl_xor(mx, 32)); \
                    const float mn = fmaxf(mrow[g], mx), alpha = __builtin_amdgcn_exp2f(mrow[g] - mn); mrow[g] = mn; float rs = 0.f; \
                    unsigned pw[4][2]; \
                    _Pragma("unroll") for (int tile = 0; tile < 4; ++tile) { f32x4 pe; \
                        _Pragma("unroll") for (int j = 0; j < 4; ++j) { pe[j] = __builtin_amdgcn_exp2f(s[tile][j] - mn); rs += pe[j]; } \
                        pw[tile][0] = cvt_pk_bf16(pe[0], pe[1]); pw[tile][1] = cvt_pk_bf16(pe[2], pe[3]); } \
                    rs += __shfl_xor(rs, 16); rs += __shfl_xor(rs, 32); \
                    lrow[g] = lrow[g] * alpha + rs; \
                    _Pragma("unroll") for (int dt = 0; dt < 4; ++dt) o[g][dt] = o[g][dt] * alpha; \
                    _Pragma("unroll") for (int ks = 0; ks < 2; ++ks) { const u32x4 w = (u32x4){pw[2 * ks][0], pw[2 * ks][1], pw[2 * ks + 1][0], pw[2 * ks + 1][1]}; const bf16x8 pf = __builtin_bit_cast(bf16x8, w); \
                        _Pragma("unroll") for (int dt = 0; dt < 4; ++dt) o[g][dt] = mfma16(vf[ks][dt], pf, o[g][dt]); } } while (0)
                if (mtype != 0) { AT_HEAD(0, true); __builtin_amdgcn_sched_barrier(0); AT_HEAD(1, true); } else { AT_HEAD(0, false); __builtin_amdgcn_sched_barrier(0); AT_HEAD(1, false); }
#undef AT_HEAD
            }
#pragma unroll
            for (int g = 0; g < 2; ++g) { const float inv = 1.f / lrow[g];
                bf16_t* p = ATTO + (size_t)(rowbase + t0 + rt * 16 + r16) * 1024 + (kvh * 4 + hp * 2 + g) * 64 + quad * 4;
#pragma unroll
                for (int dt = 0; dt < 4; ++dt) { u32x2 w; w.x = cvt_pk_bf16(o[g][dt][0] * inv, o[g][dt][1] * inv); w.y = cvt_pk_bf16(o[g][dt][2] * inv, o[g][dt][3] * inv); *(u32x2*)(p + dt * 16) = w; } }
        }
    }
    SEAM(3);

    for (int rep_ = 0; rep_ < (((RPT_MASK >> 4) & 1) ? 2 : 1); ++rep_) { if (rep_) { if (4 == 0) cg::this_grid().sync(); else xcd_barrier(xbar); }
    if (IN(4)) {
        unsigned char* const wsb = A.ws; unsigned char* const dob = (unsigned char*)A.out; (void)wsb; (void)dob;
        int tid_ph = threadIdx.x; asm volatile("" : "+v"(tid_ph)); const int tid = tid_ph; (void)tid;
        const int r16 = lane & 15, quad = lane >> 4;
        LAS bf16_t* sK = (LAS bf16_t*)lds;
        LAS bf16_t* sVT = sK + 128 * 136;
        LAS bf16_t* sS = sVT + 64 * 136;
        LAS bf16_t* sC = sS + 128 * 136;
        LAS float* sgb = (LAS float*)(sC + 80 * 136);
        LAS float *sga = sgb + 128, *sgw = sgb + 256, *sge = sgb + 384, *sgF = sgb + 512;
        const float scale = 0.08838834764831845f;
        for (int task = bx; task < 256; task += G) {
            const int vq = task & 3, dir = (task >> 2) & 1, hh = (task >> 3) & 3, b = task >> 5;
            __syncthreads();
            for (int i = tid; i < 80 * 136 / 2; i += 512) ((LAS unsigned*)sC)[i] = 0u;
            f32x4 cacc[4], nacc = (f32x4){0.f, 0.f, 0.f, 0.f};
#pragma unroll
            for (int vt = 0; vt < 4; ++vt) cacc[vt] = (f32x4){0.f, 0.f, 0.f, 0.f};
            bf16_t* Hout = (bf16_t*)(dob + (dir ? DO_HB : DO_HF)); const int sgn = dir ? 1 : -1;
            const bf16_t* const mk_ = MK; const bf16_t* const xt_ = XT; const bf16_t* const mq_ = MQ; const float* const gt_ = gates;
            u32x4 pK[4], pVT[2]; bf16x8 pQ[4]; float pG[4];
#define ML_TOK0(st) (((st) < 2) ? (ML + b * CTX + (dir ? 1 - (st) : (st)) * 128) : (b * SEQ + (dir ? 15 - ((st) - 2) : (st) - 2) * 128))
#define ML_PREFETCH(st) do { const int t0_ = ML_TOK0(st); \
                _Pragma("unroll") for (int q_ = 0; q_ < 4; ++q_) { const int i_ = tid + q_ * 512, r_ = i_ >> 4, c_ = i_ & 15; pK[q_] = *(const u32x4*)(mk_ + (size_t)(t0_ + r_) * 512 + hh * 128 + c_ * 8); } \
                if ((st) >= 2) { _Pragma("unroll") for (int ks_ = 0; ks_ < 4; ++ks_) pQ[ks_] = *(const bf16x8*)(mq_ + (size_t)(t0_ + wave * 16 + r16) * 512 + hh * 128 + ks_ * 32 + quad * 8); } \
                _Pragma("unroll") for (int q_ = 0; q_ < 2; ++q_) { const int i_ = tid + q_ * 512, r_ = i_ >> 4, c_ = i_ & 15; pVT[q_] = *(const u32x4*)(xt_ + (size_t)(256 + hh * 256 + vq * 64 + r_) * MT + t0_ + c_ * 8); } \
                if (wave == 0) { const float* gp_ = gt_ + (size_t)(t0_ + 2 * lane) * 16 + dir * 8 + hh; pG[0] = gp_[0]; pG[1] = gp_[4]; pG[2] = gp_[16]; pG[3] = gp_[20]; } } while (0)
            ML_PREFETCH(0);
            for (int step = 0; step < 18; ++step) {
                const bool isctx = step < 2; const int tok0 = ML_TOK0(step);
                __syncthreads();
#pragma unroll
                for (int q = 0; q < 4; ++q) { const int i = tid + q * 512, r = i >> 4, c = i & 15; *(LAS u32x4*)(sK + r * 136 + c * 8) = pK[q]; }
#pragma unroll
                for (int q = 0; q < 2; ++q) { const int i = tid + q * 512, r = i >> 4, c = i & 15; *(LAS u32x4*)(sVT + r * 136 + c * 8) = pVT[q]; }
                if (wave == 0) {
                    const float i0 = pG[0], f0 = pG[1], i1 = pG[2], f1 = pG[3];
                    const float loc = f0 + f1; float v = loc;
#pragma unroll
                    for (int off = 1; off < 64; off <<= 1) { const float t = __shfl_up(v, off); if (lane >= off) v += t; }
                    const float total = __shfl(v, 63); const float p0 = v - loc + f0, p1 = p0 + f1;
                    const float b0 = dir ? total - p0 + f0 : p0, b1 = dir ? total - p1 + f1 : p1;
                    const float cmid = 0.5f * total;
                    sgb[2 * lane] = __expf(fminf(b0 - cmid, 80.f)); sgb[2 * lane + 1] = __expf(fminf(b1 - cmid, 80.f));
                    sga[2 * lane] = __expf(fminf(i0 - b0 + cmid, 80.f)) * scale; sga[2 * lane + 1] = __expf(fminf(i1 - b1 + cmid, 80.f)) * scale;
                    sgw[2 * lane] = __expf(fminf(total - b0 + i0, 80.f)) * scale; sgw[2 * lane + 1] = __expf(fminf(total - b1 + i1, 80.f)) * scale;
                    sge[2 * lane] = __expf(b0); sge[2 * lane + 1] = __expf(b1); if (lane == 0) sgF[0] = __expf(total);
                }
                bf16x8 qf[4];
#pragma unroll
                for (int ks = 0; ks < 4; ++ks) qf[ks] = pQ[ks];
                if (step + 1 < 18) ML_PREFETCH(step + 1);
                __syncthreads();
                if (!isctx) {
                    const int prow = wave * 16 + r16;
                    f32x4 s[8];
#pragma unroll
                    for (int tile = 0; tile < 8; ++tile) { s[tile] = (f32x4){0.f, 0.f, 0.f, 0.f};
#pragma unroll
                        for (int ks = 0; ks < 4; ++ks) { const bf16x8 kf = *(const LAS bf16x8*)(sK + (tile * 16 + r16) * 136 + ks * 32 + quad * 8); s[tile] = mfma16(kf, qf[ks], s[tile]); } }
                    const float bp = sgb[prow]; float rs = 0.f;
#pragma unroll
                    for (int tile = 0; tile < 8; ++tile) { const f32x4 av = *(const LAS f32x4*)(sga + tile * 16 + quad * 4); f32x4 pe;
#pragma unroll
                        for (int j = 0; j < 4; ++j) { const int dd = (tile * 16 + quad * 4 + j - prow) * sgn;
                            pe[j] = __int_as_float(__float_as_int(s[tile][j] * (bp * av[j])) & ~(dd >> 31)); rs += pe[j]; }
                        u32x2 w; w.x = cvt_pk_bf16(pe[0], pe[1]); w.y = cvt_pk_bf16(pe[2], pe[3]);
                        *(LAS u32x2*)(sS + prow * 136 + tile * 16 + quad * 4) = w; }
                    rs += __shfl_xor(rs, 16); rs += __shfl_xor(rs, 32);
                    asm volatile("s_waitcnt lgkmcnt(0)" ::: "memory");
                    f32x4 a1[4], a2[5];
#pragma unroll
                    for (int vt = 0; vt < 4; ++vt) a1[vt] = (f32x4){0.f, 0.f, 0.f, 0.f};
#pragma unroll
                    for (int vt = 0; vt < 5; ++vt) a2[vt] = (f32x4){0.f, 0.f, 0.f, 0.f};
#pragma unroll
                    for (int ks = 0; ks < 4; ++ks) { const bf16x8 af = *(const LAS bf16x8*)(sS + prow * 136 + ks * 32 + quad * 8);
#pragma unroll
                        for (int vt = 0; vt < 4; ++vt) { const bf16x8 vf = *(const LAS bf16x8*)(sVT + (vt * 16 + r16) * 136 + ks * 32 + quad * 8); a1[vt] = mfma16(vf, af, a1[vt]); } }
#pragma unroll
                    for (int ks = 0; ks < 4; ++ks)
#pragma unroll
                        for (int vt = 0; vt < 5; ++vt) { const bf16x8 cf = *(const LAS bf16x8*)(sC + (vt * 16 + r16) * 136 + ks * 32 + quad * 8); a2[vt] = mfma16(cf, qf[ks], a2[vt]); }
                    const float e = sge[prow];
                    const float qn = __shfl(a2[4][0], r16); const float nq = rs + e * qn; const float inv = 1.f / fmaxf(fabsf(nq), 1.f);
                    bf16_t* hp = Hout + (size_t)(tok0 + prow) * 1024 + hh * 256 + vq * 64 + quad * 4;
#pragma unroll
                    for (int vt = 0; vt < 4; ++vt) { u32x2 w; w.x = cvt_pk_bf16((a1[vt][0] + e * a2[vt][0]) * inv, (a1[vt][1] + e * a2[vt][1]) * inv);
                        w.y = cvt_pk_bf16((a1[vt][2] + e * a2[vt][2]) * inv, (a1[vt][3] + e * a2[vt][3]) * inv); *(u32x2*)(hp + vt * 16) = w; }
                }
                __syncthreads();
                {
                    const float F = sgF[0];
#pragma unroll
                    for (int vt = 0; vt < 4; ++vt) cacc[vt] = cacc[vt] * F;
                    nacc = nacc * F;
                    bf16x8 ones; { const short o1 = (r16 == 0) ? (short)0x3F80 : (short)0;
#pragma unroll
                        for (int e = 0; e < 8; ++e) ones[e] = o1; }
#pragma unroll
                    for (int ks = 0; ks < 4; ++ks) {
                        const LAS bf16_t* kcol = sK + (ks * 32 + quad * 8) * 136 + wave * 16 + r16;
                        const f32x4 w0 = *(const LAS f32x4*)(sgw + ks * 32 + quad * 8), w1 = *(const LAS f32x4*)(sgw + ks * 32 + quad * 8 + 4);
                        f32x4 k0, k1;
#pragma unroll
                        for (int e = 0; e < 4; ++e) { k0[e] = bf2f(kcol[e * 136]) * w0[e]; k1[e] = bf2f(kcol[(4 + e) * 136]) * w1[e]; }
                        const u32x4 pk = pack8(k0, k1); const bf16x8 kts = __builtin_bit_cast(bf16x8, pk);
#pragma unroll
                        for (int vt = 0; vt < 4; ++vt) { const bf16x8 va = *(const LAS bf16x8*)(sVT + (vt * 16 + r16) * 136 + ks * 32 + quad * 8); cacc[vt] = mfma16(kts, va, cacc[vt]); }
                        nacc = mfma16(kts, ones, nacc);
                    }
#pragma unroll
                    for (int vt = 0; vt < 4; ++vt) { u32x2 w; w.x = cvt_pk_bf16(cacc[vt][0], cacc[vt][1]); w.y = cvt_pk_bf16(cacc[vt][2], cacc[vt][3]);
                        *(LAS u32x2*)(sC + (vt * 16 + r16) * 136 + wave * 16 + quad * 4) = w; }
                    if (r16 == 0) { u32x2 w; w.x = cvt_pk_bf16(nacc[0], nacc[1]); w.y = cvt_pk_bf16(nacc[2], nacc[3]); *(LAS u32x2*)(sC + 64 * 136 + wave * 16 + quad * 4) = w; }
                }
            }
        }
    }
    }
    SEAM(4);

    if (IN(5)) {
        unsigned char* const wsb = A.ws; unsigned char* const dob = (unsigned char*)A.out; (void)wsb; (void)dob;
        int tid_ph = threadIdx.x; asm volatile("" : "+v"(tid_ph)); const int tid = tid_ph; (void)tid;
        for (int row = gw; row < ML; row += NGW) {
            const size_t off = (size_t)row * 1024 + lane * 16;
            float ht[16], mo[16];
#pragma unroll
            for (int q = 0; q < 2; ++q) { const u32x4 a = *(const u32x4*)(HF + off + q * 8), c = *(const u32x4*)(HB + off + q * 8), d = *(const u32x4*)(MO + off + q * 8);
#pragma unroll
                for (int e = 0; e < 4; ++e) { ht[q * 8 + 2 * e] = __uint_as_float(a[e] << 16) + __uint_as_float(c[e] << 16); ht[q * 8 + 2 * e + 1] = __uint_as_float(a[e] & 0xffff0000u) + __uint_as_float(c[e] & 0xffff0000u);
                    mo[q * 8 + 2 * e] = __uint_as_float(d[e] << 16); mo[q * 8 + 2 * e + 1] = __uint_as_float(d[e] & 0xffff0000u); } }
            float ss = 0.f;
#pragma unroll
            for (int e = 0; e < 16; ++e) ss += ht[e] * ht[e];
            ss += __shfl_xor(ss, 1); ss += __shfl_xor(ss, 2); ss += __shfl_xor(ss, 4); ss += __shfl_xor(ss, 8);
            const float rs = rsqrtf(ss * (1.f / 256.f) + EPS);
            float r[16];
#pragma unroll
            for (int q = 0; q < 4; ++q) { const f32x4 w = *(const f32x4*)(A.ml_norm_w + lane * 16 + q * 4);
#pragma unroll
                for (int e = 0; e < 4; ++e) r[q * 4 + e] = ht[q * 4 + e] * rs * w[e] * sigmoidf_(mo[q * 4 + e]); }
#pragma unroll
            for (int q = 0; q < 2; ++q) { u32x4 w; w.x = cvt_pk_bf16(r[q * 8 + 0], r[q * 8 + 1]); w.y = cvt_pk_bf16(r[q * 8 + 2], r[q * 8 + 3]); w.z = cvt_pk_bf16(r[q * 8 + 4], r[q * 8 + 5]); w.w = cvt_pk_bf16(r[q * 8 + 6], r[q * 8 + 7]);
                *(u32x4*)(MO + off + q * 8) = w; }
        }
    }
    SEAM(5);

    for (int rep_ = 0; rep_ < (((RPT_MASK >> 6) & 1) ? 2 : 1); ++rep_) { if (rep_) { if (6 == 0) cg::this_grid().sync(); else xcd_barrier(xbar); }
    if (IN(6)) {
        unsigned char* const wsb = A.ws; unsigned char* const dob = (unsigned char*)A.out; (void)wsb; (void)dob;
        int tid_ph = threadIdx.x; asm volatile("" : "+v"(tid_ph)); const int tid = tid_ph; (void)tid;
        pg8::Order S; S.init(64, 4, G, bx, 0);
        { pg8::Gemm g{AQ, WBA, 1024, 1024, 1024, MO, WBM}; EpiMerge E{GA, GM, Y}; pg8::gemm_phase<EpiMerge, pg8::Order, false, true>(lds, g, S, E); }
    }
    }
    SEAM(6);

    for (int rep_ = 0; rep_ < (((RPT_MASK >> 7) & 1) ? 2 : 1); ++rep_) { if (rep_) { if (7 == 0) cg::this_grid().sync(); else xcd_barrier(xbar); }
    if (IN(7)) {
        unsigned char* const wsb = A.ws; unsigned char* const dob = (unsigned char*)A.out; (void)wsb; (void)dob;
        int tid_ph = threadIdx.x; asm volatile("" : "+v"(tid_ph)); const int tid = tid_ph; (void)tid;
        pg8::Order S; S.init(64, 4, G, bx, 0);
#ifdef DBG_P7PLAIN
        pg8::Gemm g{Y, WO, 1024, 1024, 1024}; EpiPlain E{T1, 1024};
        pg8::gemm_phase<EpiPlain, pg8::Order, false>(lds, g, S, E);
#else
        pg8::Gemm g{Y, WO, 1024, 1024, 1024}; EpiOut E{A.x, mod, A.norm2_w, (float*)dob, AQ, rowsq};
        pg8::gemm_phase<EpiOut, pg8::Order, false>(lds, g, S, E);
#endif
    }
    }
    SEAM(7);

    for (int rep_ = 0; rep_ < (((RPT_MASK >> 8) & 1) ? 2 : 1); ++rep_) { if (rep_) { if (8 == 0) cg::this_grid().sync(); else xcd_barrier(xbar); }
    if (IN(8)) {
        unsigned char* const wsb = A.ws; unsigned char* const dob = (unsigned char*)A.out; (void)wsb; (void)dob;
        int tid_ph = threadIdx.x; asm volatile("" : "+v"(tid_ph)); const int tid = tid_ph; (void)tid;
        pg8::Order S; S.init(64, 22, G, bx, 0);
        pg8::Gemm g{AQ, WUP, 1024, 1024, 1024}; EpiUp E{rowsq, fbias, U, HALO};
        pg8::gemm_phase<EpiUp, pg8::Order, true>(lds, g, S, E);
    }
    }
    SEAM(8);

    if (IN(9)) {
        unsigned char* const wsb = A.ws; unsigned char* const dob = (unsigned char*)A.out; (void)wsb; (void)dob;
        int tid_ph = threadIdx.x; asm volatile("" : "+v"(tid_ph)); const int tid = tid_ph; (void)tid;
        const float* cw = A.conv_w; const float* cb = A.conv_b;
        LAS u32x4* shalo = (LAS u32x4*)lds;
        for (int rp = bx; rp < 256; rp += G) {
            const u32x4 zero = (u32x4){0u, 0u, 0u, 0u};
#pragma unroll 1
            for (int k = 0; k < 3; ++k) { const int t = tid + 512 * k;
                if (t < 1408) { const int ch = t % 352, hf = t / 352, run = 2 * rp + (hf >> 1), half = hf & 1, r0 = run * 32 + 16 * half, c0 = ch * 8;
                    const bf16_t* pp = nullptr; const bf16_t* pe = nullptr;
                    if (half == 0) { if ((r0 & 2047) != 0) pp = HALO + ((size_t)(run - 1) * 2 + 1) * NUP + c0; pe = U + (size_t)(r0 + 16) * NUP + c0; }
                    else { pp = U + (size_t)(r0 - 1) * NUP + c0; if (((r0 + 16) & 2047) != 0) pe = HALO + ((size_t)(run + 1) * 2) * NUP + c0; }
                    u32x4 v0 = zero, v1 = zero, v2 = zero, v3 = zero;
                    if (pp) { v0 = *(const u32x4*)pp; v1 = *(const u32x4*)(pp + DFF); }
                    if (pe) { v2 = *(const u32x4*)pe; v3 = *(const u32x4*)(pe + DFF); }
                    shalo[(k * 4 + 0) * 512 + tid] = v0; shalo[(k * 4 + 1) * 512 + tid] = v1; shalo[(k * 4 + 2) * 512 + tid] = v2; shalo[(k * 4 + 3) * 512 + tid] = v3; } }
            __syncthreads();
#pragma unroll 1
            for (int k = 0; k < 3; ++k) { const int t = tid + 512 * k;
                if (t < 1408) { const int ch = t % 352, hf = t / 352, run = 2 * rp + (hf >> 1), half = hf & 1, r0 = run * 32 + 16 * half, c0 = ch * 8;
                    float wa[3][8], wg[3][8], ba[8], bg[8];
#pragma unroll
                    for (int i = 0; i < 3; ++i)
#pragma unroll
                        for (int q = 0; q < 2; ++q) { const f32x4 a = *(const f32x4*)(cw + i * NUP + c0 + 4 * q), g = *(const f32x4*)(cw + i * NUP + DFF + c0 + 4 * q);
#pragma unroll
                            for (int e = 0; e < 4; ++e) { wa[i][4 * q + e] = a[e]; wg[i][4 * q + e] = g[e]; } }
#pragma unroll
                    for (int q = 0; q < 2; ++q) { const f32x4 a = *(const f32x4*)(cb + c0 + 4 * q), g = *(const f32x4*)(cb + DFF + c0 + 4 * q);
#pragma unroll
                        for (int e = 0; e < 4; ++e) { ba[4 * q + e] = a[e]; bg[4 * q + e] = g[e]; } }
                    u32x4 pa = shalo[(k * 4 + 0) * 512 + tid], pg = shalo[(k * 4 + 1) * 512 + tid], ca, cg_;
                    const u32x4 ea = shalo[(k * 4 + 2) * 512 + tid], eg = shalo[(k * 4 + 3) * 512 + tid];
                    bf16_t* up = U + (size_t)r0 * NUP + c0;
                    ca = *(const u32x4*)up; cg_ = *(const u32x4*)(up + DFF);
                    for (int i0 = 0; i0 < 16; i0 += 4) {
                        u32x4 na[4], ng[4];
#pragma unroll
                        for (int q = 0; q < 4; ++q) { if (i0 + q < 15) { na[q] = *(const u32x4*)(up + (size_t)(q + 1) * NUP); ng[q] = *(const u32x4*)(up + (size_t)(q + 1) * NUP + DFF); } else { na[q] = ea; ng[q] = eg; } }
#pragma unroll
                        for (int q = 0; q < 4; ++q) {
                            float r[8];
#pragma unroll
                            for (int e = 0; e < 8; ++e) {
                                const int w = e >> 1; const bool hi16 = e & 1;
                                const float a0 = hi16 ? __uint_as_float(pa[w] & 0xffff0000u) : __uint_as_float(pa[w] << 16);
                                const float a1 = hi16 ? __uint_as_float(ca[w] & 0xffff0000u) : __uint_as_float(ca[w] << 16);
                                const float a2 = hi16 ? __uint_as_float(na[q][w] & 0xffff0000u) : __uint_as_float(na[q][w] << 16);
                                const float g0 = hi16 ? __uint_as_float(pg[w] & 0xffff0000u) : __uint_as_float(pg[w] << 16);
                                const float g1 = hi16 ? __uint_as_float(cg_[w] & 0xffff0000u) : __uint_as_float(cg_[w] << 16);
                                const float g2 = hi16 ? __uint_as_float(ng[q][w] & 0xffff0000u) : __uint_as_float(ng[q][w] << 16);
                                const float av = ba[e] + wa[0][e] * a0 + wa[1][e] * a1 + wa[2][e] * a2;
                                const float gv = bg[e] + wg[0][e] * g0 + wg[1][e] * g1 + wg[2][e] * g2;
                                r[e] = gv * sigmoidf_(gv) * av;
                            }
                            u32x4 w; w.x = cvt_pk_bf16(r[0], r[1]); w.y = cvt_pk_bf16(r[2], r[3]); w.z = cvt_pk_bf16(r[4], r[5]); w.w = cvt_pk_bf16(r[6], r[7]);
                            *(u32x4*)(up + (size_t)q * NUP) = w;
                            pa = ca; pg = cg_; ca = na[q]; cg_ = ng[q];
                        }
                        up += 4 * NUP;
                    }
                } }
            __syncthreads();
        }
    }
    SEAM(9);

    if (IN(10)) {
        unsigned char* const wsb = A.ws; unsigned char* const dob = (unsigned char*)A.out; (void)wsb; (void)dob;
        int tid_ph = threadIdx.x; asm volatile("" : "+v"(tid_ph)); const int tid = tid_ph; (void)tid;
        pg8::Order S; S.init(64, 4, G, bx, 0);
        pg8::Gemm g{U, WDN, NUP, DFF, DFF}; EpiDown E{(float*)dob, mod, AQ, A.norm2_w};
        pg8::gemm_phase<EpiDown, pg8::Order, false>(lds, g, S, E);
    }
#undef IN
#undef SEAM
}
#undef A

extern "C" void kernel_launch(void* const* d_in, const int* in_sizes, int n_in, void* d_out, int out_size, void* d_ws, size_t ws_size, hipStream_t stream) {
    static int grid = 0;
    if (grid == 0) {
        if (n_in != 21 || out_size != ML * D || ws_size < WS_END) { fprintf(stderr, "kernel_launch: unexpected shapes (n_in %d out %d ws %zu)\n", n_in, out_size, ws_size); grid = -1; return; }
        int dev = 0, cus = 0, per_cu = 0;
        hipGetDevice(&dev); hipDeviceGetAttribute(&cus, hipDeviceAttributeMultiprocessorCount, dev);
        hipFuncSetAttribute((const void*)fwd_kernel, hipFuncAttributeMaxDynamicSharedMemorySize, LDS_BYTES);
        hipOccupancyMaxActiveBlocksPerMultiprocessor(&per_cu, (const void*)fwd_kernel, 512, LDS_BYTES);
        if (per_cu < 1) { fprintf(stderr, "kernel_launch: occupancy query says %d blocks per CU\n", per_cu); per_cu = 1; }
        grid = cus * per_cu;
        (void)hipGetLastError();
    }
    if (grid < 0) return;
    Args a{};
    const float** pp = (const float**)&a;
    for (int i = 0; i < 21; ++i) pp[i] = (const float*)d_in[i];
    a.out = (float*)d_out; a.ws = (unsigned char*)d_ws;
#if ONE_LAUNCH
    a.ph_lo = 0; a.ph_hi = 11;
    void* args[] = {&a};
    hipError_t e = hipLaunchCooperativeKernel((const void*)fwd_kernel, dim3(grid), dim3(512), args, LDS_BYTES, stream);
    if (e != hipSuccess) fprintf(stderr, "cooperative launch failed: %s (grid %d)\n", hipGetErrorString(e), grid);
#else
    for (int p = 0; p < 11; ++p) { a.ph_lo = p; a.ph_hi = p + 1; hipLaunchKernelGGL(fwd_kernel, dim3(grid), dim3(512), LDS_BYTES, stream, a); }

#endif
}
```

```cpp
#include <hip/hip_runtime.h>
#include <hip/hip_cooperative_groups.h>
#include <cstdio>
#include <cstdint>
namespace cg = cooperative_groups;

#ifndef RPT_MASK
#define RPT_MASK 0
#endif
#ifndef ONE_LAUNCH
#define ONE_LAUNCH 1
#endif

#define LAS __attribute__((address_space(3)))
typedef unsigned short bf16_t;
typedef short bf16x8 __attribute__((ext_vector_type(8)));
typedef float f32x4 __attribute__((ext_vector_type(4)));
typedef unsigned u32x4 __attribute__((ext_vector_type(4)));
typedef unsigned u32x2 __attribute__((ext_vector_type(2)));

constexpr int D = 1024, NB = 8, SEQ = 2048, CTX = 256;
constexpr int ML = NB * SEQ;
constexpr int MC = NB * CTX;
constexpr int MT = ML + MC;
constexpr int DFF = 2816, NUP = 2 * DFF, INW = 6672;
constexpr float EPS = 1e-6f;
constexpr size_t MiB = 1u << 20;
constexpr size_t WS_ZERO = 0;
constexpr size_t WS_MOD = 0, WS_FB = 256 * 1024, WS_RSQ = 512 * 1024;
constexpr size_t WS_MODP = 236 * MiB + 12 * MiB;
constexpr size_t WS_RSQP = 252 * MiB;
constexpr size_t DO_FBP = 60 * MiB;
constexpr size_t WS_ROPE = 1 * MiB;
constexpr size_t WS_GATES = 2 * MiB;
constexpr size_t WS_WBA = 4 * MiB, WS_WBM = 6 * MiB, WS_WO = 8 * MiB, WS_WUP = 10 * MiB, WS_WDN = 21 * MiB;
constexpr size_t WS_AQ = 27 * MiB;
constexpr size_t WS_MQ = 59 * MiB, WS_MK = 75 * MiB  , WS_MO = 93 * MiB, WS_GA = 125 * MiB, WS_GM = 157 * MiB, WS_XT = 189 * MiB  ;
constexpr size_t WS_T1 = 59 * MiB, WS_Y = 189 * MiB;
constexpr size_t WS_U = 59 * MiB;
constexpr size_t WS_HALO = 236 * MiB;
constexpr size_t WS_ACT = 59 * MiB;
constexpr size_t WS_RAW = 147 * MiB;
constexpr size_t WS_END = 256 * MiB;
constexpr size_t DO_H = 0, DO_W1T = 36 * MiB, DO_W2T = 47 * MiB, DO_AK = 51 * MiB;
constexpr size_t DO_HF = 0, DO_HB = 32 * MiB;
constexpr int LDS_BYTES = 157696;

typedef float f32x2_t __attribute__((ext_vector_type(2))); typedef __bf16 bf16x2_t __attribute__((ext_vector_type(2)));
__device__ __forceinline__ unsigned cvt_pk_bf16(float lo, float hi) { f32x2_t v = {lo, hi}; bf16x2_t b = __builtin_convertvector(v, bf16x2_t); return __builtin_bit_cast(unsigned, b); }
__device__ __forceinline__ float bf2f(unsigned short v) { return __uint_as_float((unsigned)v << 16); }
__device__ __forceinline__ bf16_t f2bf(float f) { return (bf16_t)(cvt_pk_bf16(f, 0.f) & 0xffffu); }
__device__ __forceinline__ u32x4 pack8(f32x4 a, f32x4 b) { u32x4 w; w.x = cvt_pk_bf16(a[0], a[1]); w.y = cvt_pk_bf16(a[2], a[3]); w.z = cvt_pk_bf16(b[0], b[1]); w.w = cvt_pk_bf16(b[2], b[3]); return w; }
__device__ __forceinline__ float sigmoidf_(float x) { return 1.f / (1.f + __expf(-x)); }
__device__ __forceinline__ float wave_sum(float v) {
#pragma unroll
    for (int o = 1; o < 64; o <<= 1) v += __shfl_xor(v, o);
    return v;
}

namespace pg8 {
constexpr int BM = 256, BK = 64, HALF = 128, HTB = HALF * BK * 2, STAGE_BYTES = 8 * HTB, NXCD = 8, WGM = 8;
__host__ __device__ __forceinline__ int lds_byte(int r, int c) { const int st = (r >> 4) * 2 + (c >> 5), rr = r & 15, cc = c & 31, ob = rr * 64 + cc * 2; return st * 1024 + (ob ^ (((ob >> 9) & 1) << 5)); }
__host__ __device__ __forceinline__ void stage_rc(int b, int& R, int& C) { const int st = b / 1024, sb = b % 1024, swz = sb ^ (((sb >> 9) & 1) << 5); R = (st >> 1) * 16 + swz / 64; C = (st & 1) * 32 + (swz % 64) / 2; }
__host__ __device__ __forceinline__ int perm32(int rho) { const int n = rho >> 4, i = rho & 15; return 8 * (i >> 2) + 4 * n + (i & 3); }

struct Unit { int pm, pn; };
struct Gemm { const bf16_t* A; const bf16_t* Bt; int lda, ldb, K; const bf16_t* A2 = nullptr; const bf16_t* Bt2 = nullptr; };

struct Order {
    int nM, nN, nwg, G, c, extra;
    __device__ __forceinline__ void init(int nM_, int nN_, int G_, int c_, int extra_) { nM = nM_; nN = nN_; nwg = nM_ * nN_; G = G_; c = c_; extra = extra_; }
    __device__ __forceinline__ bool next(int i, Unit& u) const {
        const long Lq = (long)i * G + c; if (Lq >= nwg + extra) return false;
        if (Lq >= nwg) { const int e = (int)(Lq - nwg); u.pm = nM + e / 3; u.pn = e % 3; return true; }
        int wgid = (int)Lq; { const int q = nwg / NXCD, r = nwg % NXCD, xcd = wgid % NXCD, off = wgid / NXCD; wgid = (xcd < r ? xcd * (q + 1) : r * (q + 1) + (xcd - r) * q) + off; }
        const int nig = WGM * nN, gid = wgid / nig, fm = gid * WGM, gsz = (nM - fm) < WGM ? (nM - fm) : WGM;
        u.pm = fm + ((wgid % nig) % gsz); u.pn = (wgid % nig) / gsz; return true;
    }
};

template <class Epi, class Sched, bool ALIGN_EPI, bool DUAL = false>
__device__ __forceinline__ void gemm_phase(LAS unsigned char* lds, const Gemm g, const Sched& S, const Epi& E) {
    int tid_ = threadIdx.x; asm volatile("" : "+v"(tid_));
    const int tid = tid_, wid = __builtin_amdgcn_readfirstlane(tid >> 6), lane = tid & 63, wr = wid >> 2, wc = wid & 3, fr = lane & 15, fq = lane >> 4;
    const int K = g.K, nt1 = K / BK, nt = DUAL ? 2 * nt1 : nt1;
    unsigned voffA[2], voffB[2];
#pragma unroll
    for (int i = 0; i < 2; ++i) { int R, C; stage_rc(tid * 16 + i * 8192, R, C); const int Rb = ((R & ~31) + perm32(R & 31));
        voffA[i] = (unsigned)(R * g.lda + C) * 2u; voffB[i] = (unsigned)(Rb * g.ldb + C) * 2u; }
    const size_t kstep = (size_t)(BK * 2);
    const size_t hstepA = (size_t)HALF * g.lda * 2, hstepB = (size_t)HALF * g.ldb * 2;
    const size_t tstepA = 2 * hstepA, tstepB = 2 * hstepB;
    const unsigned ldsw = (unsigned)wid * 1024u;
    const int aoff = lds_byte(wr * 64 + fr, fq * 8), boff = lds_byte(wc * 32 + fr, fq * 8);
#define PG8_SA(b, h) (((b) * 2 + (h)) * HTB)
#define PG8_SB(b, h) ((4 + (b) * 2 + (h)) * HTB)
#define PG8_STAGE(bufoff, gbase, voff) do { _Pragma("unroll") for (int _i = 0; _i < 2; ++_i) \
        __builtin_amdgcn_global_load_lds((const unsigned*)((const char*)(gbase) + (voff)[_i]), (LAS unsigned*)(lds + (bufoff) + ldsw + _i * 8192), 16, 0, 0); } while (0)
#define PG8_LDA(dst, b, h) do { _Pragma("unroll") for (int m = 0; m < 4; ++m) _Pragma("unroll") for (int k = 0; k < 2; ++k) dst[m][k] = *(const LAS bf16x8*)(lds + PG8_SA(b, h) + aoff + m * 2048 + k * 1024); } while (0)
#define PG8_LDB(dst, b, h) do { _Pragma("unroll") for (int n = 0; n < 2; ++n) _Pragma("unroll") for (int k = 0; k < 2; ++k) dst[n][k] = *(const LAS bf16x8*)(lds + PG8_SB(b, h) + boff + n * 2048 + k * 1024); } while (0)
#define PG8_MMA(ai, bj, At, Bt) do { __builtin_amdgcn_s_setprio(1); _Pragma("unroll") for (int m = 0; m < 4; ++m) _Pragma("unroll") for (int n = 0; n < 2; ++n) _Pragma("unroll") for (int k = 0; k < 2; ++k) \
        acc[ai][bj][m][n] = __builtin_amdgcn_mfma_f32_16x16x32_bf16(Bt[n][k], At[m][k], acc[ai][bj][m][n], 0, 0, 0); __builtin_amdgcn_s_setprio(0); } while (0)
#define PG8_WAIT_V(n) asm volatile("s_waitcnt vmcnt(" #n ")" ::: "memory")
#define PG8_WAIT_L(n) asm volatile("s_waitcnt lgkmcnt(" #n ")" ::: "memory")
#define PG8_BAR __builtin_amdgcn_s_barrier()
#define PG8_SCHED __builtin_amdgcn_sched_barrier(0)
    Unit cur, nxt; int ui = 0;
    if (!S.next(0, cur)) return;
    f32x4 acc[2][2][4][2];
#pragma unroll
    for (int a = 0; a < 2; ++a)
#pragma unroll
        for (int b = 0; b < 2; ++b)
#pragma unroll
            for (int m = 0; m < 4; ++m)
#pragma unroll
                for (int n = 0; n < 2; ++n) acc[a][b][m][n] = (f32x4){0.f, 0.f, 0.f, 0.f};
    bf16x8 At[4][2], B0[2][2], B1[2][2];
    const char* cA = (const char*)g.A + (size_t)cur.pm * tstepA; const char* cB = (const char*)g.Bt + (size_t)cur.pn * tstepB;
    const char* cA2 = DUAL ? (const char*)g.A2 + (size_t)cur.pm * tstepA : cA; const char* cB2 = DUAL ? (const char*)g.Bt2 + (size_t)cur.pn * tstepB : cB;
    PG8_STAGE(PG8_SB(0, 0), cB, voffB); PG8_STAGE(PG8_SB(0, 1), cB + hstepB, voffB); PG8_STAGE(PG8_SA(0, 0), cA, voffA); PG8_STAGE(PG8_SA(0, 1), cA + hstepA, voffA);
    if (wr == 1) PG8_BAR;
    PG8_WAIT_V(2); PG8_BAR;
    PG8_STAGE(PG8_SB(1, 0), cB + kstep, voffB); PG8_STAGE(PG8_SA(1, 0), cA + kstep, voffA); PG8_STAGE(PG8_SB(1, 1), cB + hstepB + kstep, voffB);
    PG8_WAIT_V(6); PG8_BAR;
    for (;;) {
        const bool has_next = S.next(ui + 1, nxt);
        const char* nA = has_next ? (const char*)g.A + (size_t)nxt.pm * tstepA : cA; const char* nB = has_next ? (const char*)g.Bt + (size_t)nxt.pn * tstepB : cB;
        for (int t = 0; t < nt; t += 2) {
            const bool last = (t == nt - 2);
            const bool seg2 = DUAL && t >= nt1, seg2n = DUAL && t + 2 >= nt1;
            const char* a1 = seg2 ? cA2 + (size_t)(t + 1 - nt1) * kstep : cA + (size_t)(t + 1) * kstep;
            const char* a2 = last ? nA : (seg2n ? cA2 + (size_t)(t + 2 - nt1) * kstep : cA + (size_t)(t + 2) * kstep);
            const char* b2 = last ? nB : (seg2n ? cB2 + (size_t)(t + 2 - nt1) * kstep : cB + (size_t)(t + 2) * kstep);
            if constexpr (DUAL) { if (t == nt1) E.mid(acc, cur, wr, wc, fr, fq); }
            const char* a3 = a2 + kstep; const char* b3 = b2 + kstep;
            PG8_LDB(B0, 0, 0); PG8_LDB(B1, 0, 1); PG8_SCHED; PG8_LDA(At, 0, 0); PG8_STAGE(PG8_SA(1, 1), a1 + hstepA, voffA);
            PG8_WAIT_V(8); PG8_WAIT_L(0); PG8_BAR; PG8_MMA(0, 0, At, B0); PG8_MMA(0, 1, At, B1); PG8_BAR; PG8_SCHED;
            PG8_LDA(At, 0, 1); PG8_STAGE(PG8_SB(0, 0), b2, voffB); PG8_STAGE(PG8_SB(0, 1), b2 + hstepB, voffB); PG8_STAGE(PG8_SA(0, 0), a2, voffA);
            PG8_WAIT_V(8); PG8_WAIT_L(0); PG8_BAR; PG8_MMA(1, 0, At, B0); PG8_MMA(1, 1, At, B1); PG8_BAR; PG8_SCHED;
            PG8_LDB(B0, 1, 0); PG8_LDB(B1, 1, 1); PG8_SCHED; PG8_LDA(At, 1, 0); PG8_STAGE(PG8_SA(0, 1), a2 + hstepA, voffA);
            PG8_WAIT_V(8); PG8_WAIT_L(0); PG8_BAR; PG8_MMA(0, 0, At, B0); PG8_MMA(0, 1, At, B1); PG8_BAR; PG8_SCHED;
            PG8_LDA(At, 1, 1); PG8_STAGE(PG8_SB(1, 0), b3, voffB); PG8_STAGE(PG8_SB(1, 1), b3 + hstepB, voffB); PG8_STAGE(PG8_SA(1, 0), a3, voffA);
            PG8_WAIT_V(8); PG8_WAIT_L(0); PG8_BAR; PG8_MMA(1, 0, At, B0); PG8_MMA(1, 1, At, B1); PG8_BAR; PG8_SCHED;
        }
        if constexpr (ALIGN_EPI) { if (wr == 0) PG8_BAR; }
        E(acc, cur, wr, wc, fr, fq);
        if (!has_next) break;
#pragma unroll
        for (int a = 0; a < 2; ++a)
#pragma unroll
            for (int b = 0; b < 2; ++b)
#pragma unroll
                for (int m = 0; m < 4; ++m)
#pragma unroll
                    for (int n = 0; n < 2; ++n) acc[a][b][m][n] = (f32x4){0.f, 0.f, 0.f, 0.f};
        cur = nxt; cA = nA; cB = nB; ++ui;
        if constexpr (DUAL) { cA2 = (const char*)g.A2 + (size_t)cur.pm * tstepA; cB2 = (const char*)g.Bt2 + (size_t)cur.pn * tstepB; }
        if constexpr (ALIGN_EPI) { if (wr == 1) PG8_BAR; }
    }
    PG8_WAIT_V(0);
    if constexpr (!ALIGN_EPI) { if (wr == 0) PG8_BAR; }
    PG8_BAR;
#undef PG8_SA
#undef PG8_SB
#undef PG8_STAGE
#undef PG8_LDA
#undef PG8_LDB
#undef PG8_MMA
#undef PG8_WAIT_V
#undef PG8_WAIT_L
#undef PG8_BAR
#undef PG8_SCHED
}
}
using pg8::Unit;
typedef const f32x4 (&AccRef)[2][2][4][2];

struct EpiIn {
    bf16_t *AK_, *MK_, *AQ_, *MQ_, *MO_, *GA_, *GM_; const float *qnw, *knw, *cosT_, *sinT_;
    __device__ __forceinline__ void head_path(AccRef acc, const Unit& u, int wr, int wc, int fr, int fq_in, bf16_t* base, int ld, int coff, const float* nw) const {
        int fq = fq_in; asm volatile("" : "+v"(fq));
        const int row0 = u.pm * 256 + wr * 64 + fr;
        const bool rope = u.pm < 64;
#pragma unroll
        for (int ai = 0; ai < 2; ++ai)
#pragma unroll
            for (int m = 0; m < 4; ++m) {
                const int row = row0 + ai * 128 + m * 16;
                f32x4 v00 = acc[ai][0][m][0], v01 = acc[ai][0][m][1], v10 = acc[ai][1][m][0], v11 = acc[ai][1][m][1];
                f32x4 q = v00 * v00 + v01 * v01 + v10 * v10 + v11 * v11;
                float ss = (q[0] + q[1]) + (q[2] + q[3]);
                ss += __shfl_xor(ss, 16); ss += __shfl_xor(ss, 32);
                const float rs = rsqrtf(ss * (1.f / 64.f) + EPS);
                v00 = v00 * rs * *(const f32x4*)(nw + 8 * fq); v01 = v01 * rs * *(const f32x4*)(nw + 8 * fq + 4); v10 = v10 * rs * *(const f32x4*)(nw + 32 + 8 * fq); v11 = v11 * rs * *(const f32x4*)(nw + 32 + 8 * fq + 4);
                f32x4 o00 = v00, o01 = v01, o10 = v10, o11 = v11;
                if (rope) {
                    const int t = row & 2047;
                    const f32x4 c0 = *(const f32x4*)(cosT_ + t * 32 + 8 * fq), c1 = *(const f32x4*)(cosT_ + t * 32 + 8 * fq + 4);
                    const f32x4 s0 = *(const f32x4*)(sinT_ + t * 32 + 8 * fq), s1 = *(const f32x4*)(sinT_ + t * 32 + 8 * fq + 4);
                    o00 = v00 * c0 - v10 * s0; o01 = v01 * c1 - v11 * s1; o10 = v00 * s0 + v10 * c0; o11 = v01 * s1 + v11 * c1;
                }
                bf16_t* p = base + (size_t)row * ld + coff + wc * 64 + 8 * fq;
                *(u32x4*)p = pack8(o00, o01); *(u32x4*)(p + 32) = pack8(o10, o11);
                asm volatile("" ::: "memory");
            }
    }
    template <bool SIG> __device__ __forceinline__ void plain_path(AccRef acc, const Unit& u, int wr, int wc, int fr, int fq, bf16_t* base, int ld, int coff) const {
        const int row0 = u.pm * 256 + wr * 64 + fr;
#pragma unroll
        for (int ai = 0; ai < 2; ++ai)
#pragma unroll
            for (int m = 0; m < 4; ++m) {
                bf16_t* p = base + (size_t)(row0 + ai * 128 + m * 16) * ld + coff + wc * 32 + 8 * fq;
#pragma unroll
                for (int bj = 0; bj < 2; ++bj) { f32x4 v0 = acc[ai][bj][m][0], v1 = acc[ai][bj][m][1];
                    if (SIG) {
#pragma unroll
                        for (int e = 0; e < 4; ++e) { v0[e] = sigmoidf_(v0[e]); v1[e] = sigmoidf_(v1[e]); } }
                    *(u32x4*)(p + bj * 128) = pack8(v0, v1); }
            }
    }
    __device__ __forceinline__ void operator()(AccRef acc, const Unit& u, int wr, int wc, int fr, int fq) const {
        const int pn = u.pn;
        if (pn == 0) head_path(acc, u, wr, wc, fr, fq, AK_, 256, 0, knw);
        else if (pn <= 2) plain_path<false>(acc, u, wr, wc, fr, fq, MK_, 512, (pn - 1) * 256);
        else if (pn <= 6) head_path(acc, u, wr, wc, fr, fq, AQ_, 1024, (pn - 3) * 256, qnw);
        else if (pn <= 8) plain_path<false>(acc, u, wr, wc, fr, fq, MQ_, 512, (pn - 7) * 256);
        else if (pn <= 12) plain_path<false>(acc, u, wr, wc, fr, fq, MO_, 1024, (pn - 9) * 256);
        else if (pn <= 16) plain_path<true>(acc, u, wr, wc, fr, fq, GA_, 1024, (pn - 13) * 256);
        else plain_path<true>(acc, u, wr, wc, fr, fq, GM_, 1024, (pn - 17) * 256);
    }
};
struct EpiPlain {
    bf16_t* O; int ldc;
    __device__ __forceinline__ void operator()(AccRef acc, const Unit& u, int wr, int wc, int fr, int fq) const {
        const int row0 = u.pm * 256 + wr * 64 + fr;
#pragma unroll
        for (int ai = 0; ai < 2; ++ai)
#pragma unroll
            for (int m = 0; m < 4; ++m) {
                bf16_t* p = O + (size_t)(row0 + ai * 128 + m * 16) * ldc + u.pn * 256 + wc * 32 + 8 * fq;
#pragma unroll
                for (int bj = 0; bj < 2; ++bj) *(u32x4*)(p + bj * 128) = pack8(acc[ai][bj][m][0], acc[ai][bj][m][1]);
            }
    }
};
template <bool ADD> struct EpiGate {
    const bf16_t* Gt; const bf16_t* T; bf16_t* O;
    __device__ __forceinline__ void operator()(AccRef acc, const Unit& u, int wr, int wc, int fr, int fq) const {
        const int row0 = u.pm * 256 + wr * 64 + fr;
        const size_t off0 = (size_t)row0 * 1024 + u.pn * 256 + wc * 32 + 8 * fq;
        u32x4 gv[2][2], tv[2][2];
#pragma unroll
        for (int bj = 0; bj < 2; ++bj) { gv[0][bj] = *(const u32x4*)(Gt + off0 + bj * 128); tv[0][bj] = (u32x4){0u, 0u, 0u, 0u}; if (ADD) tv[0][bj] = *(const u32x4*)(T + off0 + bj * 128); }
#pragma unroll
        for (int it = 0; it < 8; ++it) {
            const int ai = it >> 2, m = it & 3, cur = it & 1, nx = cur ^ 1;
            const size_t off = off0 + (size_t)(ai * 128 + m * 16) * 1024;
            if (it < 7) { const size_t offn = off0 + (size_t)(((it + 1) >> 2) * 128 + ((it + 1) & 3) * 16) * 1024;
#pragma unroll
                for (int bj = 0; bj < 2; ++bj) { gv[nx][bj] = *(const u32x4*)(Gt + offn + bj * 128); tv[nx][bj] = (u32x4){0u, 0u, 0u, 0u}; if (ADD) tv[nx][bj] = *(const u32x4*)(T + offn + bj * 128); } }
#pragma unroll
            for (int bj = 0; bj < 2; ++bj) {
                float r[8];
#pragma unroll
                for (int e = 0; e < 8; ++e) {
                    const unsigned gw = gv[cur][bj][e >> 1], tw = tv[cur][bj][e >> 1];
                    const float gg = (e & 1) ? __uint_as_float(gw & 0xffff0000u) : __uint_as_float(gw << 16);
                    const float tt = (e & 1) ? __uint_as_float(tw & 0xffff0000u) : __uint_as_float(tw << 16);
                    r[e] = tt + sigmoidf_(gg) * acc[ai][bj][m][e >> 2][e & 3];
                }
                u32x4 w; w.x = cvt_pk_bf16(r[0], r[1]); w.y = cvt_pk_bf16(r[2], r[3]); w.z = cvt_pk_bf16(r[4], r[5]); w.w = cvt_pk_bf16(r[6], r[7]);
                *(u32x4*)(O + off + bj * 128) = w;
            }
        }
    }
};
struct EpiMerge {
    const bf16_t* Sa; const bf16_t* Sm; bf16_t* O;
    __device__ __forceinline__ void mid(f32x4 (&acc)[2][2][4][2], const Unit& u, int wr, int wc, int fr, int fq) const {
        const size_t off0 = (size_t)(u.pm * 256 + wr * 64 + fr) * 1024 + u.pn * 256 + wc * 32 + 8 * fq;
        u32x4 av[2][2], mv[2][2];
#pragma unroll
        for (int bj = 0; bj < 2; ++bj) { av[0][bj] = *(const u32x4*)(Sa + off0 + bj * 128); mv[0][bj] = *(const u32x4*)(Sm + off0 + bj * 128); }
#pragma unroll
        for (int it = 0; it < 8; ++it) {
            const int ai = it >> 2, m = it & 3, cur = it & 1, nx = cur ^ 1;
            if (it < 7) { const size_t offn = off0 + (size_t)(((it + 1) >> 2) * 128 + ((it + 1) & 3) * 16) * 1024;
#pragma unroll
                for (int bj = 0; bj < 2; ++bj) { av[nx][bj] = *(const u32x4*)(Sa + offn + bj * 128); mv[nx][bj] = *(const u32x4*)(Sm + offn + bj * 128); } }
#pragma unroll
            for (int bj = 0; bj < 2; ++bj)
#pragma unroll
                for (int e = 0; e < 8; ++e) {
                    const unsigned aw = av[cur][bj][e >> 1], mw = mv[cur][bj][e >> 1];
                    const float sa = (e & 1) ? __uint_as_float(aw & 0xffff0000u) : __uint_as_float(aw << 16);
                    const float sm = (e & 1) ? __uint_as_float(mw & 0xffff0000u) : __uint_as_float(mw << 16);
                    acc[ai][bj][m][e >> 2][e & 3] *= sa * __builtin_amdgcn_rcpf(fmaxf(sm, 1e-30f));
                }
        }
    }
    __device__ __forceinline__ void operator()(AccRef acc, const Unit& u, int wr, int wc, int fr, int fq) const {
        const size_t off0 = (size_t)(u.pm * 256 + wr * 64 + fr) * 1024 + u.pn * 256 + wc * 32 + 8 * fq;
        u32x4 mv[2][2];
#pragma unroll
        for (int bj = 0; bj < 2; ++bj) mv[0][bj] = *(const u32x4*)(Sm + off0 + bj * 128);
#pragma unroll
        for (int it = 0; it < 8; ++it) {
            const int ai = it >> 2, m = it & 3, cur = it & 1, nx = cur ^ 1;
            const size_t off = off0 + (size_t)(ai * 128 + m * 16) * 1024;
            if (it < 7) { const size_t offn = off0 + (size_t)(((it + 1) >> 2) * 128 + ((it + 1) & 3) * 16) * 1024;
#pragma unroll
                for (int bj = 0; bj < 2; ++bj) mv[nx][bj] = *(const u32x4*)(Sm + offn + bj * 128); }
#pragma unroll
            for (int bj = 0; bj < 2; ++bj) { float r[8];
#pragma unroll
                for (int e = 0; e < 8; ++e) { const unsigned mw = mv[cur][bj][e >> 1];
                    const float sm = (e & 1) ? __uint_as_float(mw & 0xffff0000u) : __uint_as_float(mw << 16);
                    r[e] = fmaxf(sm, 1e-30f) * acc[ai][bj][m][e >> 2][e & 3]; }
                u32x4 w; w.x = cvt_pk_bf16(r[0], r[1]); w.y = cvt_pk_bf16(r[2], r[3]); w.z = cvt_pk_bf16(r[4], r[5]); w.w = cvt_pk_bf16(r[6], r[7]);
                *(u32x4*)(O + off + bj * 128) = w; }
        }
    }
};
struct EpiOut {
    const float* x; const float* mod; const float* nw2; float* xmid; bf16_t* AP; float* rowsq;
    __device__ __forceinline__ void operator()(AccRef acc, const Unit& u, int wr, int wc, int fr, int fq) const {
        const int b = u.pm >> 3; const float* mb = mod + b * 6144;
        const int row0 = u.pm * 256 + wr * 64 + fr, col0 = u.pn * 256 + wc * 32 + 8 * fq;
        f32x4 g1[2][2], sw[2][2];
#pragma unroll
        for (int bj = 0; bj < 2; ++bj)
#pragma unroll
            for (int n = 0; n < 2; ++n) { const int c = col0 + bj * 128 + 4 * n; g1[bj][n] = *(const f32x4*)(mb + 2048 + c);
                sw[bj][n] = *(const f32x4*)(nw2 + c) * (*(const f32x4*)(mb + 4096 + c) + 1.f); }
        f32x4 xv[2][2][2];
#pragma unroll
        for (int bj = 0; bj < 2; ++bj)
#pragma unroll
            for (int n = 0; n < 2; ++n) xv[0][bj][n] = *(const f32x4*)(x + (size_t)row0 * 1024 + col0 + bj * 128 + 4 * n);
#pragma unroll
        for (int it = 0; it < 8; ++it) {
            const int ai = it >> 2, m = it & 3, cur = it & 1, nx = cur ^ 1;
            const int row = row0 + ai * 128 + m * 16; const size_t off = (size_t)row * 1024 + col0; float ss = 0.f;
            if (it < 7) { const size_t offn = (size_t)(row0 + ((it + 1) >> 2) * 128 + ((it + 1) & 3) * 16) * 1024 + col0;
#pragma unroll
                for (int bj = 0; bj < 2; ++bj)
#pragma unroll
                    for (int n = 0; n < 2; ++n) xv[nx][bj][n] = *(const f32x4*)(x + offn + bj * 128 + 4 * n); }
#pragma unroll
            for (int bj = 0; bj < 2; ++bj) {
                f32x4 v[2];
#pragma unroll
                for (int n = 0; n < 2; ++n) { v[n] = xv[cur][bj][n] + g1[bj][n] * acc[ai][bj][m][n];
                    const f32x4 q = v[n] * v[n]; ss += (q[0] + q[1]) + (q[2] + q[3]); }
                *(u32x4*)(AP + off + bj * 128) = pack8(v[0] * sw[bj][0], v[1] * sw[bj][1]);
            }
            ss += __shfl_xor(ss, 16); ss += __shfl_xor(ss, 32);
            if (fq == 0) rowsq[(size_t)row * 16 + u.pn * 4 + wc] = ss;
        }
    }
};
__device__ __forceinline__ float dpp_prev(float v) { return __int_as_float(__builtin_amdgcn_update_dpp(0, __float_as_int(v), 0x111, 0xf, 0xf, true)); }
__device__ __forceinline__ float dpp_next(float v) { return __int_as_float(__builtin_amdgcn_update_dpp(0, __float_as_int(v), 0x101, 0xf, 0xf, true)); }
struct EpiUp {
    const float* rowsq; const float* fb; const float* cw; const float* cb; bf16_t* ACT_; bf16_t* RAW_; LAS float* sp;
    __device__ __forceinline__ void operator()(AccRef acc, const Unit& u, int wr, int wc, int fr, int fq) const {
        const int b = u.pm >> 3; const int row0 = u.pm * 256 + wr * 64 + fr;
        for (int i = threadIdx.x; i < 1280; i += 512) { const int vec = i >> 7, j = u.pn * 128 + (i & 127);
            const float* src = vec == 0 ? fb + b * NUP + j : vec == 1 ? fb + b * NUP + DFF + j : vec < 5 ? cw + (vec - 2) * NUP + j : vec < 8 ? cw + (vec - 5) * NUP + DFF + j : vec == 8 ? cb + j : cb + DFF + j;
            sp[i] = *src; }
        asm volatile("s_waitcnt vmcnt(0) lgkmcnt(0)" ::: "memory"); __builtin_amdgcn_s_barrier(); asm volatile("" ::: "memory");
        const LAS float* spc = sp + wc * 32 + 8 * fq;
        const int jb = u.pn * 128 + wc * 32 + 8 * fq;
        const int pcol = u.pn * 256 + wc * 32 + 8 * fq;
        const bool interior = (fr >= 1) && (fr <= 14), rawrow = !((fr >= 2) && (fr <= 13));
        const int slot = fr < 2 ? fr : fr - 12;
#pragma unroll
        for (int ai = 0; ai < 2; ++ai)
#pragma unroll
            for (int m = 0; m < 4; ++m) {
                const int row = row0 + ai * 128 + m * 16; const f32x4 q0 = *(const f32x4*)(rowsq + (size_t)row * 16), q1 = *(const f32x4*)(rowsq + (size_t)row * 16 + 4), q2 = *(const f32x4*)(rowsq + (size_t)row * 16 + 8), q3 = *(const f32x4*)(rowsq + (size_t)row * 16 + 12);
                const f32x4 qs = (q0 + q1) + (q2 + q3); const float rstd = rsqrtf(((qs[0] + qs[1]) + (qs[2] + qs[3])) * (1.f / 1024.f) + EPS);
                float r[8]; f32x4 ua[2], ug[2];
#pragma unroll
                for (int n = 0; n < 2; ++n) {
                    ua[n] = acc[ai][0][m][n] * rstd + *(const LAS f32x4*)(spc + 0 * 128 + 4 * n);
                    ug[n] = acc[ai][1][m][n] * rstd + *(const LAS f32x4*)(spc + 1 * 128 + 4 * n);
                    const f32x4 wa0 = *(const LAS f32x4*)(spc + 2 * 128 + 4 * n), wa1 = *(const LAS f32x4*)(spc + 3 * 128 + 4 * n), wa2 = *(const LAS f32x4*)(spc + 4 * 128 + 4 * n);
                    const f32x4 wg0 = *(const LAS f32x4*)(spc + 5 * 128 + 4 * n), wg1 = *(const LAS f32x4*)(spc + 6 * 128 + 4 * n), wg2 = *(const LAS f32x4*)(spc + 7 * 128 + 4 * n);
                    const f32x4 ba = *(const LAS f32x4*)(spc + 8 * 128 + 4 * n), bg = *(const LAS f32x4*)(spc + 9 * 128 + 4 * n);
#pragma unroll
                    for (int e = 0; e < 4; ++e) {
                        const float av = ba[e] + wa0[e] * dpp_prev(ua[n][e]) + wa1[e] * ua[n][e] + wa2[e] * dpp_next(ua[n][e]);
                        const float gv = bg[e] + wg0[e] * dpp_prev(ug[n][e]) + wg1[e] * ug[n][e] + wg2[e] * dpp_next(ug[n][e]);
                        r[4 * n + e] = gv * sigmoidf_(gv) * av;
                    }
                }
                if (interior) { u32x4 w; w.x = cvt_pk_bf16(r[0], r[1]); w.y = cvt_pk_bf16(r[2], r[3]); w.z = cvt_pk_bf16(r[4], r[5]); w.w = cvt_pk_bf16(r[6], r[7]);
                    *(u32x4*)(ACT_ + (size_t)row * DFF + jb) = w; }
                if (rawrow) { bf16_t* rp = RAW_ + ((size_t)(row >> 4) * 4 + slot) * NUP + pcol;
                    *(u32x4*)rp = pack8(ua[0], ua[1]); *(u32x4*)(rp + 128) = pack8(ug[0], ug[1]); }
                asm volatile("" ::: "memory");
            }
    }
};
struct EpiDown {
    float* out; const float* mod; const bf16_t* AP; const float* nw2;
    __device__ __forceinline__ void operator()(AccRef acc, const Unit& u, int wr, int wc, int fr, int fq) const {
        const int b = u.pm >> 3; const float* mb = mod + b * 6144;
        const int row0 = u.pm * 256 + wr * 64 + fr, col0 = u.pn * 256 + wc * 32 + 8 * fq;
        f32x4 g2[2][2], rsw[2][2];
#pragma unroll
        for (int bj = 0; bj < 2; ++bj)
#pragma unroll
            for (int n = 0; n < 2; ++n) { const int c = col0 + bj * 128 + 4 * n; g2[bj][n] = *(const f32x4*)(mb + 5120 + c);
                const f32x4 sw = *(const f32x4*)(nw2 + c) * (*(const f32x4*)(mb + 4096 + c) + 1.f);
#pragma unroll
                for (int e = 0; e < 4; ++e) rsw[bj][n][e] = 1.f / sw[e]; }
        u32x4 av[2][2];
#pragma unroll
        for (int bj = 0; bj < 2; ++bj) av[0][bj] = *(const u32x4*)(AP + (size_t)row0 * 1024 + col0 + bj * 128);
#pragma unroll
        for (int it = 0; it < 8; ++it) {
            const int ai = it >> 2, m = it & 3, cur = it & 1, nx = cur ^ 1;
            const size_t off = (size_t)(row0 + ai * 128 + m * 16) * 1024 + col0;
            if (it < 7) { const size_t offn = (size_t)(row0 + ((it + 1) >> 2) * 128 + ((it + 1) & 3) * 16) * 1024 + col0;
#pragma unroll
                for (int bj = 0; bj < 2; ++bj) av[nx][bj] = *(const u32x4*)(AP + offn + bj * 128); }
#pragma unroll
            for (int bj = 0; bj < 2; ++bj)
#pragma unroll
                for (int n = 0; n < 2; ++n) { const unsigned w0 = av[cur][bj][2 * n], w1 = av[cur][bj][2 * n + 1];
                    const f32x4 ap = (f32x4){__uint_as_float(w0 << 16), __uint_as_float(w0 & 0xffff0000u), __uint_as_float(w1 << 16), __uint_as_float(w1 & 0xffff0000u)};
                    *(f32x4*)(out + off + bj * 128 + 4 * n) = ap * rsw[bj][n] + g2[bj][n] * acc[ai][bj][m][n]; }
        }
    }
};

__device__ __forceinline__ f32x4 mfma16(bf16x8 a, bf16x8 b, f32x4 c) { return __builtin_amdgcn_mfma_f32_16x16x32_bf16(a, b, c, 0, 0, 0); }

__device__ __forceinline__ void transpose_item(const float* W, int ldw, int col, int k0, bf16_t* WT, int dst_row, int dld, LAS float* scr, int lane) {
#pragma unroll 8
    for (int i = 0; i < 32; ++i) { const int kk = 2 * i + (lane >> 5); scr[kk * 33 + (lane & 31)] = W[(size_t)(k0 + kk) * ldw + col + (lane & 31)]; }
    asm volatile("s_waitcnt lgkmcnt(0)" ::: "memory");
    const int c = lane & 7;
#pragma unroll
    for (int j = 0; j < 4; ++j) { const int n = (lane >> 3) + 8 * j; const LAS float* s = scr + (8 * c) * 33 + n;
        u32x4 o; o.x = cvt_pk_bf16(s[0 * 33], s[1 * 33]); o.y = cvt_pk_bf16(s[2 * 33], s[3 * 33]); o.z = cvt_pk_bf16(s[4 * 33], s[5 * 33]); o.w = cvt_pk_bf16(s[6 * 33], s[7 * 33]);
        *(u32x4*)(WT + (size_t)(dst_row + n) * dld + k0 + 8 * c) = o; }
    asm volatile("s_waitcnt lgkmcnt(0)" ::: "memory");
}
__device__ __forceinline__ int headperm(int n0) { const int tile = n0 >> 8, l = n0 & 255; return tile * 256 + 128 * ((l >> 5) & 1) + 32 * (l >> 6); }

struct Args {
    const float *x, *c, *ctx, *c_ctx, *w_mod, *b_mod, *norm1_w, *w_in, *q_norm_w, *k_norm_w, *attn_sink, *ml_gate_b, *ml_norm_w,
        *w_branch_att, *w_branch_ml, *w_out, *norm2_w, *w_up, *conv_w, *conv_b, *w_down;
    float* out; unsigned char* ws; int ph_lo, ph_hi;
};

template <int NV, int KS, bool ATOMIC> __device__ __forceinline__ void gemv_task(const float* W, int ldw, int n0, int k0, const LAS float* svec, float* out, int ldo) {
    const int n = n0 + threadIdx.x; float a[NV];
#pragma unroll
    for (int v = 0; v < NV; ++v) a[v] = 0.f;
#pragma unroll 16
    for (int k = 0; k < KS; ++k) { const float w = W[(size_t)(k0 + k) * ldw + n];
#pragma unroll
        for (int v = 0; v < NV; ++v) a[v] += svec[v * KS + k] * w; }
#pragma unroll
    for (int v = 0; v < NV; ++v) { if (ATOMIC) atomicAdd(out + (size_t)v * ldo + n, a[v]); else out[(size_t)v * ldo + n] = a[v]; }
}

#define mod   ((float*)(wsb + WS_MOD))
#define modp  ((float*)(wsb + WS_MODP))
#define fbias ((float*)(wsb + WS_FB))
#define rowsq ((float*)(wsb + WS_RSQP))
#define fbp ((float*)(dob + DO_FBP))
#define cosT  ((float*)(wsb + WS_ROPE))
#define sinT  ((float*)(wsb + WS_ROPE) + 2048 * 32)
#define gates ((float*)(wsb + WS_GATES))
#define WBA ((bf16_t*)(wsb + WS_WBA))
#define WBM ((bf16_t*)(wsb + WS_WBM))
#define WO  ((bf16_t*)(wsb + WS_WO))
#define WUP ((bf16_t*)(wsb + WS_WUP))
#define WDN ((bf16_t*)(wsb + WS_WDN))
#define AQ  ((bf16_t*)(wsb + WS_AQ))
#ifdef DBG_ATTO
#define ATTO GA
#else
#define ATTO AQ
#endif
#define MQ  ((bf16_t*)(wsb + WS_MQ))
#define MK  ((bf16_t*)(wsb + WS_MK))
#define MO  ((bf16_t*)(wsb + WS_MO))
#define GA  ((bf16_t*)(wsb + WS_GA))
#define GM  ((bf16_t*)(wsb + WS_GM))
#define XT  ((bf16_t*)(wsb + WS_XT))
#define T1  ((bf16_t*)(wsb + WS_T1))
#define Y   ((bf16_t*)(wsb + WS_Y))
#define U   ((bf16_t*)(wsb + WS_U))
#define HALO ((bf16_t*)(wsb + WS_HALO))
#define ACT ((bf16_t*)(wsb + WS_ACT))
#define RAWU ((bf16_t*)(wsb + WS_RAW))
#define H   ((bf16_t*)(dob + DO_H))
#define W1T ((bf16_t*)(dob + DO_W1T))
#define W2T ((bf16_t*)(dob + DO_W2T))
#define AK  ((bf16_t*)(dob + DO_AK))
#define HF  ((bf16_t*)(dob + DO_HF))
#define HB  ((bf16_t*)(dob + DO_HB))

#define XB_TMO      128
#define XB_XCNT(j)  (256  + 64 * (j))
#define XB_XSUB(j)  (1280 + 64 * (j))
#define XB_XGEN(j)  (2304 + 64 * (j))
#define XB_TOP      3328
#define XB_TOPGEN   3392
#define XCD_BAR_WORDS 3456
#define XB_SPIN_CAP (1u << 18)
__device__ __forceinline__ unsigned xb_ld(unsigned* p)              { return __hip_atomic_load(p, __ATOMIC_RELAXED, __HIP_MEMORY_SCOPE_AGENT); }
__device__ __forceinline__ unsigned xb_add(unsigned* p, unsigned v) { return __hip_atomic_fetch_add(p, v, __ATOMIC_RELAXED, __HIP_MEMORY_SCOPE_AGENT); }
__device__ __forceinline__ unsigned xb_xcc_id() { return (unsigned)__builtin_amdgcn_s_getreg((3 << 11) | 20) & 0xFu; }
#define XB_SPIN(cond, bar) do { unsigned _sp = 0; while (cond) { __builtin_amdgcn_s_sleep(1); \
    if ((++_sp & 255u) == 0u) { if (xb_ld(&(bar)[XB_TMO])) break; if (_sp > XB_SPIN_CAP) { atomicAdd(&(bar)[XB_TMO], 1u); break; } } } } while (0)
struct XcdBarrier { unsigned* bar; unsigned x; volatile LAS unsigned* st; };
__device__ __forceinline__ XcdBarrier xcd_barrier_post(unsigned* bar, volatile LAS unsigned* st) {
    XcdBarrier b; b.bar = bar; b.x = xb_xcc_id(); b.st = st;
    if (threadIdx.x == 0) (void)xb_add(&bar[XB_XCNT(b.x)], 1u);
    return b;
}
__device__ __forceinline__ void xcd_barrier_complete(unsigned* bar, unsigned x, unsigned& nloc, unsigned& nx) {
    const unsigned G = gridDim.x * gridDim.y * gridDim.z;
    unsigned sum, cnt, mine, sp = 0u;
    for (;;) {
        sum = 0u; cnt = 0u; mine = 0u;
#pragma unroll
        for (unsigned j = 0; j < 16; ++j) { const unsigned c = xb_ld(&bar[XB_XCNT(j)]); sum += c; cnt += (c > 0u) ? 1u : 0u; mine = (j == x) ? c : mine; }
        if (sum == G) break;
        __builtin_amdgcn_s_sleep(1);
        if ((++sp & 255u) == 0u) { if (xb_ld(&bar[XB_TMO])) break; if (sp > XB_SPIN_CAP) { atomicAdd(&bar[XB_TMO], 1u); break; } }
    }
    nloc = mine > 0u ? mine : 1u; nx = cnt > 0u ? cnt : 1u;
}
__device__ __forceinline__ void xcd_barrier(const XcdBarrier& b) {
    asm volatile("s_waitcnt vmcnt(0)" ::: "memory");
    __syncthreads();
    if (threadIdx.x == 0) {
        unsigned* bar = b.bar;
        __builtin_amdgcn_s_waitcnt(0);
        unsigned nloc = b.st[0], nx = b.st[1];
        if (nloc == 0u) { xcd_barrier_complete(bar, b.x, nloc, nx); b.st[0] = nloc; b.st[1] = nx; }
        const unsigned old = xb_add(&bar[XB_XSUB(b.x)], 1u);
        const unsigned gen = old / nloc;
        if (old + 1u == (gen + 1u) * nloc) {
            __builtin_amdgcn_fence(__ATOMIC_RELEASE, "agent");
            asm volatile("s_waitcnt vmcnt(0)" ::: "memory");
            const unsigned og = xb_add(&bar[XB_TOP], 1u);
            const unsigned tg = og / nx;
            if (og + 1u == (tg + 1u) * nx) xb_add(&bar[XB_TOPGEN], 1u);
            else XB_SPIN(xb_ld(&bar[XB_TOPGEN]) == tg, bar);
            __builtin_amdgcn_fence(__ATOMIC_ACQUIRE, "agent");
            xb_add(&bar[XB_XGEN(b.x)], 1u);
            asm volatile("s_waitcnt vmcnt(0)" ::: "memory");
        } else {
            XB_SPIN(xb_ld(&bar[XB_XGEN(b.x)]) == gen, bar);
            __builtin_amdgcn_fence(__ATOMIC_ACQUIRE, "agent");
            asm volatile("s_waitcnt vmcnt(0)" ::: "memory");
        }
    }
    __syncthreads();
}
constexpr size_t WS_BAR = 253 * MiB;
constexpr int LDS_ST_OFF = LDS_BYTES - 16;
#define A (*(const volatile __attribute__((address_space(4))) Args*)__builtin_amdgcn_kernarg_segment_ptr())
__global__ void __launch_bounds__(512, 2) fwd_kernel(Args Aparam) {
    extern __shared__ __attribute__((aligned(16))) unsigned char lds_raw[];
    LAS unsigned char* lds = (LAS unsigned char*)lds_raw;
    const int tid = threadIdx.x, lane = tid & 63, wave = __builtin_amdgcn_readfirstlane(tid >> 6);
    const int G = gridDim.x, bx = blockIdx.x;
    const int gw = bx * 8 + wave, NGW = G * 8;
    const int lo = A.ph_lo, hi = A.ph_hi; (void)lo; (void)hi;
#ifndef PHMASK
#define PHMASK 0x1fff
#endif
#if ONE_LAUNCH
#define IN(k) (((PHMASK >> (k)) & 1) && (k) < 11)
#else
#define IN(k) (((PHMASK >> (k)) & 1) && lo <= (k) && (k) < hi)
#endif
#if ONE_LAUNCH
    XcdBarrier xbar; xbar.bar = nullptr; xbar.x = 0; xbar.st = (volatile LAS unsigned*)(lds + LDS_ST_OFF);
#define SEAM(k) do { xcd_barrier(xbar); } while (0)
    {
        unsigned* const barw = (unsigned*)(A.ws + WS_BAR);
        if (tid < 4) ((LAS unsigned*)(lds + LDS_ST_OFF))[tid] = 0u;
        if (bx == 0) for (int i = tid; i < XCD_BAR_WORDS; i += 512) barw[i] = 0u;
        cg::this_grid().sync();
        xbar = xcd_barrier_post(barw, (volatile LAS unsigned*)(lds + LDS_ST_OFF));
    }
#else
#define SEAM(k) do { } while (0)
#endif

    for (int rep_ = 0; rep_ < (((RPT_MASK >> 0) & 1) ? 2 : 1); ++rep_) { if (rep_) { if (0 == 0) cg::this_grid().sync(); else xcd_barrier(xbar); }
    if (IN(0)) {
        unsigned char* const wsb = A.ws; unsigned char* const dob = (unsigned char*)A.out; (void)wsb; (void)dob;
        LAS float* svec = (LAS float*)(lds + 131072);
        for (int task = bx; task < 192; task += G) {
            const int cb = task % 12, ks = task / 12, k0 = ks * 64;
            __syncthreads();
            for (int i = tid; i < 576; i += 512) { const int v = i >> 6, k = i & 63; const float cv = v < 8 ? A.c[v * 1024 + k0 + k] : A.c_ctx[k0 + k]; svec[i] = cv / (1.f + __expf(-cv)); }
            __syncthreads();
            gemv_task<9, 64, false>(A.w_mod, 6144, cb * 512, k0, svec, modp + (size_t)ks * 9 * 6144, 6144);
        }
        LAS float* scr = (LAS float*)(lds + wave * 16384);
        constexpr int NITEMS = 9088;
        for (int it = gw; it < NITEMS; it += NGW) {
            int r = it; const float* W; int ldw, col0, ncols, K; bf16_t* dst; int hp = 0;
            if (r < 512) { W = A.w_in; ldw = INW; col0 = 0; ncols = 1024; K = 1024; dst = W1T + (size_t)3 * 256 * 1024; hp = 1; }
            else if ((r -= 512) < 128) { W = A.w_in; ldw = INW; col0 = 1024; ncols = 256; K = 1024; dst = W1T; hp = 1; }
            else if ((r -= 128) < 128) { W = A.w_in; ldw = INW; col0 = 1280; ncols = 256; K = 1024; dst = W2T; }
            else if ((r -= 128) < 256) { W = A.w_in; ldw = INW; col0 = 1536; ncols = 512; K = 1024; dst = W1T + (size_t)7 * 256 * 1024; }
            else if ((r -= 256) < 256) { W = A.w_in; ldw = INW; col0 = 2048; ncols = 512; K = 1024; dst = W1T + (size_t)1 * 256 * 1024; }
            else if ((r -= 256) < 512) { W = A.w_in; ldw = INW; col0 = 2560; ncols = 1024; K = 1024; dst = W2T + (size_t)256 * 1024; }
            else if ((r -= 512) < 512) { W = A.w_in; ldw = INW; col0 = 3584; ncols = 1024; K = 1024; dst = W1T + (size_t)9 * 256 * 1024; }
            else if ((r -= 512) < 512) { W = A.w_in; ldw = INW; col0 = 4624; ncols = 1024; K = 1024; dst = W1T + (size_t)13 * 256 * 1024; }
            else if ((r -= 512) < 512) { W = A.w_in; ldw = INW; col0 = 5648; ncols = 1024; K = 1024; dst = W1T + (size_t)17 * 256 * 1024; }
            else if ((r -= 512) < 512) { W = A.w_branch_att; ldw = 1024; col0 = 0; ncols = 1024; K = 1024; dst = WBA; }
            else if ((r -= 512) < 512) { W = A.w_branch_ml; ldw = 1024; col0 = 0; ncols = 1024; K = 1024; dst = WBM; }
            else if ((r -= 512) < 512) { W = A.w_out; ldw = 1024; col0 = 0; ncols = 1024; K = 1024; dst = WO; }
            else if ((r -= 512) < 2816) { W = A.w_up; ldw = NUP; col0 = 0; ncols = NUP; K = 1024; dst = WUP; }
            else { r -= 2816; W = A.w_down; ldw = 1024; col0 = 0; ncols = 1024; K = DFF; dst = WDN; }
            const int nblk = ncols / 32, kb = r / nblk, nb = r % nblk, n0 = nb * 32;
            int drow = hp ? headperm(n0) : n0;
            if (W == A.w_up) drow = (n0 < DFF) ? 256 * (n0 >> 7) + (n0 & 127) : 256 * ((n0 - DFF) >> 7) + 128 + ((n0 - DFF) & 127);
            transpose_item(W, ldw, col0 + n0, kb * 64, dst, drow, K, scr, lane);
        }
        for (int i = bx * 512 + tid; i < 2048 * 32; i += G * 512) {
            const int t = i >> 5, j = i & 31; const float pos = (j < 16) ? (float)(t >> 6) : (float)(t & 63);
            const float invf = exp2f(-(float)(j & 15) * (13.287712379549449f / 16.f)); const float ang = pos * invf;
            cosT[i] = cosf(ang); sinT[i] = sinf(ang);
        }
    }
    }
    SEAM(0);

    for (int rep_ = 0; rep_ < (((RPT_MASK >> 1) & 1) ? 2 : 1); ++rep_) { if (rep_) { if (1 == 0) cg::this_grid().sync(); else xcd_barrier(xbar); }
    if (IN(1)) {
        unsigned char* const wsb = A.ws; unsigned char* const dob = (unsigned char*)A.out; (void)wsb; (void)dob;
        constexpr int GP = 1028;
        LAS float* sWg = (LAS float*)lds;
        LAS float* hT = (LAS float*)(lds + 65792);
        LAS float* svm = (LAS float*)(lds + 131584);
        LAS float* part = (LAS float*)(lds + 147968);
        LAS float* svec = part;
        for (int k = tid; k < 1024; k += 512) { const float* src = A.w_in + (size_t)k * INW + 4608;
#pragma unroll
            for (int q = 0; q < 4; ++q) { const f32x4 v = *(const f32x4*)(src + 4 * q); sWg[(4 * q + 0) * GP + k] = v[0]; sWg[(4 * q + 1) * GP + k] = v[1]; sWg[(4 * q + 2) * GP + k] = v[2]; sWg[(4 * q + 3) * GP + k] = v[3]; } }
        const int rpb = (MT + G - 1) / G, rbeg = bx * rpb, rend = (rbeg + rpb < MT) ? rbeg + rpb : MT;
        const int vlo = rbeg < ML ? (rbeg >> 11) : 8;
        for (int i = tid; i < 4096; i += 512) { const int slot = i >> 11, k = i & 2047; int v = vlo + slot; if (v > 8) v = 8; float a = A.b_mod[k];
#pragma unroll
            for (int ks = 0; ks < 16; ++ks) a += modp[((size_t)ks * 9 + v) * 6144 + k];
            svm[i] = a; }
        for (int i = bx * 512 + tid; i < 9 * 6144; i += G * 512) { float a = A.b_mod[i % 6144];
#pragma unroll
            for (int ks = 0; ks < 16; ++ks) a += modp[(size_t)ks * 9 * 6144 + i];
            mod[i] = a; }
        __syncthreads();
        {
            const float* xin = A.x; const float* cin = A.ctx; const float* n1w = A.norm1_w; const float* gbias = A.ml_gate_b;
            const int r16 = lane & 15, quad = lane >> 4;
            const int ntile = (rend - rbeg + 15) >> 4;
            f32x4 xn[2][4];
#pragma unroll
            for (int t = 0; t < 2; ++t) { const int row = rbeg + wave + 8 * t; if (row < rend) { const float* xr = row < ML ? xin + (size_t)row * 1024 : cin + (size_t)(row - ML) * 1024;
#pragma unroll
                for (int j = 0; j < 4; ++j) xn[t][j] = *(const f32x4*)(xr + 4 * lane + 256 * j); } }
            for (int tile = 0; tile < ntile; ++tile) {
                const int trow = rbeg + 16 * tile;
#pragma unroll
                for (int t = 0; t < 2; ++t) {
                    const int r = wave + 8 * t, row = trow + r;
                    f32x4 hv[4]; float ss = 0.f;
#pragma unroll
                    for (int j = 0; j < 4; ++j) { hv[j] = xn[t][j]; const f32x4 q = hv[j] * hv[j]; ss += (q[0] + q[1]) + (q[2] + q[3]); }
                    { const int rn = row + 16; if (rn < rend) { const float* xr = rn < ML ? xin + (size_t)rn * 1024 : cin + (size_t)(rn - ML) * 1024;
#pragma unroll
                        for (int j = 0; j < 4; ++j) xn[t][j] = *(const f32x4*)(xr + 4 * lane + 256 * j); } }
                    if (row < rend) {
                        const int v = row < ML ? (row >> 11) : 8;
                        const LAS float* sh = svm + (v - vlo) * 2048; const LAS float* sc = sh + 1024;
                        const float rstd = rsqrtf(wave_sum(ss) * (1.f / 1024.f) + EPS);
                        bf16_t* ho = H + (size_t)row * 1024;
#pragma unroll
                        for (int j = 0; j < 4; ++j) { const int k = 4 * lane + 256 * j;
                            hv[j] = hv[j] * rstd * (*(const f32x4*)(n1w + k)) * (*(const LAS f32x4*)(sc + k) + 1.f) + *(const LAS f32x4*)(sh + k);
                            u32x2 w; w.x = cvt_pk_bf16(hv[j][0], hv[j][1]); w.y = cvt_pk_bf16(hv[j][2], hv[j][3]); *(u32x2*)(ho + k) = w;
                            *(LAS f32x4*)(hT + r * GP + k) = hv[j]; }
                    }
                }
                __syncthreads();
                { f32x4 acc = (f32x4){0.f, 0.f, 0.f, 0.f};
#pragma unroll
                  for (int kk = 0; kk < 8; ++kk) { const f32x4 a4 = *(const LAS f32x4*)(hT + r16 * GP + wave * 128 + kk * 16 + quad * 4), b4 = *(const LAS f32x4*)(sWg + r16 * GP + wave * 128 + kk * 16 + quad * 4);
#pragma unroll
                    for (int i = 0; i < 4; ++i) acc = __builtin_amdgcn_mfma_f32_16x16x4f32(a4[i], b4[i], acc, 0, 0, 0); }
#pragma unroll
                  for (int j = 0; j < 4; ++j) part[wave * 256 + (quad * 4 + j) * 16 + r16] = acc[j]; }
                __syncthreads();
                if (tid < 256) { const int r = tid >> 4, gidx = tid & 15, row = trow + r; float gv = gbias[gidx];
#pragma unroll
                    for (int w = 0; w < 8; ++w) gv += part[w * 256 + tid];
                    if (gidx & 4) gv = fminf(gv, 0.f) - log1pf(expf(-fabsf(gv)));
                    if (row < rend) gates[(size_t)row * 16 + gidx] = gv; }
            }
        }
        for (int task = bx; task < 176; task += G) {
            const int cb = task % 11, ks = task / 11, k0 = ks * 64;
            __syncthreads();
            { const int v = tid >> 6, k = 3072 + k0 + (tid & 63); float a = A.b_mod[k];
#pragma unroll
                for (int q = 0; q < 16; ++q) a += modp[((size_t)q * 9 + v) * 6144 + k];
                svec[tid] = a; }
            __syncthreads();
            gemv_task<8, 64, false>(A.w_up, NUP, cb * 512, k0, svec, fbp + (size_t)ks * 8 * NUP, NUP);
        }
    }
    }
    SEAM(1);

    for (int rep_ = 0; rep_ < (((RPT_MASK >> 2) & 1) ? 2 : 1); ++rep_) { if (rep_) { if (2 == 0) cg::this_grid().sync(); else xcd_barrier(xbar); }
    if (IN(2)) {
        unsigned char* const wsb = A.ws; unsigned char* const dob = (unsigned char*)A.out; (void)wsb; (void)dob;
        { pg8::Gemm g{H, W1T, 1024, 1024, 1024}; pg8::Order S; S.init(64, 21, G, bx, 24);
          EpiIn E{AK, MK, AQ, MQ, MO, GA, GM, A.q_norm_w, A.k_norm_w, cosT, sinT};
          pg8::gemm_phase<EpiIn, pg8::Order, true>(lds, g, S, E); }
        { pg8::Gemm g{W2T, H, 1024, 1024, 1024}; pg8::Order S; S.init(5, 72, G, (bx + G - (1368 % G)) % G, 0);
          EpiPlain E{XT, MT};
          pg8::gemm_phase<EpiPlain, pg8::Order, true>(lds, g, S, E); }
    }
    }
    SEAM(2);

    if (IN(3)) {
        unsigned char* const wsb = A.ws; unsigned char* const dob = (unsigned char*)A.out; (void)wsb; (void)dob;
        for (int i = bx * 512 + tid; i < 8 * NUP; i += G * 512) { float a = 0.f;
#pragma unroll
            for (int ks = 0; ks < 16; ++ks) a += fbp[(size_t)ks * 8 * NUP + i];
            fbias[i] = a; }
        const int r16 = lane & 15, quad = lane >> 4;
        const int rt = wave & 3, hp = wave >> 2;
        LAS bf16_t* sK = (LAS bf16_t*)lds;
        LAS bf16_t* sVT = sK + 64 * 72;
        bf16x8 qn[2][2];
#define AT_QLOAD(un_) do { const int qb_ = (un_) & 31, kvh_ = ((un_) >> 5) & 3, b_ = (un_) >> 7; \
            _Pragma("unroll") for (int g = 0; g < 2; ++g) _Pragma("unroll") for (int ks = 0; ks < 2; ++ks) \
                qn[g][ks] = *(const bf16x8*)(AQ + (size_t)(b_ * SEQ + qb_ * 64 + rt * 16 + r16) * 1024 + (kvh_ * 4 + hp * 2 + g) * 64 + ks * 32 + quad * 8); } while (0)
        if (bx < 1024) AT_QLOAD(bx);
        for (int unit = bx; unit < 1024; unit += G) {
            const int qb = unit & 31, kvh = (unit >> 5) & 3, b = unit >> 7;
            const int rowbase = b * SEQ, t0 = qb * 64;
            bf16x8 qf[2][2];
#pragma unroll
            for (int g = 0; g < 2; ++g)
#pragma unroll
                for (int ks = 0; ks < 2; ++ks) qf[g][ks] = qn[g][ks];
            if (unit + G < 1024) AT_QLOAD(unit + G);
            f32x4 o[2][4]; float mrow[2], lrow[2];
#pragma unroll
            for (int g = 0; g < 2; ++g) { mrow[g] = A.attn_sink[kvh * 4 + hp * 2 + g]; lrow[g] = 1.f;
#pragma unroll
                for (int dt = 0; dt < 4; ++dt) o[g][dt] = (f32x4){0.f, 0.f, 0.f, 0.f}; }
            const int kb_lo = (qb < 2) ? 2 - qb : 0, kb_hi = (qb > 29) ? 33 - qb : 4;
            const bf16_t* const ak_ = AK; const bf16_t* const xt_ = XT; const int lr = tid >> 3, lc = tid & 7;
#define AT_KROW0(kb_) (((kb_) < 5) ? rowbase + (qb + (kb_) - 2) * 64 : ML + b * CTX + ((kb_) - 5) * 64)
            u32x4 pk, pv;
            { const int kr = AT_KROW0(kb_lo); pk = *(const u32x4*)(ak_ + (size_t)(kr + lr) * 256 + kvh * 64 + lc * 8); pv = *(const u32x4*)(xt_ + (size_t)(kvh * 64 + lr) * MT + kr + lc * 8); }
            for (int kb = kb_lo; kb < 9; kb = (kb == kb_hi) ? 5 : kb + 1) {
                const int mtype = (kb == 0) ? 1 : (kb == 4) ? 2 : 0;
                const int mlo = (mtype == 1) ? 0 : -4096, mhi = (mtype == 2) ? 0 : 4096, dl = quad * 4 - rt * 16 - r16;
                __syncthreads();
                *(LAS u32x4*)(sK + lr * 72 + lc * 8) = pk; *(LAS u32x4*)(sVT + lr * 72 + lc * 8) = pv;
                { const int kn = (kb == kb_hi) ? 5 : kb + 1;
                  if (kn < 9) { const int kr = AT_KROW0(kn); pk = *(const u32x4*)(ak_ + (size_t)(kr + lr) * 256 + kvh * 64 + lc * 8); pv = *(const u32x4*)(xt_ + (size_t)(kvh * 64 + lr) * MT + kr + lc * 8); } }
                __syncthreads();
                bf16x8 kf[4][2], vf[2][4];
#pragma unroll
                for (int tile = 0; tile < 4; ++tile)
#pragma unroll
                    for (int ks = 0; ks < 2; ++ks) kf[tile][ks] = *(const LAS bf16x8*)(sK + (tile * 16 + r16) * 72 + ks * 32 + quad * 8);
#pragma unroll
                for (int ks = 0; ks < 2; ++ks)
#pragma unroll
                    for (int dt = 0; dt < 4; ++dt) { const u32x2 lo = *(const LAS u32x2*)(sVT + (dt * 16 + r16) * 72 + ks * 32 + quad * 4), hi = *(const LAS u32x2*)(sVT + (dt * 16 + r16) * 72 + ks * 32 + 16 + quad * 4);
                        const u32x4 w = (u32x4){lo.x, lo.y, hi.x, hi.y}; vf[ks][dt] = __builtin_bit_cast(bf16x8, w); }
#pragma unroll
                for (int g = 0; g < 2; ++g) {
                    f32x4 s[4];
#pragma unroll
                    for (int tile = 0; tile < 4; ++tile) { s[tile] = (f32x4){0.f, 0.f, 0.f, 0.f};
#pragma unroll
                        for (int ks = 0; ks < 2; ++ks) s[tile] = mfma16(kf[tile][ks], qf[g][ks], s[tile]); }
                    float mx = -1e30f;
#pragma unroll
                    for (int tile = 0; tile < 4; ++tile)
#pragma unroll
                        for (int j = 0; j < 4; ++j) { const int dd = dl + (tile * 16 + j);
                            const int bad = ((dd - mlo) | (mhi - dd)) >> 31;
                            const float v = s[tile][j] * 0.125f + __int_as_float(bad & (int)0xF149F2CAu); s[tile][j] = v; mx = fmaxf(mx, v); }
                    mx = fmaxf(mx, __shfl_xor(mx, 16)); mx = fmaxf(mx, __shfl_xor(mx, 32));
                    const float mn = fmaxf(mrow[g], mx), alpha = __expf(mrow[g] - mn); mrow[g] = mn; float rs = 0.f;
                    unsigned pw[4][2];
#pragma unroll
                    for (int tile = 0; tile < 4; ++tile) { f32x4 pe;
#pragma unroll
                        for (int j = 0; j < 4; ++j) { pe[j] = __expf(s[tile][j] - mn); rs += pe[j]; }
                        pw[tile][0] = cvt_pk_bf16(pe[0], pe[1]); pw[tile][1] = cvt_pk_bf16(pe[2], pe[3]); }
                    rs += __shfl_xor(rs, 16); rs += __shfl_xor(rs, 32);
                    lrow[g] = lrow[g] * alpha + rs;
#pragma unroll
                    for (int dt = 0; dt < 4; ++dt) o[g][dt] = o[g][dt] * alpha;
#pragma unroll
                    for (int ks = 0; ks < 2; ++ks) { const u32x4 w = (u32x4){pw[2 * ks][0], pw[2 * ks][1], pw[2 * ks + 1][0], pw[2 * ks + 1][1]}; const bf16x8 pf = __builtin_bit_cast(bf16x8, w);
#pragma unroll
                        for (int dt = 0; dt < 4; ++dt) o[g][dt] = mfma16(vf[ks][dt], pf, o[g][dt]); }
                }
            }
#pragma unroll
            for (int g = 0; g < 2; ++g) { const float inv = 1.f / lrow[g];
                bf16_t* p = ATTO + (size_t)(rowbase + t0 + rt * 16 + r16) * 1024 + (kvh * 4 + hp * 2 + g) * 64 + quad * 4;
#pragma unroll
                for (int dt = 0; dt < 4; ++dt) { u32x2 w; w.x = cvt_pk_bf16(o[g][dt][0] * inv, o[g][dt][1] * inv); w.y = cvt_pk_bf16(o[g][dt][2] * inv, o[g][dt][3] * inv); *(u32x2*)(p + dt * 16) = w; } }
        }
    }
    SEAM(3);

    for (int rep_ = 0; rep_ < (((RPT_MASK >> 4) & 1) ? 2 : 1); ++rep_) { if (rep_) { if (4 == 0) cg::this_grid().sync(); else xcd_barrier(xbar); }
    if (IN(4)) {
        unsigned char* const wsb = A.ws; unsigned char* const dob = (unsigned char*)A.out; (void)wsb; (void)dob;
        const int r16 = lane & 15, quad = lane >> 4;
        LAS bf16_t* sK = (LAS bf16_t*)lds;
        LAS bf16_t* sVT = sK + 128 * 136;
        LAS bf16_t* sS = sVT + 64 * 136;
        LAS bf16_t* sC = sS + 128 * 136;
        LAS float* sgb = (LAS float*)(sC + 80 * 136);
        LAS float *sga = sgb + 128, *sgw = sgb + 256, *sge = sgb + 384, *sgF = sgb + 512;
        const float scale = 0.08838834764831845f;
        for (int task = bx; task < 256; task += G) {
            const int vq = task & 3, dir = (task >> 2) & 1, hh = (task >> 3) & 3, b = task >> 5;
            __syncthreads();
            for (int i = tid; i < 80 * 136 / 2; i += 512) ((LAS unsigned*)sC)[i] = 0u;
            f32x4 cacc[4], nacc = (f32x4){0.f, 0.f, 0.f, 0.f};
#pragma unroll
            for (int vt = 0; vt < 4; ++vt) cacc[vt] = (f32x4){0.f, 0.f, 0.f, 0.f};
            bf16_t* Hout = (bf16_t*)(dob + (dir ? DO_HB : DO_HF)); const int sgn = dir ? 1 : -1;
            const bf16_t* const mk_ = MK; const bf16_t* const xt_ = XT; const bf16_t* const mq_ = MQ; const float* const gt_ = gates;
            u32x4 pK[4], pVT[2]; bf16x8 pQ[4]; float pG[4];
#define ML_TOK0(st) (((st) < 2) ? (ML + b * CTX + (dir ? 1 - (st) : (st)) * 128) : (b * SEQ + (dir ? 15 - ((st) - 2) : (st) - 2) * 128))
#define ML_PREFETCH(st) do { const int t0_ = ML_TOK0(st); \
                _Pragma("unroll") for (int q_ = 0; q_ < 4; ++q_) { const int i_ = tid + q_ * 512, r_ = i_ >> 4, c_ = i_ & 15; pK[q_] = *(const u32x4*)(mk_ + (size_t)(t0_ + r_) * 512 + hh * 128 + c_ * 8); } \
                if ((st) >= 2) { _Pragma("unroll") for (int ks_ = 0; ks_ < 4; ++ks_) pQ[ks_] = *(const bf16x8*)(mq_ + (size_t)(t0_ + wave * 16 + r16) * 512 + hh * 128 + ks_ * 32 + quad * 8); } \
                _Pragma("unroll") for (int q_ = 0; q_ < 2; ++q_) { const int i_ = tid + q_ * 512, r_ = i_ >> 4, c_ = i_ & 15; pVT[q_] = *(const u32x4*)(xt_ + (size_t)(256 + hh * 256 + vq * 64 + r_) * MT + t0_ + c_ * 8); } \
                if (wave == 0) { const float* gp_ = gt_ + (size_t)(t0_ + 2 * lane) * 16 + dir * 8 + hh; pG[0] = gp_[0]; pG[1] = gp_[4]; pG[2] = gp_[16]; pG[3] = gp_[20]; } } while (0)
            ML_PREFETCH(0);
            for (int step = 0; step < 18; ++step) {
                const bool isctx = step < 2; const int tok0 = ML_TOK0(step);
                __syncthreads();
#pragma unroll
                for (int q = 0; q < 4; ++q) { const int i = tid + q * 512, r = i >> 4, c = i & 15; *(LAS u32x4*)(sK + r * 136 + c * 8) = pK[q]; }
#pragma unroll
                for (int q = 0; q < 2; ++q) { const int i = tid + q * 512, r = i >> 4, c = i & 15; *(LAS u32x4*)(sVT + r * 136 + c * 8) = pVT[q]; }
                if (wave == 0) {
                    const float i0 = pG[0], f0 = pG[1], i1 = pG[2], f1 = pG[3];
                    const float loc = f0 + f1; float v = loc;
#pragma unroll
                    for (int off = 1; off < 64; off <<= 1) { const float t = __shfl_up(v, off); if (lane >= off) v += t; }
                    const float total = __shfl(v, 63); const float p0 = v - loc + f0, p1 = p0 + f1;
                    const float b0 = dir ? total - p0 + f0 : p0, b1 = dir ? total - p1 + f1 : p1;
                    const float cmid = 0.5f * total;
                    sgb[2 * lane] = __expf(fminf(b0 - cmid, 80.f)); sgb[2 * lane + 1] = __expf(fminf(b1 - cmid, 80.f));
                    sga[2 * lane] = __expf(fminf(i0 - b0 + cmid, 80.f)) * scale; sga[2 * lane + 1] = __expf(fminf(i1 - b1 + cmid, 80.f)) * scale;
                    sgw[2 * lane] = __expf(fminf(total - b0 + i0, 80.f)) * scale; sgw[2 * lane + 1] = __expf(fminf(total - b1 + i1, 80.f)) * scale;
                    sge[2 * lane] = __expf(b0); sge[2 * lane + 1] = __expf(b1); if (lane == 0) sgF[0] = __expf(total);
                }
                bf16x8 qf[4];
#pragma unroll
                for (int ks = 0; ks < 4; ++ks) qf[ks] = pQ[ks];
                if (step + 1 < 18) ML_PREFETCH(step + 1);
                __syncthreads();
                if (!isctx) {
                    const int prow = wave * 16 + r16;
                    f32x4 s[8];
#pragma unroll
                    for (int tile = 0; tile < 8; ++tile) { s[tile] = (f32x4){0.f, 0.f, 0.f, 0.f};
#pragma unroll
                        for (int ks = 0; ks < 4; ++ks) { const bf16x8 kf = *(const LAS bf16x8*)(sK + (tile * 16 + r16) * 136 + ks * 32 + quad * 8); s[tile] = mfma16(kf, qf[ks], s[tile]); } }
                    const float bp = sgb[prow]; float rs = 0.f;
#pragma unroll
                    for (int tile = 0; tile < 8; ++tile) { const f32x4 av = *(const LAS f32x4*)(sga + tile * 16 + quad * 4); f32x4 pe;
#pragma unroll
                        for (int j = 0; j < 4; ++j) { const int dd = (tile * 16 + quad * 4 + j - prow) * sgn;
                            pe[j] = __int_as_float(__float_as_int(s[tile][j] * (bp * av[j])) & ~(dd >> 31)); rs += pe[j]; }
                        u32x2 w; w.x = cvt_pk_bf16(pe[0], pe[1]); w.y = cvt_pk_bf16(pe[2], pe[3]);
                        *(LAS u32x2*)(sS + prow * 136 + tile * 16 + quad * 4) = w; }
                    rs += __shfl_xor(rs, 16); rs += __shfl_xor(rs, 32);
                    asm volatile("s_waitcnt lgkmcnt(0)" ::: "memory");
                    f32x4 a1[4], a2[5];
#pragma unroll
                    for (int vt = 0; vt < 4; ++vt) a1[vt] = (f32x4){0.f, 0.f, 0.f, 0.f};
#pragma unroll
                    for (int vt = 0; vt < 5; ++vt) a2[vt] = (f32x4){0.f, 0.f, 0.f, 0.f};
#pragma unroll
                    for (int ks = 0; ks < 4; ++ks) { const bf16x8 af = *(const LAS bf16x8*)(sS + prow * 136 + ks * 32 + quad * 8);
#pragma unroll
                        for (int vt = 0; vt < 4; ++vt) { const bf16x8 vf = *(const LAS bf16x8*)(sVT + (vt * 16 + r16) * 136 + ks * 32 + quad * 8); a1[vt] = mfma16(vf, af, a1[vt]); } }
#pragma unroll
                    for (int ks = 0; ks < 4; ++ks)
#pragma unroll
                        for (int vt = 0; vt < 5; ++vt) { const bf16x8 cf = *(const LAS bf16x8*)(sC + (vt * 16 + r16) * 136 + ks * 32 + quad * 8); a2[vt] = mfma16(cf, qf[ks], a2[vt]); }
                    const float e = sge[prow];
                    const float qn = __shfl(a2[4][0], r16); const float nq = rs + e * qn; const float inv = 1.f / fmaxf(fabsf(nq), 1.f);
                    bf16_t* hp = Hout + (size_t)(tok0 + prow) * 1024 + hh * 256 + vq * 64 + quad * 4;
#pragma unroll
                    for (int vt = 0; vt < 4; ++vt) { u32x2 w; w.x = cvt_pk_bf16((a1[vt][0] + e * a2[vt][0]) * inv, (a1[vt][1] + e * a2[vt][1]) * inv);
                        w.y = cvt_pk_bf16((a1[vt][2] + e * a2[vt][2]) * inv, (a1[vt][3] + e * a2[vt][3]) * inv); *(u32x2*)(hp + vt * 16) = w; }
                }
                __syncthreads();
                {
                    const float F = sgF[0];
#pragma unroll
                    for (int vt = 0; vt < 4; ++vt) cacc[vt] = cacc[vt] * F;
                    nacc = nacc * F;
                    bf16x8 ones; { const short o1 = (r16 == 0) ? (short)0x3F80 : (short)0;
#pragma unroll
                        for (int e = 0; e < 8; ++e) ones[e] = o1; }
#pragma unroll
                    for (int ks = 0; ks < 4; ++ks) {
                        const LAS bf16_t* kcol = sK + (ks * 32 + quad * 8) * 136 + wave * 16 + r16;
                        const f32x4 w0 = *(const LAS f32x4*)(sgw + ks * 32 + quad * 8), w1 = *(const LAS f32x4*)(sgw + ks * 32 + quad * 8 + 4);
                        f32x4 k0, k1;
#pragma unroll
                        for (int e = 0; e < 4; ++e) { k0[e] = bf2f(kcol[e * 136]) * w0[e]; k1[e] = bf2f(kcol[(4 + e) * 136]) * w1[e]; }
                        const u32x4 pk = pack8(k0, k1); const bf16x8 kts = __builtin_bit_cast(bf16x8, pk);
#pragma unroll
                        for (int vt = 0; vt < 4; ++vt) { const bf16x8 va = *(const LAS bf16x8*)(sVT + (vt * 16 + r16) * 136 + ks * 32 + quad * 8); cacc[vt] = mfma16(kts, va, cacc[vt]); }
                        nacc = mfma16(kts, ones, nacc);
                    }
#pragma unroll
                    for (int vt = 0; vt < 4; ++vt) { u32x2 w; w.x = cvt_pk_bf16(cacc[vt][0], cacc[vt][1]); w.y = cvt_pk_bf16(cacc[vt][2], cacc[vt][3]);
                        *(LAS u32x2*)(sC + (vt * 16 + r16) * 136 + wave * 16 + quad * 4) = w; }
                    if (r16 == 0) { u32x2 w; w.x = cvt_pk_bf16(nacc[0], nacc[1]); w.y = cvt_pk_bf16(nacc[2], nacc[3]); *(LAS u32x2*)(sC + 64 * 136 + wave * 16 + quad * 4) = w; }
                }
            }
        }
    }
    }
    SEAM(4);

    if (IN(5)) {
        unsigned char* const wsb = A.ws; unsigned char* const dob = (unsigned char*)A.out; (void)wsb; (void)dob;
        for (int row = gw; row < ML; row += NGW) {
            const size_t off = (size_t)row * 1024 + lane * 16;
            float ht[16], mo[16];
#pragma unroll
            for (int q = 0; q < 2; ++q) { const u32x4 a = *(const u32x4*)(HF + off + q * 8), c = *(const u32x4*)(HB + off + q * 8), d = *(const u32x4*)(MO + off + q * 8);
#pragma unroll
                for (int e = 0; e < 4; ++e) { ht[q * 8 + 2 * e] = __uint_as_float(a[e] << 16) + __uint_as_float(c[e] << 16); ht[q * 8 + 2 * e + 1] = __uint_as_float(a[e] & 0xffff0000u) + __uint_as_float(c[e] & 0xffff0000u);
                    mo[q * 8 + 2 * e] = __uint_as_float(d[e] << 16); mo[q * 8 + 2 * e + 1] = __uint_as_float(d[e] & 0xffff0000u); } }
            float ss = 0.f;
#pragma unroll
            for (int e = 0; e < 16; ++e) ss += ht[e] * ht[e];
            ss += __shfl_xor(ss, 1); ss += __shfl_xor(ss, 2); ss += __shfl_xor(ss, 4); ss += __shfl_xor(ss, 8);
            const float rs = rsqrtf(ss * (1.f / 256.f) + EPS);
            float r[16];
#pragma unroll
            for (int q = 0; q < 4; ++q) { const f32x4 w = *(const f32x4*)(A.ml_norm_w + lane * 16 + q * 4);
#pragma unroll
                for (int e = 0; e < 4; ++e) r[q * 4 + e] = ht[q * 4 + e] * rs * w[e] * sigmoidf_(mo[q * 4 + e]); }
#pragma unroll
            for (int q = 0; q < 2; ++q) { u32x4 w; w.x = cvt_pk_bf16(r[q * 8 + 0], r[q * 8 + 1]); w.y = cvt_pk_bf16(r[q * 8 + 2], r[q * 8 + 3]); w.z = cvt_pk_bf16(r[q * 8 + 4], r[q * 8 + 5]); w.w = cvt_pk_bf16(r[q * 8 + 6], r[q * 8 + 7]);
                *(u32x4*)(MO + off + q * 8) = w; }
        }
    }
    SEAM(5);

    for (int rep_ = 0; rep_ < (((RPT_MASK >> 6) & 1) ? 2 : 1); ++rep_) { if (rep_) { if (6 == 0) cg::this_grid().sync(); else xcd_barrier(xbar); }
    if (IN(6)) {
        unsigned char* const wsb = A.ws; unsigned char* const dob = (unsigned char*)A.out; (void)wsb; (void)dob;
        pg8::Order S; S.init(64, 4, G, bx, 0);
        { pg8::Gemm g{AQ, WBA, 1024, 1024, 1024, MO, WBM}; EpiMerge E{GA, GM, Y}; pg8::gemm_phase<EpiMerge, pg8::Order, false, true>(lds, g, S, E); }
    }
    }
    SEAM(6);

    for (int rep_ = 0; rep_ < (((RPT_MASK >> 7) & 1) ? 2 : 1); ++rep_) { if (rep_) { if (7 == 0) cg::this_grid().sync(); else xcd_barrier(xbar); }
    if (IN(7)) {
        unsigned char* const wsb = A.ws; unsigned char* const dob = (unsigned char*)A.out; (void)wsb; (void)dob;
        pg8::Order S; S.init(64, 4, G, bx, 0);
#ifdef DBG_P7PLAIN
        pg8::Gemm g{Y, WO, 1024, 1024, 1024}; EpiPlain E{T1, 1024};
        pg8::gemm_phase<EpiPlain, pg8::Order, false>(lds, g, S, E);
#else
        pg8::Gemm g{Y, WO, 1024, 1024, 1024}; EpiOut E{A.x, mod, A.norm2_w, (float*)dob, AQ, rowsq};
        pg8::gemm_phase<EpiOut, pg8::Order, false>(lds, g, S, E);
#endif
    }
    }
    SEAM(7);

    for (int rep_ = 0; rep_ < (((RPT_MASK >> 8) & 1) ? 2 : 1); ++rep_) { if (rep_) { if (8 == 0) cg::this_grid().sync(); else xcd_barrier(xbar); }
    if (IN(8)) {
        unsigned char* const wsb = A.ws; unsigned char* const dob = (unsigned char*)A.out; (void)wsb; (void)dob;
        pg8::Order S; S.init(64, 22, G, bx, 0);
        pg8::Gemm g{AQ, WUP, 1024, 1024, 1024}; EpiUp E{rowsq, fbias, A.conv_w, A.conv_b, ACT, RAWU, (LAS float*)(lds + 131072)};
        pg8::gemm_phase<EpiUp, pg8::Order, true>(lds, g, S, E);
    }
    }
    SEAM(8);

    if (IN(9)) {
        unsigned char* const wsb = A.ws; unsigned char* const dob = (unsigned char*)A.out; (void)wsb; (void)dob;
        const float* cw = A.conv_w; const float* cb = A.conv_b;
        for (int task = bx * 512 + tid; task < 1025 * 352; task += G * 512) {
            const int ch = task % 352, bd = task / 352, j0 = ch * 8;
            const int pc = 256 * (j0 >> 7) + (j0 & 127);
            const bool lo_ok = bd > 0, hi_ok = bd < 1024, seam = ((bd * 16) & 2047) == 0;
            const u32x4 zero = (u32x4){0u, 0u, 0u, 0u};
            u32x4 xa[4], xg[4];
#pragma unroll
            for (int k = 0; k < 4; ++k) { xa[k] = zero; xg[k] = zero; }
            if (lo_ok) { const bf16_t* rp = RAWU + ((size_t)(bd - 1) * 4 + 2) * NUP + pc; xa[0] = *(const u32x4*)rp; xg[0] = *(const u32x4*)(rp + 128); xa[1] = *(const u32x4*)(rp + NUP); xg[1] = *(const u32x4*)(rp + NUP + 128); }
            if (hi_ok) { const bf16_t* rp = RAWU + ((size_t)bd * 4) * NUP + pc; xa[2] = *(const u32x4*)rp; xg[2] = *(const u32x4*)(rp + 128); xa[3] = *(const u32x4*)(rp + NUP); xg[3] = *(const u32x4*)(rp + NUP + 128); }
            float wa[3][8], wg[3][8], ba[8], bg[8];
#pragma unroll
            for (int i = 0; i < 3; ++i)
#pragma unroll
                for (int q = 0; q < 2; ++q) { const f32x4 a = *(const f32x4*)(cw + i * NUP + j0 + 4 * q), g = *(const f32x4*)(cw + i * NUP + DFF + j0 + 4 * q);
#pragma unroll
                    for (int e = 0; e < 4; ++e) { wa[i][4 * q + e] = a[e]; wg[i][4 * q + e] = g[e]; } }
#pragma unroll
            for (int q = 0; q < 2; ++q) { const f32x4 a = *(const f32x4*)(cb + j0 + 4 * q), g = *(const f32x4*)(cb + DFF + j0 + 4 * q);
#pragma unroll
                for (int e = 0; e < 4; ++e) { ba[4 * q + e] = a[e]; bg[4 * q + e] = g[e]; } }
#pragma unroll
            for (int side = 0; side < 2; ++side) {
                if (side == 0 ? !lo_ok : !hi_ok) continue;
                float r[8];
#pragma unroll
                for (int e = 0; e < 8; ++e) { const int w = e >> 1; const bool hi16 = e & 1;
                    float va[3], vg[3];
#pragma unroll
                    for (int k = 0; k < 3; ++k) { const unsigned aw = xa[side + k][w], gw = xg[side + k][w];
                        va[k] = hi16 ? __uint_as_float(aw & 0xffff0000u) : __uint_as_float(aw << 16); vg[k] = hi16 ? __uint_as_float(gw & 0xffff0000u) : __uint_as_float(gw << 16); }
                    if (seam) { if (side == 0) { va[2] = 0.f; vg[2] = 0.f; } else { va[0] = 0.f; vg[0] = 0.f; } }
                    const float av = ba[e] + wa[0][e] * va[0] + wa[1][e] * va[1] + wa[2][e] * va[2];
                    const float gv = bg[e] + wg[0][e] * vg[0] + wg[1][e] * vg[1] + wg[2][e] * vg[2];
                    r[e] = gv * sigmoidf_(gv) * av; }
                u32x4 w; w.x = cvt_pk_bf16(r[0], r[1]); w.y = cvt_pk_bf16(r[2], r[3]); w.z = cvt_pk_bf16(r[4], r[5]); w.w = cvt_pk_bf16(r[6], r[7]);
                *(u32x4*)(ACT + (size_t)(bd * 16 - 1 + side) * DFF + j0) = w;
            }
        }
    }
    SEAM(9);

    if (IN(10)) {
        unsigned char* const wsb = A.ws; unsigned char* const dob = (unsigned char*)A.out; (void)wsb; (void)dob;
        pg8::Order S; S.init(64, 4, G, bx, 0);
        pg8::Gemm g{ACT, WDN, DFF, DFF, DFF}; EpiDown E{(float*)dob, mod, AQ, A.norm2_w};
        pg8::gemm_phase<EpiDown, pg8::Order, false>(lds, g, S, E);
    }
#undef IN
#undef SEAM
}
#undef A

extern "C" void kernel_launch(void* const* d_in, const int* in_sizes, int n_in, void* d_out, int out_size, void* d_ws, size_t ws_size, hipStream_t stream) {
    static int grid = 0;
    if (grid == 0) {
        if (n_in != 21 || out_size != ML * D || ws_size < WS_END) { fprintf(stderr, "kernel_launch: unexpected shapes (n_in %d out %d ws %zu)\n", n_in, out_size, ws_size); grid = -1; return; }
        int dev = 0, cus = 0, per_cu = 0;
        hipGetDevice(&dev); hipDeviceGetAttribute(&cus, hipDeviceAttributeMultiprocessorCount, dev);
        hipFuncSetAttribute((const void*)fwd_kernel, hipFuncAttributeMaxDynamicSharedMemorySize, LDS_BYTES);
        hipOccupancyMaxActiveBlocksPerMultiprocessor(&per_cu, (const void*)fwd_kernel, 512, LDS_BYTES);
        if (per_cu < 1) { fprintf(stderr, "kernel_launch: occupancy query says %d blocks per CU\n", per_cu); per_cu = 1; }
        grid = cus * per_cu;
        (void)hipGetLastError();
    }
    if (grid < 0) return;
    Args a{};
    const float** pp = (const float**)&a;
    for (int i = 0; i < 21; ++i) pp[i] = (const float*)d_in[i];
    a.out = (float*)d_out; a.ws = (unsigned char*)d_ws;
#if ONE_LAUNCH
    a.ph_lo = 0; a.ph_hi = 11;
    void* args[] = {&a};
    hipError_t e = hipLaunchCooperativeKernel((const void*)fwd_kernel, dim3(grid), dim3(512), args, LDS_BYTES, stream);
    if (e != hipSuccess) fprintf(stderr, "cooperative launch failed: %s (grid %d)\n", hipGetErrorString(e), grid);
#else
    for (int p = 0; p < 11; ++p) { a.ph_lo = p; a.ph_hi = p + 1; hipLaunchKernelGGL(fwd_kernel, dim3(grid), dim3(512), LDS_BYTES, stream, a); }

#endif
}
```

```cpp
#include <hip/hip_runtime.h>
#include <hip/hip_cooperative_groups.h>
#include <cstdio>
#include <cstdint>
namespace cg = cooperative_groups;

#ifndef RPT_MASK
#define RPT_MASK 0
#endif
#ifndef ONE_LAUNCH
#define ONE_LAUNCH 1
#endif

#define LAS __attribute__((address_space(3)))
typedef unsigned short bf16_t;
typedef short bf16x8 __attribute__((ext_vector_type(8)));
typedef float f32x4 __attribute__((ext_vector_type(4)));
typedef unsigned u32x4 __attribute__((ext_vector_type(4)));
typedef unsigned u32x2 __attribute__((ext_vector_type(2)));

constexpr int D = 1024, NB = 8, SEQ = 2048, CTX = 256;
constexpr int ML = NB * SEQ;
constexpr int MC = NB * CTX;
constexpr int MT = ML + MC;
constexpr int DFF = 2816, NUP = 2 * DFF, INW = 6672;
constexpr float EPS = 1e-6f;
constexpr size_t MiB = 1u << 20;
constexpr size_t WS_ZERO = 0;
constexpr size_t WS_MOD = 0, WS_FB = 256 * 1024, WS_RSQ = 512 * 1024;
constexpr size_t WS_MODP = 236 * MiB + 12 * MiB;
constexpr size_t WS_RSQP = 252 * MiB;
constexpr size_t DO_FBP = 60 * MiB;
constexpr size_t WS_ROPE = 1 * MiB;
constexpr size_t WS_GATES = 2 * MiB;
constexpr size_t WS_WBA = 4 * MiB, WS_WBM = 6 * MiB, WS_WO = 8 * MiB, WS_WUP = 10 * MiB, WS_WDN = 21 * MiB;
constexpr size_t WS_AQ = 27 * MiB;
constexpr size_t WS_MQ = 59 * MiB, WS_MK = 75 * MiB  , WS_MO = 93 * MiB, WS_GA = 125 * MiB, WS_GM = 157 * MiB, WS_XT = 189 * MiB  ;
constexpr size_t WS_T1 = 59 * MiB, WS_Y = 189 * MiB;
constexpr size_t WS_U = 59 * MiB;
constexpr size_t WS_HALO = 236 * MiB;
constexpr size_t WS_ACT = 59 * MiB;
constexpr size_t WS_RAW = 147 * MiB;
constexpr size_t WS_END = 256 * MiB;
constexpr size_t DO_H = 0, DO_W1T = 36 * MiB, DO_W2T = 47 * MiB, DO_AK = 51 * MiB;
constexpr size_t DO_HF = 0, DO_HB = 32 * MiB;
constexpr int LDS_BYTES = 157696;

typedef float f32x2_t __attribute__((ext_vector_type(2))); typedef __bf16 bf16x2_t __attribute__((ext_vector_type(2)));
__device__ __forceinline__ unsigned cvt_pk_bf16(float lo, float hi) { f32x2_t v = {lo, hi}; bf16x2_t b = __builtin_convertvector(v, bf16x2_t); return __builtin_bit_cast(unsigned, b); }
__device__ __forceinline__ float bf2f(unsigned short v) { return __uint_as_float((unsigned)v << 16); }
__device__ __forceinline__ bf16_t f2bf(float f) { return (bf16_t)(cvt_pk_bf16(f, 0.f) & 0xffffu); }
__device__ __forceinline__ u32x4 pack8(f32x4 a, f32x4 b) { u32x4 w; w.x = cvt_pk_bf16(a[0], a[1]); w.y = cvt_pk_bf16(a[2], a[3]); w.z = cvt_pk_bf16(b[0], b[1]); w.w = cvt_pk_bf16(b[2], b[3]); return w; }
__device__ __forceinline__ float sigmoidf_(float x) { return 1.f / (1.f + __expf(-x)); }
__device__ __forceinline__ float wave_sum(float v) {
#pragma unroll
    for (int o = 1; o < 64; o <<= 1) v += __shfl_xor(v, o);
    return v;
}

namespace pg8 {
constexpr int BM = 256, BK = 64, HALF = 128, HTB = HALF * BK * 2, STAGE_BYTES = 8 * HTB, NXCD = 8, WGM = 8;
__host__ __device__ __forceinline__ int lds_byte(int r, int c) { const int st = (r >> 4) * 2 + (c >> 5), rr = r & 15, cc = c & 31, ob = rr * 64 + cc * 2; return st * 1024 + (ob ^ (((ob >> 9) & 1) << 5)); }
__host__ __device__ __forceinline__ void stage_rc(int b, int& R, int& C) { const int st = b / 1024, sb = b % 1024, swz = sb ^ (((sb >> 9) & 1) << 5); R = (st >> 1) * 16 + swz / 64; C = (st & 1) * 32 + (swz % 64) / 2; }
__host__ __device__ __forceinline__ int perm32(int rho) { const int n = rho >> 4, i = rho & 15; return 8 * (i >> 2) + 4 * n + (i & 3); }

struct Unit { int pm, pn; };
struct Gemm { const bf16_t* A; const bf16_t* Bt; int lda, ldb, K; const bf16_t* A2 = nullptr; const bf16_t* Bt2 = nullptr; };

struct Order {
    int nM, nN, nwg, G, c, extra;
    __device__ __forceinline__ void init(int nM_, int nN_, int G_, int c_, int extra_) { nM = nM_; nN = nN_; nwg = nM_ * nN_; G = G_; c = c_; extra = extra_; }
    __device__ __forceinline__ bool next(int i, Unit& u) const {
        const long Lq = (long)i * G + c; if (Lq >= nwg + extra) return false;
        if (Lq >= nwg) { const int e = (int)(Lq - nwg); u.pm = nM + e / 3; u.pn = e % 3; return true; }
        int wgid = (int)Lq; { const int q = nwg / NXCD, r = nwg % NXCD, xcd = wgid % NXCD, off = wgid / NXCD; wgid = (xcd < r ? xcd * (q + 1) : r * (q + 1) + (xcd - r) * q) + off; }
        const int nig = WGM * nN, gid = wgid / nig, fm = gid * WGM, gsz = (nM - fm) < WGM ? (nM - fm) : WGM;
        u.pm = fm + ((wgid % nig) % gsz); u.pn = (wgid % nig) / gsz; return true;
    }
};

template <class Epi, class Sched, bool ALIGN_EPI, bool DUAL = false>
__device__ __forceinline__ void gemm_phase(LAS unsigned char* lds, const Gemm g, const Sched& S, const Epi& E) {
    int tid_ = threadIdx.x; asm volatile("" : "+v"(tid_));
    const int tid = tid_, wid = __builtin_amdgcn_readfirstlane(tid >> 6), lane = tid & 63, wr = wid >> 2, wc = wid & 3, fr = lane & 15, fq = lane >> 4;
    const int K = g.K, nt1 = K / BK, nt = DUAL ? 2 * nt1 : nt1;
    unsigned voffA[2], voffB[2];
#pragma unroll
    for (int i = 0; i < 2; ++i) { int R, C; stage_rc(tid * 16 + i * 8192, R, C); const int Rb = ((R & ~31) + perm32(R & 31));
        voffA[i] = (unsigned)(R * g.lda + C) * 2u; voffB[i] = (unsigned)(Rb * g.ldb + C) * 2u; }
    const size_t kstep = (size_t)(BK * 2);
    const size_t hstepA = (size_t)HALF * g.lda * 2, hstepB = (size_t)HALF * g.ldb * 2;
    const size_t tstepA = 2 * hstepA, tstepB = 2 * hstepB;
    const unsigned ldsw = (unsigned)wid * 1024u;
    const int aoff = lds_byte(wr * 64 + fr, fq * 8), boff = lds_byte(wc * 32 + fr, fq * 8);
#define PG8_SA(b, h) (((b) * 2 + (h)) * HTB)
#define PG8_SB(b, h) ((4 + (b) * 2 + (h)) * HTB)
#define PG8_STAGE(bufoff, gbase, voff) do { _Pragma("unroll") for (int _i = 0; _i < 2; ++_i) \
        __builtin_amdgcn_global_load_lds((const unsigned*)((const char*)(gbase) + (voff)[_i]), (LAS unsigned*)(lds + (bufoff) + ldsw + _i * 8192), 16, 0, 0); } while (0)
#define PG8_LDA(dst, b, h) do { _Pragma("unroll") for (int m = 0; m < 4; ++m) _Pragma("unroll") for (int k = 0; k < 2; ++k) dst[m][k] = *(const LAS bf16x8*)(lds + PG8_SA(b, h) + aoff + m * 2048 + k * 1024); } while (0)
#define PG8_LDB(dst, b, h) do { _Pragma("unroll") for (int n = 0; n < 2; ++n) _Pragma("unroll") for (int k = 0; k < 2; ++k) dst[n][k] = *(const LAS bf16x8*)(lds + PG8_SB(b, h) + boff + n * 2048 + k * 1024); } while (0)
#define PG8_MMA(ai, bj, At, Bt) do { __builtin_amdgcn_s_setprio(1); _Pragma("unroll") for (int m = 0; m < 4; ++m) _Pragma("unroll") for (int n = 0; n < 2; ++n) _Pragma("unroll") for (int k = 0; k < 2; ++k) \
        acc[ai][bj][m][n] = __builtin_amdgcn_mfma_f32_16x16x32_bf16(Bt[n][k], At[m][k], acc[ai][bj][m][n], 0, 0, 0); __builtin_amdgcn_s_setprio(0); } while (0)
#define PG8_WAIT_V(n) asm volatile("s_waitcnt vmcnt(" #n ")" ::: "memory")
#define PG8_WAIT_L(n) asm volatile("s_waitcnt lgkmcnt(" #n ")" ::: "memory")
#define PG8_BAR __builtin_amdgcn_s_barrier()
#define PG8_SCHED __builtin_amdgcn_sched_barrier(0)
    Unit cur, nxt; int ui = 0;
    if (!S.next(0, cur)) return;
    f32x4 acc[2][2][4][2];
#pragma unroll
    for (int a = 0; a < 2; ++a)
#pragma unroll
        for (int b = 0; b < 2; ++b)
#pragma unroll
            for (int m = 0; m < 4; ++m)
#pragma unroll
                for (int n = 0; n < 2; ++n) acc[a][b][m][n] = (f32x4){0.f, 0.f, 0.f, 0.f};
    bf16x8 At[4][2], B0[2][2], B1[2][2];
    const char* cA = (const char*)g.A + (size_t)cur.pm * tstepA; const char* cB = (const char*)g.Bt + (size_t)cur.pn * tstepB;
    const char* cA2 = DUAL ? (const char*)g.A2 + (size_t)cur.pm * tstepA : cA; const char* cB2 = DUAL ? (const char*)g.Bt2 + (size_t)cur.pn * tstepB : cB;
    PG8_STAGE(PG8_SB(0, 0), cB, voffB); PG8_STAGE(PG8_SB(0, 1), cB + hstepB, voffB); PG8_STAGE(PG8_SA(0, 0), cA, voffA); PG8_STAGE(PG8_SA(0, 1), cA + hstepA, voffA);
    if (wr == 1) PG8_BAR;
    PG8_WAIT_V(2); PG8_BAR;
    PG8_STAGE(PG8_SB(1, 0), cB + kstep, voffB); PG8_STAGE(PG8_SA(1, 0), cA + kstep, voffA); PG8_STAGE(PG8_SB(1, 1), cB + hstepB + kstep, voffB);
    PG8_WAIT_V(6); PG8_BAR;
    for (;;) {
        const bool has_next = S.next(ui + 1, nxt);
        const char* nA = has_next ? (const char*)g.A + (size_t)nxt.pm * tstepA : cA; const char* nB = has_next ? (const char*)g.Bt + (size_t)nxt.pn * tstepB : cB;
        for (int t = 0; t < nt; t += 2) {
            const bool last = (t == nt - 2);
            const bool seg2 = DUAL && t >= nt1, seg2n = DUAL && t + 2 >= nt1;
            const char* a1 = seg2 ? cA2 + (size_t)(t + 1 - nt1) * kstep : cA + (size_t)(t + 1) * kstep;
            const char* a2 = last ? nA : (seg2n ? cA2 + (size_t)(t + 2 - nt1) * kstep : cA + (size_t)(t + 2) * kstep);
            const char* b2 = last ? nB : (seg2n ? cB2 + (size_t)(t + 2 - nt1) * kstep : cB + (size_t)(t + 2) * kstep);
            if constexpr (DUAL) { if (t == nt1) E.mid(acc, cur, wr, wc, fr, fq); }
            const char* a3 = a2 + kstep; const char* b3 = b2 + kstep;
            PG8_LDB(B0, 0, 0); PG8_LDB(B1, 0, 1); PG8_SCHED; PG8_LDA(At, 0, 0); PG8_STAGE(PG8_SA(1, 1), a1 + hstepA, voffA);
            PG8_WAIT_V(8); PG8_WAIT_L(0); PG8_BAR; PG8_MMA(0, 0, At, B0); PG8_MMA(0, 1, At, B1); PG8_BAR; PG8_SCHED;
            PG8_LDA(At, 0, 1); PG8_STAGE(PG8_SB(0, 0), b2, voffB); PG8_STAGE(PG8_SB(0, 1), b2 + hstepB, voffB); PG8_STAGE(PG8_SA(0, 0), a2, voffA);
            PG8_WAIT_V(8); PG8_WAIT_L(0); PG8_BAR; PG8_MMA(1, 0, At, B0); PG8_MMA(1, 1, At, B1); PG8_BAR; PG8_SCHED;
            PG8_LDB(B0, 1, 0); PG8_LDB(B1, 1, 1); PG8_SCHED; PG8_LDA(At, 1, 0); PG8_STAGE(PG8_SA(0, 1), a2 + hstepA, voffA);
            PG8_WAIT_V(8); PG8_WAIT_L(0); PG8_BAR; PG8_MMA(0, 0, At, B0); PG8_MMA(0, 1, At, B1); PG8_BAR; PG8_SCHED;
            PG8_LDA(At, 1, 1); PG8_STAGE(PG8_SB(1, 0), b3, voffB); PG8_STAGE(PG8_SB(1, 1), b3 + hstepB, voffB); PG8_STAGE(PG8_SA(1, 0), a3, voffA);
            PG8_WAIT_V(8); PG8_WAIT_L(0); PG8_BAR; PG8_MMA(1, 0, At, B0); PG8_MMA(1, 1, At, B1); PG8_BAR; PG8_SCHED;
        }
        if constexpr (ALIGN_EPI) { if (wr == 0) PG8_BAR; }
        E(acc, cur, wr, wc, fr, fq);
        if (!has_next) break;
#pragma unroll
        for (int a = 0; a < 2; ++a)
#pragma unroll
            for (int b = 0; b < 2; ++b)
#pragma unroll
                for (int m = 0; m < 4; ++m)
#pragma unroll
                    for (int n = 0; n < 2; ++n) acc[a][b][m][n] = (f32x4){0.f, 0.f, 0.f, 0.f};
        cur = nxt; cA = nA; cB = nB; ++ui;
        if constexpr (DUAL) { cA2 = (const char*)g.A2 + (size_t)cur.pm * tstepA; cB2 = (const char*)g.Bt2 + (size_t)cur.pn * tstepB; }
        if constexpr (ALIGN_EPI) { if (wr == 1) PG8_BAR; }
    }
    PG8_WAIT_V(0);
    if constexpr (!ALIGN_EPI) { if (wr == 0) PG8_BAR; }
    PG8_BAR;
#undef PG8_SA
#undef PG8_SB
#undef PG8_STAGE
#undef PG8_LDA
#undef PG8_LDB
#undef PG8_MMA
#undef PG8_WAIT_V
#undef PG8_WAIT_L
#undef PG8_BAR
#undef PG8_SCHED
}
}
using pg8::Unit;
typedef const f32x4 (&AccRef)[2][2][4][2];

struct EpiIn {
    bf16_t *AK_, *MK_, *AQ_, *MQ_, *MO_, *GA_, *GM_; const float *qnw, *knw, *cosT_, *sinT_;
    __device__ __forceinline__ void head_path(AccRef acc, const Unit& u, int wr, int wc, int fr, int fq_in, bf16_t* base, int ld, int coff, const float* nw) const {
        int fq = fq_in; asm volatile("" : "+v"(fq));
        const int row0 = u.pm * 256 + wr * 64 + fr;
        const bool rope = u.pm < 64;
#pragma unroll
        for (int ai = 0; ai < 2; ++ai)
#pragma unroll
            for (int m = 0; m < 4; ++m) {
                const int row = row0 + ai * 128 + m * 16;
                f32x4 v00 = acc[ai][0][m][0], v01 = acc[ai][0][m][1], v10 = acc[ai][1][m][0], v11 = acc[ai][1][m][1];
                f32x4 q = v00 * v00 + v01 * v01 + v10 * v10 + v11 * v11;
                float ss = (q[0] + q[1]) + (q[2] + q[3]);
                ss += __shfl_xor(ss, 16); ss += __shfl_xor(ss, 32);
                const float rs = rsqrtf(ss * (1.f / 64.f) + EPS);
                v00 = v00 * rs * *(const f32x4*)(nw + 8 * fq); v01 = v01 * rs * *(const f32x4*)(nw + 8 * fq + 4); v10 = v10 * rs * *(const f32x4*)(nw + 32 + 8 * fq); v11 = v11 * rs * *(const f32x4*)(nw + 32 + 8 * fq + 4);
                f32x4 o00 = v00, o01 = v01, o10 = v10, o11 = v11;
                if (rope) {
                    const int t = row & 2047;
                    const f32x4 c0 = *(const f32x4*)(cosT_ + t * 32 + 8 * fq), c1 = *(const f32x4*)(cosT_ + t * 32 + 8 * fq + 4);
                    const f32x4 s0 = *(const f32x4*)(sinT_ + t * 32 + 8 * fq), s1 = *(const f32x4*)(sinT_ + t * 32 + 8 * fq + 4);
                    o00 = v00 * c0 - v10 * s0; o01 = v01 * c1 - v11 * s1; o10 = v00 * s0 + v10 * c0; o11 = v01 * s1 + v11 * c1;
                }
                bf16_t* p = base + (size_t)row * ld + coff + wc * 64 + 8 * fq;
                *(u32x4*)p = pack8(o00, o01); *(u32x4*)(p + 32) = pack8(o10, o11);
                asm volatile("" ::: "memory");
            }
    }
    template <bool SIG> __device__ __forceinline__ void plain_path(AccRef acc, const Unit& u, int wr, int wc, int fr, int fq, bf16_t* base, int ld, int coff) const {
        const int row0 = u.pm * 256 + wr * 64 + fr;
#pragma unroll
        for (int ai = 0; ai < 2; ++ai)
#pragma unroll
            for (int m = 0; m < 4; ++m) {
                bf16_t* p = base + (size_t)(row0 + ai * 128 + m * 16) * ld + coff + wc * 32 + 8 * fq;
#pragma unroll
                for (int bj = 0; bj < 2; ++bj) { f32x4 v0 = acc[ai][bj][m][0], v1 = acc[ai][bj][m][1];
                    if (SIG) {
#pragma unroll
                        for (int e = 0; e < 4; ++e) { v0[e] = sigmoidf_(v0[e]); v1[e] = sigmoidf_(v1[e]); } }
                    *(u32x4*)(p + bj * 128) = pack8(v0, v1); }
            }
    }
    __device__ __forceinline__ void operator()(AccRef acc, const Unit& u, int wr, int wc, int fr, int fq) const {
        const int pn = u.pn;
        if (pn == 0) head_path(acc, u, wr, wc, fr, fq, AK_, 256, 0, knw);
        else if (pn <= 2) plain_path<false>(acc, u, wr, wc, fr, fq, MK_, 512, (pn - 1) * 256);
        else if (pn <= 6) head_path(acc, u, wr, wc, fr, fq, AQ_, 1024, (pn - 3) * 256, qnw);
        else if (pn <= 8) plain_path<false>(acc, u, wr, wc, fr, fq, MQ_, 512, (pn - 7) * 256);
        else if (pn <= 12) plain_path<false>(acc, u, wr, wc, fr, fq, MO_, 1024, (pn - 9) * 256);
        else if (pn <= 16) plain_path<true>(acc, u, wr, wc, fr, fq, GA_, 1024, (pn - 13) * 256);
        else plain_path<true>(acc, u, wr, wc, fr, fq, GM_, 1024, (pn - 17) * 256);
    }
};
struct EpiPlain {
    bf16_t* O; int ldc;
    __device__ __forceinline__ void operator()(AccRef acc, const Unit& u, int wr, int wc, int fr, int fq) const {
        const int row0 = u.pm * 256 + wr * 64 + fr;
#pragma unroll
        for (int ai = 0; ai < 2; ++ai)
#pragma unroll
            for (int m = 0; m < 4; ++m) {
                bf16_t* p = O + (size_t)(row0 + ai * 128 + m * 16) * ldc + u.pn * 256 + wc * 32 + 8 * fq;
#pragma unroll
                for (int bj = 0; bj < 2; ++bj) *(u32x4*)(p + bj * 128) = pack8(acc[ai][bj][m][0], acc[ai][bj][m][1]);
            }
    }
};
template <bool ADD> struct EpiGate {
    const bf16_t* Gt; const bf16_t* T; bf16_t* O;
    __device__ __forceinline__ void operator()(AccRef acc, const Unit& u, int wr, int wc, int fr, int fq) const {
        const int row0 = u.pm * 256 + wr * 64 + fr;
        const size_t off0 = (size_t)row0 * 1024 + u.pn * 256 + wc * 32 + 8 * fq;
        u32x4 gv[2][2], tv[2][2];
#pragma unroll
        for (int bj = 0; bj < 2; ++bj) { gv[0][bj] = *(const u32x4*)(Gt + off0 + bj * 128); tv[0][bj] = (u32x4){0u, 0u, 0u, 0u}; if (ADD) tv[0][bj] = *(const u32x4*)(T + off0 + bj * 128); }
#pragma unroll
        for (int it = 0; it < 8; ++it) {
            const int ai = it >> 2, m = it & 3, cur = it & 1, nx = cur ^ 1;
            const size_t off = off0 + (size_t)(ai * 128 + m * 16) * 1024;
            if (it < 7) { const size_t offn = off0 + (size_t)(((it + 1) >> 2) * 128 + ((it + 1) & 3) * 16) * 1024;
#pragma unroll
                for (int bj = 0; bj < 2; ++bj) { gv[nx][bj] = *(const u32x4*)(Gt + offn + bj * 128); tv[nx][bj] = (u32x4){0u, 0u, 0u, 0u}; if (ADD) tv[nx][bj] = *(const u32x4*)(T + offn + bj * 128); } }
#pragma unroll
            for (int bj = 0; bj < 2; ++bj) {
                float r[8];
#pragma unroll
                for (int e = 0; e < 8; ++e) {
                    const unsigned gw = gv[cur][bj][e >> 1], tw = tv[cur][bj][e >> 1];
                    const float gg = (e & 1) ? __uint_as_float(gw & 0xffff0000u) : __uint_as_float(gw << 16);
                    const float tt = (e & 1) ? __uint_as_float(tw & 0xffff0000u) : __uint_as_float(tw << 16);
                    r[e] = tt + sigmoidf_(gg) * acc[ai][bj][m][e >> 2][e & 3];
                }
                u32x4 w; w.x = cvt_pk_bf16(r[0], r[1]); w.y = cvt_pk_bf16(r[2], r[3]); w.z = cvt_pk_bf16(r[4], r[5]); w.w = cvt_pk_bf16(r[6], r[7]);
                *(u32x4*)(O + off + bj * 128) = w;
            }
        }
    }
};
struct EpiMerge {
    const bf16_t* Sa; const bf16_t* Sm; bf16_t* O;
    __device__ __forceinline__ void mid(f32x4 (&acc)[2][2][4][2], const Unit& u, int wr, int wc, int fr, int fq) const {
        const size_t off0 = (size_t)(u.pm * 256 + wr * 64 + fr) * 1024 + u.pn * 256 + wc * 32 + 8 * fq;
        u32x4 av[2][2], mv[2][2];
#pragma unroll
        for (int bj = 0; bj < 2; ++bj) { av[0][bj] = *(const u32x4*)(Sa + off0 + bj * 128); mv[0][bj] = *(const u32x4*)(Sm + off0 + bj * 128); }
#pragma unroll
        for (int it = 0; it < 8; ++it) {
            const int ai = it >> 2, m = it & 3, cur = it & 1, nx = cur ^ 1;
            if (it < 7) { const size_t offn = off0 + (size_t)(((it + 1) >> 2) * 128 + ((it + 1) & 3) * 16) * 1024;
#pragma unroll
                for (int bj = 0; bj < 2; ++bj) { av[nx][bj] = *(const u32x4*)(Sa + offn + bj * 128); mv[nx][bj] = *(const u32x4*)(Sm + offn + bj * 128); } }
#pragma unroll
            for (int bj = 0; bj < 2; ++bj)
#pragma unroll
                for (int e = 0; e < 8; ++e) {
                    const unsigned aw = av[cur][bj][e >> 1], mw = mv[cur][bj][e >> 1];
                    const float sa = (e & 1) ? __uint_as_float(aw & 0xffff0000u) : __uint_as_float(aw << 16);
                    const float sm = (e & 1) ? __uint_as_float(mw & 0xffff0000u) : __uint_as_float(mw << 16);
                    acc[ai][bj][m][e >> 2][e & 3] *= sa * __builtin_amdgcn_rcpf(fmaxf(sm, 1e-30f));
                }
        }
    }
    __device__ __forceinline__ void operator()(AccRef acc, const Unit& u, int wr, int wc, int fr, int fq) const {
        const size_t off0 = (size_t)(u.pm * 256 + wr * 64 + fr) * 1024 + u.pn * 256 + wc * 32 + 8 * fq;
        u32x4 mv[2][2];
#pragma unroll
        for (int bj = 0; bj < 2; ++bj) mv[0][bj] = *(const u32x4*)(Sm + off0 + bj * 128);
#pragma unroll
        for (int it = 0; it < 8; ++it) {
            const int ai = it >> 2, m = it & 3, cur = it & 1, nx = cur ^ 1;
            const size_t off = off0 + (size_t)(ai * 128 + m * 16) * 1024;
            if (it < 7) { const size_t offn = off0 + (size_t)(((it + 1) >> 2) * 128 + ((it + 1) & 3) * 16) * 1024;
#pragma unroll
                for (int bj = 0; bj < 2; ++bj) mv[nx][bj] = *(const u32x4*)(Sm + offn + bj * 128); }
#pragma unroll
            for (int bj = 0; bj < 2; ++bj) { float r[8];
#pragma unroll
                for (int e = 0; e < 8; ++e) { const unsigned mw = mv[cur][bj][e >> 1];
                    const float sm = (e & 1) ? __uint_as_float(mw & 0xffff0000u) : __uint_as_float(mw << 16);
                    r[e] = fmaxf(sm, 1e-30f) * acc[ai][bj][m][e >> 2][e & 3]; }
                u32x4 w; w.x = cvt_pk_bf16(r[0], r[1]); w.y = cvt_pk_bf16(r[2], r[3]); w.z = cvt_pk_bf16(r[4], r[5]); w.w = cvt_pk_bf16(r[6], r[7]);
                *(u32x4*)(O + off + bj * 128) = w; }
        }
    }
};
struct EpiOut {
    const float* x; const float* mod; const float* nw2; float* xmid; bf16_t* AP; float* rowsq;
    __device__ __forceinline__ void operator()(AccRef acc, const Unit& u, int wr, int wc, int fr, int fq) const {
        const int b = u.pm >> 3; const float* mb = mod + b * 6144;
        const int row0 = u.pm * 256 + wr * 64 + fr, col0 = u.pn * 256 + wc * 32 + 8 * fq;
        f32x4 g1[2][2], sw[2][2];
#pragma unroll
        for (int bj = 0; bj < 2; ++bj)
#pragma unroll
            for (int n = 0; n < 2; ++n) { const int c = col0 + bj * 128 + 4 * n; g1[bj][n] = *(const f32x4*)(mb + 2048 + c);
                sw[bj][n] = *(const f32x4*)(nw2 + c) * (*(const f32x4*)(mb + 4096 + c) + 1.f); }
        f32x4 xv[2][2][2];
#pragma unroll
        for (int bj = 0; bj < 2; ++bj)
#pragma unroll
            for (int n = 0; n < 2; ++n) xv[0][bj][n] = *(const f32x4*)(x + (size_t)row0 * 1024 + col0 + bj * 128 + 4 * n);
#pragma unroll
        for (int it = 0; it < 8; ++it) {
            const int ai = it >> 2, m = it & 3, cur = it & 1, nx = cur ^ 1;
            const int row = row0 + ai * 128 + m * 16; const size_t off = (size_t)row * 1024 + col0; float ss = 0.f;
            if (it < 7) { const size_t offn = (size_t)(row0 + ((it + 1) >> 2) * 128 + ((it + 1) & 3) * 16) * 1024 + col0;
#pragma unroll
                for (int bj = 0; bj < 2; ++bj)
#pragma unroll
                    for (int n = 0; n < 2; ++n) xv[nx][bj][n] = *(const f32x4*)(x + offn + bj * 128 + 4 * n); }
#pragma unroll
            for (int bj = 0; bj < 2; ++bj) {
                f32x4 v[2];
#pragma unroll
                for (int n = 0; n < 2; ++n) { v[n] = xv[cur][bj][n] + g1[bj][n] * acc[ai][bj][m][n];
                    const f32x4 q = v[n] * v[n]; ss += (q[0] + q[1]) + (q[2] + q[3]); }
                *(u32x4*)(AP + off + bj * 128) = pack8(v[0] * sw[bj][0], v[1] * sw[bj][1]);
            }
            ss += __shfl_xor(ss, 16); ss += __shfl_xor(ss, 32);
            if (fq == 0) rowsq[(size_t)row * 16 + u.pn * 4 + wc] = ss;
        }
    }
};
__device__ __forceinline__ float dpp_prev(float v) { return __int_as_float(__builtin_amdgcn_update_dpp(0, __float_as_int(v), 0x111, 0xf, 0xf, true)); }
__device__ __forceinline__ float dpp_next(float v) { return __int_as_float(__builtin_amdgcn_update_dpp(0, __float_as_int(v), 0x101, 0xf, 0xf, true)); }
struct EpiUp {
    const float* rowsq; const float* fb; const float* cw; const float* cb; bf16_t* ACT_; bf16_t* RAW_; LAS float* sp;
    __device__ __forceinline__ void operator()(AccRef acc, const Unit& u, int wr, int wc, int fr, int fq) const {
        const int b = u.pm >> 3; const int row0 = u.pm * 256 + wr * 64 + fr;
        int tx = threadIdx.x; asm volatile("" : "+v"(tx));
        if (tx < 256) {
            const float* qp = rowsq + (size_t)(u.pm * 256 + tx) * 16; const f32x4 q0 = *(const f32x4*)qp, q1 = *(const f32x4*)(qp + 4), q2 = *(const f32x4*)(qp + 8), q3 = *(const f32x4*)(qp + 12);
            const f32x4 qs = (q0 + q1) + (q2 + q3); sp[1280 + tx] = rsqrtf(((qs[0] + qs[1]) + (qs[2] + qs[3])) * (1.f / 1024.f) + EPS);
        } else {
            for (int i = tx - 256; i < 1280; i += 256) { const int vec = i >> 7, j = u.pn * 128 + (i & 127);
                const float* src = vec == 0 ? fb + b * NUP + j : vec == 1 ? fb + b * NUP + DFF + j : vec < 5 ? cw + (vec - 2) * NUP + j : vec < 8 ? cw + (vec - 5) * NUP + DFF + j : vec == 8 ? cb + j : cb + DFF + j;
                sp[i] = *src; } }
        asm volatile("s_waitcnt vmcnt(0) lgkmcnt(0)" ::: "memory"); __builtin_amdgcn_s_barrier(); asm volatile("" ::: "memory");
        const LAS float* spc = sp + wc * 32 + 8 * fq;
        const int jb = u.pn * 128 + wc * 32 + 8 * fq;
        const int pcol = u.pn * 256 + wc * 32 + 8 * fq;
        const bool interior = (fr >= 1) && (fr <= 14), rawrow = !((fr >= 2) && (fr <= 13));
        const int slot = fr < 2 ? fr : fr - 12;
#pragma unroll
        for (int ai = 0; ai < 2; ++ai)
#pragma unroll
            for (int m = 0; m < 4; ++m) {
                const int row = row0 + ai * 128 + m * 16; const float rstd = sp[1280 + ai * 128 + wr * 64 + m * 16 + fr];
                float r[8]; f32x4 ua[2], ug[2];
#pragma unroll
                for (int n = 0; n < 2; ++n) {
                    ua[n] = acc[ai][0][m][n] * rstd + *(const LAS f32x4*)(spc + 0 * 128 + 4 * n);
                    ug[n] = acc[ai][1][m][n] * rstd + *(const LAS f32x4*)(spc + 1 * 128 + 4 * n);
                    const f32x4 wa0 = *(const LAS f32x4*)(spc + 2 * 128 + 4 * n), wa1 = *(const LAS f32x4*)(spc + 3 * 128 + 4 * n), wa2 = *(const LAS f32x4*)(spc + 4 * 128 + 4 * n);
                    const f32x4 wg0 = *(const LAS f32x4*)(spc + 5 * 128 + 4 * n), wg1 = *(const LAS f32x4*)(spc + 6 * 128 + 4 * n), wg2 = *(const LAS f32x4*)(spc + 7 * 128 + 4 * n);
                    const f32x4 ba = *(const LAS f32x4*)(spc + 8 * 128 + 4 * n), bg = *(const LAS f32x4*)(spc + 9 * 128 + 4 * n);
#pragma unroll
                    for (int e = 0; e < 4; ++e) {
                        const float av = ba[e] + wa0[e] * dpp_prev(ua[n][e]) + wa1[e] * ua[n][e] + wa2[e] * dpp_next(ua[n][e]);
                        const float gv = bg[e] + wg0[e] * dpp_prev(ug[n][e]) + wg1[e] * ug[n][e] + wg2[e] * dpp_next(ug[n][e]);
                        r[4 * n + e] = gv * sigmoidf_(gv) * av;
                    }
                }
                if (interior) { u32x4 w; w.x = cvt_pk_bf16(r[0], r[1]); w.y = cvt_pk_bf16(r[2], r[3]); w.z = cvt_pk_bf16(r[4], r[5]); w.w = cvt_pk_bf16(r[6], r[7]);
                    *(u32x4*)(ACT_ + (size_t)row * DFF + jb) = w; }
                if (rawrow) { bf16_t* rp = RAW_ + ((size_t)(row >> 4) * 4 + slot) * NUP + pcol;
                    *(u32x4*)rp = pack8(ua[0], ua[1]); *(u32x4*)(rp + 128) = pack8(ug[0], ug[1]); }
                asm volatile("" ::: "memory");
            }
    }
};
struct EpiDown {
    float* out; const float* mod; const bf16_t* AP; const float* nw2;
    __device__ __forceinline__ void operator()(AccRef acc, const Unit& u, int wr, int wc, int fr, int fq) const {
        const int b = u.pm >> 3; const float* mb = mod + b * 6144;
        const int row0 = u.pm * 256 + wr * 64 + fr, col0 = u.pn * 256 + wc * 32 + 8 * fq;
        f32x4 g2[2][2], rsw[2][2];
#pragma unroll
        for (int bj = 0; bj < 2; ++bj)
#pragma unroll
            for (int n = 0; n < 2; ++n) { const int c = col0 + bj * 128 + 4 * n; g2[bj][n] = *(const f32x4*)(mb + 5120 + c);
                const f32x4 sw = *(const f32x4*)(nw2 + c) * (*(const f32x4*)(mb + 4096 + c) + 1.f);
#pragma unroll
                for (int e = 0; e < 4; ++e) rsw[bj][n][e] = 1.f / sw[e]; }
        u32x4 av[2][2];
#pragma unroll
        for (int bj = 0; bj < 2; ++bj) av[0][bj] = *(const u32x4*)(AP + (size_t)row0 * 1024 + col0 + bj * 128);
#pragma unroll
        for (int it = 0; it < 8; ++it) {
            const int ai = it >> 2, m = it & 3, cur = it & 1, nx = cur ^ 1;
            const size_t off = (size_t)(row0 + ai * 128 + m * 16) * 1024 + col0;
            if (it < 7) { const size_t offn = (size_t)(row0 + ((it + 1) >> 2) * 128 + ((it + 1) & 3) * 16) * 1024 + col0;
#pragma unroll
                for (int bj = 0; bj < 2; ++bj) av[nx][bj] = *(const u32x4*)(AP + offn + bj * 128); }
#pragma unroll
            for (int bj = 0; bj < 2; ++bj)
#pragma unroll
                for (int n = 0; n < 2; ++n) { const unsigned w0 = av[cur][bj][2 * n], w1 = av[cur][bj][2 * n + 1];
                    const f32x4 ap = (f32x4){__uint_as_float(w0 << 16), __uint_as_float(w0 & 0xffff0000u), __uint_as_float(w1 << 16), __uint_as_float(w1 & 0xffff0000u)};
                    *(f32x4*)(out + off + bj * 128 + 4 * n) = ap * rsw[bj][n] + g2[bj][n] * acc[ai][bj][m][n]; }
        }
    }
};

__device__ __forceinline__ f32x4 mfma16(bf16x8 a, bf16x8 b, f32x4 c) { return __builtin_amdgcn_mfma_f32_16x16x32_bf16(a, b, c, 0, 0, 0); }

__device__ __forceinline__ void transpose_item(const float* W, int ldw, int col, int k0, bf16_t* WT, int dst_row, int dld, LAS float* scr, int lane) {
#pragma unroll 8
    for (int i = 0; i < 32; ++i) { const int kk = 2 * i + (lane >> 5); scr[kk * 33 + (lane & 31)] = W[(size_t)(k0 + kk) * ldw + col + (lane & 31)]; }
    asm volatile("s_waitcnt lgkmcnt(0)" ::: "memory");
    const int c = lane & 7;
#pragma unroll
    for (int j = 0; j < 4; ++j) { const int n = (lane >> 3) + 8 * j; const LAS float* s = scr + (8 * c) * 33 + n;
        u32x4 o; o.x = cvt_pk_bf16(s[0 * 33], s[1 * 33]); o.y = cvt_pk_bf16(s[2 * 33], s[3 * 33]); o.z = cvt_pk_bf16(s[4 * 33], s[5 * 33]); o.w = cvt_pk_bf16(s[6 * 33], s[7 * 33]);
        *(u32x4*)(WT + (size_t)(dst_row + n) * dld + k0 + 8 * c) = o; }
    asm volatile("s_waitcnt lgkmcnt(0)" ::: "memory");
}
__device__ __forceinline__ int headperm(int n0) { const int tile = n0 >> 8, l = n0 & 255; return tile * 256 + 128 * ((l >> 5) & 1) + 32 * (l >> 6); }

struct Args {
    const float *x, *c, *ctx, *c_ctx, *w_mod, *b_mod, *norm1_w, *w_in, *q_norm_w, *k_norm_w, *attn_sink, *ml_gate_b, *ml_norm_w,
        *w_branch_att, *w_branch_ml, *w_out, *norm2_w, *w_up, *conv_w, *conv_b, *w_down;
    float* out; unsigned char* ws; int ph_lo, ph_hi;
};

template <int NV, int KS, bool ATOMIC> __device__ __forceinline__ void gemv_task(const float* W, int ldw, int n0, int k0, const LAS float* svec, float* out, int ldo) {
    const int n = n0 + threadIdx.x; float a[NV];
#pragma unroll
    for (int v = 0; v < NV; ++v) a[v] = 0.f;
#pragma unroll 16
    for (int k = 0; k < KS; ++k) { const float w = W[(size_t)(k0 + k) * ldw + n];
#pragma unroll
        for (int v = 0; v < NV; ++v) a[v] += svec[v * KS + k] * w; }
#pragma unroll
    for (int v = 0; v < NV; ++v) { if (ATOMIC) atomicAdd(out + (size_t)v * ldo + n, a[v]); else out[(size_t)v * ldo + n] = a[v]; }
}

#define mod   ((float*)(wsb + WS_MOD))
#define modp  ((float*)(wsb + WS_MODP))
#define fbias ((float*)(wsb + WS_FB))
#define rowsq ((float*)(wsb + WS_RSQP))
#define fbp ((float*)(dob + DO_FBP))
#define cosT  ((float*)(wsb + WS_ROPE))
#define sinT  ((float*)(wsb + WS_ROPE) + 2048 * 32)
#define gates ((float*)(wsb + WS_GATES))
#define WBA ((bf16_t*)(wsb + WS_WBA))
#define WBM ((bf16_t*)(wsb + WS_WBM))
#define WO  ((bf16_t*)(wsb + WS_WO))
#define WUP ((bf16_t*)(wsb + WS_WUP))
#define WDN ((bf16_t*)(wsb + WS_WDN))
#define AQ  ((bf16_t*)(wsb + WS_AQ))
#ifdef DBG_ATTO
#define ATTO GA
#else
#define ATTO AQ
#endif
#define MQ  ((bf16_t*)(wsb + WS_MQ))
#define MK  ((bf16_t*)(wsb + WS_MK))
#define MO  ((bf16_t*)(wsb + WS_MO))
#define GA  ((bf16_t*)(wsb + WS_GA))
#define GM  ((bf16_t*)(wsb + WS_GM))
#define XT  ((bf16_t*)(wsb + WS_XT))
#define T1  ((bf16_t*)(wsb + WS_T1))
#define Y   ((bf16_t*)(wsb + WS_Y))
#define U   ((bf16_t*)(wsb + WS_U))
#define HALO ((bf16_t*)(wsb + WS_HALO))
#define ACT ((bf16_t*)(wsb + WS_ACT))
#define RAWU ((bf16_t*)(wsb + WS_RAW))
#define H   ((bf16_t*)(dob + DO_H))
#define W1T ((bf16_t*)(dob + DO_W1T))
#define W2T ((bf16_t*)(dob + DO_W2T))
#define AK  ((bf16_t*)(dob + DO_AK))
#define HF  ((bf16_t*)(dob + DO_HF))
#define HB  ((bf16_t*)(dob + DO_HB))

#define XB_TMO      128
#define XB_XCNT(j)  (256  + 64 * (j))
#define XB_XSUB(j)  (1280 + 64 * (j))
#define XB_XGEN(j)  (2304 + 64 * (j))
#define XB_TOP      3328
#define XB_TOPGEN   3392
#define XCD_BAR_WORDS 3456
#define XB_SPIN_CAP (1u << 18)
__device__ __forceinline__ unsigned xb_ld(unsigned* p)              { return __hip_atomic_load(p, __ATOMIC_RELAXED, __HIP_MEMORY_SCOPE_AGENT); }
__device__ __forceinline__ unsigned xb_add(unsigned* p, unsigned v) { return __hip_atomic_fetch_add(p, v, __ATOMIC_RELAXED, __HIP_MEMORY_SCOPE_AGENT); }
__device__ __forceinline__ unsigned xb_xcc_id() { return (unsigned)__builtin_amdgcn_s_getreg((3 << 11) | 20) & 0xFu; }
#define XB_SPIN(cond, bar) do { unsigned _sp = 0; while (cond) { __builtin_amdgcn_s_sleep(1); \
    if ((++_sp & 255u) == 0u) { if (xb_ld(&(bar)[XB_TMO])) break; if (_sp > XB_SPIN_CAP) { atomicAdd(&(bar)[XB_TMO], 1u); break; } } } } while (0)
struct XcdBarrier { unsigned* bar; unsigned x; volatile LAS unsigned* st; };
__device__ __forceinline__ XcdBarrier xcd_barrier_post(unsigned* bar, volatile LAS unsigned* st) {
    XcdBarrier b; b.bar = bar; b.x = xb_xcc_id(); b.st = st;
    if (threadIdx.x == 0) (void)xb_add(&bar[XB_XCNT(b.x)], 1u);
    return b;
}
__device__ __forceinline__ void xcd_barrier_complete(unsigned* bar, unsigned x, unsigned& nloc, unsigned& nx) {
    const unsigned G = gridDim.x * gridDim.y * gridDim.z;
    unsigned sum, cnt, mine, sp = 0u;
    for (;;) {
        sum = 0u; cnt = 0u; mine = 0u;
#pragma unroll
        for (unsigned j = 0; j < 16; ++j) { const unsigned c = xb_ld(&bar[XB_XCNT(j)]); sum += c; cnt += (c > 0u) ? 1u : 0u; mine = (j == x) ? c : mine; }
        if (sum == G) break;
        __builtin_amdgcn_s_sleep(1);
        if ((++sp & 255u) == 0u) { if (xb_ld(&bar[XB_TMO])) break; if (sp > XB_SPIN_CAP) { atomicAdd(&bar[XB_TMO], 1u); break; } }
    }
    nloc = mine > 0u ? mine : 1u; nx = cnt > 0u ? cnt : 1u;
}
__device__ __forceinline__ void xcd_barrier(const XcdBarrier& b) {
    asm volatile("s_waitcnt vmcnt(0)" ::: "memory");
    __syncthreads();
    if (threadIdx.x == 0) {
        unsigned* bar = b.bar;
        __builtin_amdgcn_s_waitcnt(0);
        unsigned nloc = b.st[0], nx = b.st[1];
        if (nloc == 0u) { xcd_barrier_complete(bar, b.x, nloc, nx); b.st[0] = nloc; b.st[1] = nx; }
        const unsigned old = xb_add(&bar[XB_XSUB(b.x)], 1u);
        const unsigned gen = old / nloc;
        if (old + 1u == (gen + 1u) * nloc) {
            __builtin_amdgcn_fence(__ATOMIC_RELEASE, "agent");
            asm volatile("s_waitcnt vmcnt(0)" ::: "memory");
            const unsigned og = xb_add(&bar[XB_TOP], 1u);
            const unsigned tg = og / nx;
            if (og + 1u == (tg + 1u) * nx) xb_add(&bar[XB_TOPGEN], 1u);
            else XB_SPIN(xb_ld(&bar[XB_TOPGEN]) == tg, bar);
            __builtin_amdgcn_fence(__ATOMIC_ACQUIRE, "agent");
            xb_add(&bar[XB_XGEN(b.x)], 1u);
            asm volatile("s_waitcnt vmcnt(0)" ::: "memory");
        } else {
            XB_SPIN(xb_ld(&bar[XB_XGEN(b.x)]) == gen, bar);
            __builtin_amdgcn_fence(__ATOMIC_ACQUIRE, "agent");
            asm volatile("s_waitcnt vmcnt(0)" ::: "memory");
        }
    }
    __syncthreads();
}
constexpr size_t WS_BAR = 253 * MiB;
constexpr int LDS_ST_OFF = LDS_BYTES - 16;
#define A (*(const volatile __attribute__((address_space(4))) Args*)__builtin_amdgcn_kernarg_segment_ptr())
__global__ void __launch_bounds__(512, 2) fwd_kernel(Args Aparam) {
    extern __shared__ __attribute__((aligned(16))) unsigned char lds_raw[];
    LAS unsigned char* lds = (LAS unsigned char*)lds_raw;
    const int tid = threadIdx.x, lane = tid & 63, wave = __builtin_amdgcn_readfirstlane(tid >> 6);
    const int G = gridDim.x, bx = blockIdx.x;
    const int gw = bx * 8 + wave, NGW = G * 8;
    const int lo = A.ph_lo, hi = A.ph_hi; (void)lo; (void)hi;
#ifndef PHMASK
#define PHMASK 0x1fff
#endif
#if ONE_LAUNCH
#define IN(k) (((PHMASK >> (k)) & 1) && (k) < 11)
#else
#define IN(k) (((PHMASK >> (k)) & 1) && lo <= (k) && (k) < hi)
#endif
#if ONE_LAUNCH
    XcdBarrier xbar; xbar.bar = nullptr; xbar.x = 0; xbar.st = (volatile LAS unsigned*)(lds + LDS_ST_OFF);
#define SEAM(k) do { xcd_barrier(xbar); } while (0)
    {
        unsigned* const barw = (unsigned*)(A.ws + WS_BAR);
        if (tid < 4) ((LAS unsigned*)(lds + LDS_ST_OFF))[tid] = 0u;
        if (bx == 0) for (int i = tid; i < XCD_BAR_WORDS; i += 512) barw[i] = 0u;
        cg::this_grid().sync();
        xbar = xcd_barrier_post(barw, (volatile LAS unsigned*)(lds + LDS_ST_OFF));
    }
#else
#define SEAM(k) do { } while (0)
#endif

    for (int rep_ = 0; rep_ < (((RPT_MASK >> 0) & 1) ? 2 : 1); ++rep_) { if (rep_) { if (0 == 0) cg::this_grid().sync(); else xcd_barrier(xbar); }
    if (IN(0)) {
        unsigned char* const wsb = A.ws; unsigned char* const dob = (unsigned char*)A.out; (void)wsb; (void)dob;
        LAS float* svec = (LAS float*)(lds + 131072);
        for (int task = bx; task < 192; task += G) {
            const int cb = task % 12, ks = task / 12, k0 = ks * 64;
            __syncthreads();
            for (int i = tid; i < 576; i += 512) { const int v = i >> 6, k = i & 63; const float cv = v < 8 ? A.c[v * 1024 + k0 + k] : A.c_ctx[k0 + k]; svec[i] = cv / (1.f + __expf(-cv)); }
            __syncthreads();
            gemv_task<9, 64, false>(A.w_mod, 6144, cb * 512, k0, svec, modp + (size_t)ks * 9 * 6144, 6144);
        }
        LAS float* scr = (LAS float*)(lds + wave * 16384);
        constexpr int NITEMS = 9088;
        for (int it = gw; it < NITEMS; it += NGW) {
            int r = it; const float* W; int ldw, col0, ncols, K; bf16_t* dst; int hp = 0;
            if (r < 512) { W = A.w_in; ldw = INW; col0 = 0; ncols = 1024; K = 1024; dst = W1T + (size_t)3 * 256 * 1024; hp = 1; }
            else if ((r -= 512) < 128) { W = A.w_in; ldw = INW; col0 = 1024; ncols = 256; K = 1024; dst = W1T; hp = 1; }
            else if ((r -= 128) < 128) { W = A.w_in; ldw = INW; col0 = 1280; ncols = 256; K = 1024; dst = W2T; }
            else if ((r -= 128) < 256) { W = A.w_in; ldw = INW; col0 = 1536; ncols = 512; K = 1024; dst = W1T + (size_t)7 * 256 * 1024; }
            else if ((r -= 256) < 256) { W = A.w_in; ldw = INW; col0 = 2048; ncols = 512; K = 1024; dst = W1T + (size_t)1 * 256 * 1024; }
            else if ((r -= 256) < 512) { W = A.w_in; ldw = INW; col0 = 2560; ncols = 1024; K = 1024; dst = W2T + (size_t)256 * 1024; }
            else if ((r -= 512) < 512) { W = A.w_in; ldw = INW; col0 = 3584; ncols = 1024; K = 1024; dst = W1T + (size_t)9 * 256 * 1024; }
            else if ((r -= 512) < 512) { W = A.w_in; ldw = INW; col0 = 4624; ncols = 1024; K = 1024; dst = W1T + (size_t)13 * 256 * 1024; }
            else if ((r -= 512) < 512) { W = A.w_in; ldw = INW; col0 = 5648; ncols = 1024; K = 1024; dst = W1T + (size_t)17 * 256 * 1024; }
            else if ((r -= 512) < 512) { W = A.w_branch_att; ldw = 1024; col0 = 0; ncols = 1024; K = 1024; dst = WBA; }
            else if ((r -= 512) < 512) { W = A.w_branch_ml; ldw = 1024; col0 = 0; ncols = 1024; K = 1024; dst = WBM; }
            else if ((r -= 512) < 512) { W = A.w_out; ldw = 1024; col0 = 0; ncols = 1024; K = 1024; dst = WO; }
            else if ((r -= 512) < 2816) { W = A.w_up; ldw = NUP; col0 = 0; ncols = NUP; K = 1024; dst = WUP; }
            else { r -= 2816; W = A.w_down; ldw = 1024; col0 = 0; ncols = 1024; K = DFF; dst = WDN; }
            const int nblk = ncols / 32, kb = r / nblk, nb = r % nblk, n0 = nb * 32;
            int drow = hp ? headperm(n0) : n0;
            if (W == A.w_up) drow = (n0 < DFF) ? 256 * (n0 >> 7) + (n0 & 127) : 256 * ((n0 - DFF) >> 7) + 128 + ((n0 - DFF) & 127);
            transpose_item(W, ldw, col0 + n0, kb * 64, dst, drow, K, scr, lane);
        }
        for (int i = bx * 512 + tid; i < 2048 * 32; i += G * 512) {
            const int t = i >> 5, j = i & 31; const float pos = (j < 16) ? (float)(t >> 6) : (float)(t & 63);
            const float invf = exp2f(-(float)(j & 15) * (13.287712379549449f / 16.f)); const float ang = pos * invf;
            cosT[i] = cosf(ang); sinT[i] = sinf(ang);
        }
    }
    }
    SEAM(0);

    for (int rep_ = 0; rep_ < (((RPT_MASK >> 1) & 1) ? 2 : 1); ++rep_) { if (rep_) { if (1 == 0) cg::this_grid().sync(); else xcd_barrier(xbar); }
    if (IN(1)) {
        unsigned char* const wsb = A.ws; unsigned char* const dob = (unsigned char*)A.out; (void)wsb; (void)dob;
        constexpr int GP = 1028;
        LAS float* sWg = (LAS float*)lds;
        LAS float* hT = (LAS float*)(lds + 65792);
        LAS float* svm = (LAS float*)(lds + 131584);
        LAS float* part = (LAS float*)(lds + 147968);
        LAS float* svec = part;
        for (int k = tid; k < 1024; k += 512) { const float* src = A.w_in + (size_t)k * INW + 4608;
#pragma unroll
            for (int q = 0; q < 4; ++q) { const f32x4 v = *(const f32x4*)(src + 4 * q); sWg[(4 * q + 0) * GP + k] = v[0]; sWg[(4 * q + 1) * GP + k] = v[1]; sWg[(4 * q + 2) * GP + k] = v[2]; sWg[(4 * q + 3) * GP + k] = v[3]; } }
        const int rpb = (MT + G - 1) / G, rbeg = bx * rpb, rend = (rbeg + rpb < MT) ? rbeg + rpb : MT;
        const int vlo = rbeg < ML ? (rbeg >> 11) : 8;
        for (int i = tid; i < 4096; i += 512) { const int slot = i >> 11, k = i & 2047; int v = vlo + slot; if (v > 8) v = 8; float a = A.b_mod[k];
#pragma unroll
            for (int ks = 0; ks < 16; ++ks) a += modp[((size_t)ks * 9 + v) * 6144 + k];
            svm[i] = a; }
        for (int i = bx * 512 + tid; i < 9 * 6144; i += G * 512) { float a = A.b_mod[i % 6144];
#pragma unroll
            for (int ks = 0; ks < 16; ++ks) a += modp[(size_t)ks * 9 * 6144 + i];
            mod[i] = a; }
        __syncthreads();
        {
            const float* xin = A.x; const float* cin = A.ctx; const float* n1w = A.norm1_w; const float* gbias = A.ml_gate_b;
            const int r16 = lane & 15, quad = lane >> 4;
            const int ntile = (rend - rbeg + 15) >> 4;
            f32x4 xn[2][4];
#pragma unroll
            for (int t = 0; t < 2; ++t) { const int row = rbeg + wave + 8 * t; if (row < rend) { const float* xr = row < ML ? xin + (size_t)row * 1024 : cin + (size_t)(row - ML) * 1024;
#pragma unroll
                for (int j = 0; j < 4; ++j) xn[t][j] = *(const f32x4*)(xr + 4 * lane + 256 * j); } }
            for (int tile = 0; tile < ntile; ++tile) {
                const int trow = rbeg + 16 * tile;
#pragma unroll
                for (int t = 0; t < 2; ++t) {
                    const int r = wave + 8 * t, row = trow + r;
                    f32x4 hv[4]; float ss = 0.f;
#pragma unroll
                    for (int j = 0; j < 4; ++j) { hv[j] = xn[t][j]; const f32x4 q = hv[j] * hv[j]; ss += (q[0] + q[1]) + (q[2] + q[3]); }
                    { const int rn = row + 16; if (rn < rend) { const float* xr = rn < ML ? xin + (size_t)rn * 1024 : cin + (size_t)(rn - ML) * 1024;
#pragma unroll
                        for (int j = 0; j < 4; ++j) xn[t][j] = *(const f32x4*)(xr + 4 * lane + 256 * j); } }
                    if (row < rend) {
                        const int v = row < ML ? (row >> 11) : 8;
                        const LAS float* sh = svm + (v - vlo) * 2048; const LAS float* sc = sh + 1024;
                        const float rstd = rsqrtf(wave_sum(ss) * (1.f / 1024.f) + EPS);
                        bf16_t* ho = H + (size_t)row * 1024;
#pragma unroll
                        for (int j = 0; j < 4; ++j) { const int k = 4 * lane + 256 * j;
                            hv[j] = hv[j] * rstd * (*(const f32x4*)(n1w + k)) * (*(const LAS f32x4*)(sc + k) + 1.f) + *(const LAS f32x4*)(sh + k);
                            u32x2 w; w.x = cvt_pk_bf16(hv[j][0], hv[j][1]); w.y = cvt_pk_bf16(hv[j][2], hv[j][3]); *(u32x2*)(ho + k) = w;
                            *(LAS f32x4*)(hT + r * GP + k) = hv[j]; }
                    }
                }
                __syncthreads();
                { f32x4 acc = (f32x4){0.f, 0.f, 0.f, 0.f};
#pragma unroll
                  for (int kk = 0; kk < 8; ++kk) { const f32x4 a4 = *(const LAS f32x4*)(hT + r16 * GP + wave * 128 + kk * 16 + quad * 4), b4 = *(const LAS f32x4*)(sWg + r16 * GP + wave * 128 + kk * 16 + quad * 4);
#pragma unroll
                    for (int i = 0; i < 4; ++i) acc = __builtin_amdgcn_mfma_f32_16x16x4f32(a4[i], b4[i], acc, 0, 0, 0); }
#pragma unroll
                  for (int j = 0; j < 4; ++j) part[wave * 256 + (quad * 4 + j) * 16 + r16] = acc[j]; }
                __syncthreads();
                if (tid < 256) { const int r = tid >> 4, gidx = tid & 15, row = trow + r; float gv = gbias[gidx];
#pragma unroll
                    for (int w = 0; w < 8; ++w) gv += part[w * 256 + tid];
                    if (gidx & 4) gv = fminf(gv, 0.f) - log1pf(expf(-fabsf(gv)));
                    if (row < rend) gates[(size_t)row * 16 + gidx] = gv; }
            }
        }
        for (int task = bx; task < 176; task += G) {
            const int cb = task % 11, ks = task / 11, k0 = ks * 64;
            __syncthreads();
            { const int v = tid >> 6, k = 3072 + k0 + (tid & 63); float a = A.b_mod[k];
#pragma unroll
                for (int q = 0; q < 16; ++q) a += modp[((size_t)q * 9 + v) * 6144 + k];
                svec[tid] = a; }
            __syncthreads();
            gemv_task<8, 64, false>(A.w_up, NUP, cb * 512, k0, svec, fbp + (size_t)ks * 8 * NUP, NUP);
        }
    }
    }
    SEAM(1);

    for (int rep_ = 0; rep_ < (((RPT_MASK >> 2) & 1) ? 2 : 1); ++rep_) { if (rep_) { if (2 == 0) cg::this_grid().sync(); else xcd_barrier(xbar); }
    if (IN(2)) {
        unsigned char* const wsb = A.ws; unsigned char* const dob = (unsigned char*)A.out; (void)wsb; (void)dob;
        { pg8::Gemm g{H, W1T, 1024, 1024, 1024}; pg8::Order S; S.init(64, 21, G, bx, 24);
          EpiIn E{AK, MK, AQ, MQ, MO, GA, GM, A.q_norm_w, A.k_norm_w, cosT, sinT};
          pg8::gemm_phase<EpiIn, pg8::Order, true>(lds, g, S, E); }
        { pg8::Gemm g{W2T, H, 1024, 1024, 1024}; pg8::Order S; S.init(5, 72, G, (bx + G - (1368 % G)) % G, 0);
          EpiPlain E{XT, MT};
          pg8::gemm_phase<EpiPlain, pg8::Order, true>(lds, g, S, E); }
    }
    }
    SEAM(2);

    if (IN(3)) {
        unsigned char* const wsb = A.ws; unsigned char* const dob = (unsigned char*)A.out; (void)wsb; (void)dob;
        for (int i = bx * 512 + tid; i < 8 * NUP; i += G * 512) { float a = 0.f;
#pragma unroll
            for (int ks = 0; ks < 16; ++ks) a += fbp[(size_t)ks * 8 * NUP + i];
            fbias[i] = a; }
        const int r16 = lane & 15, quad = lane >> 4;
        const int rt = wave & 3, hp = wave >> 2;
        LAS bf16_t* sK = (LAS bf16_t*)lds;
        LAS bf16_t* sVT = sK + 64 * 72;
        bf16x8 qn[2][2];
#define AT_QLOAD(un_) do { const int qb_ = (un_) & 31, kvh_ = ((un_) >> 5) & 3, b_ = (un_) >> 7; \
            _Pragma("unroll") for (int g = 0; g < 2; ++g) _Pragma("unroll") for (int ks = 0; ks < 2; ++ks) \
                qn[g][ks] = *(const bf16x8*)(AQ + (size_t)(b_ * SEQ + qb_ * 64 + rt * 16 + r16) * 1024 + (kvh_ * 4 + hp * 2 + g) * 64 + ks * 32 + quad * 8); } while (0)
        if (bx < 1024) AT_QLOAD(bx);
        for (int unit = bx; unit < 1024; unit += G) {
            const int qb = unit & 31, kvh = (unit >> 5) & 3, b = unit >> 7;
            const int rowbase = b * SEQ, t0 = qb * 64;
            bf16x8 qf[2][2];
#pragma unroll
            for (int g = 0; g < 2; ++g)
#pragma unroll
                for (int ks = 0; ks < 2; ++ks) qf[g][ks] = qn[g][ks];
            if (unit + G < 1024) AT_QLOAD(unit + G);
            f32x4 o[2][4]; float mrow[2], lrow[2];
#pragma unroll
            for (int g = 0; g < 2; ++g) { mrow[g] = A.attn_sink[kvh * 4 + hp * 2 + g]; lrow[g] = 1.f;
#pragma unroll
                for (int dt = 0; dt < 4; ++dt) o[g][dt] = (f32x4){0.f, 0.f, 0.f, 0.f}; }
            const int kb_lo = (qb < 2) ? 2 - qb : 0, kb_hi = (qb > 29) ? 33 - qb : 4;
            const bf16_t* const ak_ = AK; const bf16_t* const xt_ = XT; const int lr = tid >> 3, lc = tid & 7;
#define AT_KROW0(kb_) (((kb_) < 5) ? rowbase + (qb + (kb_) - 2) * 64 : ML + b * CTX + ((kb_) - 5) * 64)
            u32x4 pk, pv;
            { const int kr = AT_KROW0(kb_lo); pk = *(const u32x4*)(ak_ + (size_t)(kr + lr) * 256 + kvh * 64 + lc * 8); pv = *(const u32x4*)(xt_ + (size_t)(kvh * 64 + lr) * MT + kr + lc * 8); }
            for (int kb = kb_lo; kb < 9; kb = (kb == kb_hi) ? 5 : kb + 1) {
                const int mtype = (kb == 0) ? 1 : (kb == 4) ? 2 : 0;
                const int mlo = (mtype == 1) ? 0 : -4096, mhi = (mtype == 2) ? 0 : 4096, dl = quad * 4 - rt * 16 - r16;
                __syncthreads();
                *(LAS u32x4*)(sK + lr * 72 + lc * 8) = pk; *(LAS u32x4*)(sVT + lr * 72 + lc * 8) = pv;
                { const int kn = (kb == kb_hi) ? 5 : kb + 1;
                  if (kn < 9) { const int kr = AT_KROW0(kn); pk = *(const u32x4*)(ak_ + (size_t)(kr + lr) * 256 + kvh * 64 + lc * 8); pv = *(const u32x4*)(xt_ + (size_t)(kvh * 64 + lr) * MT + kr + lc * 8); } }
                __syncthreads();
                bf16x8 kf[4][2], vf[2][4];
#pragma unroll
                for (int tile = 0; tile < 4; ++tile)
#pragma unroll
                    for (int ks = 0; ks < 2; ++ks) kf[tile][ks] = *(const LAS bf16x8*)(sK + (tile * 16 + r16) * 72 + ks * 32 + quad * 8);
#pragma unroll
                for (int ks = 0; ks < 2; ++ks)
#pragma unroll
                    for (int dt = 0; dt < 4; ++dt) { const u32x2 lo = *(const LAS u32x2*)(sVT + (dt * 16 + r16) * 72 + ks * 32 + quad * 4), hi = *(const LAS u32x2*)(sVT + (dt * 16 + r16) * 72 + ks * 32 + 16 + quad * 4);
                        const u32x4 w = (u32x4){lo.x, lo.y, hi.x, hi.y}; vf[ks][dt] = __builtin_bit_cast(bf16x8, w); }
#pragma unroll
                for (int g = 0; g < 2; ++g) {
                    f32x4 s[4];
#pragma unroll
                    for (int tile = 0; tile < 4; ++tile) { s[tile] = (f32x4){0.f, 0.f, 0.f, 0.f};
#pragma unroll
                        for (int ks = 0; ks < 2; ++ks) s[tile] = mfma16(kf[tile][ks], qf[g][ks], s[tile]); }
                    float mx = -1e30f;
#pragma unroll
                    for (int tile = 0; tile < 4; ++tile)
#pragma unroll
                        for (int j = 0; j < 4; ++j) { const int dd = dl + (tile * 16 + j);
                            const int bad = ((dd - mlo) | (mhi - dd)) >> 31;
                            const float v = s[tile][j] * 0.125f + __int_as_float(bad & (int)0xF149F2CAu); s[tile][j] = v; mx = fmaxf(mx, v); }
                    mx = fmaxf(mx, __shfl_xor(mx, 16)); mx = fmaxf(mx, __shfl_xor(mx, 32));
                    const float mn = fmaxf(mrow[g], mx), alpha = __expf(mrow[g] - mn); mrow[g] = mn; float rs = 0.f;
                    unsigned pw[4][2];
#pragma unroll
                    for (int tile = 0; tile < 4; ++tile) { f32x4 pe;
#pragma unroll
                        for (int j = 0; j < 4; ++j) { pe[j] = __expf(s[tile][j] - mn); rs += pe[j]; }
                        pw[tile][0] = cvt_pk_bf16(pe[0], pe[1]); pw[tile][1] = cvt_pk_bf16(pe[2], pe[3]); }
                    rs += __shfl_xor(rs, 16); rs += __shfl_xor(rs, 32);
                    lrow[g] = lrow[g] * alpha + rs;
#pragma unroll
                    for (int dt = 0; dt < 4; ++dt) o[g][dt] = o[g][dt] * alpha;
#pragma unroll
                    for (int ks = 0; ks < 2; ++ks) { const u32x4 w = (u32x4){pw[2 * ks][0], pw[2 * ks][1], pw[2 * ks + 1][0], pw[2 * ks + 1][1]}; const bf16x8 pf = __builtin_bit_cast(bf16x8, w);
#pragma unroll
                        for (int dt = 0; dt < 4; ++dt) o[g][dt] = mfma16(vf[ks][dt], pf, o[g][dt]); }
                }
            }
#pragma unroll
            for (int g = 0; g < 2; ++g) { const float inv = 1.f / lrow[g];
                bf16_t* p = ATTO + (size_t)(rowbase + t0 + rt * 16 + r16) * 1024 + (kvh * 4 + hp * 2 + g) * 64 + quad * 4;
#pragma unroll
                for (int dt = 0; dt < 4; ++dt) { u32x2 w; w.x = cvt_pk_bf16(o[g][dt][0] * inv, o[g][dt][1] * inv); w.y = cvt_pk_bf16(o[g][dt][2] * inv, o[g][dt][3] * inv); *(u32x2*)(p + dt * 16) = w; } }
        }
    }
    SEAM(3);

    for (int rep_ = 0; rep_ < (((RPT_MASK >> 4) & 1) ? 2 : 1); ++rep_) { if (rep_) { if (4 == 0) cg::this_grid().sync(); else xcd_barrier(xbar); }
    if (IN(4)) {
        unsigned char* const wsb = A.ws; unsigned char* const dob = (unsigned char*)A.out; (void)wsb; (void)dob;
        const int r16 = lane & 15, quad = lane >> 4;
        LAS bf16_t* sK = (LAS bf16_t*)lds;
        LAS bf16_t* sVT = sK + 128 * 136;
        LAS bf16_t* sS = sVT + 64 * 136;
        LAS bf16_t* sC = sS + 128 * 136;
        LAS float* sgb = (LAS float*)(sC + 80 * 136);
        LAS float *sga = sgb + 128, *sgw = sgb + 256, *sge = sgb + 384, *sgF = sgb + 512;
        const float scale = 0.08838834764831845f;
        for (int task = bx; task < 256; task += G) {
            const int vq = task & 3, dir = (task >> 2) & 1, hh = (task >> 3) & 3, b = task >> 5;
            __syncthreads();
            for (int i = tid; i < 80 * 136 / 2; i += 512) ((LAS unsigned*)sC)[i] = 0u;
            f32x4 cacc[4], nacc = (f32x4){0.f, 0.f, 0.f, 0.f};
#pragma unroll
            for (int vt = 0; vt < 4; ++vt) cacc[vt] = (f32x4){0.f, 0.f, 0.f, 0.f};
            bf16_t* Hout = (bf16_t*)(dob + (dir ? DO_HB : DO_HF)); const int sgn = dir ? 1 : -1;
            const bf16_t* const mk_ = MK; const bf16_t* const xt_ = XT; const bf16_t* const mq_ = MQ; const float* const gt_ = gates;
            u32x4 pK[4], pVT[2]; bf16x8 pQ[4]; float pG[4];
#define ML_TOK0(st) (((st) < 2) ? (ML + b * CTX + (dir ? 1 - (st) : (st)) * 128) : (b * SEQ + (dir ? 15 - ((st) - 2) : (st) - 2) * 128))
#define ML_PREFETCH(st) do { const int t0_ = ML_TOK0(st); \
                _Pragma("unroll") for (int q_ = 0; q_ < 4; ++q_) { const int i_ = tid + q_ * 512, r_ = i_ >> 4, c_ = i_ & 15; pK[q_] = *(const u32x4*)(mk_ + (size_t)(t0_ + r_) * 512 + hh * 128 + c_ * 8); } \
                if ((st) >= 2) { _Pragma("unroll") for (int ks_ = 0; ks_ < 4; ++ks_) pQ[ks_] = *(const bf16x8*)(mq_ + (size_t)(t0_ + wave * 16 + r16) * 512 + hh * 128 + ks_ * 32 + quad * 8); } \
                _Pragma("unroll") for (int q_ = 0; q_ < 2; ++q_) { const int i_ = tid + q_ * 512, r_ = i_ >> 4, c_ = i_ & 15; pVT[q_] = *(const u32x4*)(xt_ + (size_t)(256 + hh * 256 + vq * 64 + r_) * MT + t0_ + c_ * 8); } \
                if (wave == 0) { const float* gp_ = gt_ + (size_t)(t0_ + 2 * lane) * 16 + dir * 8 + hh; pG[0] = gp_[0]; pG[1] = gp_[4]; pG[2] = gp_[16]; pG[3] = gp_[20]; } } while (0)
            ML_PREFETCH(0);
            for (int step = 0; step < 18; ++step) {
                const bool isctx = step < 2; const int tok0 = ML_TOK0(step);
                __syncthreads();
#pragma unroll
                for (int q = 0; q < 4; ++q) { const int i = tid + q * 512, r = i >> 4, c = i & 15; *(LAS u32x4*)(sK + r * 136 + c * 8) = pK[q]; }
#pragma unroll
                for (int q = 0; q < 2; ++q) { const int i = tid + q * 512, r = i >> 4, c = i & 15; *(LAS u32x4*)(sVT + r * 136 + c * 8) = pVT[q]; }
                if (wave == 0) {
                    const float i0 = pG[0], f0 = pG[1], i1 = pG[2], f1 = pG[3];
                    const float loc = f0 + f1; float v = loc;
#pragma unroll
                    for (int off = 1; off < 64; off <<= 1) { const float t = __shfl_up(v, off); if (lane >= off) v += t; }
                    const float total = __shfl(v, 63); const float p0 = v - loc + f0, p1 = p0 + f1;
                    const float b0 = dir ? total - p0 + f0 : p0, b1 = dir ? total - p1 + f1 : p1;
                    const float cmid = 0.5f * total;
                    sgb[2 * lane] = __expf(fminf(b0 - cmid, 80.f)); sgb[2 * lane + 1] = __expf(fminf(b1 - cmid, 80.f));
                    sga[2 * lane] = __expf(fminf(i0 - b0 + cmid, 80.f)) * scale; sga[2 * lane + 1] = __expf(fminf(i1 - b1 + cmid, 80.f)) * scale;
                    sgw[2 * lane] = __expf(fminf(total - b0 + i0, 80.f)) * scale; sgw[2 * lane + 1] = __expf(fminf(total - b1 + i1, 80.f)) * scale;
                    sge[2 * lane] = __expf(b0); sge[2 * lane + 1] = __expf(b1); if (lane == 0) sgF[0] = __expf(total);
                }
                bf16x8 qf[4];
#pragma unroll
                for (int ks = 0; ks < 4; ++ks) qf[ks] = pQ[ks];
                if (step + 1 < 18) ML_PREFETCH(step + 1);
                __syncthreads();
                if (!isctx) {
                    const int prow = wave * 16 + r16;
                    f32x4 s[8];
#pragma unroll
                    for (int tile = 0; tile < 8; ++tile) { s[tile] = (f32x4){0.f, 0.f, 0.f, 0.f};
#pragma unroll
                        for (int ks = 0; ks < 4; ++ks) { const bf16x8 kf = *(const LAS bf16x8*)(sK + (tile * 16 + r16) * 136 + ks * 32 + quad * 8); s[tile] = mfma16(kf, qf[ks], s[tile]); } }
                    const float bp = sgb[prow]; float rs = 0.f;
#pragma unroll
                    for (int tile = 0; tile < 8; ++tile) { const f32x4 av = *(const LAS f32x4*)(sga + tile * 16 + quad * 4); f32x4 pe;
#pragma unroll
                        for (int j = 0; j < 4; ++j) { const int dd = (tile * 16 + quad * 4 + j - prow) * sgn;
                            pe[j] = __int_as_float(__float_as_int(s[tile][j] * (bp * av[j])) & ~(dd >> 31)); rs += pe[j]; }
                        u32x2 w; w.x = cvt_pk_bf16(pe[0], pe[1]); w.y = cvt_pk_bf16(pe[2], pe[3]);
                        *(LAS u32x2*)(sS + prow * 136 + tile * 16 + quad * 4) = w; }
                    rs += __shfl_xor(rs, 16); rs += __shfl_xor(rs, 32);
                    asm volatile("s_waitcnt lgkmcnt(0)" ::: "memory");
                    f32x4 a1[4], a2[5];
#pragma unroll
                    for (int vt = 0; vt < 4; ++vt) a1[vt] = (f32x4){0.f, 0.f, 0.f, 0.f};
#pragma unroll
                    for (int vt = 0; vt < 5; ++vt) a2[vt] = (f32x4){0.f, 0.f, 0.f, 0.f};
#pragma unroll
                    for (int ks = 0; ks < 4; ++ks) { const bf16x8 af = *(const LAS bf16x8*)(sS + prow * 136 + ks * 32 + quad * 8);
#pragma unroll
                        for (int vt = 0; vt < 4; ++vt) { const bf16x8 vf = *(const LAS bf16x8*)(sVT + (vt * 16 + r16) * 136 + ks * 32 + quad * 8); a1[vt] = mfma16(vf, af, a1[vt]); } }
#pragma unroll
                    for (int ks = 0; ks < 4; ++ks)
#pragma unroll
                        for (int vt = 0; vt < 5; ++vt) { const bf16x8 cf = *(const LAS bf16x8*)(sC + (vt * 16 + r16) * 136 + ks * 32 + quad * 8); a2[vt] = mfma16(cf, qf[ks], a2[vt]); }
                    const float e = sge[prow];
                    const float qn = __shfl(a2[4][0], r16); const float nq = rs + e * qn; const float inv = 1.f / fmaxf(fabsf(nq), 1.f);
                    bf16_t* hp = Hout + (size_t)(tok0 + prow) * 1024 + hh * 256 + vq * 64 + quad * 4;
#pragma unroll
                    for (int vt = 0; vt < 4; ++vt) { u32x2 w; w.x = cvt_pk_bf16((a1[vt][0] + e * a2[vt][0]) * inv, (a1[vt][1] + e * a2[vt][1]) * inv);
                        w.y = cvt_pk_bf16((a1[vt][2] + e * a2[vt][2]) * inv, (a1[vt][3] + e * a2[vt][3]) * inv); *(u32x2*)(hp + vt * 16) = w; }
                }
                __syncthreads();
                {
                    const float F = sgF[0];
#pragma unroll
                    for (int vt = 0; vt < 4; ++vt) cacc[vt] = cacc[vt] * F;
                    nacc = nacc * F;
                    bf16x8 ones; { const short o1 = (r16 == 0) ? (short)0x3F80 : (short)0;
#pragma unroll
                        for (int e = 0; e < 8; ++e) ones[e] = o1; }
#pragma unroll
                    for (int ks = 0; ks < 4; ++ks) {
                        const LAS bf16_t* kcol = sK + (ks * 32 + quad * 8) * 136 + wave * 16 + r16;
                        const f32x4 w0 = *(const LAS f32x4*)(sgw + ks * 32 + quad * 8), w1 = *(const LAS f32x4*)(sgw + ks * 32 + quad * 8 + 4);
                        f32x4 k0, k1;
#pragma unroll
                        for (int e = 0; e < 4; ++e) { k0[e] = bf2f(kcol[e * 136]) * w0[e]; k1[e] = bf2f(kcol[(4 + e) * 136]) * w1[e]; }
                        const u32x4 pk = pack8(k0, k1); const bf16x8 kts = __builtin_bit_cast(bf16x8, pk);
#pragma unroll
                        for (int vt = 0; vt < 4; ++vt) { const bf16x8 va = *(const LAS bf16x8*)(sVT + (vt * 16 + r16) * 136 + ks * 32 + quad * 8); cacc[vt] = mfma16(kts, va, cacc[vt]); }
                        nacc = mfma16(kts, ones, nacc);
                    }
#pragma unroll
                    for (int vt = 0; vt < 4; ++vt) { u32x2 w; w.x = cvt_pk_bf16(cacc[vt][0], cacc[vt][1]); w.y = cvt_pk_bf16(cacc[vt][2], cacc[vt][3]);
                        *(LAS u32x2*)(sC + (vt * 16 + r16) * 136 + wave * 16 + quad * 4) = w; }
                    if (r16 == 0) { u32x2 w; w.x = cvt_pk_bf16(nacc[0], nacc[1]); w.y = cvt_pk_bf16(nacc[2], nacc[3]); *(LAS u32x2*)(sC + 64 * 136 + wave * 16 + quad * 4) = w; }
                }
            }
        }
    }
    }
    SEAM(4);

    if (IN(5)) {
        unsigned char* const wsb = A.ws; unsigned char* const dob = (unsigned char*)A.out; (void)wsb; (void)dob;
        for (int row = gw; row < ML; row += NGW) {
            const size_t off = (size_t)row * 1024 + lane * 16;
            float ht[16], mo[16];
#pragma unroll
            for (int q = 0; q < 2; ++q) { const u32x4 a = *(const u32x4*)(HF + off + q * 8), c = *(const u32x4*)(HB + off + q * 8), d = *(const u32x4*)(MO + off + q * 8);
#pragma unroll
                for (int e = 0; e < 4; ++e) { ht[q * 8 + 2 * e] = __uint_as_float(a[e] << 16) + __uint_as_float(c[e] << 16); ht[q * 8 + 2 * e + 1] = __uint_as_float(a[e] & 0xffff0000u) + __uint_as_float(c[e] & 0xffff0000u);
                    mo[q * 8 + 2 * e] = __uint_as_float(d[e] << 16); mo[q * 8 + 2 * e + 1] = __uint_as_float(d[e] & 0xffff0000u); } }
            float ss = 0.f;
#pragma unroll
            for (int e = 0; e < 16; ++e) ss += ht[e] * ht[e];
            ss += __shfl_xor(ss, 1); ss += __shfl_xor(ss, 2); ss += __shfl_xor(ss, 4); ss += __shfl_xor(ss, 8);
            const float rs = rsqrtf(ss * (1.f / 256.f) + EPS);
            float r[16];
#pragma unroll
            for (int q = 0; q < 4; ++q) { const f32x4 w = *(const f32x4*)(A.ml_norm_w + lane * 16 + q * 4);
#pragma unroll
                for (int e = 0; e < 4; ++e) r[q * 4 + e] = ht[q * 4 + e] * rs * w[e] * sigmoidf_(mo[q * 4 + e]); }
#pragma unroll
            for (int q = 0; q < 2; ++q) { u32x4 w; w.x = cvt_pk_bf16(r[q * 8 + 0], r[q * 8 + 1]); w.y = cvt_pk_bf16(r[q * 8 + 2], r[q * 8 + 3]); w.z = cvt_pk_bf16(r[q * 8 + 4], r[q * 8 + 5]); w.w = cvt_pk_bf16(r[q * 8 + 6], r[q * 8 + 7]);
                *(u32x4*)(MO + off + q * 8) = w; }
        }
    }
    SEAM(5);

    for (int rep_ = 0; rep_ < (((RPT_MASK >> 6) & 1) ? 2 : 1); ++rep_) { if (rep_) { if (6 == 0) cg::this_grid().sync(); else xcd_barrier(xbar); }
    if (IN(6)) {
        unsigned char* const wsb = A.ws; unsigned char* const dob = (unsigned char*)A.out; (void)wsb; (void)dob;
        pg8::Order S; S.init(64, 4, G, bx, 0);
        { pg8::Gemm g{AQ, WBA, 1024, 1024, 1024, MO, WBM}; EpiMerge E{GA, GM, Y}; pg8::gemm_phase<EpiMerge, pg8::Order, false, true>(lds, g, S, E); }
    }
    }
    SEAM(6);

    for (int rep_ = 0; rep_ < (((RPT_MASK >> 7) & 1) ? 2 : 1); ++rep_) { if (rep_) { if (7 == 0) cg::this_grid().sync(); else xcd_barrier(xbar); }
    if (IN(7)) {
        unsigned char* const wsb = A.ws; unsigned char* const dob = (unsigned char*)A.out; (void)wsb; (void)dob;
        pg8::Order S; S.init(64, 4, G, bx, 0);
#ifdef DBG_P7PLAIN
        pg8::Gemm g{Y, WO, 1024, 1024, 1024}; EpiPlain E{T1, 1024};
        pg8::gemm_phase<EpiPlain, pg8::Order, false>(lds, g, S, E);
#else
        pg8::Gemm g{Y, WO, 1024, 1024, 1024}; EpiOut E{A.x, mod, A.norm2_w, (float*)dob, AQ, rowsq};
        pg8::gemm_phase<EpiOut, pg8::Order, false>(lds, g, S, E);
#endif
    }
    }
    SEAM(7);

    for (int rep_ = 0; rep_ < (((RPT_MASK >> 8) & 1) ? 2 : 1); ++rep_) { if (rep_) { if (8 == 0) cg::this_grid().sync(); else xcd_barrier(xbar); }
    if (IN(8)) {
        unsigned char* const wsb = A.ws; unsigned char* const dob = (unsigned char*)A.out; (void)wsb; (void)dob;
        pg8::Order S; S.init(64, 22, G, bx, 0);
        pg8::Gemm g{AQ, WUP, 1024, 1024, 1024}; EpiUp E{rowsq, fbias, A.conv_w, A.conv_b, ACT, RAWU, (LAS float*)(lds + 131072)};
        pg8::gemm_phase<EpiUp, pg8::Order, true>(lds, g, S, E);
    }
    }
    SEAM(8);

    if (IN(9)) {
        unsigned char* const wsb = A.ws; unsigned char* const dob = (unsigned char*)A.out; (void)wsb; (void)dob;
        const float* cw = A.conv_w; const float* cb = A.conv_b;
        for (int task = bx * 512 + tid; task < 1025 * 352; task += G * 512) {
            const int ch = task % 352, bd = task / 352, j0 = ch * 8;
            const int pc = 256 * (j0 >> 7) + (j0 & 127);
            const bool lo_ok = bd > 0, hi_ok = bd < 1024, seam = ((bd * 16) & 2047) == 0;
            const u32x4 zero = (u32x4){0u, 0u, 0u, 0u};
            u32x4 xa[4], xg[4];
#pragma unroll
            for (int k = 0; k < 4; ++k) { xa[k] = zero; xg[k] = zero; }
            if (lo_ok) { const bf16_t* rp = RAWU + ((size_t)(bd - 1) * 4 + 2) * NUP + pc; xa[0] = *(const u32x4*)rp; xg[0] = *(const u32x4*)(rp + 128); xa[1] = *(const u32x4*)(rp + NUP); xg[1] = *(const u32x4*)(rp + NUP + 128); }
            if (hi_ok) { const bf16_t* rp = RAWU + ((size_t)bd * 4) * NUP + pc; xa[2] = *(const u32x4*)rp; xg[2] = *(const u32x4*)(rp + 128); xa[3] = *(const u32x4*)(rp + NUP); xg[3] = *(const u32x4*)(rp + NUP + 128); }
            float wa[3][8], wg[3][8], ba[8], bg[8];
#pragma unroll
            for (int i = 0; i < 3; ++i)
#pragma unroll
                for (int q = 0; q < 2; ++q) { const f32x4 a = *(const f32x4*)(cw + i * NUP + j0 + 4 * q), g = *(const f32x4*)(cw + i * NUP + DFF + j0 + 4 * q);
#pragma unroll
                    for (int e = 0; e < 4; ++e) { wa[i][4 * q + e] = a[e]; wg[i][4 * q + e] = g[e]; } }
#pragma unroll
            for (int q = 0; q < 2; ++q) { const f32x4 a = *(const f32x4*)(cb + j0 + 4 * q), g = *(const f32x4*)(cb + DFF + j0 + 4 * q);
#pragma unroll
                for (int e = 0; e < 4; ++e) { ba[4 * q + e] = a[e]; bg[4 * q + e] = g[e]; } }
#pragma unroll
            for (int side = 0; side < 2; ++side) {
                if (side == 0 ? !lo_ok : !hi_ok) continue;
                float r[8];
#pragma unroll
                for (int e = 0; e < 8; ++e) { const int w = e >> 1; const bool hi16 = e & 1;
                    float va[3], vg[3];
#pragma unroll
                    for (int k = 0; k < 3; ++k) { const unsigned aw = xa[side + k][w], gw = xg[side + k][w];
                        va[k] = hi16 ? __uint_as_float(aw & 0xffff0000u) : __uint_as_float(aw << 16); vg[k] = hi16 ? __uint_as_float(gw & 0xffff0000u) : __uint_as_float(gw << 16); }
                    if (seam) { if (side == 0) { va[2] = 0.f; vg[2] = 0.f; } else { va[0] = 0.f; vg[0] = 0.f; } }
                    const float av = ba[e] + wa[0][e] * va[0] + wa[1][e] * va[1] + wa[2][e] * va[2];
                    const float gv = bg[e] + wg[0][e] * vg[0] + wg[1][e] * vg[1] + wg[2][e] * vg[2];
                    r[e] = gv * sigmoidf_(gv) * av; }
                u32x4 w; w.x = cvt_pk_bf16(r[0], r[1]); w.y = cvt_pk_bf16(r[2], r[3]); w.z = cvt_pk_bf16(r[4], r[5]); w.w = cvt_pk_bf16(r[6], r[7]);
                *(u32x4*)(ACT + (size_t)(bd * 16 - 1 + side) * DFF + j0) = w;
            }
        }
    }
    SEAM(9);

    if (IN(10)) {
        unsigned char* const wsb = A.ws; unsigned char* const dob = (unsigned char*)A.out; (void)wsb; (void)dob;
        pg8::Order S; S.init(64, 4, G, bx, 0);
        pg8::Gemm g{ACT, WDN, DFF, DFF, DFF}; EpiDown E{(float*)dob, mod, AQ, A.norm2_w};
        pg8::gemm_phase<EpiDown, pg8::Order, false>(lds, g, S, E);
    }
#undef IN
#undef SEAM
}
#undef A

extern "C" void kernel_launch(void* const* d_in, const int* in_sizes, int n_in, void* d_out, int out_size, void* d_ws, size_t ws_size, hipStream_t stream) {
    static int grid = 0;
    if (grid == 0) {
        if (n_in != 21 || out_size != ML * D || ws_size < WS_END) { fprintf(stderr, "kernel_launch: unexpected shapes (n_in %d out %d ws %zu)\n", n_in, out_size, ws_size); grid = -1; return; }
        int dev = 0, cus = 0, per_cu = 0;
        hipGetDevice(&dev); hipDeviceGetAttribute(&cus, hipDeviceAttributeMultiprocessorCount, dev);
        hipFuncSetAttribute((const void*)fwd_kernel, hipFuncAttributeMaxDynamicSharedMemorySize, LDS_BYTES);
        hipOccupancyMaxActiveBlocksPerMultiprocessor(&per_cu, (const void*)fwd_kernel, 512, LDS_BYTES);
        if (per_cu < 1) { fprintf(stderr, "kernel_launch: occupancy query says %d blocks per CU\n", per_cu); per_cu = 1; }
        grid = cus * per_cu;
        (void)hipGetLastError();
    }
    if (grid < 0) return;
    Args a{};
    const float** pp = (const float**)&a;
    for (int i = 0; i < 21; ++i) pp[i] = (const float*)d_in[i];
    a.out = (float*)d_out; a.ws = (unsigned char*)d_ws;
#if ONE_LAUNCH
    a.ph_lo = 0; a.ph_hi = 11;
    void* args[] = {&a};
    hipError_t e = hipLaunchCooperativeKernel((const void*)fwd_kernel, dim3(grid), dim3(512), args, LDS_BYTES, stream);
    if (e != hipSuccess) fprintf(stderr, "cooperative launch failed: %s (grid %d)\n", hipGetErrorString(e), grid);
#else
    for (int p = 0; p < 11; ++p) { a.ph_lo = p; a.ph_hi = p + 1; hipLaunchKernelGGL(fwd_kernel, dim3(grid), dim3(512), LDS_BYTES, stream, a); }

#endif
}
```

```cpp
#include <hip/hip_runtime.h>
#include <hip/hip_cooperative_groups.h>
#include <cstdio>
#include <cstdint>
namespace cg = cooperative_groups;

#ifndef RPT_MASK
#define RPT_MASK 0
#endif
#ifndef ONE_LAUNCH
#define ONE_LAUNCH 1
#endif

#define LAS __attribute__((address_space(3)))
typedef unsigned short bf16_t;
typedef short bf16x8 __attribute__((ext_vector_type(8)));
typedef float f32x4 __attribute__((ext_vector_type(4)));
typedef unsigned u32x4 __attribute__((ext_vector_type(4)));
typedef unsigned u32x2 __attribute__((ext_vector_type(2)));

constexpr int D = 1024, NB = 8, SEQ = 2048, CTX = 256;
constexpr int ML = NB * SEQ;
constexpr int MC = NB * CTX;
constexpr int MT = ML + MC;
constexpr int DFF = 2816, NUP = 2 * DFF, INW = 6672;
constexpr float EPS = 1e-6f;
constexpr size_t MiB = 1u << 20;
constexpr size_t WS_ZERO = 0;
constexpr size_t WS_MOD = 0, WS_FB = 256 * 1024, WS_RSQ = 512 * 1024;
constexpr size_t WS_MODP = 236 * MiB + 12 * MiB;
constexpr size_t WS_RSQP = 252 * MiB;
constexpr size_t DO_FBP = 60 * MiB;
constexpr size_t WS_ROPE = 1 * MiB;
constexpr size_t WS_GATES = 2 * MiB;
constexpr size_t WS_WBA = 4 * MiB, WS_WBM = 6 * MiB, WS_WO = 8 * MiB, WS_WUP = 10 * MiB, WS_WDN = 21 * MiB;
constexpr size_t WS_AQ = 27 * MiB;
constexpr size_t WS_MQ = 59 * MiB, WS_MK = 75 * MiB  , WS_MO = 93 * MiB, WS_GA = 125 * MiB, WS_GM = 157 * MiB, WS_XT = 189 * MiB  ;
constexpr size_t WS_T1 = 59 * MiB, WS_Y = 189 * MiB;
constexpr size_t WS_U = 59 * MiB;
constexpr size_t WS_HALO = 236 * MiB;
constexpr size_t WS_ACT = 59 * MiB;
constexpr size_t WS_RAW = 147 * MiB;
constexpr size_t WS_END = 256 * MiB;
constexpr size_t DO_H = 0, DO_W1T = 36 * MiB, DO_W2T = 47 * MiB, DO_AK = 51 * MiB;
constexpr size_t DO_HF = 0, DO_HB = 32 * MiB;
constexpr int LDS_BYTES = 157696;

typedef float f32x2_t __attribute__((ext_vector_type(2))); typedef __bf16 bf16x2_t __attribute__((ext_vector_type(2)));
__device__ __forceinline__ unsigned cvt_pk_bf16(float lo, float hi) { f32x2_t v = {lo, hi}; bf16x2_t b = __builtin_convertvector(v, bf16x2_t); return __builtin_bit_cast(unsigned, b); }
__device__ __forceinline__ float bf2f(unsigned short v) { return __uint_as_float((unsigned)v << 16); }
__device__ __forceinline__ bf16_t f2bf(float f) { return (bf16_t)(cvt_pk_bf16(f, 0.f) & 0xffffu); }
__device__ __forceinline__ u32x4 pack8(f32x4 a, f32x4 b) { u32x4 w; w.x = cvt_pk_bf16(a[0], a[1]); w.y = cvt_pk_bf16(a[2], a[3]); w.z = cvt_pk_bf16(b[0], b[1]); w.w = cvt_pk_bf16(b[2], b[3]); return w; }
__device__ __forceinline__ float sigmoidf_(float x) { return 1.f / (1.f + __expf(-x)); }
__device__ __forceinline__ float wave_sum(float v) {
#pragma unroll
    for (int o = 1; o < 64; o <<= 1) v += __shfl_xor(v, o);
    return v;
}

namespace pg8 {
constexpr int BM = 256, BK = 64, HALF = 128, HTB = HALF * BK * 2, STAGE_BYTES = 8 * HTB, NXCD = 8, WGM = 8;
__host__ __device__ __forceinline__ int lds_byte(int r, int c) { const int st = (r >> 4) * 2 + (c >> 5), rr = r & 15, cc = c & 31, ob = rr * 64 + cc * 2; return st * 1024 + (ob ^ (((ob >> 9) & 1) << 5)); }
__host__ __device__ __forceinline__ void stage_rc(int b, int& R, int& C) { const int st = b / 1024, sb = b % 1024, swz = sb ^ (((sb >> 9) & 1) << 5); R = (st >> 1) * 16 + swz / 64; C = (st & 1) * 32 + (swz % 64) / 2; }
__host__ __device__ __forceinline__ int perm32(int rho) { const int n = rho >> 4, i = rho & 15; return 8 * (i >> 2) + 4 * n + (i & 3); }

struct Unit { int pm, pn; };
struct Gemm { const bf16_t* A; const bf16_t* Bt; int lda, ldb, K; const bf16_t* A2 = nullptr; const bf16_t* Bt2 = nullptr; };

struct Order {
    int nM, nN, nwg, G, c, extra;
    __device__ __forceinline__ void init(int nM_, int nN_, int G_, int c_, int extra_) { nM = nM_; nN = nN_; nwg = nM_ * nN_; G = G_; c = c_; extra = extra_; }
    __device__ __forceinline__ bool next(int i, Unit& u) const {
        const long Lq = (long)i * G + c; if (Lq >= nwg + extra) return false;
        if (Lq >= nwg) { const int e = (int)(Lq - nwg); u.pm = nM + e / 3; u.pn = e % 3; return true; }
        int wgid = (int)Lq; { const int q = nwg / NXCD, r = nwg % NXCD, xcd = wgid % NXCD, off = wgid / NXCD; wgid = (xcd < r ? xcd * (q + 1) : r * (q + 1) + (xcd - r) * q) + off; }
        const int nig = WGM * nN, gid = wgid / nig, fm = gid * WGM, gsz = (nM - fm) < WGM ? (nM - fm) : WGM;
        u.pm = fm + ((wgid % nig) % gsz); u.pn = (wgid % nig) / gsz; return true;
    }
};

template <class Epi, class Sched, bool ALIGN_EPI, bool DUAL = false>
__device__ __forceinline__ void gemm_phase(LAS unsigned char* lds, const Gemm g, const Sched& S, const Epi& E) {
    int tid_ = threadIdx.x; asm volatile("" : "+v"(tid_));
    const int tid = tid_, wid = __builtin_amdgcn_readfirstlane(tid >> 6), lane = tid & 63, wr = wid >> 2, wc = wid & 3, fr = lane & 15, fq = lane >> 4;
    const int K = g.K, nt1 = K / BK, nt = DUAL ? 2 * nt1 : nt1;
    unsigned voffA[2], voffB[2];
#pragma unroll
    for (int i = 0; i < 2; ++i) { int R, C; stage_rc(tid * 16 + i * 8192, R, C); const int Rb = ((R & ~31) + perm32(R & 31));
        voffA[i] = (unsigned)(R * g.lda + C) * 2u; voffB[i] = (unsigned)(Rb * g.ldb + C) * 2u; }
    const size_t kstep = (size_t)(BK * 2);
    const size_t hstepA = (size_t)HALF * g.lda * 2, hstepB = (size_t)HALF * g.ldb * 2;
    const size_t tstepA = 2 * hstepA, tstepB = 2 * hstepB;
    const unsigned ldsw = (unsigned)wid * 1024u;
    const int aoff = lds_byte(wr * 64 + fr, fq * 8), boff = lds_byte(wc * 32 + fr, fq * 8);
#define PG8_SA(b, h) (((b) * 2 + (h)) * HTB)
#define PG8_SB(b, h) ((4 + (b) * 2 + (h)) * HTB)
#define PG8_STAGE(bufoff, gbase, voff) do { _Pragma("unroll") for (int _i = 0; _i < 2; ++_i) \
        __builtin_amdgcn_global_load_lds((const unsigned*)((const char*)(gbase) + (voff)[_i]), (LAS unsigned*)(lds + (bufoff) + ldsw + _i * 8192), 16, 0, 0); } while (0)
#define PG8_LDA(dst, b, h) do { _Pragma("unroll") for (int m = 0; m < 4; ++m) _Pragma("unroll") for (int k = 0; k < 2; ++k) dst[m][k] = *(const LAS bf16x8*)(lds + PG8_SA(b, h) + aoff + m * 2048 + k * 1024); } while (0)
#define PG8_LDB(dst, b, h) do { _Pragma("unroll") for (int n = 0; n < 2; ++n) _Pragma("unroll") for (int k = 0; k < 2; ++k) dst[n][k] = *(const LAS bf16x8*)(lds + PG8_SB(b, h) + boff + n * 2048 + k * 1024); } while (0)
#define PG8_MMA(ai, bj, At, Bt) do { __builtin_amdgcn_s_setprio(1); _Pragma("unroll") for (int m = 0; m < 4; ++m) _Pragma("unroll") for (int n = 0; n < 2; ++n) _Pragma("unroll") for (int k = 0; k < 2; ++k) \
        acc[ai][bj][m][n] = __builtin_amdgcn_mfma_f32_16x16x32_bf16(Bt[n][k], At[m][k], acc[ai][bj][m][n], 0, 0, 0); __builtin_amdgcn_s_setprio(0); } while (0)
#define PG8_WAIT_V(n) asm volatile("s_waitcnt vmcnt(" #n ")" ::: "memory")
#define PG8_WAIT_L(n) asm volatile("s_waitcnt lgkmcnt(" #n ")" ::: "memory")
#define PG8_BAR __builtin_amdgcn_s_barrier()
#define PG8_SCHED __builtin_amdgcn_sched_barrier(0)
    Unit cur, nxt; int ui = 0;
    if (!S.next(0, cur)) return;
    f32x4 acc[2][2][4][2];
#pragma unroll
    for (int a = 0; a < 2; ++a)
#pragma unroll
        for (int b = 0; b < 2; ++b)
#pragma unroll
            for (int m = 0; m < 4; ++m)
#pragma unroll
                for (int n = 0; n < 2; ++n) acc[a][b][m][n] = (f32x4){0.f, 0.f, 0.f, 0.f};
    bf16x8 At[4][2], B0[2][2], B1[2][2];
    const char* cA = (const char*)g.A + (size_t)cur.pm * tstepA; const char* cB = (const char*)g.Bt + (size_t)cur.pn * tstepB;
    const char* cA2 = DUAL ? (const char*)g.A2 + (size_t)cur.pm * tstepA : cA; const char* cB2 = DUAL ? (const char*)g.Bt2 + (size_t)cur.pn * tstepB : cB;
    PG8_STAGE(PG8_SB(0, 0), cB, voffB); PG8_STAGE(PG8_SB(0, 1), cB + hstepB, voffB); PG8_STAGE(PG8_SA(0, 0), cA, voffA); PG8_STAGE(PG8_SA(0, 1), cA + hstepA, voffA);
    if (wr == 1) PG8_BAR;
    PG8_WAIT_V(2); PG8_BAR;
    PG8_STAGE(PG8_SB(1, 0), cB + kstep, voffB); PG8_STAGE(PG8_SA(1, 0), cA + kstep, voffA); PG8_STAGE(PG8_SB(1, 1), cB + hstepB + kstep, voffB);
    PG8_WAIT_V(6); PG8_BAR;
    for (;;) {
        const bool has_next = S.next(ui + 1, nxt);
        const char* nA = has_next ? (const char*)g.A + (size_t)nxt.pm * tstepA : cA; const char* nB = has_next ? (const char*)g.Bt + (size_t)nxt.pn * tstepB : cB;
        for (int t = 0; t < nt; t += 2) {
            const bool last = (t == nt - 2);
            const bool seg2 = DUAL && t >= nt1, seg2n = DUAL && t + 2 >= nt1;
            const char* a1 = seg2 ? cA2 + (size_t)(t + 1 - nt1) * kstep : cA + (size_t)(t + 1) * kstep;
            const char* a2 = last ? nA : (seg2n ? cA2 + (size_t)(t + 2 - nt1) * kstep : cA + (size_t)(t + 2) * kstep);
            const char* b2 = last ? nB : (seg2n ? cB2 + (size_t)(t + 2 - nt1) * kstep : cB + (size_t)(t + 2) * kstep);
            if constexpr (DUAL) { if (t == nt1) E.mid(acc, cur, wr, wc, fr, fq); }
            const char* a3 = a2 + kstep; const char* b3 = b2 + kstep;
            PG8_LDB(B0, 0, 0); PG8_LDB(B1, 0, 1); PG8_SCHED; PG8_LDA(At, 0, 0); PG8_STAGE(PG8_SA(1, 1), a1 + hstepA, voffA);
            PG8_WAIT_V(8); PG8_WAIT_L(0); PG8_BAR; PG8_MMA(0, 0, At, B0); PG8_MMA(0, 1, At, B1); PG8_BAR; PG8_SCHED;
            PG8_LDA(At, 0, 1); PG8_STAGE(PG8_SB(0, 0), b2, voffB); PG8_STAGE(PG8_SB(0, 1), b2 + hstepB, voffB); PG8_STAGE(PG8_SA(0, 0), a2, voffA);
            PG8_WAIT_V(8); PG8_WAIT_L(0); PG8_BAR; PG8_MMA(1, 0, At, B0); PG8_MMA(1, 1, At, B1); PG8_BAR; PG8_SCHED;
            PG8_LDB(B0, 1, 0); PG8_LDB(B1, 1, 1); PG8_SCHED; PG8_LDA(At, 1, 0); PG8_STAGE(PG8_SA(0, 1), a2 + hstepA, voffA);
            PG8_WAIT_V(8); PG8_WAIT_L(0); PG8_BAR; PG8_MMA(0, 0, At, B0); PG8_MMA(0, 1, At, B1); PG8_BAR; PG8_SCHED;
            PG8_LDA(At, 1, 1); PG8_STAGE(PG8_SB(1, 0), b3, voffB); PG8_STAGE(PG8_SB(1, 1), b3 + hstepB, voffB); PG8_STAGE(PG8_SA(1, 0), a3, voffA);
            PG8_WAIT_V(8); PG8_WAIT_L(0); PG8_BAR; PG8_MMA(1, 0, At, B0); PG8_MMA(1, 1, At, B1); PG8_BAR; PG8_SCHED;
        }
        if constexpr (ALIGN_EPI) { if (wr == 0) PG8_BAR; }
        E(acc, cur, wr, wc, fr, fq);
        if (!has_next) break;
#pragma unroll
        for (int a = 0; a < 2; ++a)
#pragma unroll
            for (int b = 0; b < 2; ++b)
#pragma unroll
                for (int m = 0; m < 4; ++m)
#pragma unroll
                    for (int n = 0; n < 2; ++n) acc[a][b][m][n] = (f32x4){0.f, 0.f, 0.f, 0.f};
        cur = nxt; cA = nA; cB = nB; ++ui;
        if constexpr (DUAL) { cA2 = (const char*)g.A2 + (size_t)cur.pm * tstepA; cB2 = (const char*)g.Bt2 + (size_t)cur.pn * tstepB; }
        if constexpr (ALIGN_EPI) { if (wr == 1) PG8_BAR; }
    }
    PG8_WAIT_V(0);
    if constexpr (!ALIGN_EPI) { if (wr == 0) PG8_BAR; }
    PG8_BAR;
#undef PG8_SA
#undef PG8_SB
#undef PG8_STAGE
#undef PG8_LDA
#undef PG8_LDB
#undef PG8_MMA
#undef PG8_WAIT_V
#undef PG8_WAIT_L
#undef PG8_BAR
#undef PG8_SCHED
}
}
using pg8::Unit;
typedef const f32x4 (&AccRef)[2][2][4][2];

struct EpiIn {
    bf16_t *AK_, *MK_, *AQ_, *MQ_, *MO_, *GA_, *GM_; const float *qnw, *knw, *cosT_, *sinT_; LAS float* sp;
    __device__ __forceinline__ void head_path(AccRef acc, const Unit& u, int wr, int wc, int fr, int fq_in, bf16_t* base, int ld, int coff, const float* nw) const {
        int fq = fq_in; asm volatile("" : "+v"(fq));
        const int row0 = u.pm * 256 + wr * 64 + fr;
        const bool rope = u.pm < 64;
        { int tx = threadIdx.x; asm volatile("" : "+v"(tx)); const int tt0 = (u.pm * 256) & 2047;
          for (int i = tx; i < (rope ? 2512 : 64); i += 512) { float v;
              if (i < 64) v = nw[i];
              else if (i < 208) { const int k = i - 64, gi = k / 36, e = k - gi * 36; const int t = tt0 + 64 * gi; v = e < 16 ? cosT_[t * 32 + e] : e < 32 ? sinT_[t * 32 + e - 16] : 0.f; }
              else { const int k = i - 208, c = k / 36, e = k - c * 36; const int t = tt0 + c; v = e < 16 ? cosT_[t * 32 + 16 + e] : e < 32 ? sinT_[t * 32 + e] : 0.f; }
              sp[i] = v; }
          asm volatile("s_waitcnt vmcnt(0) lgkmcnt(0)" ::: "memory"); __builtin_amdgcn_s_barrier(); asm volatile("" ::: "memory"); }
        const f32x4 w00 = *(const LAS f32x4*)(sp + 8 * fq), w01 = *(const LAS f32x4*)(sp + 8 * fq + 4), w10 = *(const LAS f32x4*)(sp + 32 + 8 * fq), w11 = *(const LAS f32x4*)(sp + 32 + 8 * fq + 4);
#pragma unroll
        for (int ai = 0; ai < 2; ++ai)
#pragma unroll
            for (int m = 0; m < 4; ++m) {
                const int row = row0 + ai * 128 + m * 16;
                f32x4 v00 = acc[ai][0][m][0], v01 = acc[ai][0][m][1], v10 = acc[ai][1][m][0], v11 = acc[ai][1][m][1];
                f32x4 q = v00 * v00 + v01 * v01 + v10 * v10 + v11 * v11;
                float ss = (q[0] + q[1]) + (q[2] + q[3]);
                ss += __shfl_xor(ss, 16); ss += __shfl_xor(ss, 32);
                const float rs = rsqrtf(ss * (1.f / 64.f) + EPS);
                v00 = v00 * rs * w00; v01 = v01 * rs * w01; v10 = v10 * rs * w10; v11 = v11 * rs * w11;
                f32x4 o00 = v00, o01 = v01, o10 = v10, o11 = v11;
                if (rope) {
                    const int r = ai * 128 + wr * 64 + m * 16 + fr;
                    const LAS float* cp = sp + ((fq < 2) ? 64 + (r >> 6) * 36 + 8 * fq : 208 + (r & 63) * 36 + 8 * (fq - 2));
                    const f32x4 c0 = *(const LAS f32x4*)cp, c1 = *(const LAS f32x4*)(cp + 4), s0 = *(const LAS f32x4*)(cp + 16), s1 = *(const LAS f32x4*)(cp + 20);
                    o00 = v00 * c0 - v10 * s0; o01 = v01 * c1 - v11 * s1; o10 = v00 * s0 + v10 * c0; o11 = v01 * s1 + v11 * c1;
                }
                bf16_t* p = base + (size_t)row * ld + coff + wc * 64 + 8 * fq;
                *(u32x4*)p = pack8(o00, o01); *(u32x4*)(p + 32) = pack8(o10, o11);
                asm volatile("" ::: "memory");
            }
    }
    template <bool SIG> __device__ __forceinline__ void plain_path(AccRef acc, const Unit& u, int wr, int wc, int fr, int fq, bf16_t* base, int ld, int coff) const {
        const int row0 = u.pm * 256 + wr * 64 + fr;
#pragma unroll
        for (int ai = 0; ai < 2; ++ai)
#pragma unroll
            for (int m = 0; m < 4; ++m) {
                bf16_t* p = base + (size_t)(row0 + ai * 128 + m * 16) * ld + coff + wc * 32 + 8 * fq;
#pragma unroll
                for (int bj = 0; bj < 2; ++bj) { f32x4 v0 = acc[ai][bj][m][0], v1 = acc[ai][bj][m][1];
                    if (SIG) {
#pragma unroll
                        for (int e = 0; e < 4; ++e) { v0[e] = sigmoidf_(v0[e]); v1[e] = sigmoidf_(v1[e]); } }
                    *(u32x4*)(p + bj * 128) = pack8(v0, v1); }
            }
    }
    __device__ __forceinline__ void operator()(AccRef acc, const Unit& u, int wr, int wc, int fr, int fq) const {
        const int pn = u.pn;
        if (pn == 0) head_path(acc, u, wr, wc, fr, fq, AK_, 256, 0, knw);
        else if (pn <= 2) plain_path<false>(acc, u, wr, wc, fr, fq, MK_, 512, (pn - 1) * 256);
        else if (pn <= 6) head_path(acc, u, wr, wc, fr, fq, AQ_, 1024, (pn - 3) * 256, qnw);
        else if (pn <= 8) plain_path<false>(acc, u, wr, wc, fr, fq, MQ_, 512, (pn - 7) * 256);
        else if (pn <= 12) plain_path<false>(acc, u, wr, wc, fr, fq, MO_, 1024, (pn - 9) * 256);
        else if (pn <= 16) plain_path<true>(acc, u, wr, wc, fr, fq, GA_, 1024, (pn - 13) * 256);
        else plain_path<true>(acc, u, wr, wc, fr, fq, GM_, 1024, (pn - 17) * 256);
    }
};
struct EpiPlain {
    bf16_t* O; int ldc;
    __device__ __forceinline__ void operator()(AccRef acc, const Unit& u, int wr, int wc, int fr, int fq) const {
        const int row0 = u.pm * 256 + wr * 64 + fr;
#pragma unroll
        for (int ai = 0; ai < 2; ++ai)
#pragma unroll
            for (int m = 0; m < 4; ++m) {
                bf16_t* p = O + (size_t)(row0 + ai * 128 + m * 16) * ldc + u.pn * 256 + wc * 32 + 8 * fq;
#pragma unroll
                for (int bj = 0; bj < 2; ++bj) *(u32x4*)(p + bj * 128) = pack8(acc[ai][bj][m][0], acc[ai][bj][m][1]);
            }
    }
};
template <bool ADD> struct EpiGate {
    const bf16_t* Gt; const bf16_t* T; bf16_t* O;
    __device__ __forceinline__ void operator()(AccRef acc, const Unit& u, int wr, int wc, int fr, int fq) const {
        const int row0 = u.pm * 256 + wr * 64 + fr;
        const size_t off0 = (size_t)row0 * 1024 + u.pn * 256 + wc * 32 + 8 * fq;
        u32x4 gv[2][2], tv[2][2];
#pragma unroll
        for (int bj = 0; bj < 2; ++bj) { gv[0][bj] = *(const u32x4*)(Gt + off0 + bj * 128); tv[0][bj] = (u32x4){0u, 0u, 0u, 0u}; if (ADD) tv[0][bj] = *(const u32x4*)(T + off0 + bj * 128); }
#pragma unroll
        for (int it = 0; it < 8; ++it) {
            const int ai = it >> 2, m = it & 3, cur = it & 1, nx = cur ^ 1;
            const size_t off = off0 + (size_t)(ai * 128 + m * 16) * 1024;
            if (it < 7) { const size_t offn = off0 + (size_t)(((it + 1) >> 2) * 128 + ((it + 1) & 3) * 16) * 1024;
#pragma unroll
                for (int bj = 0; bj < 2; ++bj) { gv[nx][bj] = *(const u32x4*)(Gt + offn + bj * 128); tv[nx][bj] = (u32x4){0u, 0u, 0u, 0u}; if (ADD) tv[nx][bj] = *(const u32x4*)(T + offn + bj * 128); } }
#pragma unroll
            for (int bj = 0; bj < 2; ++bj) {
                float r[8];
#pragma unroll
                for (int e = 0; e < 8; ++e) {
                    const unsigned gw = gv[cur][bj][e >> 1], tw = tv[cur][bj][e >> 1];
                    const float gg = (e & 1) ? __uint_as_float(gw & 0xffff0000u) : __uint_as_float(gw << 16);
                    const float tt = (e & 1) ? __uint_as_float(tw & 0xffff0000u) : __uint_as_float(tw << 16);
                    r[e] = tt + sigmoidf_(gg) * acc[ai][bj][m][e >> 2][e & 3];
                }
                u32x4 w; w.x = cvt_pk_bf16(r[0], r[1]); w.y = cvt_pk_bf16(r[2], r[3]); w.z = cvt_pk_bf16(r[4], r[5]); w.w = cvt_pk_bf16(r[6], r[7]);
                *(u32x4*)(O + off + bj * 128) = w;
            }
        }
    }
};
struct EpiMerge {
    const bf16_t* Sa; const bf16_t* Sm; bf16_t* O;
    __device__ __forceinline__ void mid(f32x4 (&acc)[2][2][4][2], const Unit& u, int wr, int wc, int fr, int fq) const {
        const size_t off0 = (size_t)(u.pm * 256 + wr * 64 + fr) * 1024 + u.pn * 256 + wc * 32 + 8 * fq;
        u32x4 av[2][2], mv[2][2];
#pragma unroll
        for (int bj = 0; bj < 2; ++bj) { av[0][bj] = *(const u32x4*)(Sa + off0 + bj * 128); mv[0][bj] = *(const u32x4*)(Sm + off0 + bj * 128); }
#pragma unroll
        for (int it = 0; it < 8; ++it) {
            const int ai = it >> 2, m = it & 3, cur = it & 1, nx = cur ^ 1;
            if (it < 7) { const size_t offn = off0 + (size_t)(((it + 1) >> 2) * 128 + ((it + 1) & 3) * 16) * 1024;
#pragma unroll
                for (int bj = 0; bj < 2; ++bj) { av[nx][bj] = *(const u32x4*)(Sa + offn + bj * 128); mv[nx][bj] = *(const u32x4*)(Sm + offn + bj * 128); } }
#pragma unroll
            for (int bj = 0; bj < 2; ++bj)
#pragma unroll
                for (int e = 0; e < 8; ++e) {
                    const unsigned aw = av[cur][bj][e >> 1], mw = mv[cur][bj][e >> 1];
                    const float sa = (e & 1) ? __uint_as_float(aw & 0xffff0000u) : __uint_as_float(aw << 16);
                    const float sm = (e & 1) ? __uint_as_float(mw & 0xffff0000u) : __uint_as_float(mw << 16);
                    acc[ai][bj][m][e >> 2][e & 3] *= sa * __builtin_amdgcn_rcpf(fmaxf(sm, 1e-30f));
                }
        }
    }
    __device__ __forceinline__ void operator()(AccRef acc, const Unit& u, int wr, int wc, int fr, int fq) const {
        const size_t off0 = (size_t)(u.pm * 256 + wr * 64 + fr) * 1024 + u.pn * 256 + wc * 32 + 8 * fq;
        u32x4 mv[2][2];
#pragma unroll
        for (int bj = 0; bj < 2; ++bj) mv[0][bj] = *(const u32x4*)(Sm + off0 + bj * 128);
#pragma unroll
        for (int it = 0; it < 8; ++it) {
            const int ai = it >> 2, m = it & 3, cur = it & 1, nx = cur ^ 1;
            const size_t off = off0 + (size_t)(ai * 128 + m * 16) * 1024;
            if (it < 7) { const size_t offn = off0 + (size_t)(((it + 1) >> 2) * 128 + ((it + 1) & 3) * 16) * 1024;
#pragma unroll
                for (int bj = 0; bj < 2; ++bj) mv[nx][bj] = *(const u32x4*)(Sm + offn + bj * 128); }
#pragma unroll
            for (int bj = 0; bj < 2; ++bj) { float r[8];
#pragma unroll
                for (int e = 0; e < 8; ++e) { const unsigned mw = mv[cur][bj][e >> 1];
                    const float sm = (e & 1) ? __uint_as_float(mw & 0xffff0000u) : __uint_as_float(mw << 16);
                    r[e] = fmaxf(sm, 1e-30f) * acc[ai][bj][m][e >> 2][e & 3]; }
                u32x4 w; w.x = cvt_pk_bf16(r[0], r[1]); w.y = cvt_pk_bf16(r[2], r[3]); w.z = cvt_pk_bf16(r[4], r[5]); w.w = cvt_pk_bf16(r[6], r[7]);
                *(u32x4*)(O + off + bj * 128) = w; }
        }
    }
};
struct EpiOut {
    const float* x; const float* mod; const float* nw2; float* xmid; bf16_t* AP; float* rowsq;
    __device__ __forceinline__ void operator()(AccRef acc, const Unit& u, int wr, int wc, int fr, int fq) const {
        const int b = u.pm >> 3; const float* mb = mod + b * 6144;
        const int row0 = u.pm * 256 + wr * 64 + fr, col0 = u.pn * 256 + wc * 32 + 8 * fq;
        f32x4 g1[2][2], sw[2][2];
#pragma unroll
        for (int bj = 0; bj < 2; ++bj)
#pragma unroll
            for (int n = 0; n < 2; ++n) { const int c = col0 + bj * 128 + 4 * n; g1[bj][n] = *(const f32x4*)(mb + 2048 + c);
                sw[bj][n] = *(const f32x4*)(nw2 + c) * (*(const f32x4*)(mb + 4096 + c) + 1.f); }
        f32x4 xv[2][2][2];
#pragma unroll
        for (int bj = 0; bj < 2; ++bj)
#pragma unroll
            for (int n = 0; n < 2; ++n) xv[0][bj][n] = *(const f32x4*)(x + (size_t)row0 * 1024 + col0 + bj * 128 + 4 * n);
#pragma unroll
        for (int it = 0; it < 8; ++it) {
            const int ai = it >> 2, m = it & 3, cur = it & 1, nx = cur ^ 1;
            const int row = row0 + ai * 128 + m * 16; const size_t off = (size_t)row * 1024 + col0; float ss = 0.f;
            if (it < 7) { const size_t offn = (size_t)(row0 + ((it + 1) >> 2) * 128 + ((it + 1) & 3) * 16) * 1024 + col0;
#pragma unroll
                for (int bj = 0; bj < 2; ++bj)
#pragma unroll
                    for (int n = 0; n < 2; ++n) xv[nx][bj][n] = *(const f32x4*)(x + offn + bj * 128 + 4 * n); }
#pragma unroll
            for (int bj = 0; bj < 2; ++bj) {
                f32x4 v[2];
#pragma unroll
                for (int n = 0; n < 2; ++n) { v[n] = xv[cur][bj][n] + g1[bj][n] * acc[ai][bj][m][n];
                    const f32x4 q = v[n] * v[n]; ss += (q[0] + q[1]) + (q[2] + q[3]); }
                *(u32x4*)(AP + off + bj * 128) = pack8(v[0] * sw[bj][0], v[1] * sw[bj][1]);
            }
            ss += __shfl_xor(ss, 16); ss += __shfl_xor(ss, 32);
            if (fq == 0) rowsq[(size_t)row * 16 + u.pn * 4 + wc] = ss;
        }
    }
};
__device__ __forceinline__ float dpp_prev(float v) { return __int_as_float(__builtin_amdgcn_update_dpp(0, __float_as_int(v), 0x111, 0xf, 0xf, true)); }
__device__ __forceinline__ float dpp_next(float v) { return __int_as_float(__builtin_amdgcn_update_dpp(0, __float_as_int(v), 0x101, 0xf, 0xf, true)); }
struct EpiUp {
    const float* rowsq; const float* fb; const float* cw; const float* cb; bf16_t* ACT_; bf16_t* RAW_; LAS float* sp;
    __device__ __forceinline__ void operator()(AccRef acc, const Unit& u, int wr, int wc, int fr, int fq) const {
        const int b = u.pm >> 3; const int row0 = u.pm * 256 + wr * 64 + fr;
        int tx = threadIdx.x; asm volatile("" : "+v"(tx));
        if (tx < 256) {
            const float* qp = rowsq + (size_t)(u.pm * 256 + tx) * 16; const f32x4 q0 = *(const f32x4*)qp, q1 = *(const f32x4*)(qp + 4), q2 = *(const f32x4*)(qp + 8), q3 = *(const f32x4*)(qp + 12);
            const f32x4 qs = (q0 + q1) + (q2 + q3); sp[1280 + tx] = rsqrtf(((qs[0] + qs[1]) + (qs[2] + qs[3])) * (1.f / 1024.f) + EPS);
        } else {
            for (int i = tx - 256; i < 1280; i += 256) { const int vec = i >> 7, j = u.pn * 128 + (i & 127);
                const float* src = vec == 0 ? fb + b * NUP + j : vec == 1 ? fb + b * NUP + DFF + j : vec < 5 ? cw + (vec - 2) * NUP + j : vec < 8 ? cw + (vec - 5) * NUP + DFF + j : vec == 8 ? cb + j : cb + DFF + j;
                sp[i] = *src; } }
        asm volatile("s_waitcnt vmcnt(0) lgkmcnt(0)" ::: "memory"); __builtin_amdgcn_s_barrier(); asm volatile("" ::: "memory");
        const LAS float* spc = sp + wc * 32 + 8 * fq;
        const int jb = u.pn * 128 + wc * 32 + 8 * fq;
        const int pcol = u.pn * 256 + wc * 32 + 8 * fq;
        const bool interior = (fr >= 1) && (fr <= 14), rawrow = !((fr >= 2) && (fr <= 13));
        const int slot = fr < 2 ? fr : fr - 12;
#pragma unroll
        for (int ai = 0; ai < 2; ++ai)
#pragma unroll
            for (int m = 0; m < 4; ++m) {
                const int row = row0 + ai * 128 + m * 16; const float rstd = sp[1280 + ai * 128 + wr * 64 + m * 16 + fr];
                float r[8]; f32x4 ua[2], ug[2];
#pragma unroll
                for (int n = 0; n < 2; ++n) {
                    ua[n] = acc[ai][0][m][n] * rstd + *(const LAS f32x4*)(spc + 0 * 128 + 4 * n);
                    ug[n] = acc[ai][1][m][n] * rstd + *(const LAS f32x4*)(spc + 1 * 128 + 4 * n);
                    const f32x4 wa0 = *(const LAS f32x4*)(spc + 2 * 128 + 4 * n), wa1 = *(const LAS f32x4*)(spc + 3 * 128 + 4 * n), wa2 = *(const LAS f32x4*)(spc + 4 * 128 + 4 * n);
                    const f32x4 wg0 = *(const LAS f32x4*)(spc + 5 * 128 + 4 * n), wg1 = *(const LAS f32x4*)(spc + 6 * 128 + 4 * n), wg2 = *(const LAS f32x4*)(spc + 7 * 128 + 4 * n);
                    const f32x4 ba = *(const LAS f32x4*)(spc + 8 * 128 + 4 * n), bg = *(const LAS f32x4*)(spc + 9 * 128 + 4 * n);
#pragma unroll
                    for (int e = 0; e < 4; ++e) {
                        const float av = ba[e] + wa0[e] * dpp_prev(ua[n][e]) + wa1[e] * ua[n][e] + wa2[e] * dpp_next(ua[n][e]);
                        const float gv = bg[e] + wg0[e] * dpp_prev(ug[n][e]) + wg1[e] * ug[n][e] + wg2[e] * dpp_next(ug[n][e]);
                        r[4 * n + e] = gv * sigmoidf_(gv) * av;
                    }
                }
                if (interior) { u32x4 w; w.x = cvt_pk_bf16(r[0], r[1]); w.y = cvt_pk_bf16(r[2], r[3]); w.z = cvt_pk_bf16(r[4], r[5]); w.w = cvt_pk_bf16(r[6], r[7]);
                    *(u32x4*)(ACT_ + (size_t)row * DFF + jb) = w; }
                if (rawrow) { bf16_t* rp = RAW_ + ((size_t)(row >> 4) * 4 + slot) * NUP + pcol;
                    *(u32x4*)rp = pack8(ua[0], ua[1]); *(u32x4*)(rp + 128) = pack8(ug[0], ug[1]); }
                asm volatile("" ::: "memory");
            }
    }
};
struct EpiDown {
    float* out; const float* mod; const bf16_t* AP; const float* nw2;
    __device__ __forceinline__ void operator()(AccRef acc, const Unit& u, int wr, int wc, int fr, int fq) const {
        const int b = u.pm >> 3; const float* mb = mod + b * 6144;
        const int row0 = u.pm * 256 + wr * 64 + fr, col0 = u.pn * 256 + wc * 32 + 8 * fq;
        f32x4 g2[2][2], rsw[2][2];
#pragma unroll
        for (int bj = 0; bj < 2; ++bj)
#pragma unroll
            for (int n = 0; n < 2; ++n) { const int c = col0 + bj * 128 + 4 * n; g2[bj][n] = *(const f32x4*)(mb + 5120 + c);
                const f32x4 sw = *(const f32x4*)(nw2 + c) * (*(const f32x4*)(mb + 4096 + c) + 1.f);
#pragma unroll
                for (int e = 0; e < 4; ++e) rsw[bj][n][e] = 1.f / sw[e]; }
        u32x4 av[2][2];
#pragma unroll
        for (int bj = 0; bj < 2; ++bj) av[0][bj] = *(const u32x4*)(AP + (size_t)row0 * 1024 + col0 + bj * 128);
#pragma unroll
        for (int it = 0; it < 8; ++it) {
            const int ai = it >> 2, m = it & 3, cur = it & 1, nx = cur ^ 1;
            const size_t off = (size_t)(row0 + ai * 128 + m * 16) * 1024 + col0;
            if (it < 7) { const size_t offn = (size_t)(row0 + ((it + 1) >> 2) * 128 + ((it + 1) & 3) * 16) * 1024 + col0;
#pragma unroll
                for (int bj = 0; bj < 2; ++bj) av[nx][bj] = *(const u32x4*)(AP + offn + bj * 128); }
#pragma unroll
            for (int bj = 0; bj < 2; ++bj)
#pragma unroll
                for (int n = 0; n < 2; ++n) { const unsigned w0 = av[cur][bj][2 * n], w1 = av[cur][bj][2 * n + 1];
                    const f32x4 ap = (f32x4){__uint_as_float(w0 << 16), __uint_as_float(w0 & 0xffff0000u), __uint_as_float(w1 << 16), __uint_as_float(w1 & 0xffff0000u)};
                    *(f32x4*)(out + off + bj * 128 + 4 * n) = ap * rsw[bj][n] + g2[bj][n] * acc[ai][bj][m][n]; }
        }
    }
};

__device__ __forceinline__ f32x4 mfma16(bf16x8 a, bf16x8 b, f32x4 c) { return __builtin_amdgcn_mfma_f32_16x16x32_bf16(a, b, c, 0, 0, 0); }

__device__ __forceinline__ void transpose_item(const float* W, int ldw, int col, int k0, bf16_t* WT, int dst_row, int dld, LAS float* scr, int lane) {
#pragma unroll 8
    for (int i = 0; i < 32; ++i) { const int kk = 2 * i + (lane >> 5); scr[kk * 33 + (lane & 31)] = W[(size_t)(k0 + kk) * ldw + col + (lane & 31)]; }
    asm volatile("s_waitcnt lgkmcnt(0)" ::: "memory");
    const int c = lane & 7;
#pragma unroll
    for (int j = 0; j < 4; ++j) { const int n = (lane >> 3) + 8 * j; const LAS float* s = scr + (8 * c) * 33 + n;
        u32x4 o; o.x = cvt_pk_bf16(s[0 * 33], s[1 * 33]); o.y = cvt_pk_bf16(s[2 * 33], s[3 * 33]); o.z = cvt_pk_bf16(s[4 * 33], s[5 * 33]); o.w = cvt_pk_bf16(s[6 * 33], s[7 * 33]);
        *(u32x4*)(WT + (size_t)(dst_row + n) * dld + k0 + 8 * c) = o; }
    asm volatile("s_waitcnt lgkmcnt(0)" ::: "memory");
}
__device__ __forceinline__ int headperm(int n0) { const int tile = n0 >> 8, l = n0 & 255; return tile * 256 + 128 * ((l >> 5) & 1) + 32 * (l >> 6); }

struct Args {
    const float *x, *c, *ctx, *c_ctx, *w_mod, *b_mod, *norm1_w, *w_in, *q_norm_w, *k_norm_w, *attn_sink, *ml_gate_b, *ml_norm_w,
        *w_branch_att, *w_branch_ml, *w_out, *norm2_w, *w_up, *conv_w, *conv_b, *w_down;
    float* out; unsigned char* ws; int ph_lo, ph_hi;
};

template <int NV, int KS, bool ATOMIC> __device__ __forceinline__ void gemv_task(const float* W, int ldw, int n0, int k0, const LAS float* svec, float* out, int ldo) {
    const int n = n0 + threadIdx.x; float a[NV];
#pragma unroll
    for (int v = 0; v < NV; ++v) a[v] = 0.f;
#pragma unroll 16
    for (int k = 0; k < KS; ++k) { const float w = W[(size_t)(k0 + k) * ldw + n];
#pragma unroll
        for (int v = 0; v < NV; ++v) a[v] += svec[v * KS + k] * w; }
#pragma unroll
    for (int v = 0; v < NV; ++v) { if (ATOMIC) atomicAdd(out + (size_t)v * ldo + n, a[v]); else out[(size_t)v * ldo + n] = a[v]; }
}

#define mod   ((float*)(wsb + WS_MOD))
#define modp  ((float*)(wsb + WS_MODP))
#define fbias ((float*)(wsb + WS_FB))
#define rowsq ((float*)(wsb + WS_RSQP))
#define fbp ((float*)(dob + DO_FBP))
#define cosT  ((float*)(wsb + WS_ROPE))
#define sinT  ((float*)(wsb + WS_ROPE) + 2048 * 32)
#define gates ((float*)(wsb + WS_GATES))
#define WBA ((bf16_t*)(wsb + WS_WBA))
#define WBM ((bf16_t*)(wsb + WS_WBM))
#define WO  ((bf16_t*)(wsb + WS_WO))
#define WUP ((bf16_t*)(wsb + WS_WUP))
#define WDN ((bf16_t*)(wsb + WS_WDN))
#define AQ  ((bf16_t*)(wsb + WS_AQ))
#ifdef DBG_ATTO
#define ATTO GA
#else
#define ATTO AQ
#endif
#define MQ  ((bf16_t*)(wsb + WS_MQ))
#define MK  ((bf16_t*)(wsb + WS_MK))
#define MO  ((bf16_t*)(wsb + WS_MO))
#define GA  ((bf16_t*)(wsb + WS_GA))
#define GM  ((bf16_t*)(wsb + WS_GM))
#define XT  ((bf16_t*)(wsb + WS_XT))
#define T1  ((bf16_t*)(wsb + WS_T1))
#define Y   ((bf16_t*)(wsb + WS_Y))
#define U   ((bf16_t*)(wsb + WS_U))
#define HALO ((bf16_t*)(wsb + WS_HALO))
#define ACT ((bf16_t*)(wsb + WS_ACT))
#define RAWU ((bf16_t*)(wsb + WS_RAW))
#define H   ((bf16_t*)(dob + DO_H))
#define W1T ((bf16_t*)(dob + DO_W1T))
#define W2T ((bf16_t*)(dob + DO_W2T))
#define AK  ((bf16_t*)(dob + DO_AK))
#define HF  ((bf16_t*)(dob + DO_HF))
#define HB  ((bf16_t*)(dob + DO_HB))

#define XB_TMO      128
#define XB_XCNT(j)  (256  + 64 * (j))
#define XB_XSUB(j)  (1280 + 64 * (j))
#define XB_XGEN(j)  (2304 + 64 * (j))
#define XB_TOP      3328
#define XB_TOPGEN   3392
#define XCD_BAR_WORDS 3456
#define XB_SPIN_CAP (1u << 18)
__device__ __forceinline__ unsigned xb_ld(unsigned* p)              { return __hip_atomic_load(p, __ATOMIC_RELAXED, __HIP_MEMORY_SCOPE_AGENT); }
__device__ __forceinline__ unsigned xb_add(unsigned* p, unsigned v) { return __hip_atomic_fetch_add(p, v, __ATOMIC_RELAXED, __HIP_MEMORY_SCOPE_AGENT); }
__device__ __forceinline__ unsigned xb_xcc_id() { return (unsigned)__builtin_amdgcn_s_getreg((3 << 11) | 20) & 0xFu; }
#define XB_SPIN(cond, bar) do { unsigned _sp = 0; while (cond) { __builtin_amdgcn_s_sleep(1); \
    if ((++_sp & 255u) == 0u) { if (xb_ld(&(bar)[XB_TMO])) break; if (_sp > XB_SPIN_CAP) { atomicAdd(&(bar)[XB_TMO], 1u); break; } } } } while (0)
struct XcdBarrier { unsigned* bar; unsigned x; volatile LAS unsigned* st; };
__device__ __forceinline__ XcdBarrier xcd_barrier_post(unsigned* bar, volatile LAS unsigned* st) {
    XcdBarrier b; b.bar = bar; b.x = xb_xcc_id(); b.st = st;
    if (threadIdx.x == 0) (void)xb_add(&bar[XB_XCNT(b.x)], 1u);
    return b;
}
__device__ __forceinline__ void xcd_barrier_complete(unsigned* bar, unsigned x, unsigned& nloc, unsigned& nx) {
    const unsigned G = gridDim.x * gridDim.y * gridDim.z;
    unsigned sum, cnt, mine, sp = 0u;
    for (;;) {
        sum = 0u; cnt = 0u; mine = 0u;
#pragma unroll
        for (unsigned j = 0; j < 16; ++j) { const unsigned c = xb_ld(&bar[XB_XCNT(j)]); sum += c; cnt += (c > 0u) ? 1u : 0u; mine = (j == x) ? c : mine; }
        if (sum == G) break;
        __builtin_amdgcn_s_sleep(1);
        if ((++sp & 255u) == 0u) { if (xb_ld(&bar[XB_TMO])) break; if (sp > XB_SPIN_CAP) { atomicAdd(&bar[XB_TMO], 1u); break; } }
    }
    nloc = mine > 0u ? mine : 1u; nx = cnt > 0u ? cnt : 1u;
}
__device__ __forceinline__ void xcd_barrier(const XcdBarrier& b) {
    asm volatile("s_waitcnt vmcnt(0)" ::: "memory");
    __syncthreads();
    if (threadIdx.x == 0) {
        unsigned* bar = b.bar;
        __builtin_amdgcn_s_waitcnt(0);
        unsigned nloc = b.st[0], nx = b.st[1];
        if (nloc == 0u) { xcd_barrier_complete(bar, b.x, nloc, nx); b.st[0] = nloc; b.st[1] = nx; }
        const unsigned old = xb_add(&bar[XB_XSUB(b.x)], 1u);
        const unsigned gen = old / nloc;
        if (old + 1u == (gen + 1u) * nloc) {
            __builtin_amdgcn_fence(__ATOMIC_RELEASE, "agent");
            asm volatile("s_waitcnt vmcnt(0)" ::: "memory");
            const unsigned og = xb_add(&bar[XB_TOP], 1u);
            const unsigned tg = og / nx;
            if (og + 1u == (tg + 1u) * nx) xb_add(&bar[XB_TOPGEN], 1u);
            else XB_SPIN(xb_ld(&bar[XB_TOPGEN]) == tg, bar);
            __builtin_amdgcn_fence(__ATOMIC_ACQUIRE, "agent");
            xb_add(&bar[XB_XGEN(b.x)], 1u);
            asm volatile("s_waitcnt vmcnt(0)" ::: "memory");
        } else {
            XB_SPIN(xb_ld(&bar[XB_XGEN(b.x)]) == gen, bar);
            __builtin_amdgcn_fence(__ATOMIC_ACQUIRE, "agent");
            asm volatile("s_waitcnt vmcnt(0)" ::: "memory");
        }
    }
    __syncthreads();
}
constexpr size_t WS_BAR = 253 * MiB;
constexpr int LDS_ST_OFF = LDS_BYTES - 16;
#define A (*(const volatile __attribute__((address_space(4))) Args*)__builtin_amdgcn_kernarg_segment_ptr())
__global__ void __launch_bounds__(512, 2) fwd_kernel(Args Aparam) {
    extern __shared__ __attribute__((aligned(16))) unsigned char lds_raw[];
    LAS unsigned char* lds = (LAS unsigned char*)lds_raw;
    const int tid = threadIdx.x, lane = tid & 63, wave = __builtin_amdgcn_readfirstlane(tid >> 6);
    const int G = gridDim.x, bx = blockIdx.x;
    const int gw = bx * 8 + wave, NGW = G * 8;
    const int lo = A.ph_lo, hi = A.ph_hi; (void)lo; (void)hi;
#ifndef PHMASK
#define PHMASK 0x1fff
#endif
#if ONE_LAUNCH
#define IN(k) (((PHMASK >> (k)) & 1) && (k) < 11)
#else
#define IN(k) (((PHMASK >> (k)) & 1) && lo <= (k) && (k) < hi)
#endif
#if ONE_LAUNCH
    XcdBarrier xbar; xbar.bar = nullptr; xbar.x = 0; xbar.st = (volatile LAS unsigned*)(lds + LDS_ST_OFF);
#define SEAM(k) do { xcd_barrier(xbar); } while (0)
    {
        unsigned* const barw = (unsigned*)(A.ws + WS_BAR);
        if (tid < 4) ((LAS unsigned*)(lds + LDS_ST_OFF))[tid] = 0u;
        if (bx == 0) for (int i = tid; i < XCD_BAR_WORDS; i += 512) barw[i] = 0u;
        cg::this_grid().sync();
        xbar = xcd_barrier_post(barw, (volatile LAS unsigned*)(lds + LDS_ST_OFF));
    }
#else
#define SEAM(k) do { } while (0)
#endif

    for (int rep_ = 0; rep_ < (((RPT_MASK >> 0) & 1) ? 2 : 1); ++rep_) { if (rep_) { if (0 == 0) cg::this_grid().sync(); else xcd_barrier(xbar); }
    if (IN(0)) {
        unsigned char* const wsb = A.ws; unsigned char* const dob = (unsigned char*)A.out; (void)wsb; (void)dob;
        LAS float* svec = (LAS float*)(lds + 131072);
        for (int task = bx; task < 192; task += G) {
            const int cb = task % 12, ks = task / 12, k0 = ks * 64;
            __syncthreads();
            for (int i = tid; i < 576; i += 512) { const int v = i >> 6, k = i & 63; const float cv = v < 8 ? A.c[v * 1024 + k0 + k] : A.c_ctx[k0 + k]; svec[i] = cv / (1.f + __expf(-cv)); }
            __syncthreads();
            gemv_task<9, 64, false>(A.w_mod, 6144, cb * 512, k0, svec, modp + (size_t)ks * 9 * 6144, 6144);
        }
        LAS float* scr = (LAS float*)(lds + wave * 16384);
        constexpr int NITEMS = 9088;
        for (int it = gw; it < NITEMS; it += NGW) {
            int r = it; const float* W; int ldw, col0, ncols, K; bf16_t* dst; int hp = 0;
            if (r < 512) { W = A.w_in; ldw = INW; col0 = 0; ncols = 1024; K = 1024; dst = W1T + (size_t)3 * 256 * 1024; hp = 1; }
            else if ((r -= 512) < 128) { W = A.w_in; ldw = INW; col0 = 1024; ncols = 256; K = 1024; dst = W1T; hp = 1; }
            else if ((r -= 128) < 128) { W = A.w_in; ldw = INW; col0 = 1280; ncols = 256; K = 1024; dst = W2T; }
            else if ((r -= 128) < 256) { W = A.w_in; ldw = INW; col0 = 1536; ncols = 512; K = 1024; dst = W1T + (size_t)7 * 256 * 1024; }
            else if ((r -= 256) < 256) { W = A.w_in; ldw = INW; col0 = 2048; ncols = 512; K = 1024; dst = W1T + (size_t)1 * 256 * 1024; }
            else if ((r -= 256) < 512) { W = A.w_in; ldw = INW; col0 = 2560; ncols = 1024; K = 1024; dst = W2T + (size_t)256 * 1024; }
            else if ((r -= 512) < 512) { W = A.w_in; ldw = INW; col0 = 3584; ncols = 1024; K = 1024; dst = W1T + (size_t)9 * 256 * 1024; }
            else if ((r -= 512) < 512) { W = A.w_in; ldw = INW; col0 = 4624; ncols = 1024; K = 1024; dst = W1T + (size_t)13 * 256 * 1024; }
            else if ((r -= 512) < 512) { W = A.w_in; ldw = INW; col0 = 5648; ncols = 1024; K = 1024; dst = W1T + (size_t)17 * 256 * 1024; }
            else if ((r -= 512) < 512) { W = A.w_branch_att; ldw = 1024; col0 = 0; ncols = 1024; K = 1024; dst = WBA; }
            else if ((r -= 512) < 512) { W = A.w_branch_ml; ldw = 1024; col0 = 0; ncols = 1024; K = 1024; dst = WBM; }
            else if ((r -= 512) < 512) { W = A.w_out; ldw = 1024; col0 = 0; ncols = 1024; K = 1024; dst = WO; }
            else if ((r -= 512) < 2816) { W = A.w_up; ldw = NUP; col0 = 0; ncols = NUP; K = 1024; dst = WUP; }
            else { r -= 2816; W = A.w_down; ldw = 1024; col0 = 0; ncols = 1024; K = DFF; dst = WDN; }
            const int nblk = ncols / 32, kb = r / nblk, nb = r % nblk, n0 = nb * 32;
            int drow = hp ? headperm(n0) : n0;
            if (W == A.w_up) drow = (n0 < DFF) ? 256 * (n0 >> 7) + (n0 & 127) : 256 * ((n0 - DFF) >> 7) + 128 + ((n0 - DFF) & 127);
            transpose_item(W, ldw, col0 + n0, kb * 64, dst, drow, K, scr, lane);
        }
        for (int i = bx * 512 + tid; i < 2048 * 32; i += G * 512) {
            const int t = i >> 5, j = i & 31; const float pos = (j < 16) ? (float)(t >> 6) : (float)(t & 63);
            const float invf = exp2f(-(float)(j & 15) * (13.287712379549449f / 16.f)); const float ang = pos * invf;
            cosT[i] = cosf(ang); sinT[i] = sinf(ang);
        }
    }
    }
    SEAM(0);

    for (int rep_ = 0; rep_ < (((RPT_MASK >> 1) & 1) ? 2 : 1); ++rep_) { if (rep_) { if (1 == 0) cg::this_grid().sync(); else xcd_barrier(xbar); }
    if (IN(1)) {
        unsigned char* const wsb = A.ws; unsigned char* const dob = (unsigned char*)A.out; (void)wsb; (void)dob;
        constexpr int GP = 1028;
        LAS float* sWg = (LAS float*)lds;
        LAS float* hT = (LAS float*)(lds + 65792);
        LAS float* svm = (LAS float*)(lds + 131584);
        LAS float* part = (LAS float*)(lds + 147968);
        LAS float* svec = part;
        for (int k = tid; k < 1024; k += 512) { const float* src = A.w_in + (size_t)k * INW + 4608;
#pragma unroll
            for (int q = 0; q < 4; ++q) { const f32x4 v = *(const f32x4*)(src + 4 * q); sWg[(4 * q + 0) * GP + k] = v[0]; sWg[(4 * q + 1) * GP + k] = v[1]; sWg[(4 * q + 2) * GP + k] = v[2]; sWg[(4 * q + 3) * GP + k] = v[3]; } }
        const int rpb = (MT + G - 1) / G, rbeg = bx * rpb, rend = (rbeg + rpb < MT) ? rbeg + rpb : MT;
        const int vlo = rbeg < ML ? (rbeg >> 11) : 8;
        for (int i = tid; i < 4096; i += 512) { const int slot = i >> 11, k = i & 2047; int v = vlo + slot; if (v > 8) v = 8; float a = A.b_mod[k];
#pragma unroll
            for (int ks = 0; ks < 16; ++ks) a += modp[((size_t)ks * 9 + v) * 6144 + k];
            svm[i] = a; }
        for (int i = bx * 512 + tid; i < 9 * 6144; i += G * 512) { float a = A.b_mod[i % 6144];
#pragma unroll
            for (int ks = 0; ks < 16; ++ks) a += modp[(size_t)ks * 9 * 6144 + i];
            mod[i] = a; }
        __syncthreads();
        {
            const float* xin = A.x; const float* cin = A.ctx; const float* n1w = A.norm1_w; const float* gbias = A.ml_gate_b;
            const int r16 = lane & 15, quad = lane >> 4;
            const int ntile = (rend - rbeg + 15) >> 4;
            f32x4 xn[2][4];
#pragma unroll
            for (int t = 0; t < 2; ++t) { const int row = rbeg + wave + 8 * t; if (row < rend) { const float* xr = row < ML ? xin + (size_t)row * 1024 : cin + (size_t)(row - ML) * 1024;
#pragma unroll
                for (int j = 0; j < 4; ++j) xn[t][j] = *(const f32x4*)(xr + 4 * lane + 256 * j); } }
            for (int tile = 0; tile < ntile; ++tile) {
                const int trow = rbeg + 16 * tile;
#pragma unroll
                for (int t = 0; t < 2; ++t) {
                    const int r = wave + 8 * t, row = trow + r;
                    f32x4 hv[4]; float ss = 0.f;
#pragma unroll
                    for (int j = 0; j < 4; ++j) { hv[j] = xn[t][j]; const f32x4 q = hv[j] * hv[j]; ss += (q[0] + q[1]) + (q[2] + q[3]); }
                    { const int rn = row + 16; if (rn < rend) { const float* xr = rn < ML ? xin + (size_t)rn * 1024 : cin + (size_t)(rn - ML) * 1024;
#pragma unroll
                        for (int j = 0; j < 4; ++j) xn[t][j] = *(const f32x4*)(xr + 4 * lane + 256 * j); } }
                    if (row < rend) {
                        const int v = row < ML ? (row >> 11) : 8;
                        const LAS float* sh = svm + (v - vlo) * 2048; const LAS float* sc = sh + 1024;
                        const float rstd = rsqrtf(wave_sum(ss) * (1.f / 1024.f) + EPS);
                        bf16_t* ho = H + (size_t)row * 1024;
#pragma unroll
                        for (int j = 0; j < 4; ++j) { const int k = 4 * lane + 256 * j;
                            hv[j] = hv[j] * rstd * (*(const f32x4*)(n1w + k)) * (*(const LAS f32x4*)(sc + k) + 1.f) + *(const LAS f32x4*)(sh + k);
                            u32x2 w; w.x = cvt_pk_bf16(hv[j][0], hv[j][1]); w.y = cvt_pk_bf16(hv[j][2], hv[j][3]); *(u32x2*)(ho + k) = w;
                            *(LAS f32x4*)(hT + r * GP + k) = hv[j]; }
                    }
                }
                __syncthreads();
                { f32x4 acc = (f32x4){0.f, 0.f, 0.f, 0.f};
#pragma unroll
                  for (int kk = 0; kk < 8; ++kk) { const f32x4 a4 = *(const LAS f32x4*)(hT + r16 * GP + wave * 128 + kk * 16 + quad * 4), b4 = *(const LAS f32x4*)(sWg + r16 * GP + wave * 128 + kk * 16 + quad * 4);
#pragma unroll
                    for (int i = 0; i < 4; ++i) acc = __builtin_amdgcn_mfma_f32_16x16x4f32(a4[i], b4[i], acc, 0, 0, 0); }
#pragma unroll
                  for (int j = 0; j < 4; ++j) part[wave * 256 + (quad * 4 + j) * 16 + r16] = acc[j]; }
                __syncthreads();
                if (tid < 256) { const int r = tid >> 4, gidx = tid & 15, row = trow + r; float gv = gbias[gidx];
#pragma unroll
                    for (int w = 0; w < 8; ++w) gv += part[w * 256 + tid];
                    if (gidx & 4) gv = fminf(gv, 0.f) - log1pf(expf(-fabsf(gv)));
                    if (row < rend) gates[(size_t)row * 16 + gidx] = gv; }
            }
        }
        for (int task = bx; task < 176; task += G) {
            const int cb = task % 11, ks = task / 11, k0 = ks * 64;
            __syncthreads();
            { const int v = tid >> 6, k = 3072 + k0 + (tid & 63); float a = A.b_mod[k];
#pragma unroll
                for (int q = 0; q < 16; ++q) a += modp[((size_t)q * 9 + v) * 6144 + k];
                svec[tid] = a; }
            __syncthreads();
            gemv_task<8, 64, false>(A.w_up, NUP, cb * 512, k0, svec, fbp + (size_t)ks * 8 * NUP, NUP);
        }
    }
    }
    SEAM(1);

    for (int rep_ = 0; rep_ < (((RPT_MASK >> 2) & 1) ? 2 : 1); ++rep_) { if (rep_) { if (2 == 0) cg::this_grid().sync(); else xcd_barrier(xbar); }
    if (IN(2)) {
        unsigned char* const wsb = A.ws; unsigned char* const dob = (unsigned char*)A.out; (void)wsb; (void)dob;
        { pg8::Gemm g{H, W1T, 1024, 1024, 1024}; pg8::Order S; S.init(64, 21, G, bx, 24);
          EpiIn E{AK, MK, AQ, MQ, MO, GA, GM, A.q_norm_w, A.k_norm_w, cosT, sinT, (LAS float*)(lds + 131072)};
          pg8::gemm_phase<EpiIn, pg8::Order, true>(lds, g, S, E); }
        { pg8::Gemm g{W2T, H, 1024, 1024, 1024}; pg8::Order S; S.init(5, 72, G, (bx + G - (1368 % G)) % G, 0);
          EpiPlain E{XT, MT};
          pg8::gemm_phase<EpiPlain, pg8::Order, true>(lds, g, S, E); }
    }
    }
    SEAM(2);

    if (IN(3)) {
        unsigned char* const wsb = A.ws; unsigned char* const dob = (unsigned char*)A.out; (void)wsb; (void)dob;
        for (int i = bx * 512 + tid; i < 8 * NUP; i += G * 512) { float a = 0.f;
#pragma unroll
            for (int ks = 0; ks < 16; ++ks) a += fbp[(size_t)ks * 8 * NUP + i];
            fbias[i] = a; }
        const int r16 = lane & 15, quad = lane >> 4;
        const int rt = wave & 3, hp = wave >> 2;
        LAS bf16_t* sK = (LAS bf16_t*)lds;
        LAS bf16_t* sVT = sK + 64 * 72;
        bf16x8 qn[2][2];
#define AT_QLOAD(un_) do { const int qb_ = (un_) & 31, kvh_ = ((un_) >> 5) & 3, b_ = (un_) >> 7; \
            _Pragma("unroll") for (int g = 0; g < 2; ++g) _Pragma("unroll") for (int ks = 0; ks < 2; ++ks) \
                qn[g][ks] = *(const bf16x8*)(AQ + (size_t)(b_ * SEQ + qb_ * 64 + rt * 16 + r16) * 1024 + (kvh_ * 4 + hp * 2 + g) * 64 + ks * 32 + quad * 8); } while (0)
        if (bx < 1024) AT_QLOAD(bx);
        for (int unit = bx; unit < 1024; unit += G) {
            const int qb = unit & 31, kvh = (unit >> 5) & 3, b = unit >> 7;
            const int rowbase = b * SEQ, t0 = qb * 64;
            bf16x8 qf[2][2];
#pragma unroll
            for (int g = 0; g < 2; ++g)
#pragma unroll
                for (int ks = 0; ks < 2; ++ks) qf[g][ks] = qn[g][ks];
            if (unit + G < 1024) AT_QLOAD(unit + G);
            f32x4 o[2][4]; float mrow[2], lrow[2];
#pragma unroll
            for (int g = 0; g < 2; ++g) { mrow[g] = A.attn_sink[kvh * 4 + hp * 2 + g]; lrow[g] = 1.f;
#pragma unroll
                for (int dt = 0; dt < 4; ++dt) o[g][dt] = (f32x4){0.f, 0.f, 0.f, 0.f}; }
            const int kb_lo = (qb < 2) ? 2 - qb : 0, kb_hi = (qb > 29) ? 33 - qb : 4;
            const bf16_t* const ak_ = AK; const bf16_t* const xt_ = XT; const int lr = tid >> 3, lc = tid & 7;
#define AT_KROW0(kb_) (((kb_) < 5) ? rowbase + (qb + (kb_) - 2) * 64 : ML + b * CTX + ((kb_) - 5) * 64)
            u32x4 pk, pv;
            { const int kr = AT_KROW0(kb_lo); pk = *(const u32x4*)(ak_ + (size_t)(kr + lr) * 256 + kvh * 64 + lc * 8); pv = *(const u32x4*)(xt_ + (size_t)(kvh * 64 + lr) * MT + kr + lc * 8); }
            for (int kb = kb_lo; kb < 9; kb = (kb == kb_hi) ? 5 : kb + 1) {
                const int mtype = (kb == 0) ? 1 : (kb == 4) ? 2 : 0;
                const int mlo = (mtype == 1) ? 0 : -4096, mhi = (mtype == 2) ? 0 : 4096, dl = quad * 4 - rt * 16 - r16;
                __syncthreads();
                *(LAS u32x4*)(sK + lr * 72 + lc * 8) = pk; *(LAS u32x4*)(sVT + lr * 72 + lc * 8) = pv;
                { const int kn = (kb == kb_hi) ? 5 : kb + 1;
                  if (kn < 9) { const int kr = AT_KROW0(kn); pk = *(const u32x4*)(ak_ + (size_t)(kr + lr) * 256 + kvh * 64 + lc * 8); pv = *(const u32x4*)(xt_ + (size_t)(kvh * 64 + lr) * MT + kr + lc * 8); } }
                __syncthreads();
                bf16x8 kf[4][2], vf[2][4];
#pragma unroll
                for (int tile = 0; tile < 4; ++tile)
#pragma unroll
                    for (int ks = 0; ks < 2; ++ks) kf[tile][ks] = *(const LAS bf16x8*)(sK + (tile * 16 + r16) * 72 + ks * 32 + quad * 8);
#pragma unroll
                for (int ks = 0; ks < 2; ++ks)
#pragma unroll
                    for (int dt = 0; dt < 4; ++dt) { const u32x2 lo = *(const LAS u32x2*)(sVT + (dt * 16 + r16) * 72 + ks * 32 + quad * 4), hi = *(const LAS u32x2*)(sVT + (dt * 16 + r16) * 72 + ks * 32 + 16 + quad * 4);
                        const u32x4 w = (u32x4){lo.x, lo.y, hi.x, hi.y}; vf[ks][dt] = __builtin_bit_cast(bf16x8, w); }
#pragma unroll
                for (int g = 0; g < 2; ++g) {
                    f32x4 s[4];
#pragma unroll
                    for (int tile = 0; tile < 4; ++tile) { s[tile] = (f32x4){0.f, 0.f, 0.f, 0.f};
#pragma unroll
                        for (int ks = 0; ks < 2; ++ks) s[tile] = mfma16(kf[tile][ks], qf[g][ks], s[tile]); }
                    float mx = -1e30f;
#pragma unroll
                    for (int tile = 0; tile < 4; ++tile)
#pragma unroll
                        for (int j = 0; j < 4; ++j) { const int dd = dl + (tile * 16 + j);
                            const int bad = ((dd - mlo) | (mhi - dd)) >> 31;
                            const float v = s[tile][j] * 0.125f + __int_as_float(bad & (int)0xF149F2CAu); s[tile][j] = v; mx = fmaxf(mx, v); }
                    mx = fmaxf(mx, __shfl_xor(mx, 16)); mx = fmaxf(mx, __shfl_xor(mx, 32));
                    const float mn = fmaxf(mrow[g], mx), alpha = __expf(mrow[g] - mn); mrow[g] = mn; float rs = 0.f;
                    unsigned pw[4][2];
#pragma unroll
                    for (int tile = 0; tile < 4; ++tile) { f32x4 pe;
#pragma unroll
                        for (int j = 0; j < 4; ++j) { pe[j] = __expf(s[tile][j] - mn); rs += pe[j]; }
                        pw[tile][0] = cvt_pk_bf16(pe[0], pe[1]); pw[tile][1] = cvt_pk_bf16(pe[2], pe[3]); }
                    rs += __shfl_xor(rs, 16); rs += __shfl_xor(rs, 32);
                    lrow[g] = lrow[g] * alpha + rs;
#pragma unroll
                    for (int dt = 0; dt < 4; ++dt) o[g][dt] = o[g][dt] * alpha;
#pragma unroll
                    for (int ks = 0; ks < 2; ++ks) { const u32x4 w = (u32x4){pw[2 * ks][0], pw[2 * ks][1], pw[2 * ks + 1][0], pw[2 * ks + 1][1]}; const bf16x8 pf = __builtin_bit_cast(bf16x8, w);
#pragma unroll
                        for (int dt = 0; dt < 4; ++dt) o[g][dt] = mfma16(vf[ks][dt], pf, o[g][dt]); }
                }
            }
#pragma unroll
            for (int g = 0; g < 2; ++g) { const float inv = 1.f / lrow[g];
                bf16_t* p = ATTO + (size_t)(rowbase + t0 + rt * 16 + r16) * 1024 + (kvh * 4 + hp * 2 + g) * 64 + quad * 4;
#pragma unroll
                for (int dt = 0; dt < 4; ++dt) { u32x2 w; w.x = cvt_pk_bf16(o[g][dt][0] * inv, o[g][dt][1] * inv); w.y = cvt_pk_bf16(o[g][dt][2] * inv, o[g][dt][3] * inv); *(u32x2*)(p + dt * 16) = w; } }
        }
    }
    SEAM(3);

    for (int rep_ = 0; rep_ < (((RPT_MASK >> 4) & 1) ? 2 : 1); ++rep_) { if (rep_) { if (4 == 0) cg::this_grid().sync(); else xcd_barrier(xbar); }
    if (IN(4)) {
        unsigned char* const wsb = A.ws; unsigned char* const dob = (unsigned char*)A.out; (void)wsb; (void)dob;
        const int r16 = lane & 15, quad = lane >> 4;
        LAS bf16_t* sK = (LAS bf16_t*)lds;
        LAS bf16_t* sVT = sK + 128 * 136;
        LAS bf16_t* sS = sVT + 64 * 136;
        LAS bf16_t* sC = sS + 128 * 136;
        LAS float* sgb = (LAS float*)(sC + 80 * 136);
        LAS float *sga = sgb + 128, *sgw = sgb + 256, *sge = sgb + 384, *sgF = sgb + 512;
        const float scale = 0.08838834764831845f;
        for (int task = bx; task < 256; task += G) {
            const int vq = task & 3, dir = (task >> 2) & 1, hh = (task >> 3) & 3, b = task >> 5;
            __syncthreads();
            for (int i = tid; i < 80 * 136 / 2; i += 512) ((LAS unsigned*)sC)[i] = 0u;
            f32x4 cacc[4], nacc = (f32x4){0.f, 0.f, 0.f, 0.f};
#pragma unroll
            for (int vt = 0; vt < 4; ++vt) cacc[vt] = (f32x4){0.f, 0.f, 0.f, 0.f};
            bf16_t* Hout = (bf16_t*)(dob + (dir ? DO_HB : DO_HF)); const int sgn = dir ? 1 : -1;
            const bf16_t* const mk_ = MK; const bf16_t* const xt_ = XT; const bf16_t* const mq_ = MQ; const float* const gt_ = gates;
            u32x4 pK[4], pVT[2]; bf16x8 pQ[4]; float pG[4];
#define ML_TOK0(st) (((st) < 2) ? (ML + b * CTX + (dir ? 1 - (st) : (st)) * 128) : (b * SEQ + (dir ? 15 - ((st) - 2) : (st) - 2) * 128))
#define ML_PREFETCH(st) do { const int t0_ = ML_TOK0(st); \
                _Pragma("unroll") for (int q_ = 0; q_ < 4; ++q_) { const int i_ = tid + q_ * 512, r_ = i_ >> 4, c_ = i_ & 15; pK[q_] = *(const u32x4*)(mk_ + (size_t)(t0_ + r_) * 512 + hh * 128 + c_ * 8); } \
                if ((st) >= 2) { _Pragma("unroll") for (int ks_ = 0; ks_ < 4; ++ks_) pQ[ks_] = *(const bf16x8*)(mq_ + (size_t)(t0_ + wave * 16 + r16) * 512 + hh * 128 + ks_ * 32 + quad * 8); } \
                _Pragma("unroll") for (int q_ = 0; q_ < 2; ++q_) { const int i_ = tid + q_ * 512, r_ = i_ >> 4, c_ = i_ & 15; pVT[q_] = *(const u32x4*)(xt_ + (size_t)(256 + hh * 256 + vq * 64 + r_) * MT + t0_ + c_ * 8); } \
                if (wave == 0) { const float* gp_ = gt_ + (size_t)(t0_ + 2 * lane) * 16 + dir * 8 + hh; pG[0] = gp_[0]; pG[1] = gp_[4]; pG[2] = gp_[16]; pG[3] = gp_[20]; } } while (0)
            ML_PREFETCH(0);
            for (int step = 0; step < 18; ++step) {
                const bool isctx = step < 2; const int tok0 = ML_TOK0(step);
                __syncthreads();
#pragma unroll
                for (int q = 0; q < 4; ++q) { const int i = tid + q * 512, r = i >> 4, c = i & 15; *(LAS u32x4*)(sK + r * 136 + c * 8) = pK[q]; }
#pragma unroll
                for (int q = 0; q < 2; ++q) { const int i = tid + q * 512, r = i >> 4, c = i & 15; *(LAS u32x4*)(sVT + r * 136 + c * 8) = pVT[q]; }
                if (wave == 0) {
                    const float i0 = pG[0], f0 = pG[1], i1 = pG[2], f1 = pG[3];
                    const float loc = f0 + f1; float v = loc;
#pragma unroll
                    for (int off = 1; off < 64; off <<= 1) { const float t = __shfl_up(v, off); if (lane >= off) v += t; }
                    const float total = __shfl(v, 63); const float p0 = v - loc + f0, p1 = p0 + f1;
                    const float b0 = dir ? total - p0 + f0 : p0, b1 = dir ? total - p1 + f1 : p1;
                    const float cmid = 0.5f * total;
                    sgb[2 * lane] = __expf(fminf(b0 - cmid, 80.f)); sgb[2 * lane + 1] = __expf(fminf(b1 - cmid, 80.f));
                    sga[2 * lane] = __expf(fminf(i0 - b0 + cmid, 80.f)) * scale; sga[2 * lane + 1] = __expf(fminf(i1 - b1 + cmid, 80.f)) * scale;
                    sgw[2 * lane] = __expf(fminf(total - b0 + i0, 80.f)) * scale; sgw[2 * lane + 1] = __expf(fminf(total - b1 + i1, 80.f)) * scale;
                    sge[2 * lane] = __expf(b0); sge[2 * lane + 1] = __expf(b1); if (lane == 0) sgF[0] = __expf(total);
                }
                bf16x8 qf[4];
#pragma unroll
                for (int ks = 0; ks < 4; ++ks) qf[ks] = pQ[ks];
                if (step + 1 < 18) ML_PREFETCH(step + 1);
                __syncthreads();
                if (!isctx) {
                    const int prow = wave * 16 + r16;
                    f32x4 s[8];
#pragma unroll
                    for (int tile = 0; tile < 8; ++tile) { s[tile] = (f32x4){0.f, 0.f, 0.f, 0.f};
#pragma unroll
                        for (int ks = 0; ks < 4; ++ks) { const bf16x8 kf = *(const LAS bf16x8*)(sK + (tile * 16 + r16) * 136 + ks * 32 + quad * 8); s[tile] = mfma16(kf, qf[ks], s[tile]); } }
                    const float bp = sgb[prow]; float rs = 0.f;
#pragma unroll
                    for (int tile = 0; tile < 8; ++tile) { const f32x4 av = *(const LAS f32x4*)(sga + tile * 16 + quad * 4); f32x4 pe;
#pragma unroll
                        for (int j = 0; j < 4; ++j) { const int dd = (tile * 16 + quad * 4 + j - prow) * sgn;
                            pe[j] = __int_as_float(__float_as_int(s[tile][j] * (bp * av[j])) & ~(dd >> 31)); rs += pe[j]; }
                        u32x2 w; w.x = cvt_pk_bf16(pe[0], pe[1]); w.y = cvt_pk_bf16(pe[2], pe[3]);
                        *(LAS u32x2*)(sS + prow * 136 + tile * 16 + quad * 4) = w; }
                    rs += __shfl_xor(rs, 16); rs += __shfl_xor(rs, 32);
                    asm volatile("s_waitcnt lgkmcnt(0)" ::: "memory");
                    f32x4 a1[4], a2[5];
#pragma unroll
                    for (int vt = 0; vt < 4; ++vt) a1[vt] = (f32x4){0.f, 0.f, 0.f, 0.f};
#pragma unroll
                    for (int vt = 0; vt < 5; ++vt) a2[vt] = (f32x4){0.f, 0.f, 0.f, 0.f};
#pragma unroll
                    for (int ks = 0; ks < 4; ++ks) { const bf16x8 af = *(const LAS bf16x8*)(sS + prow * 136 + ks * 32 + quad * 8);
#pragma unroll
                        for (int vt = 0; vt < 4; ++vt) { const bf16x8 vf = *(const LAS bf16x8*)(sVT + (vt * 16 + r16) * 136 + ks * 32 + quad * 8); a1[vt] = mfma16(vf, af, a1[vt]); } }
#pragma unroll
                    for (int ks = 0; ks < 4; ++ks)
#pragma unroll
                        for (int vt = 0; vt < 5; ++vt) { const bf16x8 cf = *(const LAS bf16x8*)(sC + (vt * 16 + r16) * 136 + ks * 32 + quad * 8); a2[vt] = mfma16(cf, qf[ks], a2[vt]); }
                    const float e = sge[prow];
                    const float qn = __shfl(a2[4][0], r16); const float nq = rs + e * qn; const float inv = 1.f / fmaxf(fabsf(nq), 1.f);
                    bf16_t* hp = Hout + (size_t)(tok0 + prow) * 1024 + hh * 256 + vq * 64 + quad * 4;
#pragma unroll
                    for (int vt = 0; vt < 4; ++vt) { u32x2 w; w.x = cvt_pk_bf16((a1[vt][0] + e * a2[vt][0]) * inv, (a1[vt][1] + e * a2[vt][1]) * inv);
                        w.y = cvt_pk_bf16((a1[vt][2] + e * a2[vt][2]) * inv, (a1[vt][3] + e * a2[vt][3]) * inv); *(u32x2*)(hp + vt * 16) = w; }
                }
                __syncthreads();
                {
                    const float F = sgF[0];
#pragma unroll
                    for (int vt = 0; vt < 4; ++vt) cacc[vt] = cacc[vt] * F;
                    nacc = nacc * F;
                    bf16x8 ones; { const short o1 = (r16 == 0) ? (short)0x3F80 : (short)0;
#pragma unroll
                        for (int e = 0; e < 8; ++e) ones[e] = o1; }
#pragma unroll
                    for (int ks = 0; ks < 4; ++ks) {
                        const LAS bf16_t* kcol = sK + (ks * 32 + quad * 8) * 136 + wave * 16 + r16;
                        const f32x4 w0 = *(const LAS f32x4*)(sgw + ks * 32 + quad * 8), w1 = *(const LAS f32x4*)(sgw + ks * 32 + quad * 8 + 4);
                        f32x4 k0, k1;
#pragma unroll
                        for (int e = 0; e < 4; ++e) { k0[e] = bf2f(kcol[e * 136]) * w0[e]; k1[e] = bf2f(kcol[(4 + e) * 136]) * w1[e]; }
                        const u32x4 pk = pack8(k0, k1); const bf16x8 kts = __builtin_bit_cast(bf16x8, pk);
#pragma unroll
                        for (int vt = 0; vt < 4; ++vt) { const bf16x8 va = *(const LAS bf16x8*)(sVT + (vt * 16 + r16) * 136 + ks * 32 + quad * 8); cacc[vt] = mfma16(kts, va, cacc[vt]); }
                        nacc = mfma16(kts, ones, nacc);
                    }
#pragma unroll
                    for (int vt = 0; vt < 4; ++vt) { u32x2 w; w.x = cvt_pk_bf16(cacc[vt][0], cacc[vt][1]); w.y = cvt_pk_bf16(cacc[vt][2], cacc[vt][3]);
                        *(LAS u32x2*)(sC + (vt * 16 + r16) * 136 + wave * 16 + quad * 4) = w; }
                    if (r16 == 0) { u32x2 w; w.x = cvt_pk_bf16(nacc[0], nacc[1]); w.y = cvt_pk_bf16(nacc[2], nacc[3]); *(LAS u32x2*)(sC + 64 * 136 + wave * 16 + quad * 4) = w; }
                }
            }
        }
    }
    }
    SEAM(4);

    if (IN(5)) {
        unsigned char* const wsb = A.ws; unsigned char* const dob = (unsigned char*)A.out; (void)wsb; (void)dob;
        for (int row = gw; row < ML; row += NGW) {
            const size_t off = (size_t)row * 1024 + lane * 16;
            float ht[16], mo[16];
#pragma unroll
            for (int q = 0; q < 2; ++q) { const u32x4 a = *(const u32x4*)(HF + off + q * 8), c = *(const u32x4*)(HB + off + q * 8), d = *(const u32x4*)(MO + off + q * 8);
#pragma unroll
                for (int e = 0; e < 4; ++e) { ht[q * 8 + 2 * e] = __uint_as_float(a[e] << 16) + __uint_as_float(c[e] << 16); ht[q * 8 + 2 * e + 1] = __uint_as_float(a[e] & 0xffff0000u) + __uint_as_float(c[e] & 0xffff0000u);
                    mo[q * 8 + 2 * e] = __uint_as_float(d[e] << 16); mo[q * 8 + 2 * e + 1] = __uint_as_float(d[e] & 0xffff0000u); } }
            float ss = 0.f;
#pragma unroll
            for (int e = 0; e < 16; ++e) ss += ht[e] * ht[e];
            ss += __shfl_xor(ss, 1); ss += __shfl_xor(ss, 2); ss += __shfl_xor(ss, 4); ss += __shfl_xor(ss, 8);
            const float rs = rsqrtf(ss * (1.f / 256.f) + EPS);
            float r[16];
#pragma unroll
            for (int q = 0; q < 4; ++q) { const f32x4 w = *(const f32x4*)(A.ml_norm_w + lane * 16 + q * 4);
#pragma unroll
                for (int e = 0; e < 4; ++e) r[q * 4 + e] = ht[q * 4 + e] * rs * w[e] * sigmoidf_(mo[q * 4 + e]); }
#pragma unroll
            for (int q = 0; q < 2; ++q) { u32x4 w; w.x = cvt_pk_bf16(r[q * 8 + 0], r[q * 8 + 1]); w.y = cvt_pk_bf16(r[q * 8 + 2], r[q * 8 + 3]); w.z = cvt_pk_bf16(r[q * 8 + 4], r[q * 8 + 5]); w.w = cvt_pk_bf16(r[q * 8 + 6], r[q * 8 + 7]);
                *(u32x4*)(MO + off + q * 8) = w; }
        }
    }
    SEAM(5);

    for (int rep_ = 0; rep_ < (((RPT_MASK >> 6) & 1) ? 2 : 1); ++rep_) { if (rep_) { if (6 == 0) cg::this_grid().sync(); else xcd_barrier(xbar); }
    if (IN(6)) {
        unsigned char* const wsb = A.ws; unsigned char* const dob = (unsigned char*)A.out; (void)wsb; (void)dob;
        pg8::Order S; S.init(64, 4, G, bx, 0);
        { pg8::Gemm g{AQ, WBA, 1024, 1024, 1024, MO, WBM}; EpiMerge E{GA, GM, Y}; pg8::gemm_phase<EpiMerge, pg8::Order, false, true>(lds, g, S, E); }
    }
    }
    SEAM(6);

    for (int rep_ = 0; rep_ < (((RPT_MASK >> 7) & 1) ? 2 : 1); ++rep_) { if (rep_) { if (7 == 0) cg::this_grid().sync(); else xcd_barrier(xbar); }
    if (IN(7)) {
        unsigned char* const wsb = A.ws; unsigned char* const dob = (unsigned char*)A.out; (void)wsb; (void)dob;
        pg8::Order S; S.init(64, 4, G, bx, 0);
#ifdef DBG_P7PLAIN
        pg8::Gemm g{Y, WO, 1024, 1024, 1024}; EpiPlain E{T1, 1024};
        pg8::gemm_phase<EpiPlain, pg8::Order, false>(lds, g, S, E);
#else
        pg8::Gemm g{Y, WO, 1024, 1024, 1024}; EpiOut E{A.x, mod, A.norm2_w, (float*)dob, AQ, rowsq};
        pg8::gemm_phase<EpiOut, pg8::Order, false>(lds, g, S, E);
#endif
    }
    }
    SEAM(7);

    for (int rep_ = 0; rep_ < (((RPT_MASK >> 8) & 1) ? 2 : 1); ++rep_) { if (rep_) { if (8 == 0) cg::this_grid().sync(); else xcd_barrier(xbar); }
    if (IN(8)) {
        unsigned char* const wsb = A.ws; unsigned char* const dob = (unsigned char*)A.out; (void)wsb; (void)dob;
        pg8::Order S; S.init(64, 22, G, bx, 0);
        pg8::Gemm g{AQ, WUP, 1024, 1024, 1024}; EpiUp E{rowsq, fbias, A.conv_w, A.conv_b, ACT, RAWU, (LAS float*)(lds + 131072)};
        pg8::gemm_phase<EpiUp, pg8::Order, true>(lds, g, S, E);
    }
    }
    SEAM(8);

    if (IN(9)) {
        unsigned char* const wsb = A.ws; unsigned char* const dob = (unsigned char*)A.out; (void)wsb; (void)dob;
        const float* cw = A.conv_w; const float* cb = A.conv_b;
        for (int task = bx * 512 + tid; task < 1025 * 352; task += G * 512) {
            const int ch = task % 352, bd = task / 352, j0 = ch * 8;
            const int pc = 256 * (j0 >> 7) + (j0 & 127);
            const bool lo_ok = bd > 0, hi_ok = bd < 1024, seam = ((bd * 16) & 2047) == 0;
            const u32x4 zero = (u32x4){0u, 0u, 0u, 0u};
            u32x4 xa[4], xg[4];
#pragma unroll
            for (int k = 0; k < 4; ++k) { xa[k] = zero; xg[k] = zero; }
            if (lo_ok) { const bf16_t* rp = RAWU + ((size_t)(bd - 1) * 4 + 2) * NUP + pc; xa[0] = *(const u32x4*)rp; xg[0] = *(const u32x4*)(rp + 128); xa[1] = *(const u32x4*)(rp + NUP); xg[1] = *(const u32x4*)(rp + NUP + 128); }
            if (hi_ok) { const bf16_t* rp = RAWU + ((size_t)bd * 4) * NUP + pc; xa[2] = *(const u32x4*)rp; xg[2] = *(const u32x4*)(rp + 128); xa[3] = *(const u32x4*)(rp + NUP); xg[3] = *(const u32x4*)(rp + NUP + 128); }
            float wa[3][8], wg[3][8], ba[8], bg[8];
#pragma unroll
            for (int i = 0; i < 3; ++i)
#pragma unroll
                for (int q = 0; q < 2; ++q) { const f32x4 a = *(const f32x4*)(cw + i * NUP + j0 + 4 * q), g = *(const f32x4*)(cw + i * NUP + DFF + j0 + 4 * q);
#pragma unroll
                    for (int e = 0; e < 4; ++e) { wa[i][4 * q + e] = a[e]; wg[i][4 * q + e] = g[e]; } }
#pragma unroll
            for (int q = 0; q < 2; ++q) { const f32x4 a = *(const f32x4*)(cb + j0 + 4 * q), g = *(const f32x4*)(cb + DFF + j0 + 4 * q);
#pragma unroll
                for (int e = 0; e < 4; ++e) { ba[4 * q + e] = a[e]; bg[4 * q + e] = g[e]; } }
#pragma unroll
            for (int side = 0; side < 2; ++side) {
                if (side == 0 ? !lo_ok : !hi_ok) continue;
                float r[8];
#pragma unroll
                for (int e = 0; e < 8; ++e) { const int w = e >> 1; const bool hi16 = e & 1;
                    float va[3], vg[3];
#pragma unroll
                    for (int k = 0; k < 3; ++k) { const unsigned aw = xa[side + k][w], gw = xg[side + k][w];
                        va[k] = hi16 ? __uint_as_float(aw & 0xffff0000u) : __uint_as_float(aw << 16); vg[k] = hi16 ? __uint_as_float(gw & 0xffff0000u) : __uint_as_float(gw << 16); }
                    if (seam) { if (side == 0) { va[2] = 0.f; vg[2] = 0.f; } else { va[0] = 0.f; vg[0] = 0.f; } }
                    const float av = ba[e] + wa[0][e] * va[0] + wa[1][e] * va[1] + wa[2][e] * va[2];
                    const float gv = bg[e] + wg[0][e] * vg[0] + wg[1][e] * vg[1] + wg[2][e] * vg[2];
                    r[e] = gv * sigmoidf_(gv) * av; }
                u32x4 w; w.x = cvt_pk_bf16(r[0], r[1]); w.y = cvt_pk_bf16(r[2], r[3]); w.z = cvt_pk_bf16(r[4], r[5]); w.w = cvt_pk_bf16(r[6], r[7]);
                *(u32x4*)(ACT + (size_t)(bd * 16 - 1 + side) * DFF + j0) = w;
            }
        }
    }
    SEAM(9);

    if (IN(10)) {
        unsigned char* const wsb = A.ws; unsigned char* const dob = (unsigned char*)A.out; (void)wsb; (void)dob;
        pg8::Order S; S.init(64, 4, G, bx, 0);
        pg8::Gemm g{ACT, WDN, DFF, DFF, DFF}; EpiDown E{(float*)dob, mod, AQ, A.norm2_w};
        pg8::gemm_phase<EpiDown, pg8::Order, false>(lds, g, S, E);
    }
#undef IN
#undef SEAM
}
#undef A

extern "C" void kernel_launch(void* const* d_in, const int* in_sizes, int n_in, void* d_out, int out_size, void* d_ws, size_t ws_size, hipStream_t stream) {
    static int grid = 0;
    if (grid == 0) {
        if (n_in != 21 || out_size != ML * D || ws_size < WS_END) { fprintf(stderr, "kernel_launch: unexpected shapes (n_in %d out %d ws %zu)\n", n_in, out_size, ws_size); grid = -1; return; }
        int dev = 0, cus = 0, per_cu = 0;
        hipGetDevice(&dev); hipDeviceGetAttribute(&cus, hipDeviceAttributeMultiprocessorCount, dev);
        hipFuncSetAttribute((const void*)fwd_kernel, hipFuncAttributeMaxDynamicSharedMemorySize, LDS_BYTES);
        hipOccupancyMaxActiveBlocksPerMultiprocessor(&per_cu, (const void*)fwd_kernel, 512, LDS_BYTES);
        if (per_cu < 1) { fprintf(stderr, "kernel_launch: occupancy query says %d blocks per CU\n", per_cu); per_cu = 1; }
        grid = cus * per_cu;
        (void)hipGetLastError();
    }
    if (grid < 0) return;
    Args a{};
    const float** pp = (const float**)&a;
    for (int i = 0; i < 21; ++i) pp[i] = (const float*)d_in[i];
    a.out = (float*)d_out; a.ws = (unsigned char*)d_ws;
#if ONE_LAUNCH
    a.ph_lo = 0; a.ph_hi = 11;
    void* args[] = {&a};
    hipError_t e = hipLaunchCooperativeKernel((const void*)fwd_kernel, dim3(grid), dim3(512), args, LDS_BYTES, stream);
    if (e != hipSuccess) fprintf(stderr, "cooperative launch failed: %s (grid %d)\n", hipGetErrorString(e), grid);
#else
    for (int p = 0; p < 11; ++p) { a.ph_lo = p; a.ph_hi = p + 1; hipLaunchKernelGGL(fwd_kernel, dim3(grid), dim3(512), LDS_BYTES, stream, a); }

#endif
}
```

```cpp
#include <hip/hip_runtime.h>
#include <hip/hip_cooperative_groups.h>
#include <cstdio>
#include <cstdint>
namespace cg = cooperative_groups;

#ifndef RPT_MASK
#define RPT_MASK 0
#endif
#ifndef ONE_LAUNCH
#define ONE_LAUNCH 1
#endif

#define LAS __attribute__((address_space(3)))
typedef unsigned short bf16_t;
typedef short bf16x8 __attribute__((ext_vector_type(8)));
typedef float f32x4 __attribute__((ext_vector_type(4)));
typedef unsigned u32x4 __attribute__((ext_vector_type(4)));
typedef unsigned u32x2 __attribute__((ext_vector_type(2)));

constexpr int D = 1024, NB = 8, SEQ = 2048, CTX = 256;
constexpr int ML = NB * SEQ;
constexpr int MC = NB * CTX;
constexpr int MT = ML + MC;
constexpr int DFF = 2816, NUP = 2 * DFF, INW = 6672;
constexpr float EPS = 1e-6f;
constexpr size_t MiB = 1u << 20;
constexpr size_t WS_ZERO = 0;
constexpr size_t WS_MOD = 0, WS_FB = 256 * 1024, WS_RSQ = 512 * 1024;
constexpr size_t WS_MODP = 236 * MiB + 12 * MiB;
constexpr size_t WS_RSQP = 252 * MiB;
constexpr size_t DO_FBP = 60 * MiB;
constexpr size_t WS_ROPE = 1 * MiB;
constexpr size_t WS_GATES = 2 * MiB;
constexpr size_t WS_WBA = 4 * MiB, WS_WBM = 6 * MiB, WS_WO = 8 * MiB, WS_WUP = 10 * MiB, WS_WDN = 21 * MiB;
constexpr size_t WS_AQ = 27 * MiB;
constexpr size_t WS_MQ = 59 * MiB, WS_MK = 75 * MiB  , WS_MO = 93 * MiB, WS_GA = 125 * MiB, WS_GM = 157 * MiB, WS_XT = 189 * MiB  ;
constexpr size_t WS_T1 = 59 * MiB, WS_Y = 189 * MiB;
constexpr size_t WS_U = 59 * MiB;
constexpr size_t WS_HALO = 236 * MiB;
constexpr size_t WS_ACT = 59 * MiB;
constexpr size_t WS_RAW = 147 * MiB;
constexpr size_t WS_END = 256 * MiB;
constexpr size_t DO_H = 0, DO_W1T = 36 * MiB, DO_W2T = 47 * MiB, DO_AK = 51 * MiB;
constexpr size_t DO_HF = 0, DO_HB = 32 * MiB;
constexpr int LDS_BYTES = 157696;

typedef float f32x2_t __attribute__((ext_vector_type(2))); typedef __bf16 bf16x2_t __attribute__((ext_vector_type(2)));
__device__ __forceinline__ unsigned cvt_pk_bf16(float lo, float hi) { f32x2_t v = {lo, hi}; bf16x2_t b = __builtin_convertvector(v, bf16x2_t); return __builtin_bit_cast(unsigned, b); }
__device__ __forceinline__ float bf2f(unsigned short v) { return __uint_as_float((unsigned)v << 16); }
__device__ __forceinline__ bf16_t f2bf(float f) { return (bf16_t)(cvt_pk_bf16(f, 0.f) & 0xffffu); }
__device__ __forceinline__ u32x4 pack8(f32x4 a, f32x4 b) { u32x4 w; w.x = cvt_pk_bf16(a[0], a[1]); w.y = cvt_pk_bf16(a[2], a[3]); w.z = cvt_pk_bf16(b[0], b[1]); w.w = cvt_pk_bf16(b[2], b[3]); return w; }
__device__ __forceinline__ float sigmoidf_(float x) { return __builtin_amdgcn_rcpf(1.f + __expf(-x)); }
__device__ __forceinline__ float sigmoid_div(float x) { return 1.f / (1.f + __expf(-x)); }
__device__ __forceinline__ float wave_sum(float v) {
#pragma unroll
    for (int o = 1; o < 64; o <<= 1) v += __shfl_xor(v, o);
    return v;
}

namespace pg8 {
constexpr int BM = 256, BK = 64, HALF = 128, HTB = HALF * BK * 2, STAGE_BYTES = 8 * HTB, NXCD = 8, WGM = 8;
__host__ __device__ __forceinline__ int lds_byte(int r, int c) { const int st = (r >> 4) * 2 + (c >> 5), rr = r & 15, cc = c & 31, ob = rr * 64 + cc * 2; return st * 1024 + (ob ^ (((ob >> 9) & 1) << 5)); }
__host__ __device__ __forceinline__ void stage_rc(int b, int& R, int& C) { const int st = b / 1024, sb = b % 1024, swz = sb ^ (((sb >> 9) & 1) << 5); R = (st >> 1) * 16 + swz / 64; C = (st & 1) * 32 + (swz % 64) / 2; }
__host__ __device__ __forceinline__ int perm32(int rho) { const int n = rho >> 4, i = rho & 15; return 8 * (i >> 2) + 4 * n + (i & 3); }

struct Unit { int pm, pn; };
struct Gemm { const bf16_t* A; const bf16_t* Bt; int lda, ldb, K; const bf16_t* A2 = nullptr; const bf16_t* Bt2 = nullptr; };

struct Order {
    int nM, nN, nwg, G, c, extra;
    __device__ __forceinline__ void init(int nM_, int nN_, int G_, int c_, int extra_) { nM = nM_; nN = nN_; nwg = nM_ * nN_; G = G_; c = c_; extra = extra_; }
    __device__ __forceinline__ bool next(int i, Unit& u) const {
        const long Lq = (long)i * G + c; if (Lq >= nwg + extra) return false;
        if (Lq >= nwg) { const int e = (int)(Lq - nwg); u.pm = nM + e / 3; u.pn = e % 3; return true; }
        int wgid = (int)Lq; { const int q = nwg / NXCD, r = nwg % NXCD, xcd = wgid % NXCD, off = wgid / NXCD; wgid = (xcd < r ? xcd * (q + 1) : r * (q + 1) + (xcd - r) * q) + off; }
        const int nig = WGM * nN, gid = wgid / nig, fm = gid * WGM, gsz = (nM - fm) < WGM ? (nM - fm) : WGM;
        u.pm = fm + ((wgid % nig) % gsz); u.pn = (wgid % nig) / gsz; return true;
    }
};

template <class Epi, class Sched, bool ALIGN_EPI, bool DUAL = false>
__device__ __forceinline__ void gemm_phase(LAS unsigned char* lds, const Gemm g, const Sched& S, const Epi& E) {
    int tid_ = threadIdx.x; asm volatile("" : "+v"(tid_));
    const int tid = tid_, wid = __builtin_amdgcn_readfirstlane(tid >> 6), lane = tid & 63, wr = wid >> 2, wc = wid & 3, fr = lane & 15, fq = lane >> 4;
    const int K = g.K, nt1 = K / BK, nt = DUAL ? 2 * nt1 : nt1;
    unsigned voffA[2], voffB[2];
#pragma unroll
    for (int i = 0; i < 2; ++i) { int R, C; stage_rc(tid * 16 + i * 8192, R, C); const int Rb = ((R & ~31) + perm32(R & 31));
        voffA[i] = (unsigned)(R * g.lda + C) * 2u; voffB[i] = (unsigned)(Rb * g.ldb + C) * 2u; }
    const size_t kstep = (size_t)(BK * 2);
    const size_t hstepA = (size_t)HALF * g.lda * 2, hstepB = (size_t)HALF * g.ldb * 2;
    const size_t tstepA = 2 * hstepA, tstepB = 2 * hstepB;
    const unsigned ldsw = (unsigned)wid * 1024u;
    const int aoff = lds_byte(wr * 64 + fr, fq * 8), boff = lds_byte(wc * 32 + fr, fq * 8);
#define PG8_SA(b, h) (((b) * 2 + (h)) * HTB)
#define PG8_SB(b, h) ((4 + (b) * 2 + (h)) * HTB)
#define PG8_STAGE(bufoff, gbase, voff) do { _Pragma("unroll") for (int _i = 0; _i < 2; ++_i) \
        __builtin_amdgcn_global_load_lds((const unsigned*)((const char*)(gbase) + (voff)[_i]), (LAS unsigned*)(lds + (bufoff) + ldsw + _i * 8192), 16, 0, 0); } while (0)
#define PG8_LDA(dst, b, h) do { _Pragma("unroll") for (int m = 0; m < 4; ++m) _Pragma("unroll") for (int k = 0; k < 2; ++k) dst[m][k] = *(const LAS bf16x8*)(lds + PG8_SA(b, h) + aoff + m * 2048 + k * 1024); } while (0)
#define PG8_LDB(dst, b, h) do { _Pragma("unroll") for (int n = 0; n < 2; ++n) _Pragma("unroll") for (int k = 0; k < 2; ++k) dst[n][k] = *(const LAS bf16x8*)(lds + PG8_SB(b, h) + boff + n * 2048 + k * 1024); } while (0)
#define PG8_MMA(ai, bj, At, Bt) do { __builtin_amdgcn_s_setprio(1); _Pragma("unroll") for (int m = 0; m < 4; ++m) _Pragma("unroll") for (int n = 0; n < 2; ++n) _Pragma("unroll") for (int k = 0; k < 2; ++k) \
        acc[ai][bj][m][n] = __builtin_amdgcn_mfma_f32_16x16x32_bf16(Bt[n][k], At[m][k], acc[ai][bj][m][n], 0, 0, 0); __builtin_amdgcn_s_setprio(0); } while (0)
#define PG8_WAIT_V(n) asm volatile("s_waitcnt vmcnt(" #n ")" ::: "memory")
#define PG8_WAIT_L(n) asm volatile("s_waitcnt lgkmcnt(" #n ")" ::: "memory")
#define PG8_BAR __builtin_amdgcn_s_barrier()
#define PG8_SCHED __builtin_amdgcn_sched_barrier(0)
    Unit cur, nxt; int ui = 0;
    if (!S.next(0, cur)) return;
    f32x4 acc[2][2][4][2];
#pragma unroll
    for (int a = 0; a < 2; ++a)
#pragma unroll
        for (int b = 0; b < 2; ++b)
#pragma unroll
            for (int m = 0; m < 4; ++m)
#pragma unroll
                for (int n = 0; n < 2; ++n) acc[a][b][m][n] = (f32x4){0.f, 0.f, 0.f, 0.f};
    bf16x8 At[4][2], B0[2][2], B1[2][2];
    const char* cA = (const char*)g.A + (size_t)cur.pm * tstepA; const char* cB = (const char*)g.Bt + (size_t)cur.pn * tstepB;
    const char* cA2 = DUAL ? (const char*)g.A2 + (size_t)cur.pm * tstepA : cA; const char* cB2 = DUAL ? (const char*)g.Bt2 + (size_t)cur.pn * tstepB : cB;
    PG8_STAGE(PG8_SB(0, 0), cB, voffB); PG8_STAGE(PG8_SB(0, 1), cB + hstepB, voffB); PG8_STAGE(PG8_SA(0, 0), cA, voffA); PG8_STAGE(PG8_SA(0, 1), cA + hstepA, voffA);
    if (wr == 1) PG8_BAR;
    PG8_WAIT_V(2); PG8_BAR;
    PG8_STAGE(PG8_SB(1, 0), cB + kstep, voffB); PG8_STAGE(PG8_SA(1, 0), cA + kstep, voffA); PG8_STAGE(PG8_SB(1, 1), cB + hstepB + kstep, voffB);
    PG8_WAIT_V(6); PG8_BAR;
    for (;;) {
        const bool has_next = S.next(ui + 1, nxt);
        const char* nA = has_next ? (const char*)g.A + (size_t)nxt.pm * tstepA : cA; const char* nB = has_next ? (const char*)g.Bt + (size_t)nxt.pn * tstepB : cB;
        for (int t = 0; t < nt; t += 2) {
            const bool last = (t == nt - 2);
            const bool seg2 = DUAL && t >= nt1, seg2n = DUAL && t + 2 >= nt1;
            const char* a1 = seg2 ? cA2 + (size_t)(t + 1 - nt1) * kstep : cA + (size_t)(t + 1) * kstep;
            const char* a2 = last ? nA : (seg2n ? cA2 + (size_t)(t + 2 - nt1) * kstep : cA + (size_t)(t + 2) * kstep);
            const char* b2 = last ? nB : (seg2n ? cB2 + (size_t)(t + 2 - nt1) * kstep : cB + (size_t)(t + 2) * kstep);
            if constexpr (DUAL) { if (t == nt1) E.mid(acc, cur, wr, wc, fr, fq); }
            const char* a3 = a2 + kstep; const char* b3 = b2 + kstep;
            PG8_LDB(B0, 0, 0); PG8_LDB(B1, 0, 1); PG8_SCHED; PG8_LDA(At, 0, 0); PG8_STAGE(PG8_SA(1, 1), a1 + hstepA, voffA);
            PG8_WAIT_V(8); PG8_WAIT_L(0); PG8_BAR; PG8_MMA(0, 0, At, B0); PG8_MMA(0, 1, At, B1); PG8_BAR; PG8_SCHED;
            PG8_LDA(At, 0, 1); PG8_STAGE(PG8_SB(0, 0), b2, voffB); PG8_STAGE(PG8_SB(0, 1), b2 + hstepB, voffB); PG8_STAGE(PG8_SA(0, 0), a2, voffA);
            PG8_WAIT_V(8); PG8_WAIT_L(0); PG8_BAR; PG8_MMA(1, 0, At, B0); PG8_MMA(1, 1, At, B1); PG8_BAR; PG8_SCHED;
            PG8_LDB(B0, 1, 0); PG8_LDB(B1, 1, 1); PG8_SCHED; PG8_LDA(At, 1, 0); PG8_STAGE(PG8_SA(0, 1), a2 + hstepA, voffA);
            PG8_WAIT_V(8); PG8_WAIT_L(0); PG8_BAR; PG8_MMA(0, 0, At, B0); PG8_MMA(0, 1, At, B1); PG8_BAR; PG8_SCHED;
            PG8_LDA(At, 1, 1); PG8_STAGE(PG8_SB(1, 0), b3, voffB); PG8_STAGE(PG8_SB(1, 1), b3 + hstepB, voffB); PG8_STAGE(PG8_SA(1, 0), a3, voffA);
            PG8_WAIT_V(8); PG8_WAIT_L(0); PG8_BAR; PG8_MMA(1, 0, At, B0); PG8_MMA(1, 1, At, B1); PG8_BAR; PG8_SCHED;
        }
        if constexpr (ALIGN_EPI) { if (wr == 0) PG8_BAR; }
        E(acc, cur, wr, wc, fr, fq);
        if (!has_next) break;
#pragma unroll
        for (int a = 0; a < 2; ++a)
#pragma unroll
            for (int b = 0; b < 2; ++b)
#pragma unroll
                for (int m = 0; m < 4; ++m)
#pragma unroll
                    for (int n = 0; n < 2; ++n) acc[a][b][m][n] = (f32x4){0.f, 0.f, 0.f, 0.f};
        cur = nxt; cA = nA; cB = nB; ++ui;
        if constexpr (DUAL) { cA2 = (const char*)g.A2 + (size_t)cur.pm * tstepA; cB2 = (const char*)g.Bt2 + (size_t)cur.pn * tstepB; }
        if constexpr (ALIGN_EPI) { if (wr == 1) PG8_BAR; }
    }
    PG8_WAIT_V(0);
    if constexpr (!ALIGN_EPI) { if (wr == 0) PG8_BAR; }
    PG8_BAR;
#undef PG8_SA
#undef PG8_SB
#undef PG8_STAGE
#undef PG8_LDA
#undef PG8_LDB
#undef PG8_MMA
#undef PG8_WAIT_V
#undef PG8_WAIT_L
#undef PG8_BAR
#undef PG8_SCHED
}
}
using pg8::Unit;
typedef const f32x4 (&AccRef)[2][2][4][2];

struct EpiIn {
    bf16_t *AK_, *MK_, *AQ_, *MQ_, *MO_, *GA_, *GM_; const float *qnw, *knw, *cosT_, *sinT_; LAS float* sp;
    __device__ __forceinline__ void head_path(AccRef acc, const Unit& u, int wr, int wc, int fr, int fq_in, bf16_t* base, int ld, int coff, const float* nw) const {
        int fq = fq_in; asm volatile("" : "+v"(fq));
        const int row0 = u.pm * 256 + wr * 64 + fr;
        const bool rope = u.pm < 64;
        { int tx = threadIdx.x; asm volatile("" : "+v"(tx)); const int tt0 = (u.pm * 256) & 2047;
          for (int i = tx; i < (rope ? 2512 : 64); i += 512) { float v;
              if (i < 64) v = nw[i];
              else if (i < 208) { const int k = i - 64, gi = k / 36, e = k - gi * 36; const int t = tt0 + 64 * gi; v = e < 16 ? cosT_[t * 32 + e] : e < 32 ? sinT_[t * 32 + e - 16] : 0.f; }
              else { const int k = i - 208, c = k / 36, e = k - c * 36; const int t = tt0 + c; v = e < 16 ? cosT_[t * 32 + 16 + e] : e < 32 ? sinT_[t * 32 + e] : 0.f; }
              sp[i] = v; }
          asm volatile("s_waitcnt vmcnt(0) lgkmcnt(0)" ::: "memory"); __builtin_amdgcn_s_barrier(); asm volatile("" ::: "memory"); }
        const f32x4 w00 = *(const LAS f32x4*)(sp + 8 * fq), w01 = *(const LAS f32x4*)(sp + 8 * fq + 4), w10 = *(const LAS f32x4*)(sp + 32 + 8 * fq), w11 = *(const LAS f32x4*)(sp + 32 + 8 * fq + 4);
#pragma unroll
        for (int ai = 0; ai < 2; ++ai)
#pragma unroll
            for (int m = 0; m < 4; ++m) {
                const int row = row0 + ai * 128 + m * 16;
                f32x4 v00 = acc[ai][0][m][0], v01 = acc[ai][0][m][1], v10 = acc[ai][1][m][0], v11 = acc[ai][1][m][1];
                f32x4 q = v00 * v00 + v01 * v01 + v10 * v10 + v11 * v11;
                float ss = (q[0] + q[1]) + (q[2] + q[3]);
                ss += __shfl_xor(ss, 16); ss += __shfl_xor(ss, 32);
                const float rs = rsqrtf(ss * (1.f / 64.f) + EPS);
                v00 = v00 * rs * w00; v01 = v01 * rs * w01; v10 = v10 * rs * w10; v11 = v11 * rs * w11;
                f32x4 o00 = v00, o01 = v01, o10 = v10, o11 = v11;
                if (rope) {
                    const int r = ai * 128 + wr * 64 + m * 16 + fr;
                    const LAS float* cp = sp + ((fq < 2) ? 64 + (r >> 6) * 36 + 8 * fq : 208 + (r & 63) * 36 + 8 * (fq - 2));
                    const f32x4 c0 = *(const LAS f32x4*)cp, c1 = *(const LAS f32x4*)(cp + 4), s0 = *(const LAS f32x4*)(cp + 16), s1 = *(const LAS f32x4*)(cp + 20);
                    o00 = v00 * c0 - v10 * s0; o01 = v01 * c1 - v11 * s1; o10 = v00 * s0 + v10 * c0; o11 = v01 * s1 + v11 * c1;
                }
                bf16_t* p = base + (size_t)row * ld + coff + wc * 64 + 8 * fq;
                *(u32x4*)p = pack8(o00, o01); *(u32x4*)(p + 32) = pack8(o10, o11);
                asm volatile("" ::: "memory");
            }
    }
    template <bool SIG> __device__ __forceinline__ void plain_path(AccRef acc, const Unit& u, int wr, int wc, int fr, int fq, bf16_t* base, int ld, int coff) const {
        const int row0 = u.pm * 256 + wr * 64 + fr;
#pragma unroll
        for (int ai = 0; ai < 2; ++ai)
#pragma unroll
            for (int m = 0; m < 4; ++m) {
                bf16_t* p = base + (size_t)(row0 + ai * 128 + m * 16) * ld + coff + wc * 32 + 8 * fq;
#pragma unroll
                for (int bj = 0; bj < 2; ++bj) { f32x4 v0 = acc[ai][bj][m][0], v1 = acc[ai][bj][m][1];
                    if (SIG) {
#pragma unroll
                        for (int e = 0; e < 4; ++e) { v0[e] = sigmoid_div(v0[e]); v1[e] = sigmoid_div(v1[e]); } }
                    *(u32x4*)(p + bj * 128) = pack8(v0, v1); }
            }
    }
    __device__ __forceinline__ void operator()(AccRef acc, const Unit& u, int wr, int wc, int fr, int fq) const {
        const int pn = u.pn;
        if (pn == 0) head_path(acc, u, wr, wc, fr, fq, AK_, 256, 0, knw);
        else if (pn <= 2) plain_path<false>(acc, u, wr, wc, fr, fq, MK_, 512, (pn - 1) * 256);
        else if (pn <= 6) head_path(acc, u, wr, wc, fr, fq, AQ_, 1024, (pn - 3) * 256, qnw);
        else if (pn <= 8) plain_path<false>(acc, u, wr, wc, fr, fq, MQ_, 512, (pn - 7) * 256);
        else if (pn <= 12) plain_path<false>(acc, u, wr, wc, fr, fq, MO_, 1024, (pn - 9) * 256);
        else if (pn <= 16) plain_path<true>(acc, u, wr, wc, fr, fq, GA_, 1024, (pn - 13) * 256);
        else plain_path<true>(acc, u, wr, wc, fr, fq, GM_, 1024, (pn - 17) * 256);
    }
};
struct EpiPlain {
    bf16_t* O; int ldc;
    __device__ __forceinline__ void operator()(AccRef acc, const Unit& u, int wr, int wc, int fr, int fq) const {
        const int row0 = u.pm * 256 + wr * 64 + fr;
#pragma unroll
        for (int ai = 0; ai < 2; ++ai)
#pragma unroll
            for (int m = 0; m < 4; ++m) {
                bf16_t* p = O + (size_t)(row0 + ai * 128 + m * 16) * ldc + u.pn * 256 + wc * 32 + 8 * fq;
#pragma unroll
                for (int bj = 0; bj < 2; ++bj) *(u32x4*)(p + bj * 128) = pack8(acc[ai][bj][m][0], acc[ai][bj][m][1]);
            }
    }
};
template <bool ADD> struct EpiGate {
    const bf16_t* Gt; const bf16_t* T; bf16_t* O;
    __device__ __forceinline__ void operator()(AccRef acc, const Unit& u, int wr, int wc, int fr, int fq) const {
        const int row0 = u.pm * 256 + wr * 64 + fr;
        const size_t off0 = (size_t)row0 * 1024 + u.pn * 256 + wc * 32 + 8 * fq;
        u32x4 gv[2][2], tv[2][2];
#pragma unroll
        for (int bj = 0; bj < 2; ++bj) { gv[0][bj] = *(const u32x4*)(Gt + off0 + bj * 128); tv[0][bj] = (u32x4){0u, 0u, 0u, 0u}; if (ADD) tv[0][bj] = *(const u32x4*)(T + off0 + bj * 128); }
#pragma unroll
        for (int it = 0; it < 8; ++it) {
            const int ai = it >> 2, m = it & 3, cur = it & 1, nx = cur ^ 1;
            const size_t off = off0 + (size_t)(ai * 128 + m * 16) * 1024;
            if (it < 7) { const size_t offn = off0 + (size_t)(((it + 1) >> 2) * 128 + ((it + 1) & 3) * 16) * 1024;
#pragma unroll
                for (int bj = 0; bj < 2; ++bj) { gv[nx][bj] = *(const u32x4*)(Gt + offn + bj * 128); tv[nx][bj] = (u32x4){0u, 0u, 0u, 0u}; if (ADD) tv[nx][bj] = *(const u32x4*)(T + offn + bj * 128); } }
#pragma unroll
            for (int bj = 0; bj < 2; ++bj) {
                float r[8];
#pragma unroll
                for (int e = 0; e < 8; ++e) {
                    const unsigned gw = gv[cur][bj][e >> 1], tw = tv[cur][bj][e >> 1];
                    const float gg = (e & 1) ? __uint_as_float(gw & 0xffff0000u) : __uint_as_float(gw << 16);
                    const float tt = (e & 1) ? __uint_as_float(tw & 0xffff0000u) : __uint_as_float(tw << 16);
                    r[e] = tt + sigmoidf_(gg) * acc[ai][bj][m][e >> 2][e & 3];
                }
                u32x4 w; w.x = cvt_pk_bf16(r[0], r[1]); w.y = cvt_pk_bf16(r[2], r[3]); w.z = cvt_pk_bf16(r[4], r[5]); w.w = cvt_pk_bf16(r[6], r[7]);
                *(u32x4*)(O + off + bj * 128) = w;
            }
        }
    }
};
struct EpiMerge {
    const bf16_t* Sa; const bf16_t* Sm; bf16_t* O;
    __device__ __forceinline__ void mid(f32x4 (&acc)[2][2][4][2], const Unit& u, int wr, int wc, int fr, int fq) const {
        const size_t off0 = (size_t)(u.pm * 256 + wr * 64 + fr) * 1024 + u.pn * 256 + wc * 32 + 8 * fq;
        u32x4 av[2][2], mv[2][2];
#pragma unroll
        for (int bj = 0; bj < 2; ++bj) { av[0][bj] = *(const u32x4*)(Sa + off0 + bj * 128); mv[0][bj] = *(const u32x4*)(Sm + off0 + bj * 128); }
#pragma unroll
        for (int it = 0; it < 8; ++it) {
            const int ai = it >> 2, m = it & 3, cur = it & 1, nx = cur ^ 1;
            if (it < 7) { const size_t offn = off0 + (size_t)(((it + 1) >> 2) * 128 + ((it + 1) & 3) * 16) * 1024;
#pragma unroll
                for (int bj = 0; bj < 2; ++bj) { av[nx][bj] = *(const u32x4*)(Sa + offn + bj * 128); mv[nx][bj] = *(const u32x4*)(Sm + offn + bj * 128); } }
#pragma unroll
            for (int bj = 0; bj < 2; ++bj)
#pragma unroll
                for (int e = 0; e < 8; ++e) {
                    const unsigned aw = av[cur][bj][e >> 1], mw = mv[cur][bj][e >> 1];
                    const float sa = (e & 1) ? __uint_as_float(aw & 0xffff0000u) : __uint_as_float(aw << 16);
                    const float sm = (e & 1) ? __uint_as_float(mw & 0xffff0000u) : __uint_as_float(mw << 16);
                    acc[ai][bj][m][e >> 2][e & 3] *= sa * __builtin_amdgcn_rcpf(fmaxf(sm, 1e-30f));
                }
        }
    }
    __device__ __forceinline__ void operator()(AccRef acc, const Unit& u, int wr, int wc, int fr, int fq) const {
        const size_t off0 = (size_t)(u.pm * 256 + wr * 64 + fr) * 1024 + u.pn * 256 + wc * 32 + 8 * fq;
        u32x4 mv[2][2];
#pragma unroll
        for (int bj = 0; bj < 2; ++bj) mv[0][bj] = *(const u32x4*)(Sm + off0 + bj * 128);
#pragma unroll
        for (int it = 0; it < 8; ++it) {
            const int ai = it >> 2, m = it & 3, cur = it & 1, nx = cur ^ 1;
            const size_t off = off0 + (size_t)(ai * 128 + m * 16) * 1024;
            if (it < 7) { const size_t offn = off0 + (size_t)(((it + 1) >> 2) * 128 + ((it + 1) & 3) * 16) * 1024;
#pragma unroll
                for (int bj = 0; bj < 2; ++bj) mv[nx][bj] = *(const u32x4*)(Sm + offn + bj * 128); }
#pragma unroll
            for (int bj = 0; bj < 2; ++bj) { float r[8];
#pragma unroll
                for (int e = 0; e < 8; ++e) { const unsigned mw = mv[cur][bj][e >> 1];
                    const float sm = (e & 1) ? __uint_as_float(mw & 0xffff0000u) : __uint_as_float(mw << 16);
                    r[e] = fmaxf(sm, 1e-30f) * acc[ai][bj][m][e >> 2][e & 3]; }
                u32x4 w; w.x = cvt_pk_bf16(r[0], r[1]); w.y = cvt_pk_bf16(r[2], r[3]); w.z = cvt_pk_bf16(r[4], r[5]); w.w = cvt_pk_bf16(r[6], r[7]);
                *(u32x4*)(O + off + bj * 128) = w; }
        }
    }
};
struct EpiOut {
    const float* x; const float* mod; const float* nw2; float* xmid; bf16_t* AP; float* rowsq;
    __device__ __forceinline__ void operator()(AccRef acc, const Unit& u, int wr, int wc, int fr, int fq) const {
        const int b = u.pm >> 3; const float* mb = mod + b * 6144;
        const int row0 = u.pm * 256 + wr * 64 + fr, col0 = u.pn * 256 + wc * 32 + 8 * fq;
        f32x4 g1[2][2], sw[2][2];
#pragma unroll
        for (int bj = 0; bj < 2; ++bj)
#pragma unroll
            for (int n = 0; n < 2; ++n) { const int c = col0 + bj * 128 + 4 * n; g1[bj][n] = *(const f32x4*)(mb + 2048 + c);
                sw[bj][n] = *(const f32x4*)(nw2 + c) * (*(const f32x4*)(mb + 4096 + c) + 1.f); }
        f32x4 xv[2][2][2];
#pragma unroll
        for (int bj = 0; bj < 2; ++bj)
#pragma unroll
            for (int n = 0; n < 2; ++n) xv[0][bj][n] = *(const f32x4*)(x + (size_t)row0 * 1024 + col0 + bj * 128 + 4 * n);
#pragma unroll
        for (int it = 0; it < 8; ++it) {
            const int ai = it >> 2, m = it & 3, cur = it & 1, nx = cur ^ 1;
            const int row = row0 + ai * 128 + m * 16; const size_t off = (size_t)row * 1024 + col0; float ss = 0.f;
            if (it < 7) { const size_t offn = (size_t)(row0 + ((it + 1) >> 2) * 128 + ((it + 1) & 3) * 16) * 1024 + col0;
#pragma unroll
                for (int bj = 0; bj < 2; ++bj)
#pragma unroll
                    for (int n = 0; n < 2; ++n) xv[nx][bj][n] = *(const f32x4*)(x + offn + bj * 128 + 4 * n); }
#pragma unroll
            for (int bj = 0; bj < 2; ++bj) {
                f32x4 v[2];
#pragma unroll
                for (int n = 0; n < 2; ++n) { v[n] = xv[cur][bj][n] + g1[bj][n] * acc[ai][bj][m][n];
                    const f32x4 q = v[n] * v[n]; ss += (q[0] + q[1]) + (q[2] + q[3]); }
                *(u32x4*)(AP + off + bj * 128) = pack8(v[0] * sw[bj][0], v[1] * sw[bj][1]);
            }
            ss += __shfl_xor(ss, 16); ss += __shfl_xor(ss, 32);
            if (fq == 0) rowsq[(size_t)row * 16 + u.pn * 4 + wc] = ss;
        }
    }
};
__device__ __forceinline__ float dpp_prev(float v) { return __int_as_float(__builtin_amdgcn_update_dpp(0, __float_as_int(v), 0x111, 0xf, 0xf, true)); }
__device__ __forceinline__ float dpp_next(float v) { return __int_as_float(__builtin_amdgcn_update_dpp(0, __float_as_int(v), 0x101, 0xf, 0xf, true)); }
struct EpiUp {
    const float* rowsq; const float* fb; const float* cw; const float* cb; bf16_t* ACT_; bf16_t* RAW_; LAS float* sp;
    __device__ __forceinline__ void operator()(AccRef acc, const Unit& u, int wr, int wc, int fr, int fq) const {
        const int b = u.pm >> 3; const int row0 = u.pm * 256 + wr * 64 + fr;
        int tx = threadIdx.x; asm volatile("" : "+v"(tx));
        if (tx < 256) {
            const float* qp = rowsq + (size_t)(u.pm * 256 + tx) * 16; const f32x4 q0 = *(const f32x4*)qp, q1 = *(const f32x4*)(qp + 4), q2 = *(const f32x4*)(qp + 8), q3 = *(const f32x4*)(qp + 12);
            const f32x4 qs = (q0 + q1) + (q2 + q3); sp[1280 + tx] = rsqrtf(((qs[0] + qs[1]) + (qs[2] + qs[3])) * (1.f / 1024.f) + EPS);
        } else {
            for (int i = tx - 256; i < 1280; i += 256) { const int vec = i >> 7, j = u.pn * 128 + (i & 127);
                const float* src = vec == 0 ? fb + b * NUP + j : vec == 1 ? fb + b * NUP + DFF + j : vec < 5 ? cw + (vec - 2) * NUP + j : vec < 8 ? cw + (vec - 5) * NUP + DFF + j : vec == 8 ? cb + j : cb + DFF + j;
                sp[i] = *src; } }
        asm volatile("s_waitcnt vmcnt(0) lgkmcnt(0)" ::: "memory"); __builtin_amdgcn_s_barrier(); asm volatile("" ::: "memory");
        const LAS float* spc = sp + wc * 32 + 8 * fq;
        const int jb = u.pn * 128 + wc * 32 + 8 * fq;
        const int pcol = u.pn * 256 + wc * 32 + 8 * fq;
        const bool interior = (fr >= 1) && (fr <= 14), rawrow = !((fr >= 2) && (fr <= 13));
        const int slot = fr < 2 ? fr : fr - 12;
#pragma unroll
        for (int ai = 0; ai < 2; ++ai)
#pragma unroll
            for (int m = 0; m < 4; ++m) {
                const int row = row0 + ai * 128 + m * 16; const float rstd = sp[1280 + ai * 128 + wr * 64 + m * 16 + fr];
                float r[8]; f32x4 ua[2], ug[2];
#pragma unroll
                for (int n = 0; n < 2; ++n) {
                    ua[n] = acc[ai][0][m][n] * rstd + *(const LAS f32x4*)(spc + 0 * 128 + 4 * n);
                    ug[n] = acc[ai][1][m][n] * rstd + *(const LAS f32x4*)(spc + 1 * 128 + 4 * n);
                    const f32x4 wa0 = *(const LAS f32x4*)(spc + 2 * 128 + 4 * n), wa1 = *(const LAS f32x4*)(spc + 3 * 128 + 4 * n), wa2 = *(const LAS f32x4*)(spc + 4 * 128 + 4 * n);
                    const f32x4 wg0 = *(const LAS f32x4*)(spc + 5 * 128 + 4 * n), wg1 = *(const LAS f32x4*)(spc + 6 * 128 + 4 * n), wg2 = *(const LAS f32x4*)(spc + 7 * 128 + 4 * n);
                    const f32x4 ba = *(const LAS f32x4*)(spc + 8 * 128 + 4 * n), bg = *(const LAS f32x4*)(spc + 9 * 128 + 4 * n);
#pragma unroll
                    for (int e = 0; e < 4; ++e) {
                        const float av = ba[e] + wa0[e] * dpp_prev(ua[n][e]) + wa1[e] * ua[n][e] + wa2[e] * dpp_next(ua[n][e]);
                        const float gv = bg[e] + wg0[e] * dpp_prev(ug[n][e]) + wg1[e] * ug[n][e] + wg2[e] * dpp_next(ug[n][e]);
                        r[4 * n + e] = gv * sigmoidf_(gv) * av;
                    }
                }
                if (interior) { u32x4 w; w.x = cvt_pk_bf16(r[0], r[1]); w.y = cvt_pk_bf16(r[2], r[3]); w.z = cvt_pk_bf16(r[4], r[5]); w.w = cvt_pk_bf16(r[6], r[7]);
                    *(u32x4*)(ACT_ + (size_t)row * DFF + jb) = w; }
                if (rawrow) { bf16_t* rp = RAW_ + ((size_t)(row >> 4) * 4 + slot) * NUP + pcol;
                    *(u32x4*)rp = pack8(ua[0], ua[1]); *(u32x4*)(rp + 128) = pack8(ug[0], ug[1]); }
                asm volatile("" ::: "memory");
            }
    }
};
struct EpiDown {
    float* out; const float* mod; const bf16_t* AP; const float* nw2;
    __device__ __forceinline__ void operator()(AccRef acc, const Unit& u, int wr, int wc, int fr, int fq) const {
        const int b = u.pm >> 3; const float* mb = mod + b * 6144;
        const int row0 = u.pm * 256 + wr * 64 + fr, col0 = u.pn * 256 + wc * 32 + 8 * fq;
        f32x4 g2[2][2], rsw[2][2];
#pragma unroll
        for (int bj = 0; bj < 2; ++bj)
#pragma unroll
            for (int n = 0; n < 2; ++n) { const int c = col0 + bj * 128 + 4 * n; g2[bj][n] = *(const f32x4*)(mb + 5120 + c);
                const f32x4 sw = *(const f32x4*)(nw2 + c) * (*(const f32x4*)(mb + 4096 + c) + 1.f);
#pragma unroll
                for (int e = 0; e < 4; ++e) rsw[bj][n][e] = 1.f / sw[e]; }
        u32x4 av[2][2];
#pragma unroll
        for (int bj = 0; bj < 2; ++bj) av[0][bj] = *(const u32x4*)(AP + (size_t)row0 * 1024 + col0 + bj * 128);
#pragma unroll
        for (int it = 0; it < 8; ++it) {
            const int ai = it >> 2, m = it & 3, cur = it & 1, nx = cur ^ 1;
            const size_t off = (size_t)(row0 + ai * 128 + m * 16) * 1024 + col0;
            if (it < 7) { const size_t offn = (size_t)(row0 + ((it + 1) >> 2) * 128 + ((it + 1) & 3) * 16) * 1024 + col0;
#pragma unroll
                for (int bj = 0; bj < 2; ++bj) av[nx][bj] = *(const u32x4*)(AP + offn + bj * 128); }
#pragma unroll
            for (int bj = 0; bj < 2; ++bj)
#pragma unroll
                for (int n = 0; n < 2; ++n) { const unsigned w0 = av[cur][bj][2 * n], w1 = av[cur][bj][2 * n + 1];
                    const f32x4 ap = (f32x4){__uint_as_float(w0 << 16), __uint_as_float(w0 & 0xffff0000u), __uint_as_float(w1 << 16), __uint_as_float(w1 & 0xffff0000u)};
                    *(f32x4*)(out + off + bj * 128 + 4 * n) = ap * rsw[bj][n] + g2[bj][n] * acc[ai][bj][m][n]; }
        }
    }
};

__device__ __forceinline__ f32x4 mfma16(bf16x8 a, bf16x8 b, f32x4 c) { return __builtin_amdgcn_mfma_f32_16x16x32_bf16(a, b, c, 0, 0, 0); }

__device__ __forceinline__ void transpose_item(const float* W, int ldw, int col, int k0, bf16_t* WT, int dst_row, int dld, LAS float* scr, int lane) {
#pragma unroll 8
    for (int i = 0; i < 32; ++i) { const int kk = 2 * i + (lane >> 5); scr[kk * 33 + (lane & 31)] = W[(size_t)(k0 + kk) * ldw + col + (lane & 31)]; }
    asm volatile("s_waitcnt lgkmcnt(0)" ::: "memory");
    const int c = lane & 7;
#pragma unroll
    for (int j = 0; j < 4; ++j) { const int n = (lane >> 3) + 8 * j; const LAS float* s = scr + (8 * c) * 33 + n;
        u32x4 o; o.x = cvt_pk_bf16(s[0 * 33], s[1 * 33]); o.y = cvt_pk_bf16(s[2 * 33], s[3 * 33]); o.z = cvt_pk_bf16(s[4 * 33], s[5 * 33]); o.w = cvt_pk_bf16(s[6 * 33], s[7 * 33]);
        *(u32x4*)(WT + (size_t)(dst_row + n) * dld + k0 + 8 * c) = o; }
    asm volatile("s_waitcnt lgkmcnt(0)" ::: "memory");
}
__device__ __forceinline__ int headperm(int n0) { const int tile = n0 >> 8, l = n0 & 255; return tile * 256 + 128 * ((l >> 5) & 1) + 32 * (l >> 6); }

struct Args {
    const float *x, *c, *ctx, *c_ctx, *w_mod, *b_mod, *norm1_w, *w_in, *q_norm_w, *k_norm_w, *attn_sink, *ml_gate_b, *ml_norm_w,
        *w_branch_att, *w_branch_ml, *w_out, *norm2_w, *w_up, *conv_w, *conv_b, *w_down;
    float* out; unsigned char* ws; int ph_lo, ph_hi;
};

template <int NV, int KS, bool ATOMIC> __device__ __forceinline__ void gemv_task(const float* W, int ldw, int n0, int k0, const LAS float* svec, float* out, int ldo) {
    const int n = n0 + threadIdx.x; float a[NV];
#pragma unroll
    for (int v = 0; v < NV; ++v) a[v] = 0.f;
#pragma unroll 16
    for (int k = 0; k < KS; ++k) { const float w = W[(size_t)(k0 + k) * ldw + n];
#pragma unroll
        for (int v = 0; v < NV; ++v) a[v] += svec[v * KS + k] * w; }
#pragma unroll
    for (int v = 0; v < NV; ++v) { if (ATOMIC) atomicAdd(out + (size_t)v * ldo + n, a[v]); else out[(size_t)v * ldo + n] = a[v]; }
}

#define mod   ((float*)(wsb + WS_MOD))
#define modp  ((float*)(wsb + WS_MODP))
#define fbias ((float*)(wsb + WS_FB))
#define rowsq ((float*)(wsb + WS_RSQP))
#define fbp ((float*)(dob + DO_FBP))
#define cosT  ((float*)(wsb + WS_ROPE))
#define sinT  ((float*)(wsb + WS_ROPE) + 2048 * 32)
#define gates ((float*)(wsb + WS_GATES))
#define WBA ((bf16_t*)(wsb + WS_WBA))
#define WBM ((bf16_t*)(wsb + WS_WBM))
#define WO  ((bf16_t*)(wsb + WS_WO))
#define WUP ((bf16_t*)(wsb + WS_WUP))
#define WDN ((bf16_t*)(wsb + WS_WDN))
#define AQ  ((bf16_t*)(wsb + WS_AQ))
#ifdef DBG_ATTO
#define ATTO GA
#else
#define ATTO AQ
#endif
#define MQ  ((bf16_t*)(wsb + WS_MQ))
#define MK  ((bf16_t*)(wsb + WS_MK))
#define MO  ((bf16_t*)(wsb + WS_MO))
#define GA  ((bf16_t*)(wsb + WS_GA))
#define GM  ((bf16_t*)(wsb + WS_GM))
#define XT  ((bf16_t*)(wsb + WS_XT))
#define T1  ((bf16_t*)(wsb + WS_T1))
#define Y   ((bf16_t*)(wsb + WS_Y))
#define U   ((bf16_t*)(wsb + WS_U))
#define HALO ((bf16_t*)(wsb + WS_HALO))
#define ACT ((bf16_t*)(wsb + WS_ACT))
#define RAWU ((bf16_t*)(wsb + WS_RAW))
#define H   ((bf16_t*)(dob + DO_H))
#define W1T ((bf16_t*)(dob + DO_W1T))
#define W2T ((bf16_t*)(dob + DO_W2T))
#define AK  ((bf16_t*)(dob + DO_AK))
#define HF  ((bf16_t*)(dob + DO_HF))
#define HB  ((bf16_t*)(dob + DO_HB))

#define XB_TMO      128
#define XB_XCNT(j)  (256  + 64 * (j))
#define XB_XSUB(j)  (1280 + 64 * (j))
#define XB_XGEN(j)  (2304 + 64 * (j))
#define XB_TOP      3328
#define XB_TOPGEN   3392
#define XCD_BAR_WORDS 3456
#define XB_SPIN_CAP (1u << 18)
__device__ __forceinline__ unsigned xb_ld(unsigned* p)              { return __hip_atomic_load(p, __ATOMIC_RELAXED, __HIP_MEMORY_SCOPE_AGENT); }
__device__ __forceinline__ unsigned xb_add(unsigned* p, unsigned v) { return __hip_atomic_fetch_add(p, v, __ATOMIC_RELAXED, __HIP_MEMORY_SCOPE_AGENT); }
__device__ __forceinline__ unsigned xb_xcc_id() { return (unsigned)__builtin_amdgcn_s_getreg((3 << 11) | 20) & 0xFu; }
#define XB_SPIN(cond, bar) do { unsigned _sp = 0; while (cond) { __builtin_amdgcn_s_sleep(1); \
    if ((++_sp & 255u) == 0u) { if (xb_ld(&(bar)[XB_TMO])) break; if (_sp > XB_SPIN_CAP) { atomicAdd(&(bar)[XB_TMO], 1u); break; } } } } while (0)
struct XcdBarrier { unsigned* bar; unsigned x; volatile LAS unsigned* st; };
__device__ __forceinline__ XcdBarrier xcd_barrier_post(unsigned* bar, volatile LAS unsigned* st) {
    XcdBarrier b; b.bar = bar; b.x = xb_xcc_id(); b.st = st;
    if (threadIdx.x == 0) (void)xb_add(&bar[XB_XCNT(b.x)], 1u);
    return b;
}
__device__ __forceinline__ void xcd_barrier_complete(unsigned* bar, unsigned x, unsigned& nloc, unsigned& nx) {
    const unsigned G = gridDim.x * gridDim.y * gridDim.z;
    unsigned sum, cnt, mine, sp = 0u;
    for (;;) {
        sum = 0u; cnt = 0u; mine = 0u;
#pragma unroll
        for (unsigned j = 0; j < 16; ++j) { const unsigned c = xb_ld(&bar[XB_XCNT(j)]); sum += c; cnt += (c > 0u) ? 1u : 0u; mine = (j == x) ? c : mine; }
        if (sum == G) break;
        __builtin_amdgcn_s_sleep(1);
        if ((++sp & 255u) == 0u) { if (xb_ld(&bar[XB_TMO])) break; if (sp > XB_SPIN_CAP) { atomicAdd(&bar[XB_TMO], 1u); break; } }
    }
    nloc = mine > 0u ? mine : 1u; nx = cnt > 0u ? cnt : 1u;
}
__device__ __forceinline__ void xcd_barrier(const XcdBarrier& b) {
    asm volatile("s_waitcnt vmcnt(0)" ::: "memory");
    __syncthreads();
    if (threadIdx.x == 0) {
        unsigned* bar = b.bar;
        __builtin_amdgcn_s_waitcnt(0);
        unsigned nloc = b.st[0], nx = b.st[1];
        if (nloc == 0u) { xcd_barrier_complete(bar, b.x, nloc, nx); b.st[0] = nloc; b.st[1] = nx; }
        const unsigned old = xb_add(&bar[XB_XSUB(b.x)], 1u);
        const unsigned gen = old / nloc;
        if (old + 1u == (gen + 1u) * nloc) {
            __builtin_amdgcn_fence(__ATOMIC_RELEASE, "agent");
            asm volatile("s_waitcnt vmcnt(0)" ::: "memory");
            const unsigned og = xb_add(&bar[XB_TOP], 1u);
            const unsigned tg = og / nx;
            if (og + 1u == (tg + 1u) * nx) xb_add(&bar[XB_TOPGEN], 1u);
            else XB_SPIN(xb_ld(&bar[XB_TOPGEN]) == tg, bar);
            __builtin_amdgcn_fence(__ATOMIC_ACQUIRE, "agent");
            xb_add(&bar[XB_XGEN(b.x)], 1u);
            asm volatile("s_waitcnt vmcnt(0)" ::: "memory");
        } else {
            XB_SPIN(xb_ld(&bar[XB_XGEN(b.x)]) == gen, bar);
            __builtin_amdgcn_fence(__ATOMIC_ACQUIRE, "agent");
            asm volatile("s_waitcnt vmcnt(0)" ::: "memory");
        }
    }
    __syncthreads();
}
constexpr size_t WS_BAR = 253 * MiB;
constexpr int LDS_ST_OFF = LDS_BYTES - 16;
#define A (*(const volatile __attribute__((address_space(4))) Args*)__builtin_amdgcn_kernarg_segment_ptr())
__global__ void __launch_bounds__(512, 2) fwd_kernel(Args Aparam) {
    extern __shared__ __attribute__((aligned(16))) unsigned char lds_raw[];
    LAS unsigned char* lds = (LAS unsigned char*)lds_raw;
    const int tid = threadIdx.x, lane = tid & 63, wave = __builtin_amdgcn_readfirstlane(tid >> 6);
    const int G = gridDim.x, bx = blockIdx.x;
    const int gw = bx * 8 + wave, NGW = G * 8;
    const int lo = A.ph_lo, hi = A.ph_hi; (void)lo; (void)hi;
#ifndef PHMASK
#define PHMASK 0x1fff
#endif
#if ONE_LAUNCH
#define IN(k) (((PHMASK >> (k)) & 1) && (k) < 11)
#else
#define IN(k) (((PHMASK >> (k)) & 1) && lo <= (k) && (k) < hi)
#endif
#if ONE_LAUNCH
    XcdBarrier xbar; xbar.bar = nullptr; xbar.x = 0; xbar.st = (volatile LAS unsigned*)(lds + LDS_ST_OFF);
#define SEAM(k) do { xcd_barrier(xbar); } while (0)
    {
        unsigned* const barw = (unsigned*)(A.ws + WS_BAR);
        if (tid < 4) ((LAS unsigned*)(lds + LDS_ST_OFF))[tid] = 0u;
        if (bx == 0) for (int i = tid; i < XCD_BAR_WORDS; i += 512) barw[i] = 0u;
        cg::this_grid().sync();
        xbar = xcd_barrier_post(barw, (volatile LAS unsigned*)(lds + LDS_ST_OFF));
    }
#else
#define SEAM(k) do { } while (0)
#endif

    for (int rep_ = 0; rep_ < (((RPT_MASK >> 0) & 1) ? 2 : 1); ++rep_) { if (rep_) { if (0 == 0) cg::this_grid().sync(); else xcd_barrier(xbar); }
    if (IN(0)) {
        unsigned char* const wsb = A.ws; unsigned char* const dob = (unsigned char*)A.out; (void)wsb; (void)dob;
        LAS float* svec = (LAS float*)(lds + 131072);
        for (int task = bx; task < 192; task += G) {
            const int cb = task % 12, ks = task / 12, k0 = ks * 64;
            __syncthreads();
            for (int i = tid; i < 576; i += 512) { const int v = i >> 6, k = i & 63; const float cv = v < 8 ? A.c[v * 1024 + k0 + k] : A.c_ctx[k0 + k]; svec[i] = cv / (1.f + __expf(-cv)); }
            __syncthreads();
            gemv_task<9, 64, false>(A.w_mod, 6144, cb * 512, k0, svec, modp + (size_t)ks * 9 * 6144, 6144);
        }
        LAS float* scr = (LAS float*)(lds + wave * 16384);
        constexpr int NITEMS = 9088;
        for (int it = gw; it < NITEMS; it += NGW) {
            int r = it; const float* W; int ldw, col0, ncols, K; bf16_t* dst; int hp = 0;
            if (r < 512) { W = A.w_in; ldw = INW; col0 = 0; ncols = 1024; K = 1024; dst = W1T + (size_t)3 * 256 * 1024; hp = 1; }
            else if ((r -= 512) < 128) { W = A.w_in; ldw = INW; col0 = 1024; ncols = 256; K = 1024; dst = W1T; hp = 1; }
            else if ((r -= 128) < 128) { W = A.w_in; ldw = INW; col0 = 1280; ncols = 256; K = 1024; dst = W2T; }
            else if ((r -= 128) < 256) { W = A.w_in; ldw = INW; col0 = 1536; ncols = 512; K = 1024; dst = W1T + (size_t)7 * 256 * 1024; }
            else if ((r -= 256) < 256) { W = A.w_in; ldw = INW; col0 = 2048; ncols = 512; K = 1024; dst = W1T + (size_t)1 * 256 * 1024; }
            else if ((r -= 256) < 512) { W = A.w_in; ldw = INW; col0 = 2560; ncols = 1024; K = 1024; dst = W2T + (size_t)256 * 1024; }
            else if ((r -= 512) < 512) { W = A.w_in; ldw = INW; col0 = 3584; ncols = 1024; K = 1024; dst = W1T + (size_t)9 * 256 * 1024; }
            else if ((r -= 512) < 512) { W = A.w_in; ldw = INW; col0 = 4624; ncols = 1024; K = 1024; dst = W1T + (size_t)13 * 256 * 1024; }
            else if ((r -= 512) < 512) { W = A.w_in; ldw = INW; col0 = 5648; ncols = 1024; K = 1024; dst = W1T + (size_t)17 * 256 * 1024; }
            else if ((r -= 512) < 512) { W = A.w_branch_att; ldw = 1024; col0 = 0; ncols = 1024; K = 1024; dst = WBA; }
            else if ((r -= 512) < 512) { W = A.w_branch_ml; ldw = 1024; col0 = 0; ncols = 1024; K = 1024; dst = WBM; }
            else if ((r -= 512) < 512) { W = A.w_out; ldw = 1024; col0 = 0; ncols = 1024; K = 1024; dst = WO; }
            else if ((r -= 512) < 2816) { W = A.w_up; ldw = NUP; col0 = 0; ncols = NUP; K = 1024; dst = WUP; }
            else { r -= 2816; W = A.w_down; ldw = 1024; col0 = 0; ncols = 1024; K = DFF; dst = WDN; }
            const int nblk = ncols / 32, kb = r / nblk, nb = r % nblk, n0 = nb * 32;
            int drow = hp ? headperm(n0) : n0;
            if (W == A.w_up) drow = (n0 < DFF) ? 256 * (n0 >> 7) + (n0 & 127) : 256 * ((n0 - DFF) >> 7) + 128 + ((n0 - DFF) & 127);
            transpose_item(W, ldw, col0 + n0, kb * 64, dst, drow, K, scr, lane);
        }
        for (int i = bx * 512 + tid; i < 2048 * 32; i += G * 512) {
            const int t = i >> 5, j = i & 31; const float pos = (j < 16) ? (float)(t >> 6) : (float)(t & 63);
            const float invf = exp2f(-(float)(j & 15) * (13.287712379549449f / 16.f)); const float ang = pos * invf;
            cosT[i] = cosf(ang); sinT[i] = sinf(ang);
        }
    }
    }
    SEAM(0);

    for (int rep_ = 0; rep_ < (((RPT_MASK >> 1) & 1) ? 2 : 1); ++rep_) { if (rep_) { if (1 == 0) cg::this_grid().sync(); else xcd_barrier(xbar); }
    if (IN(1)) {
        unsigned char* const wsb = A.ws; unsigned char* const dob = (unsigned char*)A.out; (void)wsb; (void)dob;
        constexpr int GP = 1028;
        LAS float* sWg = (LAS float*)lds;
        LAS float* hT = (LAS float*)(lds + 65792);
        LAS float* svm = (LAS float*)(lds + 131584);
        LAS float* part = (LAS float*)(lds + 147968);
        LAS float* svec = part;
        for (int k = tid; k < 1024; k += 512) { const float* src = A.w_in + (size_t)k * INW + 4608;
#pragma unroll
            for (int q = 0; q < 4; ++q) { const f32x4 v = *(const f32x4*)(src + 4 * q); sWg[(4 * q + 0) * GP + k] = v[0]; sWg[(4 * q + 1) * GP + k] = v[1]; sWg[(4 * q + 2) * GP + k] = v[2]; sWg[(4 * q + 3) * GP + k] = v[3]; } }
        const int rpb = (MT + G - 1) / G, rbeg = bx * rpb, rend = (rbeg + rpb < MT) ? rbeg + rpb : MT;
        const int vlo = rbeg < ML ? (rbeg >> 11) : 8;
        for (int i = tid; i < 4096; i += 512) { const int slot = i >> 11, k = i & 2047; int v = vlo + slot; if (v > 8) v = 8; float a = A.b_mod[k];
#pragma unroll
            for (int ks = 0; ks < 16; ++ks) a += modp[((size_t)ks * 9 + v) * 6144 + k];
            svm[i] = a; }
        for (int i = bx * 512 + tid; i < 9 * 6144; i += G * 512) { float a = A.b_mod[i % 6144];
#pragma unroll
            for (int ks = 0; ks < 16; ++ks) a += modp[(size_t)ks * 9 * 6144 + i];
            mod[i] = a; }
        __syncthreads();
        {
            const float* xin = A.x; const float* cin = A.ctx; const float* n1w = A.norm1_w; const float* gbias = A.ml_gate_b;
            const int r16 = lane & 15, quad = lane >> 4;
            const int ntile = (rend - rbeg + 15) >> 4;
            f32x4 xn[2][4];
#pragma unroll
            for (int t = 0; t < 2; ++t) { const int row = rbeg + wave + 8 * t; if (row < rend) { const float* xr = row < ML ? xin + (size_t)row * 1024 : cin + (size_t)(row - ML) * 1024;
#pragma unroll
                for (int j = 0; j < 4; ++j) xn[t][j] = *(const f32x4*)(xr + 4 * lane + 256 * j); } }
            for (int tile = 0; tile < ntile; ++tile) {
                const int trow = rbeg + 16 * tile;
#pragma unroll
                for (int t = 0; t < 2; ++t) {
                    const int r = wave + 8 * t, row = trow + r;
                    f32x4 hv[4]; float ss = 0.f;
#pragma unroll
                    for (int j = 0; j < 4; ++j) { hv[j] = xn[t][j]; const f32x4 q = hv[j] * hv[j]; ss += (q[0] + q[1]) + (q[2] + q[3]); }
                    { const int rn = row + 16; if (rn < rend) { const float* xr = rn < ML ? xin + (size_t)rn * 1024 : cin + (size_t)(rn - ML) * 1024;
#pragma unroll
                        for (int j = 0; j < 4; ++j) xn[t][j] = *(const f32x4*)(xr + 4 * lane + 256 * j); } }
                    if (row < rend) {
                        const int v = row < ML ? (row >> 11) : 8;
                        const LAS float* sh = svm + (v - vlo) * 2048; const LAS float* sc = sh + 1024;
                        const float rstd = rsqrtf(wave_sum(ss) * (1.f / 1024.f) + EPS);
                        bf16_t* ho = H + (size_t)row * 1024;
#pragma unroll
                        for (int j = 0; j < 4; ++j) { const int k = 4 * lane + 256 * j;
                            hv[j] = hv[j] * rstd * (*(const f32x4*)(n1w + k)) * (*(const LAS f32x4*)(sc + k) + 1.f) + *(const LAS f32x4*)(sh + k);
                            u32x2 w; w.x = cvt_pk_bf16(hv[j][0], hv[j][1]); w.y = cvt_pk_bf16(hv[j][2], hv[j][3]); *(u32x2*)(ho + k) = w;
                            *(LAS f32x4*)(hT + r * GP + k) = hv[j]; }
                    }
                }
                __syncthreads();
                { f32x4 acc = (f32x4){0.f, 0.f, 0.f, 0.f};
#pragma unroll
                  for (int kk = 0; kk < 8; ++kk) { const f32x4 a4 = *(const LAS f32x4*)(hT + r16 * GP + wave * 128 + kk * 16 + quad * 4), b4 = *(const LAS f32x4*)(sWg + r16 * GP + wave * 128 + kk * 16 + quad * 4);
#pragma unroll
                    for (int i = 0; i < 4; ++i) acc = __builtin_amdgcn_mfma_f32_16x16x4f32(a4[i], b4[i], acc, 0, 0, 0); }
#pragma unroll
                  for (int j = 0; j < 4; ++j) part[wave * 256 + (quad * 4 + j) * 16 + r16] = acc[j]; }
                __syncthreads();
                if (tid < 256) { const int r = tid >> 4, gidx = tid & 15, row = trow + r; float gv = gbias[gidx];
#pragma unroll
                    for (int w = 0; w < 8; ++w) gv += part[w * 256 + tid];
                    if (gidx & 4) gv = fminf(gv, 0.f) - log1pf(expf(-fabsf(gv)));
                    if (row < rend) gates[(size_t)row * 16 + gidx] = gv; }
            }
        }
        for (int task = bx; task < 176; task += G) {
            const int cb = task % 11, ks = task / 11, k0 = ks * 64;
            __syncthreads();
            { const int v = tid >> 6, k = 3072 + k0 + (tid & 63); float a = A.b_mod[k];
#pragma unroll
                for (int q = 0; q < 16; ++q) a += modp[((size_t)q * 9 + v) * 6144 + k];
                svec[tid] = a; }
            __syncthreads();
            gemv_task<8, 64, false>(A.w_up, NUP, cb * 512, k0, svec, fbp + (size_t)ks * 8 * NUP, NUP);
        }
    }
    }
    SEAM(1);

    for (int rep_ = 0; rep_ < (((RPT_MASK >> 2) & 1) ? 2 : 1); ++rep_) { if (rep_) { if (2 == 0) cg::this_grid().sync(); else xcd_barrier(xbar); }
    if (IN(2)) {
        unsigned char* const wsb = A.ws; unsigned char* const dob = (unsigned char*)A.out; (void)wsb; (void)dob;
        { pg8::Gemm g{H, W1T, 1024, 1024, 1024}; pg8::Order S; S.init(64, 21, G, bx, 24);
          EpiIn E{AK, MK, AQ, MQ, MO, GA, GM, A.q_norm_w, A.k_norm_w, cosT, sinT, (LAS float*)(lds + 131072)};
          pg8::gemm_phase<EpiIn, pg8::Order, true>(lds, g, S, E); }
        { pg8::Gemm g{W2T, H, 1024, 1024, 1024}; pg8::Order S; S.init(5, 72, G, (bx + G - (1368 % G)) % G, 0);
          EpiPlain E{XT, MT};
          pg8::gemm_phase<EpiPlain, pg8::Order, true>(lds, g, S, E); }
    }
    }
    SEAM(2);

    if (IN(3)) {
        unsigned char* const wsb = A.ws; unsigned char* const dob = (unsigned char*)A.out; (void)wsb; (void)dob;
        for (int i = bx * 512 + tid; i < 8 * NUP; i += G * 512) { float a = 0.f;
#pragma unroll
            for (int ks = 0; ks < 16; ++ks) a += fbp[(size_t)ks * 8 * NUP + i];
            fbias[i] = a; }
        const int r16 = lane & 15, quad = lane >> 4;
        const int rt = wave & 3, hp = wave >> 2;
        LAS bf16_t* sK = (LAS bf16_t*)lds;
        LAS bf16_t* sVT = sK + 64 * 72;
        bf16x8 qn[2][2];
#define AT_QLOAD(un_) do { const int qb_ = (un_) & 31, kvh_ = ((un_) >> 5) & 3, b_ = (un_) >> 7; \
            _Pragma("unroll") for (int g = 0; g < 2; ++g) _Pragma("unroll") for (int ks = 0; ks < 2; ++ks) \
                qn[g][ks] = *(const bf16x8*)(AQ + (size_t)(b_ * SEQ + qb_ * 64 + rt * 16 + r16) * 1024 + (kvh_ * 4 + hp * 2 + g) * 64 + ks * 32 + quad * 8); } while (0)
        if (bx < 1024) AT_QLOAD(bx);
        for (int unit = bx; unit < 1024; unit += G) {
            const int qb = unit & 31, kvh = (unit >> 5) & 3, b = unit >> 7;
            const int rowbase = b * SEQ, t0 = qb * 64;
            bf16x8 qf[2][2];
#pragma unroll
            for (int g = 0; g < 2; ++g)
#pragma unroll
                for (int ks = 0; ks < 2; ++ks) qf[g][ks] = qn[g][ks];
            if (unit + G < 1024) AT_QLOAD(unit + G);
            f32x4 o[2][4]; float mrow[2], lrow[2];
#pragma unroll
            for (int g = 0; g < 2; ++g) { mrow[g] = A.attn_sink[kvh * 4 + hp * 2 + g]; lrow[g] = 1.f;
#pragma unroll
                for (int dt = 0; dt < 4; ++dt) o[g][dt] = (f32x4){0.f, 0.f, 0.f, 0.f}; }
            const int kb_lo = (qb < 2) ? 2 - qb : 0, kb_hi = (qb > 29) ? 33 - qb : 4;
            const bf16_t* const ak_ = AK; const bf16_t* const xt_ = XT; const int lr = tid >> 3, lc = tid & 7;
#define AT_KROW0(kb_) (((kb_) < 5) ? rowbase + (qb + (kb_) - 2) * 64 : ML + b * CTX + ((kb_) - 5) * 64)
            u32x4 pk, pv;
            { const int kr = AT_KROW0(kb_lo); pk = *(const u32x4*)(ak_ + (size_t)(kr + lr) * 256 + kvh * 64 + lc * 8); pv = *(const u32x4*)(xt_ + (size_t)(kvh * 64 + lr) * MT + kr + lc * 8); }
            for (int kb = kb_lo; kb < 9; kb = (kb == kb_hi) ? 5 : kb + 1) {
                const int mtype = (kb == 0) ? 1 : (kb == 4) ? 2 : 0;
                const int mlo = (mtype == 1) ? 0 : -4096, mhi = (mtype == 2) ? 0 : 4096, dl = quad * 4 - rt * 16 - r16;
                __syncthreads();
                *(LAS u32x4*)(sK + lr * 72 + lc * 8) = pk; *(LAS u32x4*)(sVT + lr * 72 + lc * 8) = pv;
                { const int kn = (kb == kb_hi) ? 5 : kb + 1;
                  if (kn < 9) { const int kr = AT_KROW0(kn); pk = *(const u32x4*)(ak_ + (size_t)(kr + lr) * 256 + kvh * 64 + lc * 8); pv = *(const u32x4*)(xt_ + (size_t)(kvh * 64 + lr) * MT + kr + lc * 8); } }
                __syncthreads();
                bf16x8 kf[4][2], vf[2][4];
#pragma unroll
                for (int tile = 0; tile < 4; ++tile)
#pragma unroll
                    for (int ks = 0; ks < 2; ++ks) kf[tile][ks] = *(const LAS bf16x8*)(sK + (tile * 16 + r16) * 72 + ks * 32 + quad * 8);
#pragma unroll
                for (int ks = 0; ks < 2; ++ks)
#pragma unroll
                    for (int dt = 0; dt < 4; ++dt) { const u32x2 lo = *(const LAS u32x2*)(sVT + (dt * 16 + r16) * 72 + ks * 32 + quad * 4), hi = *(const LAS u32x2*)(sVT + (dt * 16 + r16) * 72 + ks * 32 + 16 + quad * 4);
                        const u32x4 w = (u32x4){lo.x, lo.y, hi.x, hi.y}; vf[ks][dt] = __builtin_bit_cast(bf16x8, w); }
#pragma unroll
                for (int g = 0; g < 2; ++g) {
                    f32x4 s[4];
#pragma unroll
                    for (int tile = 0; tile < 4; ++tile) { s[tile] = (f32x4){0.f, 0.f, 0.f, 0.f};
#pragma unroll
                        for (int ks = 0; ks < 2; ++ks) s[tile] = mfma16(kf[tile][ks], qf[g][ks], s[tile]); }
                    float mx = -1e30f;
#pragma unroll
                    for (int tile = 0; tile < 4; ++tile)
#pragma unroll
                        for (int j = 0; j < 4; ++j) { const int dd = dl + (tile * 16 + j);
                            const int bad = ((dd - mlo) | (mhi - dd)) >> 31;
                            const float v = s[tile][j] * 0.125f + __int_as_float(bad & (int)0xF149F2CAu); s[tile][j] = v; mx = fmaxf(mx, v); }
                    mx = fmaxf(mx, __shfl_xor(mx, 16)); mx = fmaxf(mx, __shfl_xor(mx, 32));
                    const float mn = fmaxf(mrow[g], mx), alpha = __expf(mrow[g] - mn); mrow[g] = mn; float rs = 0.f;
                    unsigned pw[4][2];
#pragma unroll
                    for (int tile = 0; tile < 4; ++tile) { f32x4 pe;
#pragma unroll
                        for (int j = 0; j < 4; ++j) { pe[j] = __expf(s[tile][j] - mn); rs += pe[j]; }
                        pw[tile][0] = cvt_pk_bf16(pe[0], pe[1]); pw[tile][1] = cvt_pk_bf16(pe[2], pe[3]); }
                    rs += __shfl_xor(rs, 16); rs += __shfl_xor(rs, 32);
                    lrow[g] = lrow[g] * alpha + rs;
#pragma unroll
                    for (int dt = 0; dt < 4; ++dt) o[g][dt] = o[g][dt] * alpha;
#pragma unroll
                    for (int ks = 0; ks < 2; ++ks) { const u32x4 w = (u32x4){pw[2 * ks][0], pw[2 * ks][1], pw[2 * ks + 1][0], pw[2 * ks + 1][1]}; const bf16x8 pf = __builtin_bit_cast(bf16x8, w);
#pragma unroll
                        for (int dt = 0; dt < 4; ++dt) o[g][dt] = mfma16(vf[ks][dt], pf, o[g][dt]); }
                }
            }
#pragma unroll
            for (int g = 0; g < 2; ++g) { const float inv = 1.f / lrow[g];
                bf16_t* p = ATTO + (size_t)(rowbase + t0 + rt * 16 + r16) * 1024 + (kvh * 4 + hp * 2 + g) * 64 + quad * 4;
#pragma unroll
                for (int dt = 0; dt < 4; ++dt) { u32x2 w; w.x = cvt_pk_bf16(o[g][dt][0] * inv, o[g][dt][1] * inv); w.y = cvt_pk_bf16(o[g][dt][2] * inv, o[g][dt][3] * inv); *(u32x2*)(p + dt * 16) = w; } }
        }
    }
    SEAM(3);

    for (int rep_ = 0; rep_ < (((RPT_MASK >> 4) & 1) ? 2 : 1); ++rep_) { if (rep_) { if (4 == 0) cg::this_grid().sync(); else xcd_barrier(xbar); }
    if (IN(4)) {
        unsigned char* const wsb = A.ws; unsigned char* const dob = (unsigned char*)A.out; (void)wsb; (void)dob;
        const int r16 = lane & 15, quad = lane >> 4;
        LAS bf16_t* sK = (LAS bf16_t*)lds;
        LAS bf16_t* sVT = sK + 128 * 136;
        LAS bf16_t* sS = sVT + 64 * 136;
        LAS bf16_t* sC = sS + 128 * 136;
        LAS float* sgb = (LAS float*)(sC + 80 * 136);
        LAS float *sga = sgb + 128, *sgw = sgb + 256, *sge = sgb + 384, *sgF = sgb + 512;
        const float scale = 0.08838834764831845f;
        for (int task = bx; task < 256; task += G) {
            const int vq = task & 3, dir = (task >> 2) & 1, hh = (task >> 3) & 3, b = task >> 5;
            __syncthreads();
            for (int i = tid; i < 80 * 136 / 2; i += 512) ((LAS unsigned*)sC)[i] = 0u;
            f32x4 cacc[4], nacc = (f32x4){0.f, 0.f, 0.f, 0.f};
#pragma unroll
            for (int vt = 0; vt < 4; ++vt) cacc[vt] = (f32x4){0.f, 0.f, 0.f, 0.f};
            bf16_t* Hout = (bf16_t*)(dob + (dir ? DO_HB : DO_HF)); const int sgn = dir ? 1 : -1;
            const bf16_t* const mk_ = MK; const bf16_t* const xt_ = XT; const bf16_t* const mq_ = MQ; const float* const gt_ = gates;
            u32x4 pK[4], pVT[2]; bf16x8 pQ[4]; float pG[4];
#define ML_TOK0(st) (((st) < 2) ? (ML + b * CTX + (dir ? 1 - (st) : (st)) * 128) : (b * SEQ + (dir ? 15 - ((st) - 2) : (st) - 2) * 128))
#define ML_PREFETCH(st) do { const int t0_ = ML_TOK0(st); \
                _Pragma("unroll") for (int q_ = 0; q_ < 4; ++q_) { const int i_ = tid + q_ * 512, r_ = i_ >> 4, c_ = i_ & 15; pK[q_] = *(const u32x4*)(mk_ + (size_t)(t0_ + r_) * 512 + hh * 128 + c_ * 8); } \
                if ((st) >= 2) { _Pragma("unroll") for (int ks_ = 0; ks_ < 4; ++ks_) pQ[ks_] = *(const bf16x8*)(mq_ + (size_t)(t0_ + wave * 16 + r16) * 512 + hh * 128 + ks_ * 32 + quad * 8); } \
                _Pragma("unroll") for (int q_ = 0; q_ < 2; ++q_) { const int i_ = tid + q_ * 512, r_ = i_ >> 4, c_ = i_ & 15; pVT[q_] = *(const u32x4*)(xt_ + (size_t)(256 + hh * 256 + vq * 64 + r_) * MT + t0_ + c_ * 8); } \
                if (wave == 0) { const float* gp_ = gt_ + (size_t)(t0_ + 2 * lane) * 16 + dir * 8 + hh; pG[0] = gp_[0]; pG[1] = gp_[4]; pG[2] = gp_[16]; pG[3] = gp_[20]; } } while (0)
            ML_PREFETCH(0);
            for (int step = 0; step < 18; ++step) {
                const bool isctx = step < 2; const int tok0 = ML_TOK0(step);
                __syncthreads();
#pragma unroll
                for (int q = 0; q < 4; ++q) { const int i = tid + q * 512, r = i >> 4, c = i & 15; *(LAS u32x4*)(sK + r * 136 + c * 8) = pK[q]; }
#pragma unroll
                for (int q = 0; q < 2; ++q) { const int i = tid + q * 512, r = i >> 4, c = i & 15; *(LAS u32x4*)(sVT + r * 136 + c * 8) = pVT[q]; }
                if (wave == 0) {
                    const float i0 = pG[0], f0 = pG[1], i1 = pG[2], f1 = pG[3];
                    const float loc = f0 + f1; float v = loc;
#pragma unroll
                    for (int off = 1; off < 64; off <<= 1) { const float t = __shfl_up(v, off); if (lane >= off) v += t; }
                    const float total = __shfl(v, 63); const float p0 = v - loc + f0, p1 = p0 + f1;
                    const float b0 = dir ? total - p0 + f0 : p0, b1 = dir ? total - p1 + f1 : p1;
                    const float cmid = 0.5f * total;
                    sgb[2 * lane] = __expf(fminf(b0 - cmid, 80.f)); sgb[2 * lane + 1] = __expf(fminf(b1 - cmid, 80.f));
                    sga[2 * lane] = __expf(fminf(i0 - b0 + cmid, 80.f)) * scale; sga[2 * lane + 1] = __expf(fminf(i1 - b1 + cmid, 80.f)) * scale;
                    sgw[2 * lane] = __expf(fminf(total - b0 + i0, 80.f)) * scale; sgw[2 * lane + 1] = __expf(fminf(total - b1 + i1, 80.f)) * scale;
                    sge[2 * lane] = __expf(b0); sge[2 * lane + 1] = __expf(b1); if (lane == 0) sgF[0] = __expf(total);
                }
                bf16x8 qf[4];
#pragma unroll
                for (int ks = 0; ks < 4; ++ks) qf[ks] = pQ[ks];
                if (step + 1 < 18) ML_PREFETCH(step + 1);
                __syncthreads();
                if (!isctx) {
                    const int prow = wave * 16 + r16;
                    f32x4 s[8];
#pragma unroll
                    for (int tile = 0; tile < 8; ++tile) { s[tile] = (f32x4){0.f, 0.f, 0.f, 0.f};
#pragma unroll
                        for (int ks = 0; ks < 4; ++ks) { const bf16x8 kf = *(const LAS bf16x8*)(sK + (tile * 16 + r16) * 136 + ks * 32 + quad * 8); s[tile] = mfma16(kf, qf[ks], s[tile]); } }
                    const float bp = sgb[prow]; float rs = 0.f;
#pragma unroll
                    for (int tile = 0; tile < 8; ++tile) { const f32x4 av = *(const LAS f32x4*)(sga + tile * 16 + quad * 4); f32x4 pe;
#pragma unroll
                        for (int j = 0; j < 4; ++j) { const int dd = (tile * 16 + quad * 4 + j - prow) * sgn;
                            pe[j] = __int_as_float(__float_as_int(s[tile][j] * (bp * av[j])) & ~(dd >> 31)); rs += pe[j]; }
                        u32x2 w; w.x = cvt_pk_bf16(pe[0], pe[1]); w.y = cvt_pk_bf16(pe[2], pe[3]);
                        *(LAS u32x2*)(sS + prow * 136 + tile * 16 + quad * 4) = w; }
                    rs += __shfl_xor(rs, 16); rs += __shfl_xor(rs, 32);
                    asm volatile("s_waitcnt lgkmcnt(0)" ::: "memory");
                    f32x4 a1[4], a2[5];
#pragma unroll
                    for (int vt = 0; vt < 4; ++vt) a1[vt] = (f32x4){0.f, 0.f, 0.f, 0.f};
#pragma unroll
                    for (int vt = 0; vt < 5; ++vt) a2[vt] = (f32x4){0.f, 0.f, 0.f, 0.f};
#pragma unroll
                    for (int ks = 0; ks < 4; ++ks) { const bf16x8 af = *(const LAS bf16x8*)(sS + prow * 136 + ks * 32 + quad * 8);
#pragma unroll
                        for (int vt = 0; vt < 4; ++vt) { const bf16x8 vf = *(const LAS bf16x8*)(sVT + (vt * 16 + r16) * 136 + ks * 32 + quad * 8); a1[vt] = mfma16(vf, af, a1[vt]); } }
#pragma unroll
                    for (int ks = 0; ks < 4; ++ks)
#pragma unroll
                        for (int vt = 0; vt < 5; ++vt) { const bf16x8 cf = *(const LAS bf16x8*)(sC + (vt * 16 + r16) * 136 + ks * 32 + quad * 8); a2[vt] = mfma16(cf, qf[ks], a2[vt]); }
                    const float e = sge[prow];
                    const float qn = __shfl(a2[4][0], r16); const float nq = rs + e * qn; const float inv = 1.f / fmaxf(fabsf(nq), 1.f);
                    bf16_t* hp = Hout + (size_t)(tok0 + prow) * 1024 + hh * 256 + vq * 64 + quad * 4;
#pragma unroll
                    for (int vt = 0; vt < 4; ++vt) { u32x2 w; w.x = cvt_pk_bf16((a1[vt][0] + e * a2[vt][0]) * inv, (a1[vt][1] + e * a2[vt][1]) * inv);
                        w.y = cvt_pk_bf16((a1[vt][2] + e * a2[vt][2]) * inv, (a1[vt][3] + e * a2[vt][3]) * inv); *(u32x2*)(hp + vt * 16) = w; }
                }
                __syncthreads();
                {
                    const float F = sgF[0];
#pragma unroll
                    for (int vt = 0; vt < 4; ++vt) cacc[vt] = cacc[vt] * F;
                    nacc = nacc * F;
                    bf16x8 ones; { const short o1 = (r16 == 0) ? (short)0x3F80 : (short)0;
#pragma unroll
                        for (int e = 0; e < 8; ++e) ones[e] = o1; }
#pragma unroll
                    for (int ks = 0; ks < 4; ++ks) {
                        const LAS bf16_t* kcol = sK + (ks * 32 + quad * 8) * 136 + wave * 16 + r16;
                        const f32x4 w0 = *(const LAS f32x4*)(sgw + ks * 32 + quad * 8), w1 = *(const LAS f32x4*)(sgw + ks * 32 + quad * 8 + 4);
                        f32x4 k0, k1;
#pragma unroll
                        for (int e = 0; e < 4; ++e) { k0[e] = bf2f(kcol[e * 136]) * w0[e]; k1[e] = bf2f(kcol[(4 + e) * 136]) * w1[e]; }
                        const u32x4 pk = pack8(k0, k1); const bf16x8 kts = __builtin_bit_cast(bf16x8, pk);
#pragma unroll
                        for (int vt = 0; vt < 4; ++vt) { const bf16x8 va = *(const LAS bf16x8*)(sVT + (vt * 16 + r16) * 136 + ks * 32 + quad * 8); cacc[vt] = mfma16(kts, va, cacc[vt]); }
                        nacc = mfma16(kts, ones, nacc);
                    }
#pragma unroll
                    for (int vt = 0; vt < 4; ++vt) { u32x2 w; w.x = cvt_pk_bf16(cacc[vt][0], cacc[vt][1]); w.y = cvt_pk_bf16(cacc[vt][2], cacc[vt][3]);
                        *(LAS u32x2*)(sC + (vt * 16 + r16) * 136 + wave * 16 + quad * 4) = w; }
                    if (r16 == 0) { u32x2 w; w.x = cvt_pk_bf16(nacc[0], nacc[1]); w.y = cvt_pk_bf16(nacc[2], nacc[3]); *(LAS u32x2*)(sC + 64 * 136 + wave * 16 + quad * 4) = w; }
                }
            }
        }
    }
    }
    SEAM(4);

    if (IN(5)) {
        unsigned char* const wsb = A.ws; unsigned char* const dob = (unsigned char*)A.out; (void)wsb; (void)dob;
        for (int row = gw; row < ML; row += NGW) {
            const size_t off = (size_t)row * 1024 + lane * 16;
            float ht[16], mo[16];
#pragma unroll
            for (int q = 0; q < 2; ++q) { const u32x4 a = *(const u32x4*)(HF + off + q * 8), c = *(const u32x4*)(HB + off + q * 8), d = *(const u32x4*)(MO + off + q * 8);
#pragma unroll
                for (int e = 0; e < 4; ++e) { ht[q * 8 + 2 * e] = __uint_as_float(a[e] << 16) + __uint_as_float(c[e] << 16); ht[q * 8 + 2 * e + 1] = __uint_as_float(a[e] & 0xffff0000u) + __uint_as_float(c[e] & 0xffff0000u);
                    mo[q * 8 + 2 * e] = __uint_as_float(d[e] << 16); mo[q * 8 + 2 * e + 1] = __uint_as_float(d[e] & 0xffff0000u); } }
            float ss = 0.f;
#pragma unroll
            for (int e = 0; e < 16; ++e) ss += ht[e] * ht[e];
            ss += __shfl_xor(ss, 1); ss += __shfl_xor(ss, 2); ss += __shfl_xor(ss, 4); ss += __shfl_xor(ss, 8);
            const float rs = rsqrtf(ss * (1.f / 256.f) + EPS);
            float r[16];
#pragma unroll
            for (int q = 0; q < 4; ++q) { const f32x4 w = *(const f32x4*)(A.ml_norm_w + lane * 16 + q * 4);
#pragma unroll
                for (int e = 0; e < 4; ++e) r[q * 4 + e] = ht[q * 4 + e] * rs * w[e] * sigmoidf_(mo[q * 4 + e]); }
#pragma unroll
            for (int q = 0; q < 2; ++q) { u32x4 w; w.x = cvt_pk_bf16(r[q * 8 + 0], r[q * 8 + 1]); w.y = cvt_pk_bf16(r[q * 8 + 2], r[q * 8 + 3]); w.z = cvt_pk_bf16(r[q * 8 + 4], r[q * 8 + 5]); w.w = cvt_pk_bf16(r[q * 8 + 6], r[q * 8 + 7]);
                *(u32x4*)(MO + off + q * 8) = w; }
        }
    }
    SEAM(5);

    for (int rep_ = 0; rep_ < (((RPT_MASK >> 6) & 1) ? 2 : 1); ++rep_) { if (rep_) { if (6 == 0) cg::this_grid().sync(); else xcd_barrier(xbar); }
    if (IN(6)) {
        unsigned char* const wsb = A.ws; unsigned char* const dob = (unsigned char*)A.out; (void)wsb; (void)dob;
        pg8::Order S; S.init(64, 4, G, bx, 0);
        { pg8::Gemm g{AQ, WBA, 1024, 1024, 1024, MO, WBM}; EpiMerge E{GA, GM, Y}; pg8::gemm_phase<EpiMerge, pg8::Order, false, true>(lds, g, S, E); }
    }
    }
    SEAM(6);

    for (int rep_ = 0; rep_ < (((RPT_MASK >> 7) & 1) ? 2 : 1); ++rep_) { if (rep_) { if (7 == 0) cg::this_grid().sync(); else xcd_barrier(xbar); }
    if (IN(7)) {
        unsigned char* const wsb = A.ws; unsigned char* const dob = (unsigned char*)A.out; (void)wsb; (void)dob;
        pg8::Order S; S.init(64, 4, G, bx, 0);
#ifdef DBG_P7PLAIN
        pg8::Gemm g{Y, WO, 1024, 1024, 1024}; EpiPlain E{T1, 1024};
        pg8::gemm_phase<EpiPlain, pg8::Order, false>(lds, g, S, E);
#else
        pg8::Gemm g{Y, WO, 1024, 1024, 1024}; EpiOut E{A.x, mod, A.norm2_w, (float*)dob, AQ, rowsq};
        pg8::gemm_phase<EpiOut, pg8::Order, false>(lds, g, S, E);
#endif
    }
    }
    SEAM(7);

    for (int rep_ = 0; rep_ < (((RPT_MASK >> 8) & 1) ? 2 : 1); ++rep_) { if (rep_) { if (8 == 0) cg::this_grid().sync(); else xcd_barrier(xbar); }
    if (IN(8)) {
        unsigned char* const wsb = A.ws; unsigned char* const dob = (unsigned char*)A.out; (void)wsb; (void)dob;
        pg8::Order S; S.init(64, 22, G, bx, 0);
        pg8::Gemm g{AQ, WUP, 1024, 1024, 1024}; EpiUp E{rowsq, fbias, A.conv_w, A.conv_b, ACT, RAWU, (LAS float*)(lds + 131072)};
        pg8::gemm_phase<EpiUp, pg8::Order, true>(lds, g, S, E);
    }
    }
    SEAM(8);

    if (IN(9)) {
        unsigned char* const wsb = A.ws; unsigned char* const dob = (unsigned char*)A.out; (void)wsb; (void)dob;
        const float* cw = A.conv_w; const float* cb = A.conv_b;
        for (int task = bx * 512 + tid; task < 1025 * 352; task += G * 512) {
            const int ch = task % 352, bd = task / 352, j0 = ch * 8;
            const int pc = 256 * (j0 >> 7) + (j0 & 127);
            const bool lo_ok = bd > 0, hi_ok = bd < 1024, seam = ((bd * 16) & 2047) == 0;
            const u32x4 zero = (u32x4){0u, 0u, 0u, 0u};
            u32x4 xa[4], xg[4];
#pragma unroll
            for (int k = 0; k < 4; ++k) { xa[k] = zero; xg[k] = zero; }
            if (lo_ok) { const bf16_t* rp = RAWU + ((size_t)(bd - 1) * 4 + 2) * NUP + pc; xa[0] = *(const u32x4*)rp; xg[0] = *(const u32x4*)(rp + 128); xa[1] = *(const u32x4*)(rp + NUP); xg[1] = *(const u32x4*)(rp + NUP + 128); }
            if (hi_ok) { const bf16_t* rp = RAWU + ((size_t)bd * 4) * NUP + pc; xa[2] = *(const u32x4*)rp; xg[2] = *(const u32x4*)(rp + 128); xa[3] = *(const u32x4*)(rp + NUP); xg[3] = *(const u32x4*)(rp + NUP + 128); }
            float wa[3][8], wg[3][8], ba[8], bg[8];
#pragma unroll
            for (int i = 0; i < 3; ++i)
#pragma unroll
                for (int q = 0; q < 2; ++q) { const f32x4 a = *(const f32x4*)(cw + i * NUP + j0 + 4 * q), g = *(const f32x4*)(cw + i * NUP + DFF + j0 + 4 * q);
#pragma unroll
                    for (int e = 0; e < 4; ++e) { wa[i][4 * q + e] = a[e]; wg[i][4 * q + e] = g[e]; } }
#pragma unroll
            for (int q = 0; q < 2; ++q) { const f32x4 a = *(const f32x4*)(cb + j0 + 4 * q), g = *(const f32x4*)(cb + DFF + j0 + 4 * q);
#pragma unroll
                for (int e = 0; e < 4; ++e) { ba[4 * q + e] = a[e]; bg[4 * q + e] = g[e]; } }
#pragma unroll
            for (int side = 0; side < 2; ++side) {
                if (side == 0 ? !lo_ok : !hi_ok) continue;
                float r[8];
#pragma unroll
                for (int e = 0; e < 8; ++e) { const int w = e >> 1; const bool hi16 = e & 1;
                    float va[3], vg[3];
#pragma unroll
                    for (int k = 0; k < 3; ++k) { const unsigned aw = xa[side + k][w], gw = xg[side + k][w];
                        va[k] = hi16 ? __uint_as_float(aw & 0xffff0000u) : __uint_as_float(aw << 16); vg[k] = hi16 ? __uint_as_float(gw & 0xffff0000u) : __uint_as_float(gw << 16); }
                    if (seam) { if (side == 0) { va[2] = 0.f; vg[2] = 0.f; } else { va[0] = 0.f; vg[0] = 0.f; } }
                    const float av = ba[e] + wa[0][e] * va[0] + wa[1][e] * va[1] + wa[2][e] * va[2];
                    const float gv = bg[e] + wg[0][e] * vg[0] + wg[1][e] * vg[1] + wg[2][e] * vg[2];
                    r[e] = gv * sigmoidf_(gv) * av; }
                u32x4 w; w.x = cvt_pk_bf16(r[0], r[1]); w.y = cvt_pk_bf16(r[2], r[3]); w.z = cvt_pk_bf16(r[4], r[5]); w.w = cvt_pk_bf16(r[6], r[7]);
                *(u32x4*)(ACT + (size_t)(bd * 16 - 1 + side) * DFF + j0) = w;
            }
        }
    }
    SEAM(9);

    if (IN(10)) {
        unsigned char* const wsb = A.ws; unsigned char* const dob = (unsigned char*)A.out; (void)wsb; (void)dob;
        pg8::Order S; S.init(64, 4, G, bx, 0);
        pg8::Gemm g{ACT, WDN, DFF, DFF, DFF}; EpiDown E{(float*)dob, mod, AQ, A.norm2_w};
        pg8::gemm_phase<EpiDown, pg8::Order, false>(lds, g, S, E);
    }
#undef IN
#undef SEAM
}
#undef A

extern "C" void kernel_launch(void* const* d_in, const int* in_sizes, int n_in, void* d_out, int out_size, void* d_ws, size_t ws_size, hipStream_t stream) {
    static int grid = 0;
    if (grid == 0) {
        if (n_in != 21 || out_size != ML * D || ws_size < WS_END) { fprintf(stderr, "kernel_launch: unexpected shapes (n_in %d out %d ws %zu)\n", n_in, out_size, ws_size); grid = -1; return; }
        int dev = 0, cus = 0, per_cu = 0;
        hipGetDevice(&dev); hipDeviceGetAttribute(&cus, hipDeviceAttributeMultiprocessorCount, dev);
        hipFuncSetAttribute((const void*)fwd_kernel, hipFuncAttributeMaxDynamicSharedMemorySize, LDS_BYTES);
        hipOccupancyMaxActiveBlocksPerMultiprocessor(&per_cu, (const void*)fwd_kernel, 512, LDS_BYTES);
        if (per_cu < 1) { fprintf(stderr, "kernel_launch: occupancy query says %d blocks per CU\n", per_cu); per_cu = 1; }
        grid = cus * per_cu;
        (void)hipGetLastError();
    }
    if (grid < 0) return;
    Args a{};
    const float** pp = (const float**)&a;
    for (int i = 0; i < 21; ++i) pp[i] = (const float*)d_in[i];
    a.out = (float*)d_out; a.ws = (unsigned char*)d_ws;
#if ONE_LAUNCH
    a.ph_lo = 0; a.ph_hi = 11;
    void* args[] = {&a};
    hipError_t e = hipLaunchCooperativeKernel((const void*)fwd_kernel, dim3(grid), dim3(512), args, LDS_BYTES, stream);
    if (e != hipSuccess) fprintf(stderr, "cooperative launch failed: %s (grid %d)\n", hipGetErrorString(e), grid);
#else
    for (int p = 0; p < 11; ++p) { a.ph_lo = p; a.ph_hi = p + 1; hipLaunchKernelGGL(fwd_kernel, dim3(grid), dim3(512), LDS_BYTES, stream, a); }

#endif
}
```

```cpp
#include <hip/hip_runtime.h>
#include <hip/hip_cooperative_groups.h>
#include <cstdio>
#include <cstdint>
namespace cg = cooperative_groups;

#ifndef RPT_MASK
#define RPT_MASK 0
#endif
#ifndef ONE_LAUNCH
#define ONE_LAUNCH 1
#endif

#define LAS __attribute__((address_space(3)))
typedef unsigned short bf16_t;
typedef short bf16x8 __attribute__((ext_vector_type(8)));
typedef float f32x4 __attribute__((ext_vector_type(4)));
typedef unsigned u32x4 __attribute__((ext_vector_type(4)));
typedef unsigned u32x2 __attribute__((ext_vector_type(2)));

constexpr int D = 1024, NB = 8, SEQ = 2048, CTX = 256;
constexpr int ML = NB * SEQ;
constexpr int MC = NB * CTX;
constexpr int MT = ML + MC;
constexpr int DFF = 2816, NUP = 2 * DFF, INW = 6672;
constexpr float EPS = 1e-6f;
constexpr size_t MiB = 1u << 20;
constexpr size_t WS_ZERO = 0;
constexpr size_t WS_MOD = 0, WS_FB = 256 * 1024, WS_RSQ = 512 * 1024;
constexpr size_t WS_MODP = 236 * MiB + 12 * MiB;
constexpr size_t WS_RSQP = 252 * MiB;
constexpr size_t DO_FBP = 60 * MiB;
constexpr size_t WS_ROPE = 1 * MiB;
constexpr size_t WS_GATES = 2 * MiB;
constexpr size_t WS_WBA = 4 * MiB, WS_WBM = 6 * MiB, WS_WO = 8 * MiB, WS_WUP = 10 * MiB, WS_WDN = 21 * MiB;
constexpr size_t WS_AQ = 27 * MiB;
constexpr size_t WS_MQ = 59 * MiB, WS_MK = 75 * MiB  , WS_MO = 93 * MiB, WS_GA = 125 * MiB, WS_GM = 157 * MiB, WS_XT = 189 * MiB  ;
constexpr size_t WS_T1 = 59 * MiB, WS_Y = 189 * MiB;
constexpr size_t WS_U = 59 * MiB;
constexpr size_t WS_HALO = 236 * MiB;
constexpr size_t WS_ACT = 59 * MiB;
constexpr size_t WS_RAW = 147 * MiB;
constexpr size_t WS_END = 256 * MiB;
constexpr size_t DO_H = 0, DO_W1T = 36 * MiB, DO_W2T = 47 * MiB, DO_AK = 51 * MiB;
constexpr size_t DO_HF = 0, DO_HB = 32 * MiB;
constexpr int LDS_BYTES = 157696;

typedef float f32x2_t __attribute__((ext_vector_type(2))); typedef __bf16 bf16x2_t __attribute__((ext_vector_type(2)));
__device__ __forceinline__ unsigned cvt_pk_bf16(float lo, float hi) { f32x2_t v = {lo, hi}; bf16x2_t b = __builtin_convertvector(v, bf16x2_t); return __builtin_bit_cast(unsigned, b); }
__device__ __forceinline__ float bf2f(unsigned short v) { return __uint_as_float((unsigned)v << 16); }
__device__ __forceinline__ bf16_t f2bf(float f) { return (bf16_t)(cvt_pk_bf16(f, 0.f) & 0xffffu); }
__device__ __forceinline__ u32x4 pack8(f32x4 a, f32x4 b) { u32x4 w; w.x = cvt_pk_bf16(a[0], a[1]); w.y = cvt_pk_bf16(a[2], a[3]); w.z = cvt_pk_bf16(b[0], b[1]); w.w = cvt_pk_bf16(b[2], b[3]); return w; }
__device__ __forceinline__ float sigmoidf_(float x) { return __builtin_amdgcn_rcpf(1.f + __expf(-x)); }
__device__ __forceinline__ float sigmoid_div(float x) { return 1.f / (1.f + __expf(-x)); }
__device__ __forceinline__ float wave_sum(float v) {
#pragma unroll
    for (int o = 1; o < 64; o <<= 1) v += __shfl_xor(v, o);
    return v;
}

namespace pg8 {
constexpr int BM = 256, BK = 64, HALF = 128, HTB = HALF * BK * 2, STAGE_BYTES = 8 * HTB, NXCD = 8, WGM = 8;
__host__ __device__ __forceinline__ int lds_byte(int r, int c) { const int st = (r >> 4) * 2 + (c >> 5), rr = r & 15, cc = c & 31, ob = rr * 64 + cc * 2; return st * 1024 + (ob ^ (((ob >> 9) & 1) << 5)); }
__host__ __device__ __forceinline__ void stage_rc(int b, int& R, int& C) { const int st = b / 1024, sb = b % 1024, swz = sb ^ (((sb >> 9) & 1) << 5); R = (st >> 1) * 16 + swz / 64; C = (st & 1) * 32 + (swz % 64) / 2; }
__host__ __device__ __forceinline__ int perm32(int rho) { const int n = rho >> 4, i = rho & 15; return 8 * (i >> 2) + 4 * n + (i & 3); }

struct Unit { int pm, pn; };
struct Gemm { const bf16_t* A; const bf16_t* Bt; int lda, ldb, K; const bf16_t* A2 = nullptr; const bf16_t* Bt2 = nullptr; };

struct Order {
    int nM, nN, nwg, G, c, extra;
    __device__ __forceinline__ void init(int nM_, int nN_, int G_, int c_, int extra_) { nM = nM_; nN = nN_; nwg = nM_ * nN_; G = G_; c = c_; extra = extra_; }
    __device__ __forceinline__ bool next(int i, Unit& u) const {
        const long Lq = (long)i * G + c; if (Lq >= nwg + extra) return false;
        if (Lq >= nwg) { const int e = (int)(Lq - nwg); u.pm = nM + e / 3; u.pn = e % 3; return true; }
        int wgid = (int)Lq; { const int q = nwg / NXCD, r = nwg % NXCD, xcd = wgid % NXCD, off = wgid / NXCD; wgid = (xcd < r ? xcd * (q + 1) : r * (q + 1) + (xcd - r) * q) + off; }
        const int nig = WGM * nN, gid = wgid / nig, fm = gid * WGM, gsz = (nM - fm) < WGM ? (nM - fm) : WGM;
        u.pm = fm + ((wgid % nig) % gsz); u.pn = (wgid % nig) / gsz; return true;
    }
};

template <class Epi, class Sched, bool ALIGN_EPI, bool DUAL = false>
__device__ __forceinline__ void gemm_phase(LAS unsigned char* lds, const Gemm g, const Sched& S, const Epi& E) {
    int tid_ = threadIdx.x; asm volatile("" : "+v"(tid_));
    const int tid = tid_, wid = __builtin_amdgcn_readfirstlane(tid >> 6), lane = tid & 63, wr = wid >> 2, wc = wid & 3, fr = lane & 15, fq = lane >> 4;
    const int K = g.K, nt1 = K / BK, nt = DUAL ? 2 * nt1 : nt1;
    unsigned voffA[2], voffB[2];
#pragma unroll
    for (int i = 0; i < 2; ++i) { int R, C; stage_rc(tid * 16 + i * 8192, R, C); const int Rb = ((R & ~31) + perm32(R & 31));
        voffA[i] = (unsigned)(R * g.lda + C) * 2u; voffB[i] = (unsigned)(Rb * g.ldb + C) * 2u; }
    const size_t kstep = (size_t)(BK * 2);
    const size_t hstepA = (size_t)HALF * g.lda * 2, hstepB = (size_t)HALF * g.ldb * 2;
    const size_t tstepA = 2 * hstepA, tstepB = 2 * hstepB;
    const unsigned ldsw = (unsigned)wid * 1024u;
    const int aoff = lds_byte(wr * 64 + fr, fq * 8), boff = lds_byte(wc * 32 + fr, fq * 8);
#define PG8_SA(b, h) (((b) * 2 + (h)) * HTB)
#define PG8_SB(b, h) ((4 + (b) * 2 + (h)) * HTB)
#define PG8_STAGE(bufoff, gbase, voff) do { _Pragma("unroll") for (int _i = 0; _i < 2; ++_i) \
        __builtin_amdgcn_global_load_lds((const unsigned*)((const char*)(gbase) + (voff)[_i]), (LAS unsigned*)(lds + (bufoff) + ldsw + _i * 8192), 16, 0, 0); } while (0)
#define PG8_LDA(dst, b, h) do { _Pragma("unroll") for (int m = 0; m < 4; ++m) _Pragma("unroll") for (int k = 0; k < 2; ++k) dst[m][k] = *(const LAS bf16x8*)(lds + PG8_SA(b, h) + aoff + m * 2048 + k * 1024); } while (0)
#define PG8_LDB(dst, b, h) do { _Pragma("unroll") for (int n = 0; n < 2; ++n) _Pragma("unroll") for (int k = 0; k < 2; ++k) dst[n][k] = *(const LAS bf16x8*)(lds + PG8_SB(b, h) + boff + n * 2048 + k * 1024); } while (0)
#define PG8_MMA(ai, bj, At, Bt) do { __builtin_amdgcn_s_setprio(1); _Pragma("unroll") for (int m = 0; m < 4; ++m) _Pragma("unroll") for (int n = 0; n < 2; ++n) _Pragma("unroll") for (int k = 0; k < 2; ++k) \
        acc[ai][bj][m][n] = __builtin_amdgcn_mfma_f32_16x16x32_bf16(Bt[n][k], At[m][k], acc[ai][bj][m][n], 0, 0, 0); __builtin_amdgcn_s_setprio(0); } while (0)
#define PG8_WAIT_V(n) asm volatile("s_waitcnt vmcnt(" #n ")" ::: "memory")
#define PG8_WAIT_L(n) asm volatile("s_waitcnt lgkmcnt(" #n ")" ::: "memory")
#define PG8_BAR __builtin_amdgcn_s_barrier()
#define PG8_SCHED __builtin_amdgcn_sched_barrier(0)
    Unit cur, nxt; int ui = 0;
    if (!S.next(0, cur)) return;
    f32x4 acc[2][2][4][2];
#pragma unroll
    for (int a = 0; a < 2; ++a)
#pragma unroll
        for (int b = 0; b < 2; ++b)
#pragma unroll
            for (int m = 0; m < 4; ++m)
#pragma unroll
                for (int n = 0; n < 2; ++n) acc[a][b][m][n] = (f32x4){0.f, 0.f, 0.f, 0.f};
    bf16x8 At[4][2], B0[2][2], B1[2][2];
    const char* cA = (const char*)g.A + (size_t)cur.pm * tstepA; const char* cB = (const char*)g.Bt + (size_t)cur.pn * tstepB;
    const char* cA2 = DUAL ? (const char*)g.A2 + (size_t)cur.pm * tstepA : cA; const char* cB2 = DUAL ? (const char*)g.Bt2 + (size_t)cur.pn * tstepB : cB;
    PG8_STAGE(PG8_SB(0, 0), cB, voffB); PG8_STAGE(PG8_SB(0, 1), cB + hstepB, voffB); PG8_STAGE(PG8_SA(0, 0), cA, voffA); PG8_STAGE(PG8_SA(0, 1), cA + hstepA, voffA);
    if (wr == 1) PG8_BAR;
    PG8_WAIT_V(2); PG8_BAR;
    PG8_STAGE(PG8_SB(1, 0), cB + kstep, voffB); PG8_STAGE(PG8_SA(1, 0), cA + kstep, voffA); PG8_STAGE(PG8_SB(1, 1), cB + hstepB + kstep, voffB);
    PG8_WAIT_V(6); PG8_BAR;
    for (;;) {
        const bool has_next = S.next(ui + 1, nxt);
        const char* nA = has_next ? (const char*)g.A + (size_t)nxt.pm * tstepA : cA; const char* nB = has_next ? (const char*)g.Bt + (size_t)nxt.pn * tstepB : cB;
        for (int t = 0; t < nt; t += 2) {
            const bool last = (t == nt - 2);
            const bool seg2 = DUAL && t >= nt1, seg2n = DUAL && t + 2 >= nt1;
            const char* a1 = seg2 ? cA2 + (size_t)(t + 1 - nt1) * kstep : cA + (size_t)(t + 1) * kstep;
            const char* a2 = last ? nA : (seg2n ? cA2 + (size_t)(t + 2 - nt1) * kstep : cA + (size_t)(t + 2) * kstep);
            const char* b2 = last ? nB : (seg2n ? cB2 + (size_t)(t + 2 - nt1) * kstep : cB + (size_t)(t + 2) * kstep);
            if constexpr (DUAL) { if (t == nt1) E.mid(acc, cur, wr, wc, fr, fq); }
            const char* a3 = a2 + kstep; const char* b3 = b2 + kstep;
            PG8_LDB(B0, 0, 0); PG8_LDB(B1, 0, 1); PG8_SCHED; PG8_LDA(At, 0, 0); PG8_STAGE(PG8_SA(1, 1), a1 + hstepA, voffA);
            PG8_WAIT_V(8); PG8_WAIT_L(0); PG8_BAR; PG8_MMA(0, 0, At, B0); PG8_MMA(0, 1, At, B1); PG8_BAR; PG8_SCHED;
            PG8_LDA(At, 0, 1); PG8_STAGE(PG8_SB(0, 0), b2, voffB); PG8_STAGE(PG8_SB(0, 1), b2 + hstepB, voffB); PG8_STAGE(PG8_SA(0, 0), a2, voffA);
            PG8_WAIT_V(8); PG8_WAIT_L(0); PG8_BAR; PG8_MMA(1, 0, At, B0); PG8_MMA(1, 1, At, B1); PG8_BAR; PG8_SCHED;
            PG8_LDB(B0, 1, 0); PG8_LDB(B1, 1, 1); PG8_SCHED; PG8_LDA(At, 1, 0); PG8_STAGE(PG8_SA(0, 1), a2 + hstepA, voffA);
            PG8_WAIT_V(8); PG8_WAIT_L(0); PG8_BAR; PG8_MMA(0, 0, At, B0); PG8_MMA(0, 1, At, B1); PG8_BAR; PG8_SCHED;
            PG8_LDA(At, 1, 1); PG8_STAGE(PG8_SB(1, 0), b3, voffB); PG8_STAGE(PG8_SB(1, 1), b3 + hstepB, voffB); PG8_STAGE(PG8_SA(1, 0), a3, voffA);
            PG8_WAIT_V(8); PG8_WAIT_L(0); PG8_BAR; PG8_MMA(1, 0, At, B0); PG8_MMA(1, 1, At, B1); PG8_BAR; PG8_SCHED;
        }
        if constexpr (ALIGN_EPI) { if (wr == 0) PG8_BAR; }
        E(acc, cur, wr, wc, fr, fq);
        if (!has_next) break;
#pragma unroll
        for (int a = 0; a < 2; ++a)
#pragma unroll
            for (int b = 0; b < 2; ++b)
#pragma unroll
                for (int m = 0; m < 4; ++m)
#pragma unroll
                    for (int n = 0; n < 2; ++n) acc[a][b][m][n] = (f32x4){0.f, 0.f, 0.f, 0.f};
        cur = nxt; cA = nA; cB = nB; ++ui;
        if constexpr (DUAL) { cA2 = (const char*)g.A2 + (size_t)cur.pm * tstepA; cB2 = (const char*)g.Bt2 + (size_t)cur.pn * tstepB; }
        if constexpr (ALIGN_EPI) { if (wr == 1) PG8_BAR; }
    }
    PG8_WAIT_V(0);
    if constexpr (!ALIGN_EPI) { if (wr == 0) PG8_BAR; }
    PG8_BAR;
#undef PG8_SA
#undef PG8_SB
#undef PG8_STAGE
#undef PG8_LDA
#undef PG8_LDB
#undef PG8_MMA
#undef PG8_WAIT_V
#undef PG8_WAIT_L
#undef PG8_BAR
#undef PG8_SCHED
}
}
using pg8::Unit;
typedef const f32x4 (&AccRef)[2][2][4][2];

struct EpiIn {
    bf16_t *AK_, *MK_, *AQ_, *MQ_, *MO_, *GA_, *GM_; const float *qnw, *knw, *cosT_, *sinT_; LAS float* sp;
    __device__ __forceinline__ void head_path(AccRef acc, const Unit& u, int wr, int wc, int fr, int fq_in, bf16_t* base, int ld, int coff, const float* nw) const {
        int fq = fq_in; asm volatile("" : "+v"(fq));
        const int row0 = u.pm * 256 + wr * 64 + fr;
        const bool rope = u.pm < 64;
        { int tx = threadIdx.x; asm volatile("" : "+v"(tx)); const int tt0 = (u.pm * 256) & 2047;
          for (int i = tx; i < (rope ? 2512 : 64); i += 512) { float v;
              if (i < 64) v = nw[i];
              else if (i < 208) { const int k = i - 64, gi = k / 36, e = k - gi * 36; const int t = tt0 + 64 * gi; v = e < 16 ? cosT_[t * 32 + e] : e < 32 ? sinT_[t * 32 + e - 16] : 0.f; }
              else { const int k = i - 208, c = k / 36, e = k - c * 36; const int t = tt0 + c; v = e < 16 ? cosT_[t * 32 + 16 + e] : e < 32 ? sinT_[t * 32 + e] : 0.f; }
              sp[i] = v; }
          asm volatile("s_waitcnt vmcnt(0) lgkmcnt(0)" ::: "memory"); __builtin_amdgcn_s_barrier(); asm volatile("" ::: "memory"); }
        const f32x4 w00 = *(const LAS f32x4*)(sp + 8 * fq), w01 = *(const LAS f32x4*)(sp + 8 * fq + 4), w10 = *(const LAS f32x4*)(sp + 32 + 8 * fq), w11 = *(const LAS f32x4*)(sp + 32 + 8 * fq + 4);
#pragma unroll
        for (int ai = 0; ai < 2; ++ai)
#pragma unroll
            for (int m = 0; m < 4; ++m) {
                const int row = row0 + ai * 128 + m * 16;
                f32x4 v00 = acc[ai][0][m][0], v01 = acc[ai][0][m][1], v10 = acc[ai][1][m][0], v11 = acc[ai][1][m][1];
                f32x4 q = v00 * v00 + v01 * v01 + v10 * v10 + v11 * v11;
                float ss = (q[0] + q[1]) + (q[2] + q[3]);
                ss += __shfl_xor(ss, 16); ss += __shfl_xor(ss, 32);
                const float rs = rsqrtf(ss * (1.f / 64.f) + EPS);
                v00 = v00 * rs * w00; v01 = v01 * rs * w01; v10 = v10 * rs * w10; v11 = v11 * rs * w11;
                f32x4 o00 = v00, o01 = v01, o10 = v10, o11 = v11;
                if (rope) {
                    const int r = ai * 128 + wr * 64 + m * 16 + fr;
                    const LAS float* cp = sp + ((fq < 2) ? 64 + (r >> 6) * 36 + 8 * fq : 208 + (r & 63) * 36 + 8 * (fq - 2));
                    const f32x4 c0 = *(const LAS f32x4*)cp, c1 = *(const LAS f32x4*)(cp + 4), s0 = *(const LAS f32x4*)(cp + 16), s1 = *(const LAS f32x4*)(cp + 20);
                    o00 = v00 * c0 - v10 * s0; o01 = v01 * c1 - v11 * s1; o10 = v00 * s0 + v10 * c0; o11 = v01 * s1 + v11 * c1;
                }
                bf16_t* p = base + (size_t)row * ld + coff + wc * 64 + 8 * fq;
                *(u32x4*)p = pack8(o00, o01); *(u32x4*)(p + 32) = pack8(o10, o11);
                asm volatile("" ::: "memory");
            }
    }
    template <bool SIG> __device__ __forceinline__ void plain_path(AccRef acc, const Unit& u, int wr, int wc, int fr, int fq, bf16_t* base, int ld, int coff) const {
        const int row0 = u.pm * 256 + wr * 64 + fr;
#pragma unroll
        for (int ai = 0; ai < 2; ++ai)
#pragma unroll
            for (int m = 0; m < 4; ++m) {
                bf16_t* p = base + (size_t)(row0 + ai * 128 + m * 16) * ld + coff + wc * 32 + 8 * fq;
#pragma unroll
                for (int bj = 0; bj < 2; ++bj) { f32x4 v0 = acc[ai][bj][m][0], v1 = acc[ai][bj][m][1];
                    if (SIG) {
#pragma unroll
                        for (int e = 0; e < 4; ++e) { v0[e] = sigmoid_div(v0[e]); v1[e] = sigmoid_div(v1[e]); } }
                    *(u32x4*)(p + bj * 128) = pack8(v0, v1); }
            }
    }
    __device__ __forceinline__ void operator()(AccRef acc, const Unit& u, int wr, int wc, int fr, int fq) const {
        const int pn = u.pn;
        if (pn == 0) head_path(acc, u, wr, wc, fr, fq, AK_, 256, 0, knw);
        else if (pn <= 2) plain_path<false>(acc, u, wr, wc, fr, fq, MK_, 512, (pn - 1) * 256);
        else if (pn <= 6) head_path(acc, u, wr, wc, fr, fq, AQ_, 1024, (pn - 3) * 256, qnw);
        else if (pn <= 8) plain_path<false>(acc, u, wr, wc, fr, fq, MQ_, 512, (pn - 7) * 256);
        else if (pn <= 12) plain_path<false>(acc, u, wr, wc, fr, fq, MO_, 1024, (pn - 9) * 256);
        else if (pn <= 16) plain_path<true>(acc, u, wr, wc, fr, fq, GA_, 1024, (pn - 13) * 256);
        else plain_path<true>(acc, u, wr, wc, fr, fq, GM_, 1024, (pn - 17) * 256);
    }
};
struct EpiPlain {
    bf16_t* O; int ldc;
    __device__ __forceinline__ void operator()(AccRef acc, const Unit& u, int wr, int wc, int fr, int fq) const {
        const int row0 = u.pm * 256 + wr * 64 + fr;
#pragma unroll
        for (int ai = 0; ai < 2; ++ai)
#pragma unroll
            for (int m = 0; m < 4; ++m) {
                bf16_t* p = O + (size_t)(row0 + ai * 128 + m * 16) * ldc + u.pn * 256 + wc * 32 + 8 * fq;
#pragma unroll
                for (int bj = 0; bj < 2; ++bj) *(u32x4*)(p + bj * 128) = pack8(acc[ai][bj][m][0], acc[ai][bj][m][1]);
            }
    }
};
template <bool ADD> struct EpiGate {
    const bf16_t* Gt; const bf16_t* T; bf16_t* O;
    __device__ __forceinline__ void operator()(AccRef acc, const Unit& u, int wr, int wc, int fr, int fq) const {
        const int row0 = u.pm * 256 + wr * 64 + fr;
        const size_t off0 = (size_t)row0 * 1024 + u.pn * 256 + wc * 32 + 8 * fq;
        u32x4 gv[2][2], tv[2][2];
#pragma unroll
        for (int bj = 0; bj < 2; ++bj) { gv[0][bj] = *(const u32x4*)(Gt + off0 + bj * 128); tv[0][bj] = (u32x4){0u, 0u, 0u, 0u}; if (ADD) tv[0][bj] = *(const u32x4*)(T + off0 + bj * 128); }
#pragma unroll
        for (int it = 0; it < 8; ++it) {
            const int ai = it >> 2, m = it & 3, cur = it & 1, nx = cur ^ 1;
            const size_t off = off0 + (size_t)(ai * 128 + m * 16) * 1024;
            if (it < 7) { const size_t offn = off0 + (size_t)(((it + 1) >> 2) * 128 + ((it + 1) & 3) * 16) * 1024;
#pragma unroll
                for (int bj = 0; bj < 2; ++bj) { gv[nx][bj] = *(const u32x4*)(Gt + offn + bj * 128); tv[nx][bj] = (u32x4){0u, 0u, 0u, 0u}; if (ADD) tv[nx][bj] = *(const u32x4*)(T + offn + bj * 128); } }
#pragma unroll
            for (int bj = 0; bj < 2; ++bj) {
                float r[8];
#pragma unroll
                for (int e = 0; e < 8; ++e) {
                    const unsigned gw = gv[cur][bj][e >> 1], tw = tv[cur][bj][e >> 1];
                    const float gg = (e & 1) ? __uint_as_float(gw & 0xffff0000u) : __uint_as_float(gw << 16);
                    const float tt = (e & 1) ? __uint_as_float(tw & 0xffff0000u) : __uint_as_float(tw << 16);
                    r[e] = tt + sigmoidf_(gg) * acc[ai][bj][m][e >> 2][e & 3];
                }
                u32x4 w; w.x = cvt_pk_bf16(r[0], r[1]); w.y = cvt_pk_bf16(r[2], r[3]); w.z = cvt_pk_bf16(r[4], r[5]); w.w = cvt_pk_bf16(r[6], r[7]);
                *(u32x4*)(O + off + bj * 128) = w;
            }
        }
    }
};
struct EpiMerge {
    const bf16_t* Sa; const bf16_t* Sm; bf16_t* O;
    __device__ __forceinline__ void mid(f32x4 (&acc)[2][2][4][2], const Unit& u, int wr, int wc, int fr, int fq) const {
        const size_t off0 = (size_t)(u.pm * 256 + wr * 64 + fr) * 1024 + u.pn * 256 + wc * 32 + 8 * fq;
        u32x4 av[2][2], mv[2][2];
#pragma unroll
        for (int bj = 0; bj < 2; ++bj) { av[0][bj] = *(const u32x4*)(Sa + off0 + bj * 128); mv[0][bj] = *(const u32x4*)(Sm + off0 + bj * 128); }
#pragma unroll
        for (int it = 0; it < 8; ++it) {
            const int ai = it >> 2, m = it & 3, cur = it & 1, nx = cur ^ 1;
            if (it < 7) { const size_t offn = off0 + (size_t)(((it + 1) >> 2) * 128 + ((it + 1) & 3) * 16) * 1024;
#pragma unroll
                for (int bj = 0; bj < 2; ++bj) { av[nx][bj] = *(const u32x4*)(Sa + offn + bj * 128); mv[nx][bj] = *(const u32x4*)(Sm + offn + bj * 128); } }
#pragma unroll
            for (int bj = 0; bj < 2; ++bj)
#pragma unroll
                for (int e = 0; e < 8; ++e) {
                    const unsigned aw = av[cur][bj][e >> 1], mw = mv[cur][bj][e >> 1];
                    const float sa = (e & 1) ? __uint_as_float(aw & 0xffff0000u) : __uint_as_float(aw << 16);
                    const float sm = (e & 1) ? __uint_as_float(mw & 0xffff0000u) : __uint_as_float(mw << 16);
                    acc[ai][bj][m][e >> 2][e & 3] *= sa * __builtin_amdgcn_rcpf(fmaxf(sm, 1e-30f));
                }
        }
    }
    __device__ __forceinline__ void operator()(AccRef acc, const Unit& u, int wr, int wc, int fr, int fq) const {
        const size_t off0 = (size_t)(u.pm * 256 + wr * 64 + fr) * 1024 + u.pn * 256 + wc * 32 + 8 * fq;
        u32x4 mv[2][2];
#pragma unroll
        for (int bj = 0; bj < 2; ++bj) mv[0][bj] = *(const u32x4*)(Sm + off0 + bj * 128);
#pragma unroll
        for (int it = 0; it < 8; ++it) {
            const int ai = it >> 2, m = it & 3, cur = it & 1, nx = cur ^ 1;
            const size_t off = off0 + (size_t)(ai * 128 + m * 16) * 1024;
            if (it < 7) { const size_t offn = off0 + (size_t)(((it + 1) >> 2) * 128 + ((it + 1) & 3) * 16) * 1024;
#pragma unroll
                for (int bj = 0; bj < 2; ++bj) mv[nx][bj] = *(const u32x4*)(Sm + offn + bj * 128); }
#pragma unroll
            for (int bj = 0; bj < 2; ++bj) { float r[8];
#pragma unroll
                for (int e = 0; e < 8; ++e) { const unsigned mw = mv[cur][bj][e >> 1];
                    const float sm = (e & 1) ? __uint_as_float(mw & 0xffff0000u) : __uint_as_float(mw << 16);
                    r[e] = fmaxf(sm, 1e-30f) * acc[ai][bj][m][e >> 2][e & 3]; }
                u32x4 w; w.x = cvt_pk_bf16(r[0], r[1]); w.y = cvt_pk_bf16(r[2], r[3]); w.z = cvt_pk_bf16(r[4], r[5]); w.w = cvt_pk_bf16(r[6], r[7]);
                *(u32x4*)(O + off + bj * 128) = w; }
        }
    }
};
struct EpiOut {
    const float* x; const float* mod; const float* nw2; float* xmid; bf16_t* AP; float* rowsq;
    __device__ __forceinline__ void operator()(AccRef acc, const Unit& u, int wr, int wc, int fr, int fq) const {
        const int b = u.pm >> 3; const float* mb = mod + b * 6144;
        const int row0 = u.pm * 256 + wr * 64 + fr, col0 = u.pn * 256 + wc * 32 + 8 * fq;
        f32x4 g1[2][2], sw[2][2];
#pragma unroll
        for (int bj = 0; bj < 2; ++bj)
#pragma unroll
            for (int n = 0; n < 2; ++n) { const int c = col0 + bj * 128 + 4 * n; g1[bj][n] = *(const f32x4*)(mb + 2048 + c);
                sw[bj][n] = *(const f32x4*)(nw2 + c) * (*(const f32x4*)(mb + 4096 + c) + 1.f); }
        f32x4 xv[2][2][2];
#pragma unroll
        for (int bj = 0; bj < 2; ++bj)
#pragma unroll
            for (int n = 0; n < 2; ++n) xv[0][bj][n] = *(const f32x4*)(x + (size_t)row0 * 1024 + col0 + bj * 128 + 4 * n);
#pragma unroll
        for (int it = 0; it < 8; ++it) {
            const int ai = it >> 2, m = it & 3, cur = it & 1, nx = cur ^ 1;
            const int row = row0 + ai * 128 + m * 16; const size_t off = (size_t)row * 1024 + col0; float ss = 0.f;
            if (it < 7) { const size_t offn = (size_t)(row0 + ((it + 1) >> 2) * 128 + ((it + 1) & 3) * 16) * 1024 + col0;
#pragma unroll
                for (int bj = 0; bj < 2; ++bj)
#pragma unroll
                    for (int n = 0; n < 2; ++n) xv[nx][bj][n] = *(const f32x4*)(x + offn + bj * 128 + 4 * n); }
#pragma unroll
            for (int bj = 0; bj < 2; ++bj) {
                f32x4 v[2];
#pragma unroll
                for (int n = 0; n < 2; ++n) { v[n] = xv[cur][bj][n] + g1[bj][n] * acc[ai][bj][m][n];
                    const f32x4 q = v[n] * v[n]; ss += (q[0] + q[1]) + (q[2] + q[3]); }
                *(u32x4*)(AP + off + bj * 128) = pack8(v[0] * sw[bj][0], v[1] * sw[bj][1]);
            }
            ss += __shfl_xor(ss, 16); ss += __shfl_xor(ss, 32);
            if (fq == 0) rowsq[(size_t)row * 16 + u.pn * 4 + wc] = ss;
        }
    }
};
__device__ __forceinline__ float dpp_prev(float v) { return __int_as_float(__builtin_amdgcn_update_dpp(0, __float_as_int(v), 0x111, 0xf, 0xf, true)); }
__device__ __forceinline__ float dpp_next(float v) { return __int_as_float(__builtin_amdgcn_update_dpp(0, __float_as_int(v), 0x101, 0xf, 0xf, true)); }
struct EpiUp {
    const float* rowsq; const float* fb; const float* cw; const float* cb; bf16_t* ACT_; bf16_t* RAW_; LAS float* sp;
    __device__ __forceinline__ void operator()(AccRef acc, const Unit& u, int wr, int wc, int fr, int fq) const {
        const int b = u.pm >> 3; const int row0 = u.pm * 256 + wr * 64 + fr;
        int tx = threadIdx.x; asm volatile("" : "+v"(tx));
        if (tx < 256) {
            const float* qp = rowsq + (size_t)(u.pm * 256 + tx) * 16; const f32x4 q0 = *(const f32x4*)qp, q1 = *(const f32x4*)(qp + 4), q2 = *(const f32x4*)(qp + 8), q3 = *(const f32x4*)(qp + 12);
            const f32x4 qs = (q0 + q1) + (q2 + q3); sp[1280 + tx] = rsqrtf(((qs[0] + qs[1]) + (qs[2] + qs[3])) * (1.f / 1024.f) + EPS);
        } else {
            for (int i = tx - 256; i < 1280; i += 256) { const int vec = i >> 7, j = u.pn * 128 + (i & 127);
                const float* src = vec == 0 ? fb + b * NUP + j : vec == 1 ? fb + b * NUP + DFF + j : vec < 5 ? cw + (vec - 2) * NUP + j : vec < 8 ? cw + (vec - 5) * NUP + DFF + j : vec == 8 ? cb + j : cb + DFF + j;
                sp[i] = *src; } }
        asm volatile("s_waitcnt vmcnt(0) lgkmcnt(0)" ::: "memory"); __builtin_amdgcn_s_barrier(); asm volatile("" ::: "memory");
        const LAS float* spc = sp + wc * 32 + 8 * fq;
        const int jb = u.pn * 128 + wc * 32 + 8 * fq;
        const int pcol = u.pn * 256 + wc * 32 + 8 * fq;
        const bool interior = (fr >= 1) && (fr <= 14), rawrow = !((fr >= 2) && (fr <= 13));
        const int slot = fr < 2 ? fr : fr - 12;
#pragma unroll
        for (int ai = 0; ai < 2; ++ai)
#pragma unroll
            for (int m = 0; m < 4; ++m) {
                const int row = row0 + ai * 128 + m * 16; const float rstd = sp[1280 + ai * 128 + wr * 64 + m * 16 + fr];
                float r[8]; f32x4 ua[2], ug[2];
#pragma unroll
                for (int n = 0; n < 2; ++n) {
                    ua[n] = acc[ai][0][m][n] * rstd + *(const LAS f32x4*)(spc + 0 * 128 + 4 * n);
                    ug[n] = acc[ai][1][m][n] * rstd + *(const LAS f32x4*)(spc + 1 * 128 + 4 * n);
                    const f32x4 wa0 = *(const LAS f32x4*)(spc + 2 * 128 + 4 * n), wa1 = *(const LAS f32x4*)(spc + 3 * 128 + 4 * n), wa2 = *(const LAS f32x4*)(spc + 4 * 128 + 4 * n);
                    const f32x4 wg0 = *(const LAS f32x4*)(spc + 5 * 128 + 4 * n), wg1 = *(const LAS f32x4*)(spc + 6 * 128 + 4 * n), wg2 = *(const LAS f32x4*)(spc + 7 * 128 + 4 * n);
                    const f32x4 ba = *(const LAS f32x4*)(spc + 8 * 128 + 4 * n), bg = *(const LAS f32x4*)(spc + 9 * 128 + 4 * n);
#pragma unroll
                    for (int e = 0; e < 4; ++e) {
                        const float av = ba[e] + wa0[e] * dpp_prev(ua[n][e]) + wa1[e] * ua[n][e] + wa2[e] * dpp_next(ua[n][e]);
                        const float gv = bg[e] + wg0[e] * dpp_prev(ug[n][e]) + wg1[e] * ug[n][e] + wg2[e] * dpp_next(ug[n][e]);
                        r[4 * n + e] = gv * sigmoidf_(gv) * av;
                    }
                }
                if (interior) { u32x4 w; w.x = cvt_pk_bf16(r[0], r[1]); w.y = cvt_pk_bf16(r[2], r[3]); w.z = cvt_pk_bf16(r[4], r[5]); w.w = cvt_pk_bf16(r[6], r[7]);
                    *(u32x4*)(ACT_ + (size_t)row * DFF + jb) = w; }
                if (rawrow) { bf16_t* rp = RAW_ + ((size_t)(row >> 4) * 4 + slot) * NUP + pcol;
                    *(u32x4*)rp = pack8(ua[0], ua[1]); *(u32x4*)(rp + 128) = pack8(ug[0], ug[1]); }
                asm volatile("" ::: "memory");
            }
    }
};
struct EpiDown {
    float* out; const float* mod; const bf16_t* AP; const float* nw2;
    __device__ __forceinline__ void operator()(AccRef acc, const Unit& u, int wr, int wc, int fr, int fq) const {
        const int b = u.pm >> 3; const float* mb = mod + b * 6144;
        const int row0 = u.pm * 256 + wr * 64 + fr, col0 = u.pn * 256 + wc * 32 + 8 * fq;
        f32x4 g2[2][2], rsw[2][2];
#pragma unroll
        for (int bj = 0; bj < 2; ++bj)
#pragma unroll
            for (int n = 0; n < 2; ++n) { const int c = col0 + bj * 128 + 4 * n; g2[bj][n] = *(const f32x4*)(mb + 5120 + c);
                const f32x4 sw = *(const f32x4*)(nw2 + c) * (*(const f32x4*)(mb + 4096 + c) + 1.f);
#pragma unroll
                for (int e = 0; e < 4; ++e) rsw[bj][n][e] = 1.f / sw[e]; }
        u32x4 av[2][2];
#pragma unroll
        for (int bj = 0; bj < 2; ++bj) av[0][bj] = *(const u32x4*)(AP + (size_t)row0 * 1024 + col0 + bj * 128);
#pragma unroll
        for (int it = 0; it < 8; ++it) {
            const int ai = it >> 2, m = it & 3, cur = it & 1, nx = cur ^ 1;
            const size_t off = (size_t)(row0 + ai * 128 + m * 16) * 1024 + col0;
            if (it < 7) { const size_t offn = (size_t)(row0 + ((it + 1) >> 2) * 128 + ((it + 1) & 3) * 16) * 1024 + col0;
#pragma unroll
                for (int bj = 0; bj < 2; ++bj) av[nx][bj] = *(const u32x4*)(AP + offn + bj * 128); }
#pragma unroll
            for (int bj = 0; bj < 2; ++bj)
#pragma unroll
                for (int n = 0; n < 2; ++n) { const unsigned w0 = av[cur][bj][2 * n], w1 = av[cur][bj][2 * n + 1];
                    const f32x4 ap = (f32x4){__uint_as_float(w0 << 16), __uint_as_float(w0 & 0xffff0000u), __uint_as_float(w1 << 16), __uint_as_float(w1 & 0xffff0000u)};
                    *(f32x4*)(out + off + bj * 128 + 4 * n) = ap * rsw[bj][n] + g2[bj][n] * acc[ai][bj][m][n]; }
        }
    }
};

__device__ __forceinline__ f32x4 mfma16(bf16x8 a, bf16x8 b, f32x4 c) { return __builtin_amdgcn_mfma_f32_16x16x32_bf16(a, b, c, 0, 0, 0); }

__device__ __forceinline__ void transpose_item(const float* W, int ldw, int col, int k0, bf16_t* WT, int dst_row, int dld, LAS float* scr, int lane) {
#pragma unroll 8
    for (int i = 0; i < 32; ++i) { const int kk = 2 * i + (lane >> 5); scr[kk * 33 + (lane & 31)] = W[(size_t)(k0 + kk) * ldw + col + (lane & 31)]; }
    asm volatile("s_waitcnt lgkmcnt(0)" ::: "memory");
    const int c = lane & 7;
#pragma unroll
    for (int j = 0; j < 4; ++j) { const int n = (lane >> 3) + 8 * j; const LAS float* s = scr + (8 * c) * 33 + n;
        u32x4 o; o.x = cvt_pk_bf16(s[0 * 33], s[1 * 33]); o.y = cvt_pk_bf16(s[2 * 33], s[3 * 33]); o.z = cvt_pk_bf16(s[4 * 33], s[5 * 33]); o.w = cvt_pk_bf16(s[6 * 33], s[7 * 33]);
        *(u32x4*)(WT + (size_t)(dst_row + n) * dld + k0 + 8 * c) = o; }
    asm volatile("s_waitcnt lgkmcnt(0)" ::: "memory");
}
__device__ __forceinline__ int headperm(int n0) { const int tile = n0 >> 8, l = n0 & 255; return tile * 256 + 128 * ((l >> 5) & 1) + 32 * (l >> 6); }

struct Args {
    const float *x, *c, *ctx, *c_ctx, *w_mod, *b_mod, *norm1_w, *w_in, *q_norm_w, *k_norm_w, *attn_sink, *ml_gate_b, *ml_norm_w,
        *w_branch_att, *w_branch_ml, *w_out, *norm2_w, *w_up, *conv_w, *conv_b, *w_down;
    float* out; unsigned char* ws; int ph_lo, ph_hi;
};

template <int NV, int KS, bool ATOMIC> __device__ __forceinline__ void gemv_task(const float* W, int ldw, int n0, int k0, const LAS float* svec, float* out, int ldo) {
    const int n = n0 + threadIdx.x; float a[NV];
#pragma unroll
    for (int v = 0; v < NV; ++v) a[v] = 0.f;
#pragma unroll 16
    for (int k = 0; k < KS; ++k) { const float w = W[(size_t)(k0 + k) * ldw + n];
#pragma unroll
        for (int v = 0; v < NV; ++v) a[v] += svec[v * KS + k] * w; }
#pragma unroll
    for (int v = 0; v < NV; ++v) { if (ATOMIC) atomicAdd(out + (size_t)v * ldo + n, a[v]); else out[(size_t)v * ldo + n] = a[v]; }
}

#define mod   ((float*)(wsb + WS_MOD))
#define modp  ((float*)(wsb + WS_MODP))
#define fbias ((float*)(wsb + WS_FB))
#define rowsq ((float*)(wsb + WS_RSQP))
#define fbp ((float*)(dob + DO_FBP))
#define cosT  ((float*)(wsb + WS_ROPE))
#define sinT  ((float*)(wsb + WS_ROPE) + 2048 * 32)
#define gates ((float*)(wsb + WS_GATES))
#define WBA ((bf16_t*)(wsb + WS_WBA))
#define WBM ((bf16_t*)(wsb + WS_WBM))
#define WO  ((bf16_t*)(wsb + WS_WO))
#define WUP ((bf16_t*)(wsb + WS_WUP))
#define WDN ((bf16_t*)(wsb + WS_WDN))
#define AQ  ((bf16_t*)(wsb + WS_AQ))
#ifdef DBG_ATTO
#define ATTO GA
#else
#define ATTO AQ
#endif
#define MQ  ((bf16_t*)(wsb + WS_MQ))
#define MK  ((bf16_t*)(wsb + WS_MK))
#define MO  ((bf16_t*)(wsb + WS_MO))
#define GA  ((bf16_t*)(wsb + WS_GA))
#define GM  ((bf16_t*)(wsb + WS_GM))
#define XT  ((bf16_t*)(wsb + WS_XT))
#define T1  ((bf16_t*)(wsb + WS_T1))
#define Y   ((bf16_t*)(wsb + WS_Y))
#define U   ((bf16_t*)(wsb + WS_U))
#define HALO ((bf16_t*)(wsb + WS_HALO))
#define ACT ((bf16_t*)(wsb + WS_ACT))
#define RAWU ((bf16_t*)(wsb + WS_RAW))
#define H   ((bf16_t*)(dob + DO_H))
#define W1T ((bf16_t*)(dob + DO_W1T))
#define W2T ((bf16_t*)(dob + DO_W2T))
#define AK  ((bf16_t*)(dob + DO_AK))
#define HF  ((bf16_t*)(dob + DO_HF))
#define HB  ((bf16_t*)(dob + DO_HB))

#define XB_TMO      128
#define XB_XCNT(j)  (256  + 64 * (j))
#define XB_XSUB(j)  (1280 + 64 * (j))
#define XB_XGEN(j)  (2304 + 64 * (j))
#define XB_TOP      3328
#define XB_TOPGEN   3392
#define XCD_BAR_WORDS 3456
#define XB_SPIN_CAP (1u << 18)
__device__ __forceinline__ unsigned xb_ld(unsigned* p)              { return __hip_atomic_load(p, __ATOMIC_RELAXED, __HIP_MEMORY_SCOPE_AGENT); }
__device__ __forceinline__ unsigned xb_add(unsigned* p, unsigned v) { return __hip_atomic_fetch_add(p, v, __ATOMIC_RELAXED, __HIP_MEMORY_SCOPE_AGENT); }
__device__ __forceinline__ unsigned xb_xcc_id() { return (unsigned)__builtin_amdgcn_s_getreg((3 << 11) | 20) & 0xFu; }
#define XB_SPIN(cond, bar) do { unsigned _sp = 0; while (cond) { __builtin_amdgcn_s_sleep(1); \
    if ((++_sp & 255u) == 0u) { if (xb_ld(&(bar)[XB_TMO])) break; if (_sp > XB_SPIN_CAP) { atomicAdd(&(bar)[XB_TMO], 1u); break; } } } } while (0)
struct XcdBarrier { unsigned* bar; unsigned x; volatile LAS unsigned* st; };
__device__ __forceinline__ XcdBarrier xcd_barrier_post(unsigned* bar, volatile LAS unsigned* st) {
    XcdBarrier b; b.bar = bar; b.x = xb_xcc_id(); b.st = st;
    if (threadIdx.x == 0) (void)xb_add(&bar[XB_XCNT(b.x)], 1u);
    return b;
}
__device__ __forceinline__ void xcd_barrier_complete(unsigned* bar, unsigned x, unsigned& nloc, unsigned& nx) {
    const unsigned G = gridDim.x * gridDim.y * gridDim.z;
    unsigned sum, cnt, mine, sp = 0u;
    for (;;) {
        sum = 0u; cnt = 0u; mine = 0u;
#pragma unroll
        for (unsigned j = 0; j < 16; ++j) { const unsigned c = xb_ld(&bar[XB_XCNT(j)]); sum += c; cnt += (c > 0u) ? 1u : 0u; mine = (j == x) ? c : mine; }
        if (sum == G) break;
        __builtin_amdgcn_s_sleep(1);
        if ((++sp & 255u) == 0u) { if (xb_ld(&bar[XB_TMO])) break; if (sp > XB_SPIN_CAP) { atomicAdd(&bar[XB_TMO], 1u); break; } }
    }
    nloc = mine > 0u ? mine : 1u; nx = cnt > 0u ? cnt : 1u;
}
__device__ __forceinline__ void xcd_barrier(const XcdBarrier& b) {
    asm volatile("s_waitcnt vmcnt(0)" ::: "memory");
    __syncthreads();
    if (threadIdx.x == 0) {
        unsigned* bar = b.bar;
        __builtin_amdgcn_s_waitcnt(0);
        unsigned nloc = b.st[0], nx = b.st[1];
        if (nloc == 0u) { xcd_barrier_complete(bar, b.x, nloc, nx); b.st[0] = nloc; b.st[1] = nx; }
        const unsigned old = xb_add(&bar[XB_XSUB(b.x)], 1u);
        const unsigned gen = old / nloc;
        if (old + 1u == (gen + 1u) * nloc) {
            __builtin_amdgcn_fence(__ATOMIC_RELEASE, "agent");
            asm volatile("s_waitcnt vmcnt(0)" ::: "memory");
            const unsigned og = xb_add(&bar[XB_TOP], 1u);
            const unsigned tg = og / nx;
            if (og + 1u == (tg + 1u) * nx) xb_add(&bar[XB_TOPGEN], 1u);
            else XB_SPIN(xb_ld(&bar[XB_TOPGEN]) == tg, bar);
            __builtin_amdgcn_fence(__ATOMIC_ACQUIRE, "agent");
            xb_add(&bar[XB_XGEN(b.x)], 1u);
            asm volatile("s_waitcnt vmcnt(0)" ::: "memory");
        } else {
            XB_SPIN(xb_ld(&bar[XB_XGEN(b.x)]) == gen, bar);
            __builtin_amdgcn_fence(__ATOMIC_ACQUIRE, "agent");
            asm volatile("s_waitcnt vmcnt(0)" ::: "memory");
        }
    }
    __syncthreads();
}
constexpr size_t WS_BAR = 253 * MiB;
constexpr int LDS_ST_OFF = LDS_BYTES - 16;
#define A (*(const volatile __attribute__((address_space(4))) Args*)__builtin_amdgcn_kernarg_segment_ptr())
__global__ void __launch_bounds__(512, 2) fwd_kernel(Args Aparam) {
    extern __shared__ __attribute__((aligned(16))) unsigned char lds_raw[];
    LAS unsigned char* lds = (LAS unsigned char*)lds_raw;
    const int tid = threadIdx.x, lane = tid & 63, wave = __builtin_amdgcn_readfirstlane(tid >> 6);
    const int G = gridDim.x, bx = blockIdx.x;
    const int gw = bx * 8 + wave, NGW = G * 8;
    const int lo = A.ph_lo, hi = A.ph_hi; (void)lo; (void)hi;
#ifndef PHMASK
#define PHMASK 0x1fff
#endif
#if ONE_LAUNCH
#define IN(k) (((PHMASK >> (k)) & 1) && (k) < 11)
#else
#define IN(k) (((PHMASK >> (k)) & 1) && lo <= (k) && (k) < hi)
#endif
#if ONE_LAUNCH
    XcdBarrier xbar; xbar.bar = nullptr; xbar.x = 0; xbar.st = (volatile LAS unsigned*)(lds + LDS_ST_OFF);
#define SEAM(k) do { xcd_barrier(xbar); } while (0)
    {
        unsigned* const barw = (unsigned*)(A.ws + WS_BAR);
        if (tid < 4) ((LAS unsigned*)(lds + LDS_ST_OFF))[tid] = 0u;
        if (bx == 0) for (int i = tid; i < XCD_BAR_WORDS; i += 512) barw[i] = 0u;
        cg::this_grid().sync();
        xbar = xcd_barrier_post(barw, (volatile LAS unsigned*)(lds + LDS_ST_OFF));
    }
#else
#define SEAM(k) do { } while (0)
#endif

    for (int rep_ = 0; rep_ < (((RPT_MASK >> 0) & 1) ? 2 : 1); ++rep_) { if (rep_) { if (0 == 0) cg::this_grid().sync(); else xcd_barrier(xbar); }
    if (IN(0)) {
        unsigned char* const wsb = A.ws; unsigned char* const dob = (unsigned char*)A.out; (void)wsb; (void)dob;
        LAS float* svec = (LAS float*)(lds + 131072);
        for (int task = bx; task < 192; task += G) {
            const int cb = task % 12, ks = task / 12, k0 = ks * 64;
            __syncthreads();
            for (int i = tid; i < 576; i += 512) { const int v = i >> 6, k = i & 63; const float cv = v < 8 ? A.c[v * 1024 + k0 + k] : A.c_ctx[k0 + k]; svec[i] = cv / (1.f + __expf(-cv)); }
            __syncthreads();
            gemv_task<9, 64, false>(A.w_mod, 6144, cb * 512, k0, svec, modp + (size_t)ks * 9 * 6144, 6144);
        }
        LAS float* scr = (LAS float*)(lds + wave * 16384);
        constexpr int NITEMS = 9088;
        for (int it = gw; it < NITEMS; it += NGW) {
            int r = it; const float* W; int ldw, col0, ncols, K; bf16_t* dst; int hp = 0;
            if (r < 512) { W = A.w_in; ldw = INW; col0 = 0; ncols = 1024; K = 1024; dst = W1T + (size_t)3 * 256 * 1024; hp = 1; }
            else if ((r -= 512) < 128) { W = A.w_in; ldw = INW; col0 = 1024; ncols = 256; K = 1024; dst = W1T; hp = 1; }
            else if ((r -= 128) < 128) { W = A.w_in; ldw = INW; col0 = 1280; ncols = 256; K = 1024; dst = W2T; }
            else if ((r -= 128) < 256) { W = A.w_in; ldw = INW; col0 = 1536; ncols = 512; K = 1024; dst = W1T + (size_t)7 * 256 * 1024; }
            else if ((r -= 256) < 256) { W = A.w_in; ldw = INW; col0 = 2048; ncols = 512; K = 1024; dst = W1T + (size_t)1 * 256 * 1024; }
            else if ((r -= 256) < 512) { W = A.w_in; ldw = INW; col0 = 2560; ncols = 1024; K = 1024; dst = W2T + (size_t)256 * 1024; }
            else if ((r -= 512) < 512) { W = A.w_in; ldw = INW; col0 = 3584; ncols = 1024; K = 1024; dst = W1T + (size_t)9 * 256 * 1024; }
            else if ((r -= 512) < 512) { W = A.w_in; ldw = INW; col0 = 4624; ncols = 1024; K = 1024; dst = W1T + (size_t)13 * 256 * 1024; }
            else if ((r -= 512) < 512) { W = A.w_in; ldw = INW; col0 = 5648; ncols = 1024; K = 1024; dst = W1T + (size_t)17 * 256 * 1024; }
            else if ((r -= 512) < 512) { W = A.w_branch_att; ldw = 1024; col0 = 0; ncols = 1024; K = 1024; dst = WBA; }
            else if ((r -= 512) < 512) { W = A.w_branch_ml; ldw = 1024; col0 = 0; ncols = 1024; K = 1024; dst = WBM; }
            else if ((r -= 512) < 512) { W = A.w_out; ldw = 1024; col0 = 0; ncols = 1024; K = 1024; dst = WO; }
            else if ((r -= 512) < 2816) { W = A.w_up; ldw = NUP; col0 = 0; ncols = NUP; K = 1024; dst = WUP; }
            else { r -= 2816; W = A.w_down; ldw = 1024; col0 = 0; ncols = 1024; K = DFF; dst = WDN; }
            const int nblk = ncols / 32, kb = r / nblk, nb = r % nblk, n0 = nb * 32;
            int drow = hp ? headperm(n0) : n0;
            if (W == A.w_up) drow = (n0 < DFF) ? 256 * (n0 >> 7) + (n0 & 127) : 256 * ((n0 - DFF) >> 7) + 128 + ((n0 - DFF) & 127);
            transpose_item(W, ldw, col0 + n0, kb * 64, dst, drow, K, scr, lane);
        }
        for (int i = bx * 512 + tid; i < 2048 * 32; i += G * 512) {
            const int t = i >> 5, j = i & 31; const float pos = (j < 16) ? (float)(t >> 6) : (float)(t & 63);
            const float invf = exp2f(-(float)(j & 15) * (13.287712379549449f / 16.f)); const float ang = pos * invf;
            cosT[i] = cosf(ang); sinT[i] = sinf(ang);
        }
    }
    }
    SEAM(0);

    for (int rep_ = 0; rep_ < (((RPT_MASK >> 1) & 1) ? 2 : 1); ++rep_) { if (rep_) { if (1 == 0) cg::this_grid().sync(); else xcd_barrier(xbar); }
    if (IN(1)) {
        unsigned char* const wsb = A.ws; unsigned char* const dob = (unsigned char*)A.out; (void)wsb; (void)dob;
        constexpr int GP = 1028;
        LAS float* sWg = (LAS float*)lds;
        LAS float* hT = (LAS float*)(lds + 65792);
        LAS float* svm = (LAS float*)(lds + 131584);
        LAS float* part = (LAS float*)(lds + 147968);
        LAS float* svec = part;
        for (int k = tid; k < 1024; k += 512) { const float* src = A.w_in + (size_t)k * INW + 4608;
#pragma unroll
            for (int q = 0; q < 4; ++q) { const f32x4 v = *(const f32x4*)(src + 4 * q); sWg[(4 * q + 0) * GP + k] = v[0]; sWg[(4 * q + 1) * GP + k] = v[1]; sWg[(4 * q + 2) * GP + k] = v[2]; sWg[(4 * q + 3) * GP + k] = v[3]; } }
        const int rpb = (MT + G - 1) / G, rbeg = bx * rpb, rend = (rbeg + rpb < MT) ? rbeg + rpb : MT;
        const int vlo = rbeg < ML ? (rbeg >> 11) : 8;
        for (int i = tid; i < 4096; i += 512) { const int slot = i >> 11, k = i & 2047; int v = vlo + slot; if (v > 8) v = 8; float a = A.b_mod[k];
#pragma unroll
            for (int ks = 0; ks < 16; ++ks) a += modp[((size_t)ks * 9 + v) * 6144 + k];
            svm[i] = a; }
        for (int i = bx * 512 + tid; i < 9 * 6144; i += G * 512) { float a = A.b_mod[i % 6144];
#pragma unroll
            for (int ks = 0; ks < 16; ++ks) a += modp[(size_t)ks * 9 * 6144 + i];
            mod[i] = a; }
        __syncthreads();
        {
            const float* xin = A.x; const float* cin = A.ctx; const float* n1w = A.norm1_w; const float* gbias = A.ml_gate_b;
            const int r16 = lane & 15, quad = lane >> 4;
            const int ntile = (rend - rbeg + 15) >> 4;
            f32x4 xn[2][4];
#pragma unroll
            for (int t = 0; t < 2; ++t) { const int row = rbeg + wave + 8 * t; if (row < rend) { const float* xr = row < ML ? xin + (size_t)row * 1024 : cin + (size_t)(row - ML) * 1024;
#pragma unroll
                for (int j = 0; j < 4; ++j) xn[t][j] = *(const f32x4*)(xr + 4 * lane + 256 * j); } }
            for (int tile = 0; tile < ntile; ++tile) {
                const int trow = rbeg + 16 * tile;
#pragma unroll
                for (int t = 0; t < 2; ++t) {
                    const int r = wave + 8 * t, row = trow + r;
                    f32x4 hv[4]; float ss = 0.f;
#pragma unroll
                    for (int j = 0; j < 4; ++j) { hv[j] = xn[t][j]; const f32x4 q = hv[j] * hv[j]; ss += (q[0] + q[1]) + (q[2] + q[3]); }
                    { const int rn = row + 16; if (rn < rend) { const float* xr = rn < ML ? xin + (size_t)rn * 1024 : cin + (size_t)(rn - ML) * 1024;
#pragma unroll
                        for (int j = 0; j < 4; ++j) xn[t][j] = *(const f32x4*)(xr + 4 * lane + 256 * j); } }
                    if (row < rend) {
                        const int v = row < ML ? (row >> 11) : 8;
                        const LAS float* sh = svm + (v - vlo) * 2048; const LAS float* sc = sh + 1024;
                        const float rstd = rsqrtf(wave_sum(ss) * (1.f / 1024.f) + EPS);
                        bf16_t* ho = H + (size_t)row * 1024;
#pragma unroll
                        for (int j = 0; j < 4; ++j) { const int k = 4 * lane + 256 * j;
                            hv[j] = hv[j] * rstd * (*(const f32x4*)(n1w + k)) * (*(const LAS f32x4*)(sc + k) + 1.f) + *(const LAS f32x4*)(sh + k);
                            u32x2 w; w.x = cvt_pk_bf16(hv[j][0], hv[j][1]); w.y = cvt_pk_bf16(hv[j][2], hv[j][3]); *(u32x2*)(ho + k) = w;
                            *(LAS f32x4*)(hT + r * GP + k) = hv[j]; }
                    }
                }
                __syncthreads();
                { f32x4 acc = (f32x4){0.f, 0.f, 0.f, 0.f};
#pragma unroll
                  for (int kk = 0; kk < 8; ++kk) { const f32x4 a4 = *(const LAS f32x4*)(hT + r16 * GP + wave * 128 + kk * 16 + quad * 4), b4 = *(const LAS f32x4*)(sWg + r16 * GP + wave * 128 + kk * 16 + quad * 4);
#pragma unroll
                    for (int i = 0; i < 4; ++i) acc = __builtin_amdgcn_mfma_f32_16x16x4f32(a4[i], b4[i], acc, 0, 0, 0); }
#pragma unroll
                  for (int j = 0; j < 4; ++j) part[wave * 256 + (quad * 4 + j) * 16 + r16] = acc[j]; }
                __syncthreads();
                if (tid < 256) { const int r = tid >> 4, gidx = tid & 15, row = trow + r; float gv = gbias[gidx];
#pragma unroll
                    for (int w = 0; w < 8; ++w) gv += part[w * 256 + tid];
                    if (gidx & 4) gv = fminf(gv, 0.f) - log1pf(expf(-fabsf(gv)));
                    if (row < rend) gates[(size_t)row * 16 + gidx] = gv; }
            }
        }
        for (int task = bx; task < 176; task += G) {
            const int cb = task % 11, ks = task / 11, k0 = ks * 64;
            __syncthreads();
            { const int v = tid >> 6, k = 3072 + k0 + (tid & 63); float a = A.b_mod[k];
#pragma unroll
                for (int q = 0; q < 16; ++q) a += modp[((size_t)q * 9 + v) * 6144 + k];
                svec[tid] = a; }
            __syncthreads();
            gemv_task<8, 64, false>(A.w_up, NUP, cb * 512, k0, svec, fbp + (size_t)ks * 8 * NUP, NUP);
        }
    }
    }
    SEAM(1);

    for (int rep_ = 0; rep_ < (((RPT_MASK >> 2) & 1) ? 2 : 1); ++rep_) { if (rep_) { if (2 == 0) cg::this_grid().sync(); else xcd_barrier(xbar); }
    if (IN(2)) {
        unsigned char* const wsb = A.ws; unsigned char* const dob = (unsigned char*)A.out; (void)wsb; (void)dob;
        { pg8::Gemm g{H, W1T, 1024, 1024, 1024}; pg8::Order S; S.init(64, 21, G, bx, 24);
          EpiIn E{AK, MK, AQ, MQ, MO, GA, GM, A.q_norm_w, A.k_norm_w, cosT, sinT, (LAS float*)(lds + 131072)};
          pg8::gemm_phase<EpiIn, pg8::Order, true>(lds, g, S, E); }
        { pg8::Gemm g{W2T, H, 1024, 1024, 1024}; pg8::Order S; S.init(5, 72, G, (bx + G - (1368 % G)) % G, 0);
          EpiPlain E{XT, MT};
          pg8::gemm_phase<EpiPlain, pg8::Order, true>(lds, g, S, E); }
    }
    }
    SEAM(2);

    if (IN(3)) {
        unsigned char* const wsb = A.ws; unsigned char* const dob = (unsigned char*)A.out; (void)wsb; (void)dob;
        for (int i = bx * 512 + tid; i < 8 * NUP; i += G * 512) { float a = 0.f;
#pragma unroll
            for (int ks = 0; ks < 16; ++ks) a += fbp[(size_t)ks * 8 * NUP + i];
            fbias[i] = a; }
        const int r16 = lane & 15, quad = lane >> 4;
        const int rt = wave & 3, hp = wave >> 2;
        LAS bf16_t* sK = (LAS bf16_t*)lds;
        LAS bf16_t* sVT = sK + 64 * 72;
        bf16x8 qn[2][2];
#define AT_QLOAD(un_) do { const int qb_ = (un_) & 31, kvh_ = ((un_) >> 5) & 3, b_ = (un_) >> 7; \
            _Pragma("unroll") for (int g = 0; g < 2; ++g) _Pragma("unroll") for (int ks = 0; ks < 2; ++ks) \
                qn[g][ks] = *(const bf16x8*)(AQ + (size_t)(b_ * SEQ + qb_ * 64 + rt * 16 + r16) * 1024 + (kvh_ * 4 + hp * 2 + g) * 64 + ks * 32 + quad * 8); } while (0)
        if (bx < 1024) AT_QLOAD(bx);
        for (int unit = bx; unit < 1024; unit += G) {
            const int qb = unit & 31, kvh = (unit >> 5) & 3, b = unit >> 7;
            const int rowbase = b * SEQ, t0 = qb * 64;
            bf16x8 qf[2][2];
#pragma unroll
            for (int g = 0; g < 2; ++g)
#pragma unroll
                for (int ks = 0; ks < 2; ++ks) qf[g][ks] = qn[g][ks];
            if (unit + G < 1024) AT_QLOAD(unit + G);
            f32x4 o[2][4]; float mrow[2], lrow[2];
#pragma unroll
            for (int g = 0; g < 2; ++g) { mrow[g] = A.attn_sink[kvh * 4 + hp * 2 + g]; lrow[g] = 1.f;
#pragma unroll
                for (int dt = 0; dt < 4; ++dt) o[g][dt] = (f32x4){0.f, 0.f, 0.f, 0.f}; }
            const int kb_lo = (qb < 2) ? 2 - qb : 0, kb_hi = (qb > 29) ? 33 - qb : 4;
            const bf16_t* const ak_ = AK; const bf16_t* const xt_ = XT; const int lr = tid >> 3, lc = tid & 7;
#define AT_KROW0(kb_) (((kb_) < 5) ? rowbase + (qb + (kb_) - 2) * 64 : ML + b * CTX + ((kb_) - 5) * 64)
            u32x4 pk, pv;
            { const int kr = AT_KROW0(kb_lo); pk = *(const u32x4*)(ak_ + (size_t)(kr + lr) * 256 + kvh * 64 + lc * 8); pv = *(const u32x4*)(xt_ + (size_t)(kvh * 64 + lr) * MT + kr + lc * 8); }
            for (int kb = kb_lo; kb < 9; kb = (kb == kb_hi) ? 5 : kb + 1) {
                const int mtype = (kb == 0) ? 1 : (kb == 4) ? 2 : 0;
                const int mlo = (mtype == 1) ? 0 : -4096, mhi = (mtype == 2) ? 0 : 4096, dl = quad * 4 - rt * 16 - r16;
                __syncthreads();
                *(LAS u32x4*)(sK + lr * 72 + lc * 8) = pk; *(LAS u32x4*)(sVT + lr * 72 + lc * 8) = pv;
                { const int kn = (kb == kb_hi) ? 5 : kb + 1;
                  if (kn < 9) { const int kr = AT_KROW0(kn); pk = *(const u32x4*)(ak_ + (size_t)(kr + lr) * 256 + kvh * 64 + lc * 8); pv = *(const u32x4*)(xt_ + (size_t)(kvh * 64 + lr) * MT + kr + lc * 8); } }
                __syncthreads();
                bf16x8 kf[4][2], vf[2][4];
#pragma unroll
                for (int tile = 0; tile < 4; ++tile)
#pragma unroll
                    for (int ks = 0; ks < 2; ++ks) kf[tile][ks] = *(const LAS bf16x8*)(sK + (tile * 16 + r16) * 72 + ks * 32 + quad * 8);
#pragma unroll
                for (int ks = 0; ks < 2; ++ks)
#pragma unroll
                    for (int dt = 0; dt < 4; ++dt) { const u32x2 lo = *(const LAS u32x2*)(sVT + (dt * 16 + r16) * 72 + ks * 32 + quad * 4), hi = *(const LAS u32x2*)(sVT + (dt * 16 + r16) * 72 + ks * 32 + 16 + quad * 4);
                        const u32x4 w = (u32x4){lo.x, lo.y, hi.x, hi.y}; vf[ks][dt] = __builtin_bit_cast(bf16x8, w); }
#pragma unroll
                for (int g = 0; g < 2; ++g) {
                    f32x4 s[4];
#pragma unroll
                    for (int tile = 0; tile < 4; ++tile) { s[tile] = (f32x4){0.f, 0.f, 0.f, 0.f};
#pragma unroll
                        for (int ks = 0; ks < 2; ++ks) s[tile] = mfma16(kf[tile][ks], qf[g][ks], s[tile]); }
                    float mx = -1e30f;
#pragma unroll
                    for (int tile = 0; tile < 4; ++tile)
#pragma unroll
                        for (int j = 0; j < 4; ++j) { const int dd = dl + (tile * 16 + j);
                            const int bad = ((dd - mlo) | (mhi - dd)) >> 31;
                            const float v = s[tile][j] * 0.125f + __int_as_float(bad & (int)0xF149F2CAu); s[tile][j] = v; mx = fmaxf(mx, v); }
                    mx = fmaxf(mx, __shfl_xor(mx, 16)); mx = fmaxf(mx, __shfl_xor(mx, 32));
                    const float mn = fmaxf(mrow[g], mx), alpha = __expf(mrow[g] - mn); mrow[g] = mn; float rs = 0.f;
                    unsigned pw[4][2];
#pragma unroll
                    for (int tile = 0; tile < 4; ++tile) { f32x4 pe;
#pragma unroll
                        for (int j = 0; j < 4; ++j) { pe[j] = __expf(s[tile][j] - mn); rs += pe[j]; }
                        pw[tile][0] = cvt_pk_bf16(pe[0], pe[1]); pw[tile][1] = cvt_pk_bf16(pe[2], pe[3]); }
                    rs += __shfl_xor(rs, 16); rs += __shfl_xor(rs, 32);
                    lrow[g] = lrow[g] * alpha + rs;
#pragma unroll
                    for (int dt = 0; dt < 4; ++dt) o[g][dt] = o[g][dt] * alpha;
#pragma unroll
                    for (int ks = 0; ks < 2; ++ks) { const u32x4 w = (u32x4){pw[2 * ks][0], pw[2 * ks][1], pw[2 * ks + 1][0], pw[2 * ks + 1][1]}; const bf16x8 pf = __builtin_bit_cast(bf16x8, w);
#pragma unroll
                        for (int dt = 0; dt < 4; ++dt) o[g][dt] = mfma16(vf[ks][dt], pf, o[g][dt]); }
                }
            }
#pragma unroll
            for (int g = 0; g < 2; ++g) { const float inv = 1.f / lrow[g];
                bf16_t* p = ATTO + (size_t)(rowbase + t0 + rt * 16 + r16) * 1024 + (kvh * 4 + hp * 2 + g) * 64 + quad * 4;
#pragma unroll
                for (int dt = 0; dt < 4; ++dt) { u32x2 w; w.x = cvt_pk_bf16(o[g][dt][0] * inv, o[g][dt][1] * inv); w.y = cvt_pk_bf16(o[g][dt][2] * inv, o[g][dt][3] * inv); *(u32x2*)(p + dt * 16) = w; } }
        }
    }
    SEAM(3);

    for (int rep_ = 0; rep_ < (((RPT_MASK >> 4) & 1) ? 2 : 1); ++rep_) { if (rep_) { if (4 == 0) cg::this_grid().sync(); else xcd_barrier(xbar); }
    if (IN(4)) {
        unsigned char* const wsb = A.ws; unsigned char* const dob = (unsigned char*)A.out; (void)wsb; (void)dob;
        const int r16 = lane & 15, quad = lane >> 4;
        LAS bf16_t* sK = (LAS bf16_t*)lds;
        LAS bf16_t* sVT = sK + 128 * 136;
        LAS bf16_t* sS = sVT + 64 * 136;
        LAS bf16_t* sC = sS + 128 * 136;
        LAS float* sgall = (LAS float*)(sC + 80 * 136);
        const float scale = 0.08838834764831845f;
        for (int task = bx; task < 256; task += G) {
            const int vq = task & 3, dir = (task >> 2) & 1, hh = (task >> 3) & 3, b = task >> 5;
            __syncthreads();
            for (int i = tid; i < 80 * 136 / 2; i += 512) ((LAS unsigned*)sC)[i] = 0u;
            for (int st = wave; st < 18; st += 8) {
                const int t0g = ((st < 2) ? (ML + b * CTX + (dir ? 1 - st : st) * 128) : (b * SEQ + (dir ? 15 - (st - 2) : st - 2) * 128));
                const float* gp = gates + (size_t)(t0g + 2 * lane) * 16 + dir * 8 + hh;
                const float i0 = gp[0], f0 = gp[4], i1 = gp[16], f1 = gp[20];
                const float loc = f0 + f1; float v = loc;
#pragma unroll
                for (int off = 1; off < 64; off <<= 1) { const float t = __shfl_up(v, off); if (lane >= off) v += t; }
                const float total = __shfl(v, 63); const float p0 = v - loc + f0, p1 = p0 + f1;
                const float b0 = dir ? total - p0 + f0 : p0, b1 = dir ? total - p1 + f1 : p1;
                const float cmid = 0.5f * total; LAS float* g = sgall + st * 576;
                g[2 * lane] = __expf(fminf(b0 - cmid, 80.f)); g[2 * lane + 1] = __expf(fminf(b1 - cmid, 80.f));
                g[128 + 2 * lane] = __expf(fminf(i0 - b0 + cmid, 80.f)) * scale; g[128 + 2 * lane + 1] = __expf(fminf(i1 - b1 + cmid, 80.f)) * scale;
                g[256 + 2 * lane] = __expf(fminf(total - b0 + i0, 80.f)) * scale; g[256 + 2 * lane + 1] = __expf(fminf(total - b1 + i1, 80.f)) * scale;
                g[384 + 2 * lane] = __expf(b0); g[384 + 2 * lane + 1] = __expf(b1); if (lane == 0) g[512] = __expf(total);
            }
            f32x4 cacc[4], nacc = (f32x4){0.f, 0.f, 0.f, 0.f};
#pragma unroll
            for (int vt = 0; vt < 4; ++vt) cacc[vt] = (f32x4){0.f, 0.f, 0.f, 0.f};
            bf16_t* Hout = (bf16_t*)(dob + (dir ? DO_HB : DO_HF)); const int sgn = dir ? 1 : -1;
            const bf16_t* const mk_ = MK; const bf16_t* const xt_ = XT; const bf16_t* const mq_ = MQ;
            u32x4 pK[4], pVT[2]; bf16x8 pQ[4];
#define ML_TOK0(st) (((st) < 2) ? (ML + b * CTX + (dir ? 1 - (st) : (st)) * 128) : (b * SEQ + (dir ? 15 - ((st) - 2) : (st) - 2) * 128))
#define ML_PREFETCH(st) do { const int t0_ = ML_TOK0(st); \
                _Pragma("unroll") for (int q_ = 0; q_ < 4; ++q_) { const int i_ = tid + q_ * 512, r_ = i_ >> 4, c_ = i_ & 15; pK[q_] = *(const u32x4*)(mk_ + (size_t)(t0_ + r_) * 512 + hh * 128 + c_ * 8); } \
                if ((st) >= 2) { _Pragma("unroll") for (int ks_ = 0; ks_ < 4; ++ks_) pQ[ks_] = *(const bf16x8*)(mq_ + (size_t)(t0_ + wave * 16 + r16) * 512 + hh * 128 + ks_ * 32 + quad * 8); } \
                _Pragma("unroll") for (int q_ = 0; q_ < 2; ++q_) { const int i_ = tid + q_ * 512, r_ = i_ >> 4, c_ = i_ & 15; pVT[q_] = *(const u32x4*)(xt_ + (size_t)(256 + hh * 256 + vq * 64 + r_) * MT + t0_ + c_ * 8); } \
                } while (0)
            ML_PREFETCH(0);
            for (int step = 0; step < 18; ++step) {
                const bool isctx = step < 2; const int tok0 = ML_TOK0(step);
                const LAS float* sgb = sgall + step * 576; const LAS float *sga = sgb + 128, *sgw = sgb + 256, *sge = sgb + 384, *sgF = sgb + 512;
                __syncthreads();
#pragma unroll
                for (int q = 0; q < 4; ++q) { const int i = tid + q * 512, r = i >> 4, c = i & 15; *(LAS u32x4*)(sK + r * 136 + c * 8) = pK[q]; }
#pragma unroll
                for (int q = 0; q < 2; ++q) { const int i = tid + q * 512, r = i >> 4, c = i & 15; *(LAS u32x4*)(sVT + r * 136 + c * 8) = pVT[q]; }
                bf16x8 qf[4];
#pragma unroll
                for (int ks = 0; ks < 4; ++ks) qf[ks] = pQ[ks];
                if (step + 1 < 18) ML_PREFETCH(step + 1);
                __syncthreads();
                if (!isctx) {
                    const int prow = wave * 16 + r16;
                    f32x4 s[8];
#pragma unroll
                    for (int tile = 0; tile < 8; ++tile) { s[tile] = (f32x4){0.f, 0.f, 0.f, 0.f};
#pragma unroll
                        for (int ks = 0; ks < 4; ++ks) { const bf16x8 kf = *(const LAS bf16x8*)(sK + (tile * 16 + r16) * 136 + ks * 32 + quad * 8); s[tile] = mfma16(kf, qf[ks], s[tile]); } }
                    const float bp = sgb[prow]; float rs = 0.f;
#pragma unroll
                    for (int tile = 0; tile < 8; ++tile) { const f32x4 av = *(const LAS f32x4*)(sga + tile * 16 + quad * 4); f32x4 pe;
#pragma unroll
                        for (int j = 0; j < 4; ++j) { const int dd = (tile * 16 + quad * 4 + j - prow) * sgn;
                            pe[j] = __int_as_float(__float_as_int(s[tile][j] * (bp * av[j])) & ~(dd >> 31)); rs += pe[j]; }
                        u32x2 w; w.x = cvt_pk_bf16(pe[0], pe[1]); w.y = cvt_pk_bf16(pe[2], pe[3]);
                        *(LAS u32x2*)(sS + prow * 136 + tile * 16 + quad * 4) = w; }
                    rs += __shfl_xor(rs, 16); rs += __shfl_xor(rs, 32);
                    asm volatile("s_waitcnt lgkmcnt(0)" ::: "memory");
                    f32x4 a1[4], a2[5];
#pragma unroll
                    for (int vt = 0; vt < 4; ++vt) a1[vt] = (f32x4){0.f, 0.f, 0.f, 0.f};
#pragma unroll
                    for (int vt = 0; vt < 5; ++vt) a2[vt] = (f32x4){0.f, 0.f, 0.f, 0.f};
#pragma unroll
                    for (int ks = 0; ks < 4; ++ks) { const bf16x8 af = *(const LAS bf16x8*)(sS + prow * 136 + ks * 32 + quad * 8);
#pragma unroll
                        for (int vt = 0; vt < 4; ++vt) { const bf16x8 vf = *(const LAS bf16x8*)(sVT + (vt * 16 + r16) * 136 + ks * 32 + quad * 8); a1[vt] = mfma16(vf, af, a1[vt]); } }
#pragma unroll
                    for (int ks = 0; ks < 4; ++ks)
#pragma unroll
                        for (int vt = 0; vt < 5; ++vt) { const bf16x8 cf = *(const LAS bf16x8*)(sC + (vt * 16 + r16) * 136 + ks * 32 + quad * 8); a2[vt] = mfma16(cf, qf[ks], a2[vt]); }
                    const float e = sge[prow];
                    const float qn = __shfl(a2[4][0], r16); const float nq = rs + e * qn; const float inv = 1.f / fmaxf(fabsf(nq), 1.f);
                    bf16_t* hp = Hout + (size_t)(tok0 + prow) * 1024 + hh * 256 + vq * 64 + quad * 4;
#pragma unroll
                    for (int vt = 0; vt < 4; ++vt) { u32x2 w; w.x = cvt_pk_bf16((a1[vt][0] + e * a2[vt][0]) * inv, (a1[vt][1] + e * a2[vt][1]) * inv);
                        w.y = cvt_pk_bf16((a1[vt][2] + e * a2[vt][2]) * inv, (a1[vt][3] + e * a2[vt][3]) * inv); *(u32x2*)(hp + vt * 16) = w; }
                }
                __syncthreads();
                {
                    const float F = sgF[0];
#pragma unroll
                    for (int vt = 0; vt < 4; ++vt) cacc[vt] = cacc[vt] * F;
                    nacc = nacc * F;
                    bf16x8 ones; { const short o1 = (r16 == 0) ? (short)0x3F80 : (short)0;
#pragma unroll
                        for (int e = 0; e < 8; ++e) ones[e] = o1; }
#pragma unroll
                    for (int ks = 0; ks < 4; ++ks) {
                        const LAS bf16_t* kcol = sK + (ks * 32 + quad * 8) * 136 + wave * 16 + r16;
                        const f32x4 w0 = *(const LAS f32x4*)(sgw + ks * 32 + quad * 8), w1 = *(const LAS f32x4*)(sgw + ks * 32 + quad * 8 + 4);
                        f32x4 k0, k1;
#pragma unroll
                        for (int e = 0; e < 4; ++e) { k0[e] = bf2f(kcol[e * 136]) * w0[e]; k1[e] = bf2f(kcol[(4 + e) * 136]) * w1[e]; }
                        const u32x4 pk = pack8(k0, k1); const bf16x8 kts = __builtin_bit_cast(bf16x8, pk);
#pragma unroll
                        for (int vt = 0; vt < 4; ++vt) { const bf16x8 va = *(const LAS bf16x8*)(sVT + (vt * 16 + r16) * 136 + ks * 32 + quad * 8); cacc[vt] = mfma16(kts, va, cacc[vt]); }
                        nacc = mfma16(kts, ones, nacc);
                    }
#pragma unroll
                    for (int vt = 0; vt < 4; ++vt) { u32x2 w; w.x = cvt_pk_bf16(cacc[vt][0], cacc[vt][1]); w.y = cvt_pk_bf16(cacc[vt][2], cacc[vt][3]);
                        *(LAS u32x2*)(sC + (vt * 16 + r16) * 136 + wave * 16 + quad * 4) = w; }
                    if (r16 == 0) { u32x2 w; w.x = cvt_pk_bf16(nacc[0], nacc[1]); w.y = cvt_pk_bf16(nacc[2], nacc[3]); *(LAS u32x2*)(sC + 64 * 136 + wave * 16 + quad * 4) = w; }
                }
            }
        }
    }
    }
    SEAM(4);

    if (IN(5)) {
        unsigned char* const wsb = A.ws; unsigned char* const dob = (unsigned char*)A.out; (void)wsb; (void)dob;
        for (int row = gw; row < ML; row += NGW) {
            const size_t off = (size_t)row * 1024 + lane * 16;
            float ht[16], mo[16];
#pragma unroll
            for (int q = 0; q < 2; ++q) { const u32x4 a = *(const u32x4*)(HF + off + q * 8), c = *(const u32x4*)(HB + off + q * 8), d = *(const u32x4*)(MO + off + q * 8);
#pragma unroll
                for (int e = 0; e < 4; ++e) { ht[q * 8 + 2 * e] = __uint_as_float(a[e] << 16) + __uint_as_float(c[e] << 16); ht[q * 8 + 2 * e + 1] = __uint_as_float(a[e] & 0xffff0000u) + __uint_as_float(c[e] & 0xffff0000u);
                    mo[q * 8 + 2 * e] = __uint_as_float(d[e] << 16); mo[q * 8 + 2 * e + 1] = __uint_as_float(d[e] & 0xffff0000u); } }
            float ss = 0.f;
#pragma unroll
            for (int e = 0; e < 16; ++e) ss += ht[e] * ht[e];
            ss += __shfl_xor(ss, 1); ss += __shfl_xor(ss, 2); ss += __shfl_xor(ss, 4); ss += __shfl_xor(ss, 8);
            const float rs = rsqrtf(ss * (1.f / 256.f) + EPS);
            float r[16];
#pragma unroll
            for (int q = 0; q < 4; ++q) { const f32x4 w = *(const f32x4*)(A.ml_norm_w + lane * 16 + q * 4);
#pragma unroll
                for (int e = 0; e < 4; ++e) r[q * 4 + e] = ht[q * 4 + e] * rs * w[e] * sigmoidf_(mo[q * 4 + e]); }
#pragma unroll
            for (int q = 0; q < 2; ++q) { u32x4 w; w.x = cvt_pk_bf16(r[q * 8 + 0], r[q * 8 + 1]); w.y = cvt_pk_bf16(r[q * 8 + 2], r[q * 8 + 3]); w.z = cvt_pk_bf16(r[q * 8 + 4], r[q * 8 + 5]); w.w = cvt_pk_bf16(r[q * 8 + 6], r[q * 8 + 7]);
                *(u32x4*)(MO + off + q * 8) = w; }
        }
    }
    SEAM(5);

    for (int rep_ = 0; rep_ < (((RPT_MASK >> 6) & 1) ? 2 : 1); ++rep_) { if (rep_) { if (6 == 0) cg::this_grid().sync(); else xcd_barrier(xbar); }
    if (IN(6)) {
        unsigned char* const wsb = A.ws; unsigned char* const dob = (unsigned char*)A.out; (void)wsb; (void)dob;
        pg8::Order S; S.init(64, 4, G, bx, 0);
        { pg8::Gemm g{AQ, WBA, 1024, 1024, 1024, MO, WBM}; EpiMerge E{GA, GM, Y}; pg8::gemm_phase<EpiMerge, pg8::Order, false, true>(lds, g, S, E); }
    }
    }
    SEAM(6);

    for (int rep_ = 0; rep_ < (((RPT_MASK >> 7) & 1) ? 2 : 1); ++rep_) { if (rep_) { if (7 == 0) cg::this_grid().sync(); else xcd_barrier(xbar); }
    if (IN(7)) {
        unsigned char* const wsb = A.ws; unsigned char* const dob = (unsigned char*)A.out; (void)wsb; (void)dob;
        pg8::Order S; S.init(64, 4, G, bx, 0);
#ifdef DBG_P7PLAIN
        pg8::Gemm g{Y, WO, 1024, 1024, 1024}; EpiPlain E{T1, 1024};
        pg8::gemm_phase<EpiPlain, pg8::Order, false>(lds, g, S, E);
#else
        pg8::Gemm g{Y, WO, 1024, 1024, 1024}; EpiOut E{A.x, mod, A.norm2_w, (float*)dob, AQ, rowsq};
        pg8::gemm_phase<EpiOut, pg8::Order, false>(lds, g, S, E);
#endif
    }
    }
    SEAM(7);

    for (int rep_ = 0; rep_ < (((RPT_MASK >> 8) & 1) ? 2 : 1); ++rep_) { if (rep_) { if (8 == 0) cg::this_grid().sync(); else xcd_barrier(xbar); }
    if (IN(8)) {
        unsigned char* const wsb = A.ws; unsigned char* const dob = (unsigned char*)A.out; (void)wsb; (void)dob;
        pg8::Order S; S.init(64, 22, G, bx, 0);
        pg8::Gemm g{AQ, WUP, 1024, 1024, 1024}; EpiUp E{rowsq, fbias, A.conv_w, A.conv_b, ACT, RAWU, (LAS float*)(lds + 131072)};
        pg8::gemm_phase<EpiUp, pg8::Order, true>(lds, g, S, E);
    }
    }
    SEAM(8);

    if (IN(9)) {
        unsigned char* const wsb = A.ws; unsigned char* const dob = (unsigned char*)A.out; (void)wsb; (void)dob;
        const float* cw = A.conv_w; const float* cb = A.conv_b;
        for (int task = bx * 512 + tid; task < 1025 * 352; task += G * 512) {
            const int ch = task % 352, bd = task / 352, j0 = ch * 8;
            const int pc = 256 * (j0 >> 7) + (j0 & 127);
            const bool lo_ok = bd > 0, hi_ok = bd < 1024, seam = ((bd * 16) & 2047) == 0;
            const u32x4 zero = (u32x4){0u, 0u, 0u, 0u};
            u32x4 xa[4], xg[4];
#pragma unroll
            for (int k = 0; k < 4; ++k) { xa[k] = zero; xg[k] = zero; }
            if (lo_ok) { const bf16_t* rp = RAWU + ((size_t)(bd - 1) * 4 + 2) * NUP + pc; xa[0] = *(const u32x4*)rp; xg[0] = *(const u32x4*)(rp + 128); xa[1] = *(const u32x4*)(rp + NUP); xg[1] = *(const u32x4*)(rp + NUP + 128); }
            if (hi_ok) { const bf16_t* rp = RAWU + ((size_t)bd * 4) * NUP + pc; xa[2] = *(const u32x4*)rp; xg[2] = *(const u32x4*)(rp + 128); xa[3] = *(const u32x4*)(rp + NUP); xg[3] = *(const u32x4*)(rp + NUP + 128); }
            float wa[3][8], wg[3][8], ba[8], bg[8];
#pragma unroll
            for (int i = 0; i < 3; ++i)
#pragma unroll
                for (int q = 0; q < 2; ++q) { const f32x4 a = *(const f32x4*)(cw + i * NUP + j0 + 4 * q), g = *(const f32x4*)(cw + i * NUP + DFF + j0 + 4 * q);
#pragma unroll
                    for (int e = 0; e < 4; ++e) { wa[i][4 * q + e] = a[e]; wg[i][4 * q + e] = g[e]; } }
#pragma unroll
            for (int q = 0; q < 2; ++q) { const f32x4 a = *(const f32x4*)(cb + j0 + 4 * q), g = *(const f32x4*)(cb + DFF + j0 + 4 * q);
#pragma unroll
                for (int e = 0; e < 4; ++e) { ba[4 * q + e] = a[e]; bg[4 * q + e] = g[e]; } }
#pragma unroll
            for (int side = 0; side < 2; ++side) {
                if (side == 0 ? !lo_ok : !hi_ok) continue;
                float r[8];
#pragma unroll
                for (int e = 0; e < 8; ++e) { const int w = e >> 1; const bool hi16 = e & 1;
                    float va[3], vg[3];
#pragma unroll
                    for (int k = 0; k < 3; ++k) { const unsigned aw = xa[side + k][w], gw = xg[side + k][w];
                        va[k] = hi16 ? __uint_as_float(aw & 0xffff0000u) : __uint_as_float(aw << 16); vg[k] = hi16 ? __uint_as_float(gw & 0xffff0000u) : __uint_as_float(gw << 16); }
                    if (seam) { if (side == 0) { va[2] = 0.f; vg[2] = 0.f; } else { va[0] = 0.f; vg[0] = 0.f; } }
                    const float av = ba[e] + wa[0][e] * va[0] + wa[1][e] * va[1] + wa[2][e] * va[2];
                    const float gv = bg[e] + wg[0][e] * vg[0] + wg[1][e] * vg[1] + wg[2][e] * vg[2];
                    r[e] = gv * sigmoidf_(gv) * av; }
                u32x4 w; w.x = cvt_pk_bf16(r[0], r[1]); w.y = cvt_pk_bf16(r[2], r[3]); w.z = cvt_pk_bf16(r[4], r[5]); w.w = cvt_pk_bf16(r[6], r[7]);
                *(u32x4*)(ACT + (size_t)(bd * 16 - 1 + side) * DFF + j0) = w;
            }
        }
    }
    SEAM(9);

    if (IN(10)) {
        unsigned char* const wsb = A.ws; unsigned char* const dob = (unsigned char*)A.out; (void)wsb; (void)dob;
        pg8::Order S; S.init(64, 4, G, bx, 0);
        pg8::Gemm g{ACT, WDN, DFF, DFF, DFF}; EpiDown E{(float*)dob, mod, AQ, A.norm2_w};
        pg8::gemm_phase<EpiDown, pg8::Order, false>(lds, g, S, E);
    }
#undef IN
#undef SEAM
}
#undef A

extern "C" void kernel_launch(void* const* d_in, const int* in_sizes, int n_in, void* d_out, int out_size, void* d_ws, size_t ws_size, hipStream_t stream) {
    static int grid = 0;
    if (grid == 0) {
        if (n_in != 21 || out_size != ML * D || ws_size < WS_END) { fprintf(stderr, "kernel_launch: unexpected shapes (n_in %d out %d ws %zu)\n", n_in, out_size, ws_size); grid = -1; return; }
        int dev = 0, cus = 0, per_cu = 0;
        hipGetDevice(&dev); hipDeviceGetAttribute(&cus, hipDeviceAttributeMultiprocessorCount, dev);
        hipFuncSetAttribute((const void*)fwd_kernel, hipFuncAttributeMaxDynamicSharedMemorySize, LDS_BYTES);
        hipOccupancyMaxActiveBlocksPerMultiprocessor(&per_cu, (const void*)fwd_kernel, 512, LDS_BYTES);
        if (per_cu < 1) { fprintf(stderr, "kernel_launch: occupancy query says %d blocks per CU\n", per_cu); per_cu = 1; }
        grid = cus * per_cu;
        (void)hipGetLastError();
    }
    if (grid < 0) return;
    Args a{};
    const float** pp = (const float**)&a;
    for (int i = 0; i < 21; ++i) pp[i] = (const float*)d_in[i];
    a.out = (float*)d_out; a.ws = (unsigned char*)d_ws;
#if ONE_LAUNCH
    a.ph_lo = 0; a.ph_hi = 11;
    void* args[] = {&a};
    hipError_t e = hipLaunchCooperativeKernel((const void*)fwd_kernel, dim3(grid), dim3(512), args, LDS_BYTES, stream);
    if (e != hipSuccess) fprintf(stderr, "cooperative launch failed: %s (grid %d)\n", hipGetErrorString(e), grid);
#else
    for (int p = 0; p < 11; ++p) { a.ph_lo = p; a.ph_hi = p + 1; hipLaunchKernelGGL(fwd_kernel, dim3(grid), dim3(512), LDS_BYTES, stream, a); }

#endif
}
```

```cpp
#include <hip/hip_runtime.h>
#include <hip/hip_cooperative_groups.h>
#include <cstdio>
#include <cstdint>
namespace cg = cooperative_groups;

#ifndef RPT_MASK
#define RPT_MASK 0
#endif
#ifndef ONE_LAUNCH
#define ONE_LAUNCH 1
#endif

#define LAS __attribute__((address_space(3)))
typedef unsigned short bf16_t;
typedef short bf16x8 __attribute__((ext_vector_type(8)));
typedef float f32x4 __attribute__((ext_vector_type(4)));
typedef unsigned u32x4 __attribute__((ext_vector_type(4)));
typedef unsigned u32x2 __attribute__((ext_vector_type(2)));

constexpr int D = 1024, NB = 8, SEQ = 2048, CTX = 256;
constexpr int ML = NB * SEQ;
constexpr int MC = NB * CTX;
constexpr int MT = ML + MC;
constexpr int DFF = 2816, NUP = 2 * DFF, INW = 6672;
constexpr float EPS = 1e-6f;
constexpr size_t MiB = 1u << 20;
constexpr size_t WS_ZERO = 0;
constexpr size_t WS_MOD = 0, WS_FB = 256 * 1024, WS_RSQ = 512 * 1024;
constexpr size_t WS_MODP = 236 * MiB + 12 * MiB;
constexpr size_t WS_RSQP = 252 * MiB;
constexpr size_t DO_FBP = 60 * MiB;
constexpr size_t WS_ROPE = 1 * MiB;
constexpr size_t WS_GATES = 2 * MiB;
constexpr size_t WS_WBA = 4 * MiB, WS_WBM = 6 * MiB, WS_WO = 8 * MiB, WS_WUP = 10 * MiB, WS_WDN = 21 * MiB;
constexpr size_t WS_AQ = 27 * MiB;
constexpr size_t WS_MQ = 59 * MiB, WS_MK = 75 * MiB  , WS_MO = 93 * MiB, WS_GA = 125 * MiB, WS_GM = 157 * MiB, WS_XT = 189 * MiB  ;
constexpr size_t WS_T1 = 59 * MiB, WS_Y = 189 * MiB;
constexpr size_t WS_U = 59 * MiB;
constexpr size_t WS_HALO = 236 * MiB;
constexpr size_t WS_ACT = 59 * MiB;
constexpr size_t WS_RAW = 147 * MiB;
constexpr size_t WS_END = 256 * MiB;
constexpr size_t DO_H = 0, DO_W1T = 36 * MiB, DO_W2T = 47 * MiB, DO_AK = 51 * MiB;
constexpr size_t DO_HF = 0, DO_HB = 32 * MiB;
constexpr int LDS_BYTES = 157696;

typedef float f32x2_t __attribute__((ext_vector_type(2))); typedef __bf16 bf16x2_t __attribute__((ext_vector_type(2)));
__device__ __forceinline__ unsigned cvt_pk_bf16(float lo, float hi) { f32x2_t v = {lo, hi}; bf16x2_t b = __builtin_convertvector(v, bf16x2_t); return __builtin_bit_cast(unsigned, b); }
__device__ __forceinline__ float bf2f(unsigned short v) { return __uint_as_float((unsigned)v << 16); }
__device__ __forceinline__ bf16_t f2bf(float f) { return (bf16_t)(cvt_pk_bf16(f, 0.f) & 0xffffu); }
__device__ __forceinline__ u32x4 pack8(f32x4 a, f32x4 b) { u32x4 w; w.x = cvt_pk_bf16(a[0], a[1]); w.y = cvt_pk_bf16(a[2], a[3]); w.z = cvt_pk_bf16(b[0], b[1]); w.w = cvt_pk_bf16(b[2], b[3]); return w; }
__device__ __forceinline__ float sigmoidf_(float x) { return __builtin_amdgcn_rcpf(1.f + __expf(-x)); }
__device__ __forceinline__ float sigmoid_div(float x) { return 1.f / (1.f + __expf(-x)); }
__device__ __forceinline__ float wave_sum(float v) {
#pragma unroll
    for (int o = 1; o < 64; o <<= 1) v += __shfl_xor(v, o);
    return v;
}

namespace pg8 {
constexpr int BM = 256, BK = 64, HALF = 128, HTB = HALF * BK * 2, STAGE_BYTES = 8 * HTB, NXCD = 8, WGM = 8;
__host__ __device__ __forceinline__ int lds_byte(int r, int c) { const int st = (r >> 4) * 2 + (c >> 5), rr = r & 15, cc = c & 31, ob = rr * 64 + cc * 2; return st * 1024 + (ob ^ (((ob >> 9) & 1) << 5)); }
__host__ __device__ __forceinline__ void stage_rc(int b, int& R, int& C) { const int st = b / 1024, sb = b % 1024, swz = sb ^ (((sb >> 9) & 1) << 5); R = (st >> 1) * 16 + swz / 64; C = (st & 1) * 32 + (swz % 64) / 2; }
__host__ __device__ __forceinline__ int perm32(int rho) { const int n = rho >> 4, i = rho & 15; return 8 * (i >> 2) + 4 * n + (i & 3); }

struct Unit { int pm, pn; };
struct Gemm { const bf16_t* A; const bf16_t* Bt; int lda, ldb, K; const bf16_t* A2 = nullptr; const bf16_t* Bt2 = nullptr; };

struct Order {
    int nM, nN, nwg, G, c, extra;
    __device__ __forceinline__ void init(int nM_, int nN_, int G_, int c_, int extra_) { nM = nM_; nN = nN_; nwg = nM_ * nN_; G = G_; c = c_; extra = extra_; }
    __device__ __forceinline__ bool next(int i, Unit& u) const {
        const long Lq = (long)i * G + c; if (Lq >= nwg + extra) return false;
        if (Lq >= nwg) { const int e = (int)(Lq - nwg); u.pm = nM + e / 3; u.pn = e % 3; return true; }
        int wgid = (int)Lq; { const int q = nwg / NXCD, r = nwg % NXCD, xcd = wgid % NXCD, off = wgid / NXCD; wgid = (xcd < r ? xcd * (q + 1) : r * (q + 1) + (xcd - r) * q) + off; }
        const int nig = WGM * nN, gid = wgid / nig, fm = gid * WGM, gsz = (nM - fm) < WGM ? (nM - fm) : WGM;
        u.pm = fm + ((wgid % nig) % gsz); u.pn = (wgid % nig) / gsz; return true;
    }
};

template <class Epi, class Sched, bool ALIGN_EPI, bool DUAL = false>
__device__ __forceinline__ void gemm_phase(LAS unsigned char* lds, const Gemm g, const Sched& S, const Epi& E) {
    int tid_ = threadIdx.x; asm volatile("" : "+v"(tid_));
    const int tid = tid_, wid = __builtin_amdgcn_readfirstlane(tid >> 6), lane = tid & 63, wr = wid >> 2, wc = wid & 3, fr = lane & 15, fq = lane >> 4;
    const int K = g.K, nt1 = K / BK, nt = DUAL ? 2 * nt1 : nt1;
    unsigned voffA[2], voffB[2];
#pragma unroll
    for (int i = 0; i < 2; ++i) { int R, C; stage_rc(tid * 16 + i * 8192, R, C); const int Rb = ((R & ~31) + perm32(R & 31));
        voffA[i] = (unsigned)(R * g.lda + C) * 2u; voffB[i] = (unsigned)(Rb * g.ldb + C) * 2u; }
    const size_t kstep = (size_t)(BK * 2);
    const size_t hstepA = (size_t)HALF * g.lda * 2, hstepB = (size_t)HALF * g.ldb * 2;
    const size_t tstepA = 2 * hstepA, tstepB = 2 * hstepB;
    const unsigned ldsw = (unsigned)wid * 1024u;
    const int aoff = lds_byte(wr * 64 + fr, fq * 8), boff = lds_byte(wc * 32 + fr, fq * 8);
#define PG8_SA(b, h) (((b) * 2 + (h)) * HTB)
#define PG8_SB(b, h) ((4 + (b) * 2 + (h)) * HTB)
#define PG8_STAGE(bufoff, gbase, voff) do { _Pragma("unroll") for (int _i = 0; _i < 2; ++_i) \
        __builtin_amdgcn_global_load_lds((const unsigned*)((const char*)(gbase) + (voff)[_i]), (LAS unsigned*)(lds + (bufoff) + ldsw + _i * 8192), 16, 0, 0); } while (0)
#define PG8_LDA(dst, b, h) do { _Pragma("unroll") for (int m = 0; m < 4; ++m) _Pragma("unroll") for (int k = 0; k < 2; ++k) dst[m][k] = *(const LAS bf16x8*)(lds + PG8_SA(b, h) + aoff + m * 2048 + k * 1024); } while (0)
#define PG8_LDB(dst, b, h) do { _Pragma("unroll") for (int n = 0; n < 2; ++n) _Pragma("unroll") for (int k = 0; k < 2; ++k) dst[n][k] = *(const LAS bf16x8*)(lds + PG8_SB(b, h) + boff + n * 2048 + k * 1024); } while (0)
#define PG8_MMA(ai, bj, At, Bt) do { __builtin_amdgcn_s_setprio(1); _Pragma("unroll") for (int m = 0; m < 4; ++m) _Pragma("unroll") for (int n = 0; n < 2; ++n) _Pragma("unroll") for (int k = 0; k < 2; ++k) \
        acc[ai][bj][m][n] = __builtin_amdgcn_mfma_f32_16x16x32_bf16(Bt[n][k], At[m][k], acc[ai][bj][m][n], 0, 0, 0); __builtin_amdgcn_s_setprio(0); } while (0)
#define PG8_WAIT_V(n) asm volatile("s_waitcnt vmcnt(" #n ")" ::: "memory")
#define PG8_WAIT_L(n) asm volatile("s_waitcnt lgkmcnt(" #n ")" ::: "memory")
#define PG8_BAR __builtin_amdgcn_s_barrier()
#define PG8_SCHED __builtin_amdgcn_sched_barrier(0)
    Unit cur, nxt; int ui = 0;
    if (!S.next(0, cur)) return;
    f32x4 acc[2][2][4][2];
#pragma unroll
    for (int a = 0; a < 2; ++a)
#pragma unroll
        for (int b = 0; b < 2; ++b)
#pragma unroll
            for (int m = 0; m < 4; ++m)
#pragma unroll
                for (int n = 0; n < 2; ++n) acc[a][b][m][n] = (f32x4){0.f, 0.f, 0.f, 0.f};
    bf16x8 At[4][2], B0[2][2], B1[2][2];
    const char* cA = (const char*)g.A + (size_t)cur.pm * tstepA; const char* cB = (const char*)g.Bt + (size_t)cur.pn * tstepB;
    const char* cA2 = DUAL ? (const char*)g.A2 + (size_t)cur.pm * tstepA : cA; const char* cB2 = DUAL ? (const char*)g.Bt2 + (size_t)cur.pn * tstepB : cB;
    PG8_STAGE(PG8_SB(0, 0), cB, voffB); PG8_STAGE(PG8_SB(0, 1), cB + hstepB, voffB); PG8_STAGE(PG8_SA(0, 0), cA, voffA); PG8_STAGE(PG8_SA(0, 1), cA + hstepA, voffA);
    if (wr == 1) PG8_BAR;
    PG8_WAIT_V(2); PG8_BAR;
    PG8_STAGE(PG8_SB(1, 0), cB + kstep, voffB); PG8_STAGE(PG8_SA(1, 0), cA + kstep, voffA); PG8_STAGE(PG8_SB(1, 1), cB + hstepB + kstep, voffB);
    PG8_WAIT_V(6); PG8_BAR;
    for (;;) {
        const bool has_next = S.next(ui + 1, nxt);
        const char* nA = has_next ? (const char*)g.A + (size_t)nxt.pm * tstepA : cA; const char* nB = has_next ? (const char*)g.Bt + (size_t)nxt.pn * tstepB : cB;
        for (int t = 0; t < nt; t += 2) {
            const bool last = (t == nt - 2);
            const bool seg2 = DUAL && t >= nt1, seg2n = DUAL && t + 2 >= nt1;
            const char* a1 = seg2 ? cA2 + (size_t)(t + 1 - nt1) * kstep : cA + (size_t)(t + 1) * kstep;
            const char* a2 = last ? nA : (seg2n ? cA2 + (size_t)(t + 2 - nt1) * kstep : cA + (size_t)(t + 2) * kstep);
            const char* b2 = last ? nB : (seg2n ? cB2 + (size_t)(t + 2 - nt1) * kstep : cB + (size_t)(t + 2) * kstep);
            if constexpr (DUAL) { if (t == nt1) E.mid(acc, cur, wr, wc, fr, fq); }
            const char* a3 = a2 + kstep; const char* b3 = b2 + kstep;
            PG8_LDB(B0, 0, 0); PG8_LDB(B1, 0, 1); PG8_SCHED; PG8_LDA(At, 0, 0); PG8_STAGE(PG8_SA(1, 1), a1 + hstepA, voffA);
            PG8_WAIT_V(8); PG8_WAIT_L(0); PG8_BAR; PG8_MMA(0, 0, At, B0); PG8_MMA(0, 1, At, B1); PG8_BAR; PG8_SCHED;
            PG8_LDA(At, 0, 1); PG8_STAGE(PG8_SB(0, 0), b2, voffB); PG8_STAGE(PG8_SB(0, 1), b2 + hstepB, voffB); PG8_STAGE(PG8_SA(0, 0), a2, voffA);
            PG8_WAIT_V(8); PG8_WAIT_L(0); PG8_BAR; PG8_MMA(1, 0, At, B0); PG8_MMA(1, 1, At, B1); PG8_BAR; PG8_SCHED;
            PG8_LDB(B0, 1, 0); PG8_LDB(B1, 1, 1); PG8_SCHED; PG8_LDA(At, 1, 0); PG8_STAGE(PG8_SA(0, 1), a2 + hstepA, voffA);
            PG8_WAIT_V(8); PG8_WAIT_L(0); PG8_BAR; PG8_MMA(0, 0, At, B0); PG8_MMA(0, 1, At, B1); PG8_BAR; PG8_SCHED;
            PG8_LDA(At, 1, 1); PG8_STAGE(PG8_SB(1, 0), b3, voffB); PG8_STAGE(PG8_SB(1, 1), b3 + hstepB, voffB); PG8_STAGE(PG8_SA(1, 0), a3, voffA);
            PG8_WAIT_V(8); PG8_WAIT_L(0); PG8_BAR; PG8_MMA(1, 0, At, B0); PG8_MMA(1, 1, At, B1); PG8_BAR; PG8_SCHED;
        }
        if constexpr (ALIGN_EPI) { if (wr == 0) PG8_BAR; }
        E(acc, cur, wr, wc, fr, fq);
        if (!has_next) break;
#pragma unroll
        for (int a = 0; a < 2; ++a)
#pragma unroll
            for (int b = 0; b < 2; ++b)
#pragma unroll
                for (int m = 0; m < 4; ++m)
#pragma unroll
                    for (int n = 0; n < 2; ++n) acc[a][b][m][n] = (f32x4){0.f, 0.f, 0.f, 0.f};
        cur = nxt; cA = nA; cB = nB; ++ui;
        if constexpr (DUAL) { cA2 = (const char*)g.A2 + (size_t)cur.pm * tstepA; cB2 = (const char*)g.Bt2 + (size_t)cur.pn * tstepB; }
        if constexpr (ALIGN_EPI) { if (wr == 1) PG8_BAR; }
    }
    PG8_WAIT_V(0);
    if constexpr (!ALIGN_EPI) { if (wr == 0) PG8_BAR; }
    PG8_BAR;
#undef PG8_SA
#undef PG8_SB
#undef PG8_STAGE
#undef PG8_LDA
#undef PG8_LDB
#undef PG8_MMA
#undef PG8_WAIT_V
#undef PG8_WAIT_L
#undef PG8_BAR
#undef PG8_SCHED
}
}
using pg8::Unit;
typedef const f32x4 (&AccRef)[2][2][4][2];

struct EpiIn {
    bf16_t *AK_, *MK_, *AQ_, *MQ_, *MO_, *GA_, *GM_; const float *qnw, *knw, *cosT_, *sinT_; LAS float* sp;
    __device__ __forceinline__ void head_path(AccRef acc, const Unit& u, int wr, int wc, int fr, int fq_in, bf16_t* base, int ld, int coff, const float* nw) const {
        int fq = fq_in; asm volatile("" : "+v"(fq));
        const int row0 = u.pm * 256 + wr * 64 + fr;
        const bool rope = u.pm < 64;
        { int tx = threadIdx.x; asm volatile("" : "+v"(tx)); const int tt0 = (u.pm * 256) & 2047;
          for (int i = tx; i < (rope ? 2512 : 64); i += 512) { float v;
              if (i < 64) v = nw[i];
              else if (i < 208) { const int k = i - 64, gi = k / 36, e = k - gi * 36; const int t = tt0 + 64 * gi; v = e < 16 ? cosT_[t * 32 + e] : e < 32 ? sinT_[t * 32 + e - 16] : 0.f; }
              else { const int k = i - 208, c = k / 36, e = k - c * 36; const int t = tt0 + c; v = e < 16 ? cosT_[t * 32 + 16 + e] : e < 32 ? sinT_[t * 32 + e] : 0.f; }
              sp[i] = v; }
          asm volatile("s_waitcnt vmcnt(0) lgkmcnt(0)" ::: "memory"); __builtin_amdgcn_s_barrier(); asm volatile("" ::: "memory"); }
        const f32x4 w00 = *(const LAS f32x4*)(sp + 8 * fq), w01 = *(const LAS f32x4*)(sp + 8 * fq + 4), w10 = *(const LAS f32x4*)(sp + 32 + 8 * fq), w11 = *(const LAS f32x4*)(sp + 32 + 8 * fq + 4);
#pragma unroll
        for (int ai = 0; ai < 2; ++ai)
#pragma unroll
            for (int m = 0; m < 4; ++m) {
                const int row = row0 + ai * 128 + m * 16;
                f32x4 v00 = acc[ai][0][m][0], v01 = acc[ai][0][m][1], v10 = acc[ai][1][m][0], v11 = acc[ai][1][m][1];
                f32x4 q = v00 * v00 + v01 * v01 + v10 * v10 + v11 * v11;
                float ss = (q[0] + q[1]) + (q[2] + q[3]);
                ss += __shfl_xor(ss, 16); ss += __shfl_xor(ss, 32);
                const float rs = rsqrtf(ss * (1.f / 64.f) + EPS);
                v00 = v00 * rs * w00; v01 = v01 * rs * w01; v10 = v10 * rs * w10; v11 = v11 * rs * w11;
                f32x4 o00 = v00, o01 = v01, o10 = v10, o11 = v11;
                if (rope) {
                    const int r = ai * 128 + wr * 64 + m * 16 + fr;
                    const LAS float* cp = sp + ((fq < 2) ? 64 + (r >> 6) * 36 + 8 * fq : 208 + (r & 63) * 36 + 8 * (fq - 2));
                    const f32x4 c0 = *(const LAS f32x4*)cp, c1 = *(const LAS f32x4*)(cp + 4), s0 = *(const LAS f32x4*)(cp + 16), s1 = *(const LAS f32x4*)(cp + 20);
                    o00 = v00 * c0 - v10 * s0; o01 = v01 * c1 - v11 * s1; o10 = v00 * s0 + v10 * c0; o11 = v01 * s1 + v11 * c1;
                }
                bf16_t* p = base + (size_t)row * ld + coff + wc * 64 + 8 * fq;
                *(u32x4*)p = pack8(o00, o01); *(u32x4*)(p + 32) = pack8(o10, o11);
                asm volatile("" ::: "memory");
            }
    }
    template <bool SIG> __device__ __forceinline__ void plain_path(AccRef acc, const Unit& u, int wr, int wc, int fr, int fq, bf16_t* base, int ld, int coff) const {
        const int row0 = u.pm * 256 + wr * 64 + fr;
#pragma unroll
        for (int ai = 0; ai < 2; ++ai)
#pragma unroll
            for (int m = 0; m < 4; ++m) {
                bf16_t* p = base + (size_t)(row0 + ai * 128 + m * 16) * ld + coff + wc * 32 + 8 * fq;
#pragma unroll
                for (int bj = 0; bj < 2; ++bj) { f32x4 v0 = acc[ai][bj][m][0], v1 = acc[ai][bj][m][1];
                    if (SIG) {
#pragma unroll
                        for (int e = 0; e < 4; ++e) { v0[e] = sigmoid_div(v0[e]); v1[e] = sigmoid_div(v1[e]); } }
                    *(u32x4*)(p + bj * 128) = pack8(v0, v1); }
            }
    }
    __device__ __forceinline__ void operator()(AccRef acc, const Unit& u, int wr, int wc, int fr, int fq) const {
        const int pn = u.pn;
        if (pn == 0) head_path(acc, u, wr, wc, fr, fq, AK_, 256, 0, knw);
        else if (pn <= 2) plain_path<false>(acc, u, wr, wc, fr, fq, MK_, 512, (pn - 1) * 256);
        else if (pn <= 6) head_path(acc, u, wr, wc, fr, fq, AQ_, 1024, (pn - 3) * 256, qnw);
        else if (pn <= 8) plain_path<false>(acc, u, wr, wc, fr, fq, MQ_, 512, (pn - 7) * 256);
        else if (pn <= 12) plain_path<false>(acc, u, wr, wc, fr, fq, MO_, 1024, (pn - 9) * 256);
        else if (pn <= 16) plain_path<true>(acc, u, wr, wc, fr, fq, GA_, 1024, (pn - 13) * 256);
        else plain_path<true>(acc, u, wr, wc, fr, fq, GM_, 1024, (pn - 17) * 256);
    }
};
struct EpiPlain {
    bf16_t* O; int ldc;
    __device__ __forceinline__ void operator()(AccRef acc, const Unit& u, int wr, int wc, int fr, int fq) const {
        const int row0 = u.pm * 256 + wr * 64 + fr;
#pragma unroll
        for (int ai = 0; ai < 2; ++ai)
#pragma unroll
            for (int m = 0; m < 4; ++m) {
                bf16_t* p = O + (size_t)(row0 + ai * 128 + m * 16) * ldc + u.pn * 256 + wc * 32 + 8 * fq;
#pragma unroll
                for (int bj = 0; bj < 2; ++bj) *(u32x4*)(p + bj * 128) = pack8(acc[ai][bj][m][0], acc[ai][bj][m][1]);
            }
    }
};
template <bool ADD> struct EpiGate {
    const bf16_t* Gt; const bf16_t* T; bf16_t* O;
    __device__ __forceinline__ void operator()(AccRef acc, const Unit& u, int wr, int wc, int fr, int fq) const {
        const int row0 = u.pm * 256 + wr * 64 + fr;
        const size_t off0 = (size_t)row0 * 1024 + u.pn * 256 + wc * 32 + 8 * fq;
        u32x4 gv[2][2], tv[2][2];
#pragma unroll
        for (int bj = 0; bj < 2; ++bj) { gv[0][bj] = *(const u32x4*)(Gt + off0 + bj * 128); tv[0][bj] = (u32x4){0u, 0u, 0u, 0u}; if (ADD) tv[0][bj] = *(const u32x4*)(T + off0 + bj * 128); }
#pragma unroll
        for (int it = 0; it < 8; ++it) {
            const int ai = it >> 2, m = it & 3, cur = it & 1, nx = cur ^ 1;
            const size_t off = off0 + (size_t)(ai * 128 + m * 16) * 1024;
            if (it < 7) { const size_t offn = off0 + (size_t)(((it + 1) >> 2) * 128 + ((it + 1) & 3) * 16) * 1024;
#pragma unroll
                for (int bj = 0; bj < 2; ++bj) { gv[nx][bj] = *(const u32x4*)(Gt + offn + bj * 128); tv[nx][bj] = (u32x4){0u, 0u, 0u, 0u}; if (ADD) tv[nx][bj] = *(const u32x4*)(T + offn + bj * 128); } }
#pragma unroll
            for (int bj = 0; bj < 2; ++bj) {
                float r[8];
#pragma unroll
                for (int e = 0; e < 8; ++e) {
                    const unsigned gw = gv[cur][bj][e >> 1], tw = tv[cur][bj][e >> 1];
                    const float gg = (e & 1) ? __uint_as_float(gw & 0xffff0000u) : __uint_as_float(gw << 16);
                    const float tt = (e & 1) ? __uint_as_float(tw & 0xffff0000u) : __uint_as_float(tw << 16);
                    r[e] = tt + sigmoidf_(gg) * acc[ai][bj][m][e >> 2][e & 3];
                }
                u32x4 w; w.x = cvt_pk_bf16(r[0], r[1]); w.y = cvt_pk_bf16(r[2], r[3]); w.z = cvt_pk_bf16(r[4], r[5]); w.w = cvt_pk_bf16(r[6], r[7]);
                *(u32x4*)(O + off + bj * 128) = w;
            }
        }
    }
};
struct EpiMerge {
    const bf16_t* Sa; const bf16_t* Sm; bf16_t* O;
    __device__ __forceinline__ void mid(f32x4 (&acc)[2][2][4][2], const Unit& u, int wr, int wc, int fr, int fq) const {
        const size_t off0 = (size_t)(u.pm * 256 + wr * 64 + fr) * 1024 + u.pn * 256 + wc * 32 + 8 * fq;
        u32x4 av[2][2], mv[2][2];
#pragma unroll
        for (int bj = 0; bj < 2; ++bj) { av[0][bj] = *(const u32x4*)(Sa + off0 + bj * 128); mv[0][bj] = *(const u32x4*)(Sm + off0 + bj * 128); }
#pragma unroll
        for (int it = 0; it < 8; ++it) {
            const int ai = it >> 2, m = it & 3, cur = it & 1, nx = cur ^ 1;
            if (it < 7) { const size_t offn = off0 + (size_t)(((it + 1) >> 2) * 128 + ((it + 1) & 3) * 16) * 1024;
#pragma unroll
                for (int bj = 0; bj < 2; ++bj) { av[nx][bj] = *(const u32x4*)(Sa + offn + bj * 128); mv[nx][bj] = *(const u32x4*)(Sm + offn + bj * 128); } }
#pragma unroll
            for (int bj = 0; bj < 2; ++bj)
#pragma unroll
                for (int e = 0; e < 8; ++e) {
                    const unsigned aw = av[cur][bj][e >> 1], mw = mv[cur][bj][e >> 1];
                    const float sa = (e & 1) ? __uint_as_float(aw & 0xffff0000u) : __uint_as_float(aw << 16);
                    const float sm = (e & 1) ? __uint_as_float(mw & 0xffff0000u) : __uint_as_float(mw << 16);
                    acc[ai][bj][m][e >> 2][e & 3] *= sa * __builtin_amdgcn_rcpf(fmaxf(sm, 1e-30f));
                }
        }
    }
    __device__ __forceinline__ void operator()(AccRef acc, const Unit& u, int wr, int wc, int fr, int fq) const {
        const size_t off0 = (size_t)(u.pm * 256 + wr * 64 + fr) * 1024 + u.pn * 256 + wc * 32 + 8 * fq;
        u32x4 mv[2][2];
#pragma unroll
        for (int bj = 0; bj < 2; ++bj) mv[0][bj] = *(const u32x4*)(Sm + off0 + bj * 128);
#pragma unroll
        for (int it = 0; it < 8; ++it) {
            const int ai = it >> 2, m = it & 3, cur = it & 1, nx = cur ^ 1;
            const size_t off = off0 + (size_t)(ai * 128 + m * 16) * 1024;
            if (it < 7) { const size_t offn = off0 + (size_t)(((it + 1) >> 2) * 128 + ((it + 1) & 3) * 16) * 1024;
#pragma unroll
                for (int bj = 0; bj < 2; ++bj) mv[nx][bj] = *(const u32x4*)(Sm + offn + bj * 128); }
#pragma unroll
            for (int bj = 0; bj < 2; ++bj) { float r[8];
#pragma unroll
                for (int e = 0; e < 8; ++e) { const unsigned mw = mv[cur][bj][e >> 1];
                    const float sm = (e & 1) ? __uint_as_float(mw & 0xffff0000u) : __uint_as_float(mw << 16);
                    r[e] = fmaxf(sm, 1e-30f) * acc[ai][bj][m][e >> 2][e & 3]; }
                u32x4 w; w.x = cvt_pk_bf16(r[0], r[1]); w.y = cvt_pk_bf16(r[2], r[3]); w.z = cvt_pk_bf16(r[4], r[5]); w.w = cvt_pk_bf16(r[6], r[7]);
                *(u32x4*)(O + off + bj * 128) = w; }
        }
    }
};
struct EpiOut {
    const float* x; const float* mod; const float* nw2; float* xmid; bf16_t* AP; float* rowsq;
    __device__ __forceinline__ void operator()(AccRef acc, const Unit& u, int wr, int wc, int fr, int fq) const {
        const int b = u.pm >> 3; const float* mb = mod + b * 6144;
        const int row0 = u.pm * 256 + wr * 64 + fr, col0 = u.pn * 256 + wc * 32 + 8 * fq;
        f32x4 g1[2][2], sw[2][2];
#pragma unroll
        for (int bj = 0; bj < 2; ++bj)
#pragma unroll
            for (int n = 0; n < 2; ++n) { const int c = col0 + bj * 128 + 4 * n; g1[bj][n] = *(const f32x4*)(mb + 2048 + c);
                sw[bj][n] = *(const f32x4*)(nw2 + c) * (*(const f32x4*)(mb + 4096 + c) + 1.f); }
        f32x4 xv[2][2][2];
#pragma unroll
        for (int bj = 0; bj < 2; ++bj)
#pragma unroll
            for (int n = 0; n < 2; ++n) xv[0][bj][n] = *(const f32x4*)(x + (size_t)row0 * 1024 + col0 + bj * 128 + 4 * n);
#pragma unroll
        for (int it = 0; it < 8; ++it) {
            const int ai = it >> 2, m = it & 3, cur = it & 1, nx = cur ^ 1;
            const int row = row0 + ai * 128 + m * 16; const size_t off = (size_t)row * 1024 + col0; float ss = 0.f;
            if (it < 7) { const size_t offn = (size_t)(row0 + ((it + 1) >> 2) * 128 + ((it + 1) & 3) * 16) * 1024 + col0;
#pragma unroll
                for (int bj = 0; bj < 2; ++bj)
#pragma unroll
                    for (int n = 0; n < 2; ++n) xv[nx][bj][n] = *(const f32x4*)(x + offn + bj * 128 + 4 * n); }
#pragma unroll
            for (int bj = 0; bj < 2; ++bj) {
                f32x4 v[2];
#pragma unroll
                for (int n = 0; n < 2; ++n) { v[n] = xv[cur][bj][n] + g1[bj][n] * acc[ai][bj][m][n];
                    const f32x4 q = v[n] * v[n]; ss += (q[0] + q[1]) + (q[2] + q[3]); }
                *(u32x4*)(AP + off + bj * 128) = pack8(v[0] * sw[bj][0], v[1] * sw[bj][1]);
            }
            ss += __shfl_xor(ss, 16); ss += __shfl_xor(ss, 32);
            if (fq == 0) rowsq[(size_t)row * 16 + u.pn * 4 + wc] = ss;
        }
    }
};
__device__ __forceinline__ float dpp_prev(float v) { return __int_as_float(__builtin_amdgcn_update_dpp(0, __float_as_int(v), 0x111, 0xf, 0xf, true)); }
__device__ __forceinline__ float dpp_next(float v) { return __int_as_float(__builtin_amdgcn_update_dpp(0, __float_as_int(v), 0x101, 0xf, 0xf, true)); }
struct EpiUp {
    const float* rowsq; const float* fb; const float* cw; const float* cb; bf16_t* ACT_; bf16_t* RAW_; LAS float* sp;
    __device__ __forceinline__ void operator()(AccRef acc, const Unit& u, int wr, int wc, int fr, int fq) const {
        const int b = u.pm >> 3; const int row0 = u.pm * 256 + wr * 64 + fr;
        int tx = threadIdx.x; asm volatile("" : "+v"(tx));
        if (tx < 256) {
            const float* qp = rowsq + (size_t)(u.pm * 256 + tx) * 16; const f32x4 q0 = *(const f32x4*)qp, q1 = *(const f32x4*)(qp + 4), q2 = *(const f32x4*)(qp + 8), q3 = *(const f32x4*)(qp + 12);
            const f32x4 qs = (q0 + q1) + (q2 + q3); sp[1280 + tx] = rsqrtf(((qs[0] + qs[1]) + (qs[2] + qs[3])) * (1.f / 1024.f) + EPS);
        } else {
            for (int i = tx - 256; i < 1280; i += 256) { const int vec = i >> 7, j = u.pn * 128 + (i & 127);
                const float* src = vec == 0 ? fb + b * NUP + j : vec == 1 ? fb + b * NUP + DFF + j : vec < 5 ? cw + (vec - 2) * NUP + j : vec < 8 ? cw + (vec - 5) * NUP + DFF + j : vec == 8 ? cb + j : cb + DFF + j;
                sp[i] = *src; } }
        asm volatile("s_waitcnt vmcnt(0) lgkmcnt(0)" ::: "memory"); __builtin_amdgcn_s_barrier(); asm volatile("" ::: "memory");
        const LAS float* spc = sp + wc * 32 + 8 * fq;
        const int jb = u.pn * 128 + wc * 32 + 8 * fq;
        const int pcol = u.pn * 256 + wc * 32 + 8 * fq;
        const bool interior = (fr >= 1) && (fr <= 14), rawrow = !((fr >= 2) && (fr <= 13));
        const int slot = fr < 2 ? fr : fr - 12;
#pragma unroll
        for (int ai = 0; ai < 2; ++ai)
#pragma unroll
            for (int m = 0; m < 4; ++m) {
                const int row = row0 + ai * 128 + m * 16; const float rstd = sp[1280 + ai * 128 + wr * 64 + m * 16 + fr];
                float r[8]; f32x4 ua[2], ug[2];
#pragma unroll
                for (int n = 0; n < 2; ++n) {
                    ua[n] = acc[ai][0][m][n] * rstd + *(const LAS f32x4*)(spc + 0 * 128 + 4 * n);
                    ug[n] = acc[ai][1][m][n] * rstd + *(const LAS f32x4*)(spc + 1 * 128 + 4 * n);
                    const f32x4 wa0 = *(const LAS f32x4*)(spc + 2 * 128 + 4 * n), wa1 = *(const LAS f32x4*)(spc + 3 * 128 + 4 * n), wa2 = *(const LAS f32x4*)(spc + 4 * 128 + 4 * n);
                    const f32x4 wg0 = *(const LAS f32x4*)(spc + 5 * 128 + 4 * n), wg1 = *(const LAS f32x4*)(spc + 6 * 128 + 4 * n), wg2 = *(const LAS f32x4*)(spc + 7 * 128 + 4 * n);
                    const f32x4 ba = *(const LAS f32x4*)(spc + 8 * 128 + 4 * n), bg = *(const LAS f32x4*)(spc + 9 * 128 + 4 * n);
#pragma unroll
                    for (int e = 0; e < 4; ++e) {
                        const float av = ba[e] + wa0[e] * dpp_prev(ua[n][e]) + wa1[e] * ua[n][e] + wa2[e] * dpp_next(ua[n][e]);
                        const float gv = bg[e] + wg0[e] * dpp_prev(ug[n][e]) + wg1[e] * ug[n][e] + wg2[e] * dpp_next(ug[n][e]);
                        r[4 * n + e] = gv * sigmoidf_(gv) * av;
                    }
                }
                if (interior) { u32x4 w; w.x = cvt_pk_bf16(r[0], r[1]); w.y = cvt_pk_bf16(r[2], r[3]); w.z = cvt_pk_bf16(r[4], r[5]); w.w = cvt_pk_bf16(r[6], r[7]);
                    *(u32x4*)(ACT_ + (size_t)row * DFF + jb) = w; }
                if (rawrow) { bf16_t* rp = RAW_ + ((size_t)(row >> 4) * 4 + slot) * NUP + pcol;
                    *(u32x4*)rp = pack8(ua[0], ua[1]); *(u32x4*)(rp + 128) = pack8(ug[0], ug[1]); }
                asm volatile("" ::: "memory");
            }
    }
};
struct EpiDown {
    float* out; const float* mod; const bf16_t* AP; const float* nw2;
    __device__ __forceinline__ void operator()(AccRef acc, const Unit& u, int wr, int wc, int fr, int fq) const {
        const int b = u.pm >> 3; const float* mb = mod + b * 6144;
        const int row0 = u.pm * 256 + wr * 64 + fr, col0 = u.pn * 256 + wc * 32 + 8 * fq;
        f32x4 g2[2][2], rsw[2][2];
#pragma unroll
        for (int bj = 0; bj < 2; ++bj)
#pragma unroll
            for (int n = 0; n < 2; ++n) { const int c = col0 + bj * 128 + 4 * n; g2[bj][n] = *(const f32x4*)(mb + 5120 + c);
                const f32x4 sw = *(const f32x4*)(nw2 + c) * (*(const f32x4*)(mb + 4096 + c) + 1.f);
#pragma unroll
                for (int e = 0; e < 4; ++e) rsw[bj][n][e] = 1.f / sw[e]; }
        u32x4 av[2][2];
#pragma unroll
        for (int bj = 0; bj < 2; ++bj) av[0][bj] = *(const u32x4*)(AP + (size_t)row0 * 1024 + col0 + bj * 128);
#pragma unroll
        for (int it = 0; it < 8; ++it) {
            const int ai = it >> 2, m = it & 3, cur = it & 1, nx = cur ^ 1;
            const size_t off = (size_t)(row0 + ai * 128 + m * 16) * 1024 + col0;
            if (it < 7) { const size_t offn = (size_t)(row0 + ((it + 1) >> 2) * 128 + ((it + 1) & 3) * 16) * 1024 + col0;
#pragma unroll
                for (int bj = 0; bj < 2; ++bj) av[nx][bj] = *(const u32x4*)(AP + offn + bj * 128); }
#pragma unroll
            for (int bj = 0; bj < 2; ++bj)
#pragma unroll
                for (int n = 0; n < 2; ++n) { const unsigned w0 = av[cur][bj][2 * n], w1 = av[cur][bj][2 * n + 1];
                    const f32x4 ap = (f32x4){__uint_as_float(w0 << 16), __uint_as_float(w0 & 0xffff0000u), __uint_as_float(w1 << 16), __uint_as_float(w1 & 0xffff0000u)};
                    *(f32x4*)(out + off + bj * 128 + 4 * n) = ap * rsw[bj][n] + g2[bj][n] * acc[ai][bj][m][n]; }
        }
    }
};

__device__ __forceinline__ f32x4 mfma16(bf16x8 a, bf16x8 b, f32x4 c) { return __builtin_amdgcn_mfma_f32_16x16x32_bf16(a, b, c, 0, 0, 0); }

__device__ __forceinline__ void transpose_item(const float* W, int ldw, int col, int k0, bf16_t* WT, int dst_row, int dld, LAS float* scr, int lane) {
#pragma unroll 8
    for (int i = 0; i < 32; ++i) { const int kk = 2 * i + (lane >> 5); scr[kk * 33 + (lane & 31)] = W[(size_t)(k0 + kk) * ldw + col + (lane & 31)]; }
    asm volatile("s_waitcnt lgkmcnt(0)" ::: "memory");
    const int c = lane & 7;
#pragma unroll
    for (int j = 0; j < 4; ++j) { const int n = (lane >> 3) + 8 * j; const LAS float* s = scr + (8 * c) * 33 + n;
        u32x4 o; o.x = cvt_pk_bf16(s[0 * 33], s[1 * 33]); o.y = cvt_pk_bf16(s[2 * 33], s[3 * 33]); o.z = cvt_pk_bf16(s[4 * 33], s[5 * 33]); o.w = cvt_pk_bf16(s[6 * 33], s[7 * 33]);
        *(u32x4*)(WT + (size_t)(dst_row + n) * dld + k0 + 8 * c) = o; }
    asm volatile("s_waitcnt lgkmcnt(0)" ::: "memory");
}
__device__ __forceinline__ int headperm(int n0) { const int tile = n0 >> 8, l = n0 & 255; return tile * 256 + 128 * ((l >> 5) & 1) + 32 * (l >> 6); }

struct Args {
    const float *x, *c, *ctx, *c_ctx, *w_mod, *b_mod, *norm1_w, *w_in, *q_norm_w, *k_norm_w, *attn_sink, *ml_gate_b, *ml_norm_w,
        *w_branch_att, *w_branch_ml, *w_out, *norm2_w, *w_up, *conv_w, *conv_b, *w_down;
    float* out; unsigned char* ws; int ph_lo, ph_hi;
};

template <int NV, int KS, bool ATOMIC> __device__ __forceinline__ void gemv_task(const float* W, int ldw, int n0, int k0, const LAS float* svec, float* out, int ldo) {
    const int n = n0 + threadIdx.x; float a[NV];
#pragma unroll
    for (int v = 0; v < NV; ++v) a[v] = 0.f;
#pragma unroll 16
    for (int k = 0; k < KS; ++k) { const float w = W[(size_t)(k0 + k) * ldw + n];
#pragma unroll
        for (int v = 0; v < NV; ++v) a[v] += svec[v * KS + k] * w; }
#pragma unroll
    for (int v = 0; v < NV; ++v) { if (ATOMIC) atomicAdd(out + (size_t)v * ldo + n, a[v]); else out[(size_t)v * ldo + n] = a[v]; }
}

#define mod   ((float*)(wsb + WS_MOD))
#define modp  ((float*)(wsb + WS_MODP))
#define fbias ((float*)(wsb + WS_FB))
#define rowsq ((float*)(wsb + WS_RSQP))
#define fbp ((float*)(dob + DO_FBP))
#define cosT  ((float*)(wsb + WS_ROPE))
#define sinT  ((float*)(wsb + WS_ROPE) + 2048 * 32)
#define gates ((float*)(wsb + WS_GATES))
#define WBA ((bf16_t*)(wsb + WS_WBA))
#define WBM ((bf16_t*)(wsb + WS_WBM))
#define WO  ((bf16_t*)(wsb + WS_WO))
#define WUP ((bf16_t*)(wsb + WS_WUP))
#define WDN ((bf16_t*)(wsb + WS_WDN))
#define AQ  ((bf16_t*)(wsb + WS_AQ))
#ifdef DBG_ATTO
#define ATTO GA
#else
#define ATTO AQ
#endif
#define MQ  ((bf16_t*)(wsb + WS_MQ))
#define MK  ((bf16_t*)(wsb + WS_MK))
#define MO  ((bf16_t*)(wsb + WS_MO))
#define GA  ((bf16_t*)(wsb + WS_GA))
#define GM  ((bf16_t*)(wsb + WS_GM))
#define XT  ((bf16_t*)(wsb + WS_XT))
#define T1  ((bf16_t*)(wsb + WS_T1))
#define Y   ((bf16_t*)(wsb + WS_Y))
#define U   ((bf16_t*)(wsb + WS_U))
#define HALO ((bf16_t*)(wsb + WS_HALO))
#define ACT ((bf16_t*)(wsb + WS_ACT))
#define RAWU ((bf16_t*)(wsb + WS_RAW))
#define H   ((bf16_t*)(dob + DO_H))
#define W1T ((bf16_t*)(dob + DO_W1T))
#define W2T ((bf16_t*)(dob + DO_W2T))
#define AK  ((bf16_t*)(dob + DO_AK))
#define HF  ((bf16_t*)(dob + DO_HF))
#define HB  ((bf16_t*)(dob + DO_HB))

#define XB_TMO      128
#define XB_XCNT(j)  (256  + 64 * (j))
#define XB_XSUB(j)  (1280 + 64 * (j))
#define XB_XGEN(j)  (2304 + 64 * (j))
#define XB_TOP      3328
#define XB_TOPGEN   3392
#define XCD_BAR_WORDS 3456
#define XB_SPIN_CAP (1u << 18)
__device__ __forceinline__ unsigned xb_ld(unsigned* p)              { return __hip_atomic_load(p, __ATOMIC_RELAXED, __HIP_MEMORY_SCOPE_AGENT); }
__device__ __forceinline__ unsigned xb_add(unsigned* p, unsigned v) { return __hip_atomic_fetch_add(p, v, __ATOMIC_RELAXED, __HIP_MEMORY_SCOPE_AGENT); }
__device__ __forceinline__ unsigned xb_xcc_id() { return (unsigned)__builtin_amdgcn_s_getreg((3 << 11) | 20) & 0xFu; }
#define XB_SPIN(cond, bar) do { unsigned _sp = 0; while (cond) { __builtin_amdgcn_s_sleep(1); \
    if ((++_sp & 255u) == 0u) { if (xb_ld(&(bar)[XB_TMO])) break; if (_sp > XB_SPIN_CAP) { atomicAdd(&(bar)[XB_TMO], 1u); break; } } } } while (0)
struct XcdBarrier { unsigned* bar; unsigned x; volatile LAS unsigned* st; };
__device__ __forceinline__ XcdBarrier xcd_barrier_post(unsigned* bar, volatile LAS unsigned* st) {
    XcdBarrier b; b.bar = bar; b.x = xb_xcc_id(); b.st = st;
    if (threadIdx.x == 0) (void)xb_add(&bar[XB_XCNT(b.x)], 1u);
    return b;
}
__device__ __forceinline__ void xcd_barrier_complete(unsigned* bar, unsigned x, unsigned& nloc, unsigned& nx) {
    const unsigned G = gridDim.x * gridDim.y * gridDim.z;
    unsigned sum, cnt, mine, sp = 0u;
    for (;;) {
        sum = 0u; cnt = 0u; mine = 0u;
#pragma unroll
        for (unsigned j = 0; j < 16; ++j) { const unsigned c = xb_ld(&bar[XB_XCNT(j)]); sum += c; cnt += (c > 0u) ? 1u : 0u; mine = (j == x) ? c : mine; }
        if (sum == G) break;
        __builtin_amdgcn_s_sleep(1);
        if ((++sp & 255u) == 0u) { if (xb_ld(&bar[XB_TMO])) break; if (sp > XB_SPIN_CAP) { atomicAdd(&bar[XB_TMO], 1u); break; } }
    }
    nloc = mine > 0u ? mine : 1u; nx = cnt > 0u ? cnt : 1u;
}
__device__ __forceinline__ void xcd_barrier(const XcdBarrier& b) {
    asm volatile("s_waitcnt vmcnt(0)" ::: "memory");
    __syncthreads();
    if (threadIdx.x == 0) {
        unsigned* bar = b.bar;
        __builtin_amdgcn_s_waitcnt(0);
        unsigned nloc = b.st[0], nx = b.st[1];
        if (nloc == 0u) { xcd_barrier_complete(bar, b.x, nloc, nx); b.st[0] = nloc; b.st[1] = nx; }
        const unsigned old = xb_add(&bar[XB_XSUB(b.x)], 1u);
        const unsigned gen = old / nloc;
        if (old + 1u == (gen + 1u) * nloc) {
            __builtin_amdgcn_fence(__ATOMIC_RELEASE, "agent");
            asm volatile("s_waitcnt vmcnt(0)" ::: "memory");
            const unsigned og = xb_add(&bar[XB_TOP], 1u);
            const unsigned tg = og / nx;
            if (og + 1u == (tg + 1u) * nx) xb_add(&bar[XB_TOPGEN], 1u);
            else XB_SPIN(xb_ld(&bar[XB_TOPGEN]) == tg, bar);
            __builtin_amdgcn_fence(__ATOMIC_ACQUIRE, "agent");
            xb_add(&bar[XB_XGEN(b.x)], 1u);
            asm volatile("s_waitcnt vmcnt(0)" ::: "memory");
        } else {
            XB_SPIN(xb_ld(&bar[XB_XGEN(b.x)]) == gen, bar);
            __builtin_amdgcn_fence(__ATOMIC_ACQUIRE, "agent");
            asm volatile("s_waitcnt vmcnt(0)" ::: "memory");
        }
    }
    __syncthreads();
}
constexpr size_t WS_BAR = 253 * MiB;
constexpr int LDS_ST_OFF = LDS_BYTES - 16;
#define A (*(const volatile __attribute__((address_space(4))) Args*)__builtin_amdgcn_kernarg_segment_ptr())
__global__ void __launch_bounds__(512, 2) fwd_kernel(Args Aparam) {
    extern __shared__ __attribute__((aligned(16))) unsigned char lds_raw[];
    LAS unsigned char* lds = (LAS unsigned char*)lds_raw;
    const int tid = threadIdx.x, lane = tid & 63, wave = __builtin_amdgcn_readfirstlane(tid >> 6);
    const int G = gridDim.x, bx = blockIdx.x;
    const int gw = bx * 8 + wave, NGW = G * 8;
    const int lo = A.ph_lo, hi = A.ph_hi; (void)lo; (void)hi;
#ifndef PHMASK
#define PHMASK 0x1fff
#endif
#if ONE_LAUNCH
#define IN(k) (((PHMASK >> (k)) & 1) && (k) < 11)
#else
#define IN(k) (((PHMASK >> (k)) & 1) && lo <= (k) && (k) < hi)
#endif
#if ONE_LAUNCH
    XcdBarrier xbar; xbar.bar = nullptr; xbar.x = 0; xbar.st = (volatile LAS unsigned*)(lds + LDS_ST_OFF);
#define SEAM(k) do { xcd_barrier(xbar); } while (0)
    {
        unsigned* const barw = (unsigned*)(A.ws + WS_BAR);
        if (tid < 4) ((LAS unsigned*)(lds + LDS_ST_OFF))[tid] = 0u;
        if (bx == 0) for (int i = tid; i < XCD_BAR_WORDS; i += 512) barw[i] = 0u;
        cg::this_grid().sync();
        xbar = xcd_barrier_post(barw, (volatile LAS unsigned*)(lds + LDS_ST_OFF));
    }
#else
#define SEAM(k) do { } while (0)
#endif

    for (int rep_ = 0; rep_ < (((RPT_MASK >> 0) & 1) ? 2 : 1); ++rep_) { if (rep_) { if (0 == 0) cg::this_grid().sync(); else xcd_barrier(xbar); }
    if (IN(0)) {
        unsigned char* const wsb = A.ws; unsigned char* const dob = (unsigned char*)A.out; (void)wsb; (void)dob;
        LAS float* svec = (LAS float*)(lds + 131072);
        for (int task = bx; task < 192; task += G) {
            const int cb = task % 12, ks = task / 12, k0 = ks * 64;
            __syncthreads();
            for (int i = tid; i < 576; i += 512) { const int v = i >> 6, k = i & 63; const float cv = v < 8 ? A.c[v * 1024 + k0 + k] : A.c_ctx[k0 + k]; svec[i] = cv / (1.f + __expf(-cv)); }
            __syncthreads();
            gemv_task<9, 64, false>(A.w_mod, 6144, cb * 512, k0, svec, modp + (size_t)ks * 9 * 6144, 6144);
        }
        LAS float* scr = (LAS float*)(lds + wave * 16384);
        constexpr int NITEMS = 9088;
        for (int it = gw; it < NITEMS; it += NGW) {
            int r = it; const float* W; int ldw, col0, ncols, K; bf16_t* dst; int hp = 0;
            if (r < 512) { W = A.w_in; ldw = INW; col0 = 0; ncols = 1024; K = 1024; dst = W1T + (size_t)3 * 256 * 1024; hp = 1; }
            else if ((r -= 512) < 128) { W = A.w_in; ldw = INW; col0 = 1024; ncols = 256; K = 1024; dst = W1T; hp = 1; }
            else if ((r -= 128) < 128) { W = A.w_in; ldw = INW; col0 = 1280; ncols = 256; K = 1024; dst = W2T; }
            else if ((r -= 128) < 256) { W = A.w_in; ldw = INW; col0 = 1536; ncols = 512; K = 1024; dst = W1T + (size_t)7 * 256 * 1024; }
            else if ((r -= 256) < 256) { W = A.w_in; ldw = INW; col0 = 2048; ncols = 512; K = 1024; dst = W1T + (size_t)1 * 256 * 1024; }
            else if ((r -= 256) < 512) { W = A.w_in; ldw = INW; col0 = 2560; ncols = 1024; K = 1024; dst = W2T + (size_t)256 * 1024; }
            else if ((r -= 512) < 512) { W = A.w_in; ldw = INW; col0 = 3584; ncols = 1024; K = 1024; dst = W1T + (size_t)9 * 256 * 1024; }
            else if ((r -= 512) < 512) { W = A.w_in; ldw = INW; col0 = 4624; ncols = 1024; K = 1024; dst = W1T + (size_t)13 * 256 * 1024; }
            else if ((r -= 512) < 512) { W = A.w_in; ldw = INW; col0 = 5648; ncols = 1024; K = 1024; dst = W1T + (size_t)17 * 256 * 1024; }
            else if ((r -= 512) < 512) { W = A.w_branch_att; ldw = 1024; col0 = 0; ncols = 1024; K = 1024; dst = WBA; }
            else if ((r -= 512) < 512) { W = A.w_branch_ml; ldw = 1024; col0 = 0; ncols = 1024; K = 1024; dst = WBM; }
            else if ((r -= 512) < 512) { W = A.w_out; ldw = 1024; col0 = 0; ncols = 1024; K = 1024; dst = WO; }
            else if ((r -= 512) < 2816) { W = A.w_up; ldw = NUP; col0 = 0; ncols = NUP; K = 1024; dst = WUP; }
            else { r -= 2816; W = A.w_down; ldw = 1024; col0 = 0; ncols = 1024; K = DFF; dst = WDN; }
            const int nblk = ncols / 32, kb = r / nblk, nb = r % nblk, n0 = nb * 32;
            int drow = hp ? headperm(n0) : n0;
            if (W == A.w_up) drow = (n0 < DFF) ? 256 * (n0 >> 7) + (n0 & 127) : 256 * ((n0 - DFF) >> 7) + 128 + ((n0 - DFF) & 127);
            transpose_item(W, ldw, col0 + n0, kb * 64, dst, drow, K, scr, lane);
        }
        for (int i = bx * 512 + tid; i < 2048 * 32; i += G * 512) {
            const int t = i >> 5, j = i & 31; const float pos = (j < 16) ? (float)(t >> 6) : (float)(t & 63);
            const float invf = exp2f(-(float)(j & 15) * (13.287712379549449f / 16.f)); const float ang = pos * invf;
            cosT[i] = cosf(ang); sinT[i] = sinf(ang);
        }
    }
    }
    SEAM(0);

    for (int rep_ = 0; rep_ < (((RPT_MASK >> 1) & 1) ? 2 : 1); ++rep_) { if (rep_) { if (1 == 0) cg::this_grid().sync(); else xcd_barrier(xbar); }
    if (IN(1)) {
        unsigned char* const wsb = A.ws; unsigned char* const dob = (unsigned char*)A.out; (void)wsb; (void)dob;
        constexpr int GP = 1028;
        LAS float* sWg = (LAS float*)lds;
        LAS float* hT = (LAS float*)(lds + 65792);
        LAS float* svm = (LAS float*)(lds + 131584);
        LAS float* part = (LAS float*)(lds + 147968);
        LAS float* svec = part;
        for (int k = tid; k < 1024; k += 512) { const float* src = A.w_in + (size_t)k * INW + 4608;
#pragma unroll
            for (int q = 0; q < 4; ++q) { const f32x4 v = *(const f32x4*)(src + 4 * q); sWg[(4 * q + 0) * GP + k] = v[0]; sWg[(4 * q + 1) * GP + k] = v[1]; sWg[(4 * q + 2) * GP + k] = v[2]; sWg[(4 * q + 3) * GP + k] = v[3]; } }
        const int rpb = (MT + G - 1) / G, rbeg = bx * rpb, rend = (rbeg + rpb < MT) ? rbeg + rpb : MT;
        const int vlo = rbeg < ML ? (rbeg >> 11) : 8;
        for (int i = tid; i < 4096; i += 512) { const int slot = i >> 11, k = i & 2047; int v = vlo + slot; if (v > 8) v = 8; float a = A.b_mod[k];
#pragma unroll
            for (int ks = 0; ks < 16; ++ks) a += modp[((size_t)ks * 9 + v) * 6144 + k];
            svm[i] = a; }
        for (int i = bx * 512 + tid; i < 9 * 6144; i += G * 512) { float a = A.b_mod[i % 6144];
#pragma unroll
            for (int ks = 0; ks < 16; ++ks) a += modp[(size_t)ks * 9 * 6144 + i];
            mod[i] = a; }
        __syncthreads();
        {
            const float* xin = A.x; const float* cin = A.ctx; const float* n1w = A.norm1_w; const float* gbias = A.ml_gate_b;
            const int r16 = lane & 15, quad = lane >> 4;
            const int ntile = (rend - rbeg + 15) >> 4;
            f32x4 xn[2][4];
#pragma unroll
            for (int t = 0; t < 2; ++t) { const int row = rbeg + wave + 8 * t; if (row < rend) { const float* xr = row < ML ? xin + (size_t)row * 1024 : cin + (size_t)(row - ML) * 1024;
#pragma unroll
                for (int j = 0; j < 4; ++j) xn[t][j] = *(const f32x4*)(xr + 4 * lane + 256 * j); } }
            for (int tile = 0; tile < ntile; ++tile) {
                const int trow = rbeg + 16 * tile;
#pragma unroll
                for (int t = 0; t < 2; ++t) {
                    const int r = wave + 8 * t, row = trow + r;
                    f32x4 hv[4]; float ss = 0.f;
#pragma unroll
                    for (int j = 0; j < 4; ++j) { hv[j] = xn[t][j]; const f32x4 q = hv[j] * hv[j]; ss += (q[0] + q[1]) + (q[2] + q[3]); }
                    { const int rn = row + 16; if (rn < rend) { const float* xr = rn < ML ? xin + (size_t)rn * 1024 : cin + (size_t)(rn - ML) * 1024;
#pragma unroll
                        for (int j = 0; j < 4; ++j) xn[t][j] = *(const f32x4*)(xr + 4 * lane + 256 * j); } }
                    if (row < rend) {
                        const int v = row < ML ? (row >> 11) : 8;
                        const LAS float* sh = svm + (v - vlo) * 2048; const LAS float* sc = sh + 1024;
                        const float rstd = rsqrtf(wave_sum(ss) * (1.f / 1024.f) + EPS);
                        bf16_t* ho = H + (size_t)row * 1024;
#pragma unroll
                        for (int j = 0; j < 4; ++j) { const int k = 4 * lane + 256 * j;
                            hv[j] = hv[j] * rstd * (*(const f32x4*)(n1w + k)) * (*(const LAS f32x4*)(sc + k) + 1.f) + *(const LAS f32x4*)(sh + k);
                            u32x2 w; w.x = cvt_pk_bf16(hv[j][0], hv[j][1]); w.y = cvt_pk_bf16(hv[j][2], hv[j][3]); *(u32x2*)(ho + k) = w;
                            *(LAS f32x4*)(hT + r * GP + k) = hv[j]; }
                    }
                }
                __syncthreads();
                { f32x4 acc = (f32x4){0.f, 0.f, 0.f, 0.f};
#pragma unroll
                  for (int kk = 0; kk < 8; ++kk) { const f32x4 a4 = *(const LAS f32x4*)(hT + r16 * GP + wave * 128 + kk * 16 + quad * 4), b4 = *(const LAS f32x4*)(sWg + r16 * GP + wave * 128 + kk * 16 + quad * 4);
#pragma unroll
                    for (int i = 0; i < 4; ++i) acc = __builtin_amdgcn_mfma_f32_16x16x4f32(a4[i], b4[i], acc, 0, 0, 0); }
#pragma unroll
                  for (int j = 0; j < 4; ++j) part[wave * 256 + (quad * 4 + j) * 16 + r16] = acc[j]; }
                __syncthreads();
                if (tid < 256) { const int r = tid >> 4, gidx = tid & 15, row = trow + r; float gv = gbias[gidx];
#pragma unroll
                    for (int w = 0; w < 8; ++w) gv += part[w * 256 + tid];
                    if (gidx & 4) gv = fminf(gv, 0.f) - log1pf(expf(-fabsf(gv)));
                    if (row < rend) gates[(size_t)row * 16 + gidx] = gv; }
            }
        }
        for (int task = bx; task < 176; task += G) {
            const int cb = task % 11, ks = task / 11, k0 = ks * 64;
            __syncthreads();
            { const int v = tid >> 6, k = 3072 + k0 + (tid & 63); float a = A.b_mod[k];
#pragma unroll
                for (int q = 0; q < 16; ++q) a += modp[((size_t)q * 9 + v) * 6144 + k];
                svec[tid] = a; }
            __syncthreads();
            gemv_task<8, 64, false>(A.w_up, NUP, cb * 512, k0, svec, fbp + (size_t)ks * 8 * NUP, NUP);
        }
    }
    }
    SEAM(1);

    for (int rep_ = 0; rep_ < (((RPT_MASK >> 2) & 1) ? 2 : 1); ++rep_) { if (rep_) { if (2 == 0) cg::this_grid().sync(); else xcd_barrier(xbar); }
    if (IN(2)) {
        unsigned char* const wsb = A.ws; unsigned char* const dob = (unsigned char*)A.out; (void)wsb; (void)dob;
        { pg8::Gemm g{H, W1T, 1024, 1024, 1024}; pg8::Order S; S.init(64, 21, G, bx, 24);
          EpiIn E{AK, MK, AQ, MQ, MO, GA, GM, A.q_norm_w, A.k_norm_w, cosT, sinT, (LAS float*)(lds + 131072)};
          pg8::gemm_phase<EpiIn, pg8::Order, true>(lds, g, S, E); }
        { pg8::Gemm g{W2T, H, 1024, 1024, 1024}; pg8::Order S; S.init(5, 72, G, (bx + G - (1368 % G)) % G, 0);
          EpiPlain E{XT, MT};
          pg8::gemm_phase<EpiPlain, pg8::Order, true>(lds, g, S, E); }
    }
    }
    SEAM(2);

    if (IN(3)) {
        unsigned char* const wsb = A.ws; unsigned char* const dob = (unsigned char*)A.out; (void)wsb; (void)dob;
        for (int i = bx * 512 + tid; i < 8 * NUP; i += G * 512) { float a = 0.f;
#pragma unroll
            for (int ks = 0; ks < 16; ++ks) a += fbp[(size_t)ks * 8 * NUP + i];
            fbias[i] = a; }
        const int r16 = lane & 15, quad = lane >> 4;
        const int rt = wave & 3, hp = wave >> 2;
        LAS bf16_t* sK = (LAS bf16_t*)lds;
        LAS bf16_t* sVT = sK + 64 * 72;
        bf16x8 qn[2][2];
#define AT_QLOAD(un_) do { const int qb_ = (un_) & 31, kvh_ = ((un_) >> 5) & 3, b_ = (un_) >> 7; \
            _Pragma("unroll") for (int g = 0; g < 2; ++g) _Pragma("unroll") for (int ks = 0; ks < 2; ++ks) \
                qn[g][ks] = *(const bf16x8*)(AQ + (size_t)(b_ * SEQ + qb_ * 64 + rt * 16 + r16) * 1024 + (kvh_ * 4 + hp * 2 + g) * 64 + ks * 32 + quad * 8); } while (0)
        const int vcu3 = (G % 8 == 0) ? (bx % 8) * (G / 8) + bx / 8 : bx;
        if (vcu3 < 1024) AT_QLOAD(vcu3);
        for (int unit = vcu3; unit < 1024; unit += G) {
            const int qb = unit & 31, kvh = (unit >> 5) & 3, b = unit >> 7;
            const int rowbase = b * SEQ, t0 = qb * 64;
            bf16x8 qf[2][2];
#pragma unroll
            for (int g = 0; g < 2; ++g)
#pragma unroll
                for (int ks = 0; ks < 2; ++ks) qf[g][ks] = qn[g][ks];
            if (unit + G < 1024) AT_QLOAD(unit + G);
            f32x4 o[2][4]; float mrow[2], lrow[2];
#pragma unroll
            for (int g = 0; g < 2; ++g) { mrow[g] = A.attn_sink[kvh * 4 + hp * 2 + g]; lrow[g] = 1.f;
#pragma unroll
                for (int dt = 0; dt < 4; ++dt) o[g][dt] = (f32x4){0.f, 0.f, 0.f, 0.f}; }
            const int kb_lo = (qb < 2) ? 2 - qb : 0, kb_hi = (qb > 29) ? 33 - qb : 4;
            const bf16_t* const ak_ = AK; const bf16_t* const xt_ = XT; const int lr = tid >> 3, lc = tid & 7;
#define AT_KROW0(kb_) (((kb_) < 5) ? rowbase + (qb + (kb_) - 2) * 64 : ML + b * CTX + ((kb_) - 5) * 64)
            u32x4 pk, pv;
            { const int kr = AT_KROW0(kb_lo); pk = *(const u32x4*)(ak_ + (size_t)(kr + lr) * 256 + kvh * 64 + lc * 8); pv = *(const u32x4*)(xt_ + (size_t)(kvh * 64 + lr) * MT + kr + lc * 8); }
            for (int kb = kb_lo; kb < 9; kb = (kb == kb_hi) ? 5 : kb + 1) {
                const int mtype = (kb == 0) ? 1 : (kb == 4) ? 2 : 0;
                const int mlo = (mtype == 1) ? 0 : -4096, mhi = (mtype == 2) ? 0 : 4096, dl = quad * 4 - rt * 16 - r16;
                __syncthreads();
                *(LAS u32x4*)(sK + lr * 72 + lc * 8) = pk; *(LAS u32x4*)(sVT + lr * 72 + lc * 8) = pv;
                { const int kn = (kb == kb_hi) ? 5 : kb + 1;
                  if (kn < 9) { const int kr = AT_KROW0(kn); pk = *(const u32x4*)(ak_ + (size_t)(kr + lr) * 256 + kvh * 64 + lc * 8); pv = *(const u32x4*)(xt_ + (size_t)(kvh * 64 + lr) * MT + kr + lc * 8); } }
                __syncthreads();
                bf16x8 kf[4][2], vf[2][4];
#pragma unroll
                for (int tile = 0; tile < 4; ++tile)
#pragma unroll
                    for (int ks = 0; ks < 2; ++ks) kf[tile][ks] = *(const LAS bf16x8*)(sK + (tile * 16 + r16) * 72 + ks * 32 + quad * 8);
#pragma unroll
                for (int ks = 0; ks < 2; ++ks)
#pragma unroll
                    for (int dt = 0; dt < 4; ++dt) { const u32x2 lo = *(const LAS u32x2*)(sVT + (dt * 16 + r16) * 72 + ks * 32 + quad * 4), hi = *(const LAS u32x2*)(sVT + (dt * 16 + r16) * 72 + ks * 32 + 16 + quad * 4);
                        const u32x4 w = (u32x4){lo.x, lo.y, hi.x, hi.y}; vf[ks][dt] = __builtin_bit_cast(bf16x8, w); }
#pragma unroll
                for (int g = 0; g < 2; ++g) {
                    f32x4 s[4];
#pragma unroll
                    for (int tile = 0; tile < 4; ++tile) { s[tile] = (f32x4){0.f, 0.f, 0.f, 0.f};
#pragma unroll
                        for (int ks = 0; ks < 2; ++ks) s[tile] = mfma16(kf[tile][ks], qf[g][ks], s[tile]); }
                    float mx = -1e30f;
#pragma unroll
                    for (int tile = 0; tile < 4; ++tile)
#pragma unroll
                        for (int j = 0; j < 4; ++j) { const int dd = dl + (tile * 16 + j);
                            const int bad = ((dd - mlo) | (mhi - dd)) >> 31;
                            const float v = s[tile][j] * 0.125f + __int_as_float(bad & (int)0xF149F2CAu); s[tile][j] = v; mx = fmaxf(mx, v); }
                    mx = fmaxf(mx, __shfl_xor(mx, 16)); mx = fmaxf(mx, __shfl_xor(mx, 32));
                    const float mn = fmaxf(mrow[g], mx), alpha = __expf(mrow[g] - mn); mrow[g] = mn; float rs = 0.f;
                    unsigned pw[4][2];
#pragma unroll
                    for (int tile = 0; tile < 4; ++tile) { f32x4 pe;
#pragma unroll
                        for (int j = 0; j < 4; ++j) { pe[j] = __expf(s[tile][j] - mn); rs += pe[j]; }
                        pw[tile][0] = cvt_pk_bf16(pe[0], pe[1]); pw[tile][1] = cvt_pk_bf16(pe[2], pe[3]); }
                    rs += __shfl_xor(rs, 16); rs += __shfl_xor(rs, 32);
                    lrow[g] = lrow[g] * alpha + rs;
#pragma unroll
                    for (int dt = 0; dt < 4; ++dt) o[g][dt] = o[g][dt] * alpha;
#pragma unroll
                    for (int ks = 0; ks < 2; ++ks) { const u32x4 w = (u32x4){pw[2 * ks][0], pw[2 * ks][1], pw[2 * ks + 1][0], pw[2 * ks + 1][1]}; const bf16x8 pf = __builtin_bit_cast(bf16x8, w);
#pragma unroll
                        for (int dt = 0; dt < 4; ++dt) o[g][dt] = mfma16(vf[ks][dt], pf, o[g][dt]); }
                }
            }
#pragma unroll
            for (int g = 0; g < 2; ++g) { const float inv = 1.f / lrow[g];
                bf16_t* p = ATTO + (size_t)(rowbase + t0 + rt * 16 + r16) * 1024 + (kvh * 4 + hp * 2 + g) * 64 + quad * 4;
#pragma unroll
                for (int dt = 0; dt < 4; ++dt) { u32x2 w; w.x = cvt_pk_bf16(o[g][dt][0] * inv, o[g][dt][1] * inv); w.y = cvt_pk_bf16(o[g][dt][2] * inv, o[g][dt][3] * inv); *(u32x2*)(p + dt * 16) = w; } }
        }
    }
    SEAM(3);

    for (int rep_ = 0; rep_ < (((RPT_MASK >> 4) & 1) ? 2 : 1); ++rep_) { if (rep_) { if (4 == 0) cg::this_grid().sync(); else xcd_barrier(xbar); }
    if (IN(4)) {
        unsigned char* const wsb = A.ws; unsigned char* const dob = (unsigned char*)A.out; (void)wsb; (void)dob;
        const int r16 = lane & 15, quad = lane >> 4;
        LAS bf16_t* sK = (LAS bf16_t*)lds;
        LAS bf16_t* sVT = sK + 128 * 136;
        LAS bf16_t* sS = sVT + 64 * 136;
        LAS bf16_t* sC = sS + 128 * 136;
        LAS float* sgall = (LAS float*)(sC + 80 * 136);
        const float scale = 0.08838834764831845f;
        const int vcu4 = (G % 8 == 0) ? (bx % 8) * (G / 8) + bx / 8 : bx;
        for (int task = vcu4; task < 256; task += G) {
            const int vq = task & 3, dir = (task >> 2) & 1, hh = (task >> 3) & 3, b = task >> 5;
            __syncthreads();
            for (int i = tid; i < 80 * 136 / 2; i += 512) ((LAS unsigned*)sC)[i] = 0u;
            for (int st = wave; st < 18; st += 8) {
                const int t0g = ((st < 2) ? (ML + b * CTX + (dir ? 1 - st : st) * 128) : (b * SEQ + (dir ? 15 - (st - 2) : st - 2) * 128));
                const float* gp = gates + (size_t)(t0g + 2 * lane) * 16 + dir * 8 + hh;
                const float i0 = gp[0], f0 = gp[4], i1 = gp[16], f1 = gp[20];
                const float loc = f0 + f1; float v = loc;
#pragma unroll
                for (int off = 1; off < 64; off <<= 1) { const float t = __shfl_up(v, off); if (lane >= off) v += t; }
                const float total = __shfl(v, 63); const float p0 = v - loc + f0, p1 = p0 + f1;
                const float b0 = dir ? total - p0 + f0 : p0, b1 = dir ? total - p1 + f1 : p1;
                const float cmid = 0.5f * total; LAS float* g = sgall + st * 576;
                g[2 * lane] = __expf(fminf(b0 - cmid, 80.f)); g[2 * lane + 1] = __expf(fminf(b1 - cmid, 80.f));
                g[128 + 2 * lane] = __expf(fminf(i0 - b0 + cmid, 80.f)) * scale; g[128 + 2 * lane + 1] = __expf(fminf(i1 - b1 + cmid, 80.f)) * scale;
                g[256 + 2 * lane] = __expf(fminf(total - b0 + i0, 80.f)) * scale; g[256 + 2 * lane + 1] = __expf(fminf(total - b1 + i1, 80.f)) * scale;
                g[384 + 2 * lane] = __expf(b0); g[384 + 2 * lane + 1] = __expf(b1); if (lane == 0) g[512] = __expf(total);
            }
            f32x4 cacc[4], nacc = (f32x4){0.f, 0.f, 0.f, 0.f};
#pragma unroll
            for (int vt = 0; vt < 4; ++vt) cacc[vt] = (f32x4){0.f, 0.f, 0.f, 0.f};
            bf16_t* Hout = (bf16_t*)(dob + (dir ? DO_HB : DO_HF)); const int sgn = dir ? 1 : -1;
            const bf16_t* const mk_ = MK; const bf16_t* const xt_ = XT; const bf16_t* const mq_ = MQ;
            u32x4 pK[4], pVT[2]; bf16x8 pQ[4];
#define ML_TOK0(st) (((st) < 2) ? (ML + b * CTX + (dir ? 1 - (st) : (st)) * 128) : (b * SEQ + (dir ? 15 - ((st) - 2) : (st) - 2) * 128))
#define ML_PREFETCH(st) do { const int t0_ = ML_TOK0(st); \
                _Pragma("unroll") for (int q_ = 0; q_ < 4; ++q_) { const int i_ = tid + q_ * 512, r_ = i_ >> 4, c_ = i_ & 15; pK[q_] = *(const u32x4*)(mk_ + (size_t)(t0_ + r_) * 512 + hh * 128 + c_ * 8); } \
                if ((st) >= 2) { _Pragma("unroll") for (int ks_ = 0; ks_ < 4; ++ks_) pQ[ks_] = *(const bf16x8*)(mq_ + (size_t)(t0_ + wave * 16 + r16) * 512 + hh * 128 + ks_ * 32 + quad * 8); } \
                _Pragma("unroll") for (int q_ = 0; q_ < 2; ++q_) { const int i_ = tid + q_ * 512, r_ = i_ >> 4, c_ = i_ & 15; pVT[q_] = *(const u32x4*)(xt_ + (size_t)(256 + hh * 256 + vq * 64 + r_) * MT + t0_ + c_ * 8); } \
                } while (0)
            ML_PREFETCH(0);
            for (int step = 0; step < 18; ++step) {
                const bool isctx = step < 2; const int tok0 = ML_TOK0(step);
                const LAS float* sgb = sgall + step * 576; const LAS float *sga = sgb + 128, *sgw = sgb + 256, *sge = sgb + 384, *sgF = sgb + 512;
                __syncthreads();
#pragma unroll
                for (int q = 0; q < 4; ++q) { const int i = tid + q * 512, r = i >> 4, c = i & 15; *(LAS u32x4*)(sK + r * 136 + c * 8) = pK[q]; }
#pragma unroll
                for (int q = 0; q < 2; ++q) { const int i = tid + q * 512, r = i >> 4, c = i & 15; *(LAS u32x4*)(sVT + r * 136 + c * 8) = pVT[q]; }
                bf16x8 qf[4];
#pragma unroll
                for (int ks = 0; ks < 4; ++ks) qf[ks] = pQ[ks];
                if (step + 1 < 18) ML_PREFETCH(step + 1);
                __syncthreads();
                if (!isctx) {
                    const int prow = wave * 16 + r16;
                    f32x4 s[8];
#pragma unroll
                    for (int tile = 0; tile < 8; ++tile) { s[tile] = (f32x4){0.f, 0.f, 0.f, 0.f};
#pragma unroll
                        for (int ks = 0; ks < 4; ++ks) { const bf16x8 kf = *(const LAS bf16x8*)(sK + (tile * 16 + r16) * 136 + ks * 32 + quad * 8); s[tile] = mfma16(kf, qf[ks], s[tile]); } }
                    const float bp = sgb[prow]; float rs = 0.f;
#pragma unroll
                    for (int tile = 0; tile < 8; ++tile) { const f32x4 av = *(const LAS f32x4*)(sga + tile * 16 + quad * 4); f32x4 pe;
#pragma unroll
                        for (int j = 0; j < 4; ++j) { const int dd = (tile * 16 + quad * 4 + j - prow) * sgn;
                            pe[j] = __int_as_float(__float_as_int(s[tile][j] * (bp * av[j])) & ~(dd >> 31)); rs += pe[j]; }
                        u32x2 w; w.x = cvt_pk_bf16(pe[0], pe[1]); w.y = cvt_pk_bf16(pe[2], pe[3]);
                        *(LAS u32x2*)(sS + prow * 136 + tile * 16 + quad * 4) = w; }
                    rs += __shfl_xor(rs, 16); rs += __shfl_xor(rs, 32);
                    asm volatile("s_waitcnt lgkmcnt(0)" ::: "memory");
                    f32x4 a1[4], a2[5];
#pragma unroll
                    for (int vt = 0; vt < 4; ++vt) a1[vt] = (f32x4){0.f, 0.f, 0.f, 0.f};
#pragma unroll
                    for (int vt = 0; vt < 5; ++vt) a2[vt] = (f32x4){0.f, 0.f, 0.f, 0.f};
#pragma unroll
                    for (int ks = 0; ks < 4; ++ks) { const bf16x8 af = *(const LAS bf16x8*)(sS + prow * 136 + ks * 32 + quad * 8);
#pragma unroll
                        for (int vt = 0; vt < 4; ++vt) { const bf16x8 vf = *(const LAS bf16x8*)(sVT + (vt * 16 + r16) * 136 + ks * 32 + quad * 8); a1[vt] = mfma16(vf, af, a1[vt]); } }
#pragma unroll
                    for (int ks = 0; ks < 4; ++ks)
#pragma unroll
                        for (int vt = 0; vt < 5; ++vt) { const bf16x8 cf = *(const LAS bf16x8*)(sC + (vt * 16 + r16) * 136 + ks * 32 + quad * 8); a2[vt] = mfma16(cf, qf[ks], a2[vt]); }
                    const float e = sge[prow];
                    const float qn = __shfl(a2[4][0], r16); const float nq = rs + e * qn; const float inv = 1.f / fmaxf(fabsf(nq), 1.f);
                    bf16_t* hp = Hout + (size_t)(tok0 + prow) * 1024 + hh * 256 + vq * 64 + quad * 4;
#pragma unroll
                    for (int vt = 0; vt < 4; ++vt) { u32x2 w; w.x = cvt_pk_bf16((a1[vt][0] + e * a2[vt][0]) * inv, (a1[vt][1] + e * a2[vt][1]) * inv);
                        w.y = cvt_pk_bf16((a1[vt][2] + e * a2[vt][2]) * inv, (a1[vt][3] + e * a2[vt][3]) * inv); *(u32x2*)(hp + vt * 16) = w; }
                }
                __syncthreads();
                {
                    const float F = sgF[0];
#pragma unroll
                    for (int vt = 0; vt < 4; ++vt) cacc[vt] = cacc[vt] * F;
                    nacc = nacc * F;
                    bf16x8 ones; { const short o1 = (r16 == 0) ? (short)0x3F80 : (short)0;
#pragma unroll
                        for (int e = 0; e < 8; ++e) ones[e] = o1; }
#pragma unroll
                    for (int ks = 0; ks < 4; ++ks) {
                        const LAS bf16_t* kcol = sK + (ks * 32 + quad * 8) * 136 + wave * 16 + r16;
                        const f32x4 w0 = *(const LAS f32x4*)(sgw + ks * 32 + quad * 8), w1 = *(const LAS f32x4*)(sgw + ks * 32 + quad * 8 + 4);
                        f32x4 k0, k1;
#pragma unroll
                        for (int e = 0; e < 4; ++e) { k0[e] = bf2f(kcol[e * 136]) * w0[e]; k1[e] = bf2f(kcol[(4 + e) * 136]) * w1[e]; }
                        const u32x4 pk = pack8(k0, k1); const bf16x8 kts = __builtin_bit_cast(bf16x8, pk);
#pragma unroll
                        for (int vt = 0; vt < 4; ++vt) { const bf16x8 va = *(const LAS bf16x8*)(sVT + (vt * 16 + r16) * 136 + ks * 32 + quad * 8); cacc[vt] = mfma16(kts, va, cacc[vt]); }
                        nacc = mfma16(kts, ones, nacc);
                    }
#pragma unroll
                    for (int vt = 0; vt < 4; ++vt) { u32x2 w; w.x = cvt_pk_bf16(cacc[vt][0], cacc[vt][1]); w.y = cvt_pk_bf16(cacc[vt][2], cacc[vt][3]);
                        *(LAS u32x2*)(sC + (vt * 16 + r16) * 136 + wave * 16 + quad * 4) = w; }
                    if (r16 == 0) { u32x2 w; w.x = cvt_pk_bf16(nacc[0], nacc[1]); w.y = cvt_pk_bf16(nacc[2], nacc[3]); *(LAS u32x2*)(sC + 64 * 136 + wave * 16 + quad * 4) = w; }
                }
            }
        }
    }
    }
    SEAM(4);

    if (IN(5)) {
        unsigned char* const wsb = A.ws; unsigned char* const dob = (unsigned char*)A.out; (void)wsb; (void)dob;
        for (int row = gw; row < ML; row += NGW) {
            const size_t off = (size_t)row * 1024 + lane * 16;
            float ht[16], mo[16];
#pragma unroll
            for (int q = 0; q < 2; ++q) { const u32x4 a = *(const u32x4*)(HF + off + q * 8), c = *(const u32x4*)(HB + off + q * 8), d = *(const u32x4*)(MO + off + q * 8);
#pragma unroll
                for (int e = 0; e < 4; ++e) { ht[q * 8 + 2 * e] = __uint_as_float(a[e] << 16) + __uint_as_float(c[e] << 16); ht[q * 8 + 2 * e + 1] = __uint_as_float(a[e] & 0xffff0000u) + __uint_as_float(c[e] & 0xffff0000u);
                    mo[q * 8 + 2 * e] = __uint_as_float(d[e] << 16); mo[q * 8 + 2 * e + 1] = __uint_as_float(d[e] & 0xffff0000u); } }
            float ss = 0.f;
#pragma unroll
            for (int e = 0; e < 16; ++e) ss += ht[e] * ht[e];
            ss += __shfl_xor(ss, 1); ss += __shfl_xor(ss, 2); ss += __shfl_xor(ss, 4); ss += __shfl_xor(ss, 8);
            const float rs = rsqrtf(ss * (1.f / 256.f) + EPS);
            float r[16];
#pragma unroll
            for (int q = 0; q < 4; ++q) { const f32x4 w = *(const f32x4*)(A.ml_norm_w + lane * 16 + q * 4);
#pragma unroll
                for (int e = 0; e < 4; ++e) r[q * 4 + e] = ht[q * 4 + e] * rs * w[e] * sigmoidf_(mo[q * 4 + e]); }
#pragma unroll
            for (int q = 0; q < 2; ++q) { u32x4 w; w.x = cvt_pk_bf16(r[q * 8 + 0], r[q * 8 + 1]); w.y = cvt_pk_bf16(r[q * 8 + 2], r[q * 8 + 3]); w.z = cvt_pk_bf16(r[q * 8 + 4], r[q * 8 + 5]); w.w = cvt_pk_bf16(r[q * 8 + 6], r[q * 8 + 7]);
                *(u32x4*)(MO + off + q * 8) = w; }
        }
    }
    SEAM(5);

    for (int rep_ = 0; rep_ < (((RPT_MASK >> 6) & 1) ? 2 : 1); ++rep_) { if (rep_) { if (6 == 0) cg::this_grid().sync(); else xcd_barrier(xbar); }
    if (IN(6)) {
        unsigned char* const wsb = A.ws; unsigned char* const dob = (unsigned char*)A.out; (void)wsb; (void)dob;
        pg8::Order S; S.init(64, 4, G, bx, 0);
        { pg8::Gemm g{AQ, WBA, 1024, 1024, 1024, MO, WBM}; EpiMerge E{GA, GM, Y}; pg8::gemm_phase<EpiMerge, pg8::Order, false, true>(lds, g, S, E); }
    }
    }
    SEAM(6);

    for (int rep_ = 0; rep_ < (((RPT_MASK >> 7) & 1) ? 2 : 1); ++rep_) { if (rep_) { if (7 == 0) cg::this_grid().sync(); else xcd_barrier(xbar); }
    if (IN(7)) {
        unsigned char* const wsb = A.ws; unsigned char* const dob = (unsigned char*)A.out; (void)wsb; (void)dob;
        pg8::Order S; S.init(64, 4, G, bx, 0);
#ifdef DBG_P7PLAIN
        pg8::Gemm g{Y, WO, 1024, 1024, 1024}; EpiPlain E{T1, 1024};
        pg8::gemm_phase<EpiPlain, pg8::Order, false>(lds, g, S, E);
#else
        pg8::Gemm g{Y, WO, 1024, 1024, 1024}; EpiOut E{A.x, mod, A.norm2_w, (float*)dob, AQ, rowsq};
        pg8::gemm_phase<EpiOut, pg8::Order, false>(lds, g, S, E);
#endif
    }
    }
    SEAM(7);

    for (int rep_ = 0; rep_ < (((RPT_MASK >> 8) & 1) ? 2 : 1); ++rep_) { if (rep_) { if (8 == 0) cg::this_grid().sync(); else xcd_barrier(xbar); }
    if (IN(8)) {
        unsigned char* const wsb = A.ws; unsigned char* const dob = (unsigned char*)A.out; (void)wsb; (void)dob;
        pg8::Order S; S.init(64, 22, G, bx, 0);
        pg8::Gemm g{AQ, WUP, 1024, 1024, 1024}; EpiUp E{rowsq, fbias, A.conv_w, A.conv_b, ACT, RAWU, (LAS float*)(lds + 131072)};
        pg8::gemm_phase<EpiUp, pg8::Order, true>(lds, g, S, E);
    }
    }
    SEAM(8);

    if (IN(9)) {
        unsigned char* const wsb = A.ws; unsigned char* const dob = (unsigned char*)A.out; (void)wsb; (void)dob;
        const float* cw = A.conv_w; const float* cb = A.conv_b;
        for (int task = bx * 512 + tid; task < 1025 * 352; task += G * 512) {
            const int ch = task % 352, bd = task / 352, j0 = ch * 8;
            const int pc = 256 * (j0 >> 7) + (j0 & 127);
            const bool lo_ok = bd > 0, hi_ok = bd < 1024, seam = ((bd * 16) & 2047) == 0;
            const u32x4 zero = (u32x4){0u, 0u, 0u, 0u};
            u32x4 xa[4], xg[4];
#pragma unroll
            for (int k = 0; k < 4; ++k) { xa[k] = zero; xg[k] = zero; }
            if (lo_ok) { const bf16_t* rp = RAWU + ((size_t)(bd - 1) * 4 + 2) * NUP + pc; xa[0] = *(const u32x4*)rp; xg[0] = *(const u32x4*)(rp + 128); xa[1] = *(const u32x4*)(rp + NUP); xg[1] = *(const u32x4*)(rp + NUP + 128); }
            if (hi_ok) { const bf16_t* rp = RAWU + ((size_t)bd * 4) * NUP + pc; xa[2] = *(const u32x4*)rp; xg[2] = *(const u32x4*)(rp + 128); xa[3] = *(const u32x4*)(rp + NUP); xg[3] = *(const u32x4*)(rp + NUP + 128); }
            float wa[3][8], wg[3][8], ba[8], bg[8];
#pragma unroll
            for (int i = 0; i < 3; ++i)
#pragma unroll
                for (int q = 0; q < 2; ++q) { const f32x4 a = *(const f32x4*)(cw + i * NUP + j0 + 4 * q), g = *(const f32x4*)(cw + i * NUP + DFF + j0 + 4 * q);
#pragma unroll
                    for (int e = 0; e < 4; ++e) { wa[i][4 * q + e] = a[e]; wg[i][4 * q + e] = g[e]; } }
#pragma unroll
            for (int q = 0; q < 2; ++q) { const f32x4 a = *(const f32x4*)(cb + j0 + 4 * q), g = *(const f32x4*)(cb + DFF + j0 + 4 * q);
#pragma unroll
                for (int e = 0; e < 4; ++e) { ba[4 * q + e] = a[e]; bg[4 * q + e] = g[e]; } }
#pragma unroll
            for (int side = 0; side < 2; ++side) {
                if (side == 0 ? !lo_ok : !hi_ok) continue;
                float r[8];
#pragma unroll
                for (int e = 0; e < 8; ++e) { const int w = e >> 1; const bool hi16 = e & 1;
                    float va[3], vg[3];
#pragma unroll
                    for (int k = 0; k < 3; ++k) { const unsigned aw = xa[side + k][w], gw = xg[side + k][w];
                        va[k] = hi16 ? __uint_as_float(aw & 0xffff0000u) : __uint_as_float(aw << 16); vg[k] = hi16 ? __uint_as_float(gw & 0xffff0000u) : __uint_as_float(gw << 16); }
                    if (seam) { if (side == 0) { va[2] = 0.f; vg[2] = 0.f; } else { va[0] = 0.f; vg[0] = 0.f; } }
                    const float av = ba[e] + wa[0][e] * va[0] + wa[1][e] * va[1] + wa[2][e] * va[2];
                    const float gv = bg[e] + wg[0][e] * vg[0] + wg[1][e] * vg[1] + wg[2][e] * vg[2];
                    r[e] = gv * sigmoidf_(gv) * av; }
                u32x4 w; w.x = cvt_pk_bf16(r[0], r[1]); w.y = cvt_pk_bf16(r[2], r[3]); w.z = cvt_pk_bf16(r[4], r[5]); w.w = cvt_pk_bf16(r[6], r[7]);
                *(u32x4*)(ACT + (size_t)(bd * 16 - 1 + side) * DFF + j0) = w;
            }
        }
    }
    SEAM(9);

    if (IN(10)) {
        unsigned char* const wsb = A.ws; unsigned char* const dob = (unsigned char*)A.out; (void)wsb; (void)dob;
        pg8::Order S; S.init(64, 4, G, bx, 0);
        pg8::Gemm g{ACT, WDN, DFF, DFF, DFF}; EpiDown E{(float*)dob, mod, AQ, A.norm2_w};
        pg8::gemm_phase<EpiDown, pg8::Order, false>(lds, g, S, E);
    }
#undef IN
#undef SEAM
}
#undef A

extern "C" void kernel_launch(void* const* d_in, const int* in_sizes, int n_in, void* d_out, int out_size, void* d_ws, size_t ws_size, hipStream_t stream) {
    static int grid = 0;
    if (grid == 0) {
        if (n_in != 21 || out_size != ML * D || ws_size < WS_END) { fprintf(stderr, "kernel_launch: unexpected shapes (n_in %d out %d ws %zu)\n", n_in, out_size, ws_size); grid = -1; return; }
        int dev = 0, cus = 0, per_cu = 0;
        hipGetDevice(&dev); hipDeviceGetAttribute(&cus, hipDeviceAttributeMultiprocessorCount, dev);
        hipFuncSetAttribute((const void*)fwd_kernel, hipFuncAttributeMaxDynamicSharedMemorySize, LDS_BYTES);
        hipOccupancyMaxActiveBlocksPerMultiprocessor(&per_cu, (const void*)fwd_kernel, 512, LDS_BYTES);
        if (per_cu < 1) { fprintf(stderr, "kernel_launch: occupancy query says %d blocks per CU\n", per_cu); per_cu = 1; }
        grid = cus * per_cu;
        (void)hipGetLastError();
    }
    if (grid < 0) return;
    Args a{};
    const float** pp = (const float**)&a;
    for (int i = 0; i < 21; ++i) pp[i] = (const float*)d_in[i];
    a.out = (float*)d_out; a.ws = (unsigned char*)d_ws;
#if ONE_LAUNCH
    a.ph_lo = 0; a.ph_hi = 11;
    void* args[] = {&a};
    hipError_t e = hipLaunchCooperativeKernel((const void*)fwd_kernel, dim3(grid), dim3(512), args, LDS_BYTES, stream);
    if (e != hipSuccess) fprintf(stderr, "cooperative launch failed: %s (grid %d)\n", hipGetErrorString(e), grid);
#else
    for (int p = 0; p < 11; ++p) { a.ph_lo = p; a.ph_hi = p + 1; hipLaunchKernelGGL(fwd_kernel, dim3(grid), dim3(512), LDS_BYTES, stream, a); }

#endif
}
```

```cpp
#include <hip/hip_runtime.h>
#include <hip/hip_cooperative_groups.h>
#include <cstdio>
#include <cstdint>
namespace cg = cooperative_groups;

#ifndef RPT_MASK
#define RPT_MASK 0
#endif
#ifndef ONE_LAUNCH
#define ONE_LAUNCH 1
#endif

#define LAS __attribute__((address_space(3)))
typedef unsigned short bf16_t;
typedef short bf16x8 __attribute__((ext_vector_type(8)));
typedef float f32x4 __attribute__((ext_vector_type(4)));
typedef unsigned u32x4 __attribute__((ext_vector_type(4)));
typedef unsigned u32x2 __attribute__((ext_vector_type(2)));

constexpr int D = 1024, NB = 8, SEQ = 2048, CTX = 256;
constexpr int ML = NB * SEQ;
constexpr int MC = NB * CTX;
constexpr int MT = ML + MC;
constexpr int DFF = 2816, NUP = 2 * DFF, INW = 6672;
constexpr float EPS = 1e-6f;
constexpr size_t MiB = 1u << 20;
constexpr size_t WS_ZERO = 0;
constexpr size_t WS_MOD = 0, WS_FB = 256 * 1024, WS_RSQ = 512 * 1024;
constexpr size_t WS_MODP = 236 * MiB + 12 * MiB;
constexpr size_t WS_RSQP = 252 * MiB;
constexpr size_t DO_FBP = 60 * MiB;
constexpr size_t WS_ROPE = 1 * MiB;
constexpr size_t WS_GATES = 2 * MiB;
constexpr size_t WS_WBA = 4 * MiB, WS_WBM = 6 * MiB, WS_WO = 8 * MiB, WS_WUP = 10 * MiB, WS_WDN = 21 * MiB;
constexpr size_t WS_AQ = 27 * MiB;
constexpr size_t WS_MQ = 59 * MiB, WS_MK = 75 * MiB  , WS_MO = 93 * MiB, WS_GA = 125 * MiB, WS_GM = 157 * MiB, WS_XT = 189 * MiB  ;
constexpr size_t WS_T1 = 59 * MiB, WS_Y = 189 * MiB;
constexpr size_t WS_U = 59 * MiB;
constexpr size_t WS_HALO = 236 * MiB;
constexpr size_t WS_ACT = 59 * MiB;
constexpr size_t WS_RAW = 147 * MiB;
constexpr size_t WS_END = 256 * MiB;
constexpr size_t DO_H = 0, DO_W1T = 36 * MiB, DO_W2T = 47 * MiB, DO_AK = 51 * MiB;
constexpr size_t DO_HF = 0, DO_HB = 32 * MiB;
constexpr int LDS_BYTES = 157696;

typedef float f32x2_t __attribute__((ext_vector_type(2))); typedef __bf16 bf16x2_t __attribute__((ext_vector_type(2)));
__device__ __forceinline__ unsigned cvt_pk_bf16(float lo, float hi) { f32x2_t v = {lo, hi}; bf16x2_t b = __builtin_convertvector(v, bf16x2_t); return __builtin_bit_cast(unsigned, b); }
__device__ __forceinline__ float bf2f(unsigned short v) { return __uint_as_float((unsigned)v << 16); }
__device__ __forceinline__ bf16_t f2bf(float f) { return (bf16_t)(cvt_pk_bf16(f, 0.f) & 0xffffu); }
__device__ __forceinline__ u32x4 pack8(f32x4 a, f32x4 b) { u32x4 w; w.x = cvt_pk_bf16(a[0], a[1]); w.y = cvt_pk_bf16(a[2], a[3]); w.z = cvt_pk_bf16(b[0], b[1]); w.w = cvt_pk_bf16(b[2], b[3]); return w; }
__device__ __forceinline__ float sigmoidf_(float x) { return __builtin_amdgcn_rcpf(1.f + __expf(-x)); }
__device__ __forceinline__ float sigmoid_div(float x) { return 1.f / (1.f + __expf(-x)); }
__device__ __forceinline__ float wave_sum(float v) {
#pragma unroll
    for (int o = 1; o < 64; o <<= 1) v += __shfl_xor(v, o);
    return v;
}

namespace pg8 {
constexpr int BM = 256, BK = 64, HALF = 128, HTB = HALF * BK * 2, STAGE_BYTES = 8 * HTB, NXCD = 8, WGM = 8;
__host__ __device__ __forceinline__ int lds_byte(int r, int c) { const int st = (r >> 4) * 2 + (c >> 5), rr = r & 15, cc = c & 31, ob = rr * 64 + cc * 2; return st * 1024 + (ob ^ (((ob >> 9) & 1) << 5)); }
__host__ __device__ __forceinline__ void stage_rc(int b, int& R, int& C) { const int st = b / 1024, sb = b % 1024, swz = sb ^ (((sb >> 9) & 1) << 5); R = (st >> 1) * 16 + swz / 64; C = (st & 1) * 32 + (swz % 64) / 2; }
__host__ __device__ __forceinline__ int perm32(int rho) { const int n = rho >> 4, i = rho & 15; return 8 * (i >> 2) + 4 * n + (i & 3); }

struct Unit { int pm, pn; };
struct Gemm { const bf16_t* A; const bf16_t* Bt; int lda, ldb, K; const bf16_t* A2 = nullptr; const bf16_t* Bt2 = nullptr; };

struct Order {
    int nM, nN, nwg, G, c, extra;
    __device__ __forceinline__ void init(int nM_, int nN_, int G_, int c_, int extra_) { nM = nM_; nN = nN_; nwg = nM_ * nN_; G = G_; c = c_; extra = extra_; }
    __device__ __forceinline__ bool next(int i, Unit& u) const {
        const long Lq = (long)i * G + c; if (Lq >= nwg + extra) return false;
        if (Lq >= nwg) { const int e = (int)(Lq - nwg); u.pm = nM + e / 3; u.pn = e % 3; return true; }
        int wgid = (int)Lq; { const int q = nwg / NXCD, r = nwg % NXCD, xcd = wgid % NXCD, off = wgid / NXCD; wgid = (xcd < r ? xcd * (q + 1) : r * (q + 1) + (xcd - r) * q) + off; }
        const int nig = WGM * nN, gid = wgid / nig, fm = gid * WGM, gsz = (nM - fm) < WGM ? (nM - fm) : WGM;
        u.pm = fm + ((wgid % nig) % gsz); u.pn = (wgid % nig) / gsz; return true;
    }
};

template <class Epi, class Sched, bool ALIGN_EPI, bool DUAL = false>
__device__ __forceinline__ void gemm_phase(LAS unsigned char* lds, const Gemm g, const Sched& S, const Epi& E) {
    int tid_ = threadIdx.x; asm volatile("" : "+v"(tid_));
    const int tid = tid_, wid = __builtin_amdgcn_readfirstlane(tid >> 6), lane = tid & 63, wr = wid >> 2, wc = wid & 3, fr = lane & 15, fq = lane >> 4;
    const int K = g.K, nt1 = K / BK, nt = DUAL ? 2 * nt1 : nt1;
    unsigned voffA[2], voffB[2];
#pragma unroll
    for (int i = 0; i < 2; ++i) { int R, C; stage_rc(tid * 16 + i * 8192, R, C); const int Rb = ((R & ~31) + perm32(R & 31));
        voffA[i] = (unsigned)(R * g.lda + C) * 2u; voffB[i] = (unsigned)(Rb * g.ldb + C) * 2u; }
    const size_t kstep = (size_t)(BK * 2);
    const size_t hstepA = (size_t)HALF * g.lda * 2, hstepB = (size_t)HALF * g.ldb * 2;
    const size_t tstepA = 2 * hstepA, tstepB = 2 * hstepB;
    const unsigned ldsw = (unsigned)wid * 1024u;
    const int aoff = lds_byte(wr * 64 + fr, fq * 8), boff = lds_byte(wc * 32 + fr, fq * 8);
#define PG8_SA(b, h) (((b) * 2 + (h)) * HTB)
#define PG8_SB(b, h) ((4 + (b) * 2 + (h)) * HTB)
#define PG8_STAGE(bufoff, gbase, voff) do { _Pragma("unroll") for (int _i = 0; _i < 2; ++_i) \
        __builtin_amdgcn_global_load_lds((const unsigned*)((const char*)(gbase) + (voff)[_i]), (LAS unsigned*)(lds + (bufoff) + ldsw + _i * 8192), 16, 0, 0); } while (0)
#define PG8_LDA(dst, b, h) do { _Pragma("unroll") for (int m = 0; m < 4; ++m) _Pragma("unroll") for (int k = 0; k < 2; ++k) dst[m][k] = *(const LAS bf16x8*)(lds + PG8_SA(b, h) + aoff + m * 2048 + k * 1024); } while (0)
#define PG8_LDB(dst, b, h) do { _Pragma("unroll") for (int n = 0; n < 2; ++n) _Pragma("unroll") for (int k = 0; k < 2; ++k) dst[n][k] = *(const LAS bf16x8*)(lds + PG8_SB(b, h) + boff + n * 2048 + k * 1024); } while (0)
#define PG8_MMA(ai, bj, At, Bt) do { __builtin_amdgcn_s_setprio(1); _Pragma("unroll") for (int m = 0; m < 4; ++m) _Pragma("unroll") for (int n = 0; n < 2; ++n) _Pragma("unroll") for (int k = 0; k < 2; ++k) \
        acc[ai][bj][m][n] = __builtin_amdgcn_mfma_f32_16x16x32_bf16(Bt[n][k], At[m][k], acc[ai][bj][m][n], 0, 0, 0); __builtin_amdgcn_s_setprio(0); } while (0)
#define PG8_WAIT_V(n) asm volatile("s_waitcnt vmcnt(" #n ")" ::: "memory")
#define PG8_WAIT_L(n) asm volatile("s_waitcnt lgkmcnt(" #n ")" ::: "memory")
#define PG8_BAR __builtin_amdgcn_s_barrier()
#define PG8_SCHED __builtin_amdgcn_sched_barrier(0)
    Unit cur, nxt; int ui = 0;
    if (!S.next(0, cur)) return;
    f32x4 acc[2][2][4][2];
#pragma unroll
    for (int a = 0; a < 2; ++a)
#pragma unroll
        for (int b = 0; b < 2; ++b)
#pragma unroll
            for (int m = 0; m < 4; ++m)
#pragma unroll
                for (int n = 0; n < 2; ++n) acc[a][b][m][n] = (f32x4){0.f, 0.f, 0.f, 0.f};
    bf16x8 At[4][2], B0[2][2], B1[2][2];
    const char* cA = (const char*)g.A + (size_t)cur.pm * tstepA; const char* cB = (const char*)g.Bt + (size_t)cur.pn * tstepB;
    const char* cA2 = DUAL ? (const char*)g.A2 + (size_t)cur.pm * tstepA : cA; const char* cB2 = DUAL ? (const char*)g.Bt2 + (size_t)cur.pn * tstepB : cB;
    PG8_STAGE(PG8_SB(0, 0), cB, voffB); PG8_STAGE(PG8_SB(0, 1), cB + hstepB, voffB); PG8_STAGE(PG8_SA(0, 0), cA, voffA); PG8_STAGE(PG8_SA(0, 1), cA + hstepA, voffA);
    if (wr == 1) PG8_BAR;
    PG8_WAIT_V(2); PG8_BAR;
    PG8_STAGE(PG8_SB(1, 0), cB + kstep, voffB); PG8_STAGE(PG8_SA(1, 0), cA + kstep, voffA); PG8_STAGE(PG8_SB(1, 1), cB + hstepB + kstep, voffB);
    PG8_WAIT_V(6); PG8_BAR;
    for (;;) {
        const bool has_next = S.next(ui + 1, nxt);
        const char* nA = has_next ? (const char*)g.A + (size_t)nxt.pm * tstepA : cA; const char* nB = has_next ? (const char*)g.Bt + (size_t)nxt.pn * tstepB : cB;
        for (int t = 0; t < nt; t += 2) {
            const bool last = (t == nt - 2);
            const bool seg2 = DUAL && t >= nt1, seg2n = DUAL && t + 2 >= nt1;
            const char* a1 = seg2 ? cA2 + (size_t)(t + 1 - nt1) * kstep : cA + (size_t)(t + 1) * kstep;
            const char* a2 = last ? nA : (seg2n ? cA2 + (size_t)(t + 2 - nt1) * kstep : cA + (size_t)(t + 2) * kstep);
            const char* b2 = last ? nB : (seg2n ? cB2 + (size_t)(t + 2 - nt1) * kstep : cB + (size_t)(t + 2) * kstep);
            if constexpr (DUAL) { if (t == nt1) E.mid(acc, cur, wr, wc, fr, fq); }
            const char* a3 = a2 + kstep; const char* b3 = b2 + kstep;
            PG8_LDB(B0, 0, 0); PG8_LDB(B1, 0, 1); PG8_SCHED; PG8_LDA(At, 0, 0); PG8_STAGE(PG8_SA(1, 1), a1 + hstepA, voffA);
            PG8_WAIT_V(8); PG8_WAIT_L(0); PG8_BAR; PG8_MMA(0, 0, At, B0); PG8_MMA(0, 1, At, B1); PG8_BAR; PG8_SCHED;
            PG8_LDA(At, 0, 1); PG8_STAGE(PG8_SB(0, 0), b2, voffB); PG8_STAGE(PG8_SB(0, 1), b2 + hstepB, voffB); PG8_STAGE(PG8_SA(0, 0), a2, voffA);
            PG8_WAIT_V(8); PG8_WAIT_L(0); PG8_BAR; PG8_MMA(1, 0, At, B0); PG8_MMA(1, 1, At, B1); PG8_BAR; PG8_SCHED;
            PG8_LDB(B0, 1, 0); PG8_LDB(B1, 1, 1); PG8_SCHED; PG8_LDA(At, 1, 0); PG8_STAGE(PG8_SA(0, 1), a2 + hstepA, voffA);
            PG8_WAIT_V(8); PG8_WAIT_L(0); PG8_BAR; PG8_MMA(0, 0, At, B0); PG8_MMA(0, 1, At, B1); PG8_BAR; PG8_SCHED;
            PG8_LDA(At, 1, 1); PG8_STAGE(PG8_SB(1, 0), b3, voffB); PG8_STAGE(PG8_SB(1, 1), b3 + hstepB, voffB); PG8_STAGE(PG8_SA(1, 0), a3, voffA);
            PG8_WAIT_V(8); PG8_WAIT_L(0); PG8_BAR; PG8_MMA(1, 0, At, B0); PG8_MMA(1, 1, At, B1); PG8_BAR; PG8_SCHED;
        }
        if constexpr (ALIGN_EPI) { if (wr == 0) PG8_BAR; }
        E(acc, cur, wr, wc, fr, fq);
        if (!has_next) break;
#pragma unroll
        for (int a = 0; a < 2; ++a)
#pragma unroll
            for (int b = 0; b < 2; ++b)
#pragma unroll
                for (int m = 0; m < 4; ++m)
#pragma unroll
                    for (int n = 0; n < 2; ++n) acc[a][b][m][n] = (f32x4){0.f, 0.f, 0.f, 0.f};
        cur = nxt; cA = nA; cB = nB; ++ui;
        if constexpr (DUAL) { cA2 = (const char*)g.A2 + (size_t)cur.pm * tstepA; cB2 = (const char*)g.Bt2 + (size_t)cur.pn * tstepB; }
        if constexpr (ALIGN_EPI) { if (wr == 1) PG8_BAR; }
    }
    PG8_WAIT_V(0);
    if constexpr (!ALIGN_EPI) { if (wr == 0) PG8_BAR; }
    PG8_BAR;
#undef PG8_SA
#undef PG8_SB
#undef PG8_STAGE
#undef PG8_LDA
#undef PG8_LDB
#undef PG8_MMA
#undef PG8_WAIT_V
#undef PG8_WAIT_L
#undef PG8_BAR
#undef PG8_SCHED
}
}
using pg8::Unit;
typedef const f32x4 (&AccRef)[2][2][4][2];

struct EpiIn {
    bf16_t *AK_, *MK_, *AQ_, *MQ_, *MO_, *GA_, *GM_; const float *qnw, *knw, *cosT_, *sinT_; LAS float* sp;
    __device__ __forceinline__ void head_path(AccRef acc, const Unit& u, int wr, int wc, int fr, int fq_in, bf16_t* base, int ld, int coff, const float* nw) const {
        int fq = fq_in; asm volatile("" : "+v"(fq));
        const int row0 = u.pm * 256 + wr * 64 + fr;
        const bool rope = u.pm < 64;
        { int tx = threadIdx.x; asm volatile("" : "+v"(tx)); const int tt0 = (u.pm * 256) & 2047;
          for (int i = tx; i < (rope ? 2512 : 64); i += 512) { float v;
              if (i < 64) v = nw[i];
              else if (i < 208) { const int k = i - 64, gi = k / 36, e = k - gi * 36; const int t = tt0 + 64 * gi; v = e < 16 ? cosT_[t * 32 + e] : e < 32 ? sinT_[t * 32 + e - 16] : 0.f; }
              else { const int k = i - 208, c = k / 36, e = k - c * 36; const int t = tt0 + c; v = e < 16 ? cosT_[t * 32 + 16 + e] : e < 32 ? sinT_[t * 32 + e] : 0.f; }
              sp[i] = v; }
          asm volatile("s_waitcnt vmcnt(0) lgkmcnt(0)" ::: "memory"); __builtin_amdgcn_s_barrier(); asm volatile("" ::: "memory"); }
        const f32x4 w00 = *(const LAS f32x4*)(sp + 8 * fq), w01 = *(const LAS f32x4*)(sp + 8 * fq + 4), w10 = *(const LAS f32x4*)(sp + 32 + 8 * fq), w11 = *(const LAS f32x4*)(sp + 32 + 8 * fq + 4);
#pragma unroll
        for (int ai = 0; ai < 2; ++ai)
#pragma unroll
            for (int m = 0; m < 4; ++m) {
                const int row = row0 + ai * 128 + m * 16;
                f32x4 v00 = acc[ai][0][m][0], v01 = acc[ai][0][m][1], v10 = acc[ai][1][m][0], v11 = acc[ai][1][m][1];
                f32x4 q = v00 * v00 + v01 * v01 + v10 * v10 + v11 * v11;
                float ss = (q[0] + q[1]) + (q[2] + q[3]);
                ss += __shfl_xor(ss, 16); ss += __shfl_xor(ss, 32);
                const float rs = rsqrtf(ss * (1.f / 64.f) + EPS);
                v00 = v00 * rs * w00; v01 = v01 * rs * w01; v10 = v10 * rs * w10; v11 = v11 * rs * w11;
                f32x4 o00 = v00, o01 = v01, o10 = v10, o11 = v11;
                if (rope) {
                    const int r = ai * 128 + wr * 64 + m * 16 + fr;
                    const LAS float* cp = sp + ((fq < 2) ? 64 + (r >> 6) * 36 + 8 * fq : 208 + (r & 63) * 36 + 8 * (fq - 2));
                    const f32x4 c0 = *(const LAS f32x4*)cp, c1 = *(const LAS f32x4*)(cp + 4), s0 = *(const LAS f32x4*)(cp + 16), s1 = *(const LAS f32x4*)(cp + 20);
                    o00 = v00 * c0 - v10 * s0; o01 = v01 * c1 - v11 * s1; o10 = v00 * s0 + v10 * c0; o11 = v01 * s1 + v11 * c1;
                }
                bf16_t* p = base + (size_t)row * ld + coff + wc * 64 + 8 * fq;
                *(u32x4*)p = pack8(o00, o01); *(u32x4*)(p + 32) = pack8(o10, o11);
                asm volatile("" ::: "memory");
            }
    }
    template <bool SIG> __device__ __forceinline__ void plain_path(AccRef acc, const Unit& u, int wr, int wc, int fr, int fq, bf16_t* base, int ld, int coff) const {
        const int row0 = u.pm * 256 + wr * 64 + fr;
#pragma unroll
        for (int ai = 0; ai < 2; ++ai)
#pragma unroll
            for (int m = 0; m < 4; ++m) {
                bf16_t* p = base + (size_t)(row0 + ai * 128 + m * 16) * ld + coff + wc * 32 + 8 * fq;
#pragma unroll
                for (int bj = 0; bj < 2; ++bj) { f32x4 v0 = acc[ai][bj][m][0], v1 = acc[ai][bj][m][1];
                    if (SIG) {
#pragma unroll
                        for (int e = 0; e < 4; ++e) { v0[e] = sigmoid_div(v0[e]); v1[e] = sigmoid_div(v1[e]); } }
                    *(u32x4*)(p + bj * 128) = pack8(v0, v1); }
            }
    }
    __device__ __forceinline__ void operator()(AccRef acc, const Unit& u, int wr, int wc, int fr, int fq) const {
        const int pn = u.pn;
        if (pn == 0) head_path(acc, u, wr, wc, fr, fq, AK_, 256, 0, knw);
        else if (pn <= 2) plain_path<false>(acc, u, wr, wc, fr, fq, MK_, 512, (pn - 1) * 256);
        else if (pn <= 6) head_path(acc, u, wr, wc, fr, fq, AQ_, 1024, (pn - 3) * 256, qnw);
        else if (pn <= 8) plain_path<false>(acc, u, wr, wc, fr, fq, MQ_, 512, (pn - 7) * 256);
        else if (pn <= 12) plain_path<false>(acc, u, wr, wc, fr, fq, MO_, 1024, (pn - 9) * 256);
        else if (pn <= 16) plain_path<true>(acc, u, wr, wc, fr, fq, GA_, 1024, (pn - 13) * 256);
        else plain_path<true>(acc, u, wr, wc, fr, fq, GM_, 1024, (pn - 17) * 256);
    }
};
struct EpiPlain {
    bf16_t* O; int ldc;
    __device__ __forceinline__ void operator()(AccRef acc, const Unit& u, int wr, int wc, int fr, int fq) const {
        const int row0 = u.pm * 256 + wr * 64 + fr;
#pragma unroll
        for (int ai = 0; ai < 2; ++ai)
#pragma unroll
            for (int m = 0; m < 4; ++m) {
                bf16_t* p = O + (size_t)(row0 + ai * 128 + m * 16) * ldc + u.pn * 256 + wc * 32 + 8 * fq;
#pragma unroll
                for (int bj = 0; bj < 2; ++bj) *(u32x4*)(p + bj * 128) = pack8(acc[ai][bj][m][0], acc[ai][bj][m][1]);
            }
    }
};
template <bool ADD> struct EpiGate {
    const bf16_t* Gt; const bf16_t* T; bf16_t* O;
    __device__ __forceinline__ void operator()(AccRef acc, const Unit& u, int wr, int wc, int fr, int fq) const {
        const int row0 = u.pm * 256 + wr * 64 + fr;
        const size_t off0 = (size_t)row0 * 1024 + u.pn * 256 + wc * 32 + 8 * fq;
        u32x4 gv[2][2], tv[2][2];
#pragma unroll
        for (int bj = 0; bj < 2; ++bj) { gv[0][bj] = *(const u32x4*)(Gt + off0 + bj * 128); tv[0][bj] = (u32x4){0u, 0u, 0u, 0u}; if (ADD) tv[0][bj] = *(const u32x4*)(T + off0 + bj * 128); }
#pragma unroll
        for (int it = 0; it < 8; ++it) {
            const int ai = it >> 2, m = it & 3, cur = it & 1, nx = cur ^ 1;
            const size_t off = off0 + (size_t)(ai * 128 + m * 16) * 1024;
            if (it < 7) { const size_t offn = off0 + (size_t)(((it + 1) >> 2) * 128 + ((it + 1) & 3) * 16) * 1024;
#pragma unroll
                for (int bj = 0; bj < 2; ++bj) { gv[nx][bj] = *(const u32x4*)(Gt + offn + bj * 128); tv[nx][bj] = (u32x4){0u, 0u, 0u, 0u}; if (ADD) tv[nx][bj] = *(const u32x4*)(T + offn + bj * 128); } }
#pragma unroll
            for (int bj = 0; bj < 2; ++bj) {
                float r[8];
#pragma unroll
                for (int e = 0; e < 8; ++e) {
                    const unsigned gw = gv[cur][bj][e >> 1], tw = tv[cur][bj][e >> 1];
                    const float gg = (e & 1) ? __uint_as_float(gw & 0xffff0000u) : __uint_as_float(gw << 16);
                    const float tt = (e & 1) ? __uint_as_float(tw & 0xffff0000u) : __uint_as_float(tw << 16);
                    r[e] = tt + sigmoidf_(gg) * acc[ai][bj][m][e >> 2][e & 3];
                }
                u32x4 w; w.x = cvt_pk_bf16(r[0], r[1]); w.y = cvt_pk_bf16(r[2], r[3]); w.z = cvt_pk_bf16(r[4], r[5]); w.w = cvt_pk_bf16(r[6], r[7]);
                *(u32x4*)(O + off + bj * 128) = w;
            }
        }
    }
};
struct EpiMerge {
    const bf16_t* Sa; const bf16_t* Sm; bf16_t* O;
    __device__ __forceinline__ void mid(f32x4 (&acc)[2][2][4][2], const Unit& u, int wr, int wc, int fr, int fq) const {
        const size_t off0 = (size_t)(u.pm * 256 + wr * 64 + fr) * 1024 + u.pn * 256 + wc * 32 + 8 * fq;
        u32x4 av[2][2], mv[2][2];
#pragma unroll
        for (int bj = 0; bj < 2; ++bj) { av[0][bj] = *(const u32x4*)(Sa + off0 + bj * 128); mv[0][bj] = *(const u32x4*)(Sm + off0 + bj * 128); }
#pragma unroll
        for (int it = 0; it < 8; ++it) {
            const int ai = it >> 2, m = it & 3, cur = it & 1, nx = cur ^ 1;
            if (it < 7) { const size_t offn = off0 + (size_t)(((it + 1) >> 2) * 128 + ((it + 1) & 3) * 16) * 1024;
#pragma unroll
                for (int bj = 0; bj < 2; ++bj) { av[nx][bj] = *(const u32x4*)(Sa + offn + bj * 128); mv[nx][bj] = *(const u32x4*)(Sm + offn + bj * 128); } }
#pragma unroll
            for (int bj = 0; bj < 2; ++bj)
#pragma unroll
                for (int e = 0; e < 8; ++e) {
                    const unsigned aw = av[cur][bj][e >> 1], mw = mv[cur][bj][e >> 1];
                    const float sa = (e & 1) ? __uint_as_float(aw & 0xffff0000u) : __uint_as_float(aw << 16);
                    const float sm = (e & 1) ? __uint_as_float(mw & 0xffff0000u) : __uint_as_float(mw << 16);
                    acc[ai][bj][m][e >> 2][e & 3] *= sa * __builtin_amdgcn_rcpf(fmaxf(sm, 1e-30f));
                }
        }
    }
    __device__ __forceinline__ void operator()(AccRef acc, const Unit& u, int wr, int wc, int fr, int fq) const {
        const size_t off0 = (size_t)(u.pm * 256 + wr * 64 + fr) * 1024 + u.pn * 256 + wc * 32 + 8 * fq;
        u32x4 mv[2][2];
#pragma unroll
        for (int bj = 0; bj < 2; ++bj) mv[0][bj] = *(const u32x4*)(Sm + off0 + bj * 128);
#pragma unroll
        for (int it = 0; it < 8; ++it) {
            const int ai = it >> 2, m = it & 3, cur = it & 1, nx = cur ^ 1;
            const size_t off = off0 + (size_t)(ai * 128 + m * 16) * 1024;
            if (it < 7) { const size_t offn = off0 + (size_t)(((it + 1) >> 2) * 128 + ((it + 1) & 3) * 16) * 1024;
#pragma unroll
                for (int bj = 0; bj < 2; ++bj) mv[nx][bj] = *(const u32x4*)(Sm + offn + bj * 128); }
#pragma unroll
            for (int bj = 0; bj < 2; ++bj) { float r[8];
#pragma unroll
                for (int e = 0; e < 8; ++e) { const unsigned mw = mv[cur][bj][e >> 1];
                    const float sm = (e & 1) ? __uint_as_float(mw & 0xffff0000u) : __uint_as_float(mw << 16);
                    r[e] = fmaxf(sm, 1e-30f) * acc[ai][bj][m][e >> 2][e & 3]; }
                u32x4 w; w.x = cvt_pk_bf16(r[0], r[1]); w.y = cvt_pk_bf16(r[2], r[3]); w.z = cvt_pk_bf16(r[4], r[5]); w.w = cvt_pk_bf16(r[6], r[7]);
                *(u32x4*)(O + off + bj * 128) = w; }
        }
    }
};
struct EpiOut {
    const float* x; const float* mod; const float* nw2; float* xmid; bf16_t* AP; float* rowsq;
    __device__ __forceinline__ void operator()(AccRef acc, const Unit& u, int wr, int wc, int fr, int fq) const {
        const int b = u.pm >> 3; const float* mb = mod + b * 6144;
        const int row0 = u.pm * 256 + wr * 64 + fr, col0 = u.pn * 256 + wc * 32 + 8 * fq;
        f32x4 g1[2][2], sw[2][2];
#pragma unroll
        for (int bj = 0; bj < 2; ++bj)
#pragma unroll
            for (int n = 0; n < 2; ++n) { const int c = col0 + bj * 128 + 4 * n; g1[bj][n] = *(const f32x4*)(mb + 2048 + c);
                sw[bj][n] = *(const f32x4*)(nw2 + c) * (*(const f32x4*)(mb + 4096 + c) + 1.f); }
        f32x4 xv[2][2][2];
#pragma unroll
        for (int bj = 0; bj < 2; ++bj)
#pragma unroll
            for (int n = 0; n < 2; ++n) xv[0][bj][n] = *(const f32x4*)(x + (size_t)row0 * 1024 + col0 + bj * 128 + 4 * n);
#pragma unroll
        for (int it = 0; it < 8; ++it) {
            const int ai = it >> 2, m = it & 3, cur = it & 1, nx = cur ^ 1;
            const int row = row0 + ai * 128 + m * 16; const size_t off = (size_t)row * 1024 + col0; float ss = 0.f;
            if (it < 7) { const size_t offn = (size_t)(row0 + ((it + 1) >> 2) * 128 + ((it + 1) & 3) * 16) * 1024 + col0;
#pragma unroll
                for (int bj = 0; bj < 2; ++bj)
#pragma unroll
                    for (int n = 0; n < 2; ++n) xv[nx][bj][n] = *(const f32x4*)(x + offn + bj * 128 + 4 * n); }
#pragma unroll
            for (int bj = 0; bj < 2; ++bj) {
                f32x4 v[2];
#pragma unroll
                for (int n = 0; n < 2; ++n) { v[n] = xv[cur][bj][n] + g1[bj][n] * acc[ai][bj][m][n];
                    const f32x4 q = v[n] * v[n]; ss += (q[0] + q[1]) + (q[2] + q[3]); }
                *(u32x4*)(AP + off + bj * 128) = pack8(v[0] * sw[bj][0], v[1] * sw[bj][1]);
            }
            ss += __shfl_xor(ss, 16); ss += __shfl_xor(ss, 32);
            if (fq == 0) rowsq[(size_t)row * 16 + u.pn * 4 + wc] = ss;
        }
    }
};
__device__ __forceinline__ float dpp_prev(float v) { return __int_as_float(__builtin_amdgcn_update_dpp(0, __float_as_int(v), 0x111, 0xf, 0xf, true)); }
__device__ __forceinline__ float dpp_next(float v) { return __int_as_float(__builtin_amdgcn_update_dpp(0, __float_as_int(v), 0x101, 0xf, 0xf, true)); }
struct EpiUp {
    const float* rowsq; const float* fb; const float* cw; const float* cb; bf16_t* ACT_; bf16_t* RAW_; LAS float* sp;
    __device__ __forceinline__ void operator()(AccRef acc, const Unit& u, int wr, int wc, int fr, int fq) const {
        const int b = u.pm >> 3; const int row0 = u.pm * 256 + wr * 64 + fr;
        int tx = threadIdx.x; asm volatile("" : "+v"(tx));
        if (tx < 256) {
            const float* qp = rowsq + (size_t)(u.pm * 256 + tx) * 16; const f32x4 q0 = *(const f32x4*)qp, q1 = *(const f32x4*)(qp + 4), q2 = *(const f32x4*)(qp + 8), q3 = *(const f32x4*)(qp + 12);
            const f32x4 qs = (q0 + q1) + (q2 + q3); sp[1280 + tx] = rsqrtf(((qs[0] + qs[1]) + (qs[2] + qs[3])) * (1.f / 1024.f) + EPS);
        } else {
            for (int i = tx - 256; i < 1280; i += 256) { const int vec = i >> 7, j = u.pn * 128 + (i & 127);
                const float* src = vec == 0 ? fb + b * NUP + j : vec == 1 ? fb + b * NUP + DFF + j : vec < 5 ? cw + (vec - 2) * NUP + j : vec < 8 ? cw + (vec - 5) * NUP + DFF + j : vec == 8 ? cb + j : cb + DFF + j;
                sp[i] = *src; } }
        asm volatile("s_waitcnt vmcnt(0) lgkmcnt(0)" ::: "memory"); __builtin_amdgcn_s_barrier(); asm volatile("" ::: "memory");
        const LAS float* spc = sp + wc * 32 + 8 * fq;
        const int jb = u.pn * 128 + wc * 32 + 8 * fq;
        const int pcol = u.pn * 256 + wc * 32 + 8 * fq;
        const bool interior = (fr >= 1) && (fr <= 14), rawrow = !((fr >= 2) && (fr <= 13));
        const int slot = fr < 2 ? fr : fr - 12;
#pragma unroll
        for (int ai = 0; ai < 2; ++ai)
#pragma unroll
            for (int m = 0; m < 4; ++m) {
                const int row = row0 + ai * 128 + m * 16; const float rstd = sp[1280 + ai * 128 + wr * 64 + m * 16 + fr];
                float r[8]; f32x4 ua[2], ug[2];
#pragma unroll
                for (int n = 0; n < 2; ++n) {
                    ua[n] = acc[ai][0][m][n] * rstd + *(const LAS f32x4*)(spc + 0 * 128 + 4 * n);
                    ug[n] = acc[ai][1][m][n] * rstd + *(const LAS f32x4*)(spc + 1 * 128 + 4 * n);
                    const f32x4 wa0 = *(const LAS f32x4*)(spc + 2 * 128 + 4 * n), wa1 = *(const LAS f32x4*)(spc + 3 * 128 + 4 * n), wa2 = *(const LAS f32x4*)(spc + 4 * 128 + 4 * n);
                    const f32x4 wg0 = *(const LAS f32x4*)(spc + 5 * 128 + 4 * n), wg1 = *(const LAS f32x4*)(spc + 6 * 128 + 4 * n), wg2 = *(const LAS f32x4*)(spc + 7 * 128 + 4 * n);
                    const f32x4 ba = *(const LAS f32x4*)(spc + 8 * 128 + 4 * n), bg = *(const LAS f32x4*)(spc + 9 * 128 + 4 * n);
#pragma unroll
                    for (int e = 0; e < 4; ++e) {
                        const float av = ba[e] + wa0[e] * dpp_prev(ua[n][e]) + wa1[e] * ua[n][e] + wa2[e] * dpp_next(ua[n][e]);
                        const float gv = bg[e] + wg0[e] * dpp_prev(ug[n][e]) + wg1[e] * ug[n][e] + wg2[e] * dpp_next(ug[n][e]);
                        r[4 * n + e] = gv * sigmoidf_(gv) * av;
                    }
                }
                if (interior) { u32x4 w; w.x = cvt_pk_bf16(r[0], r[1]); w.y = cvt_pk_bf16(r[2], r[3]); w.z = cvt_pk_bf16(r[4], r[5]); w.w = cvt_pk_bf16(r[6], r[7]);
                    *(u32x4*)(ACT_ + (size_t)row * DFF + jb) = w; }
                if (rawrow) { bf16_t* rp = RAW_ + ((size_t)(row >> 4) * 4 + slot) * NUP + pcol;
                    *(u32x4*)rp = pack8(ua[0], ua[1]); *(u32x4*)(rp + 128) = pack8(ug[0], ug[1]); }
                asm volatile("" ::: "memory");
            }
    }
};
struct EpiDown {
    float* out; const float* mod; const bf16_t* AP; const float* nw2;
    __device__ __forceinline__ void operator()(AccRef acc, const Unit& u, int wr, int wc, int fr, int fq) const {
        const int b = u.pm >> 3; const float* mb = mod + b * 6144;
        const int row0 = u.pm * 256 + wr * 64 + fr, col0 = u.pn * 256 + wc * 32 + 8 * fq;
        f32x4 g2[2][2], rsw[2][2];
#pragma unroll
        for (int bj = 0; bj < 2; ++bj)
#pragma unroll
            for (int n = 0; n < 2; ++n) { const int c = col0 + bj * 128 + 4 * n; g2[bj][n] = *(const f32x4*)(mb + 5120 + c);
                const f32x4 sw = *(const f32x4*)(nw2 + c) * (*(const f32x4*)(mb + 4096 + c) + 1.f);
#pragma unroll
                for (int e = 0; e < 4; ++e) rsw[bj][n][e] = 1.f / sw[e]; }
        u32x4 av[2][2];
#pragma unroll
        for (int bj = 0; bj < 2; ++bj) av[0][bj] = *(const u32x4*)(AP + (size_t)row0 * 1024 + col0 + bj * 128);
#pragma unroll
        for (int it = 0; it < 8; ++it) {
            const int ai = it >> 2, m = it & 3, cur = it & 1, nx = cur ^ 1;
            const size_t off = (size_t)(row0 + ai * 128 + m * 16) * 1024 + col0;
            if (it < 7) { const size_t offn = (size_t)(row0 + ((it + 1) >> 2) * 128 + ((it + 1) & 3) * 16) * 1024 + col0;
#pragma unroll
                for (int bj = 0; bj < 2; ++bj) av[nx][bj] = *(const u32x4*)(AP + offn + bj * 128); }
#pragma unroll
            for (int bj = 0; bj < 2; ++bj)
#pragma unroll
                for (int n = 0; n < 2; ++n) { const unsigned w0 = av[cur][bj][2 * n], w1 = av[cur][bj][2 * n + 1];
                    const f32x4 ap = (f32x4){__uint_as_float(w0 << 16), __uint_as_float(w0 & 0xffff0000u), __uint_as_float(w1 << 16), __uint_as_float(w1 & 0xffff0000u)};
                    *(f32x4*)(out + off + bj * 128 + 4 * n) = ap * rsw[bj][n] + g2[bj][n] * acc[ai][bj][m][n]; }
        }
    }
};

__device__ __forceinline__ f32x4 mfma16(bf16x8 a, bf16x8 b, f32x4 c) { return __builtin_amdgcn_mfma_f32_16x16x32_bf16(a, b, c, 0, 0, 0); }

__device__ __forceinline__ void transpose_item(const float* W, int ldw, int col, int k0, bf16_t* WT, int dst_row, int dld, LAS float* scr, int lane) {
#pragma unroll 8
    for (int i = 0; i < 32; ++i) { const int kk = 2 * i + (lane >> 5); scr[kk * 33 + (lane & 31)] = W[(size_t)(k0 + kk) * ldw + col + (lane & 31)]; }
    asm volatile("s_waitcnt lgkmcnt(0)" ::: "memory");
    const int c = lane & 7;
#pragma unroll
    for (int j = 0; j < 4; ++j) { const int n = (lane >> 3) + 8 * j; const LAS float* s = scr + (8 * c) * 33 + n;
        u32x4 o; o.x = cvt_pk_bf16(s[0 * 33], s[1 * 33]); o.y = cvt_pk_bf16(s[2 * 33], s[3 * 33]); o.z = cvt_pk_bf16(s[4 * 33], s[5 * 33]); o.w = cvt_pk_bf16(s[6 * 33], s[7 * 33]);
        *(u32x4*)(WT + (size_t)(dst_row + n) * dld + k0 + 8 * c) = o; }
    asm volatile("s_waitcnt lgkmcnt(0)" ::: "memory");
}
__device__ __forceinline__ int headperm(int n0) { const int tile = n0 >> 8, l = n0 & 255; return tile * 256 + 128 * ((l >> 5) & 1) + 32 * (l >> 6); }

struct Args {
    const float *x, *c, *ctx, *c_ctx, *w_mod, *b_mod, *norm1_w, *w_in, *q_norm_w, *k_norm_w, *attn_sink, *ml_gate_b, *ml_norm_w,
        *w_branch_att, *w_branch_ml, *w_out, *norm2_w, *w_up, *conv_w, *conv_b, *w_down;
    float* out; unsigned char* ws; int ph_lo, ph_hi;
};

template <int NV, int KS, bool ATOMIC> __device__ __forceinline__ void gemv_task(const float* W, int ldw, int n0, int k0, const LAS float* svec, float* out, int ldo) {
    const int n = n0 + threadIdx.x; float a[NV];
#pragma unroll
    for (int v = 0; v < NV; ++v) a[v] = 0.f;
#pragma unroll 16
    for (int k = 0; k < KS; ++k) { const float w = W[(size_t)(k0 + k) * ldw + n];
#pragma unroll
        for (int v = 0; v < NV; ++v) a[v] += svec[v * KS + k] * w; }
#pragma unroll
    for (int v = 0; v < NV; ++v) { if (ATOMIC) atomicAdd(out + (size_t)v * ldo + n, a[v]); else out[(size_t)v * ldo + n] = a[v]; }
}

#define mod   ((float*)(wsb + WS_MOD))
#define modp  ((float*)(wsb + WS_MODP))
#define fbias ((float*)(wsb + WS_FB))
#define rowsq ((float*)(wsb + WS_RSQP))
#define fbp ((float*)(dob + DO_FBP))
#define cosT  ((float*)(wsb + WS_ROPE))
#define sinT  ((float*)(wsb + WS_ROPE) + 2048 * 32)
#define gates ((float*)(wsb + WS_GATES))
#define WBA ((bf16_t*)(wsb + WS_WBA))
#define WBM ((bf16_t*)(wsb + WS_WBM))
#define WO  ((bf16_t*)(wsb + WS_WO))
#define WUP ((bf16_t*)(wsb + WS_WUP))
#define WDN ((bf16_t*)(wsb + WS_WDN))
#define AQ  ((bf16_t*)(wsb + WS_AQ))
#ifdef DBG_ATTO
#define ATTO GA
#else
#define ATTO AQ
#endif
#define MQ  ((bf16_t*)(wsb + WS_MQ))
#define MK  ((bf16_t*)(wsb + WS_MK))
#define MO  ((bf16_t*)(wsb + WS_MO))
#define GA  ((bf16_t*)(wsb + WS_GA))
#define GM  ((bf16_t*)(wsb + WS_GM))
#define XT  ((bf16_t*)(wsb + WS_XT))
#define T1  ((bf16_t*)(wsb + WS_T1))
#define Y   ((bf16_t*)(wsb + WS_Y))
#define U   ((bf16_t*)(wsb + WS_U))
#define HALO ((bf16_t*)(wsb + WS_HALO))
#define ACT ((bf16_t*)(wsb + WS_ACT))
#define RAWU ((bf16_t*)(wsb + WS_RAW))
#define H   ((bf16_t*)(dob + DO_H))
#define W1T ((bf16_t*)(dob + DO_W1T))
#define W2T ((bf16_t*)(dob + DO_W2T))
#define AK  ((bf16_t*)(wsb + WS_HALO))
#define HF  ((bf16_t*)(dob + DO_HF))
#define HB  ((bf16_t*)(dob + DO_HB))

#define XB_TMO      128
#define XB_XCNT(j)  (256  + 64 * (j))
#define XB_XSUB(j)  (1280 + 64 * (j))
#define XB_XGEN(j)  (2304 + 64 * (j))
#define XB_TOP      3328
#define XB_TOPGEN   3392
#define XCD_BAR_WORDS 3456
#define XB_SPIN_CAP (1u << 18)
__device__ __forceinline__ unsigned xb_ld(unsigned* p)              { return __hip_atomic_load(p, __ATOMIC_RELAXED, __HIP_MEMORY_SCOPE_AGENT); }
__device__ __forceinline__ unsigned xb_add(unsigned* p, unsigned v) { return __hip_atomic_fetch_add(p, v, __ATOMIC_RELAXED, __HIP_MEMORY_SCOPE_AGENT); }
__device__ __forceinline__ unsigned xb_xcc_id() { return (unsigned)__builtin_amdgcn_s_getreg((3 << 11) | 20) & 0xFu; }
#define XB_SPIN(cond, bar) do { unsigned _sp = 0; while (cond) { __builtin_amdgcn_s_sleep(1); \
    if ((++_sp & 255u) == 0u) { if (xb_ld(&(bar)[XB_TMO])) break; if (_sp > XB_SPIN_CAP) { atomicAdd(&(bar)[XB_TMO], 1u); break; } } } } while (0)
struct XcdBarrier { unsigned* bar; unsigned x; volatile LAS unsigned* st; };
__device__ __forceinline__ XcdBarrier xcd_barrier_post(unsigned* bar, volatile LAS unsigned* st) {
    XcdBarrier b; b.bar = bar; b.x = xb_xcc_id(); b.st = st;
    if (threadIdx.x == 0) (void)xb_add(&bar[XB_XCNT(b.x)], 1u);
    return b;
}
__device__ __forceinline__ void xcd_barrier_complete(unsigned* bar, unsigned x, unsigned& nloc, unsigned& nx) {
    const unsigned G = gridDim.x * gridDim.y * gridDim.z;
    unsigned sum, cnt, mine, sp = 0u;
    for (;;) {
        sum = 0u; cnt = 0u; mine = 0u;
#pragma unroll
        for (unsigned j = 0; j < 16; ++j) { const unsigned c = xb_ld(&bar[XB_XCNT(j)]); sum += c; cnt += (c > 0u) ? 1u : 0u; mine = (j == x) ? c : mine; }
        if (sum == G) break;
        __builtin_amdgcn_s_sleep(1);
        if ((++sp & 255u) == 0u) { if (xb_ld(&bar[XB_TMO])) break; if (sp > XB_SPIN_CAP) { atomicAdd(&bar[XB_TMO], 1u); break; } }
    }
    nloc = mine > 0u ? mine : 1u; nx = cnt > 0u ? cnt : 1u;
}
__device__ __forceinline__ void xcd_barrier(const XcdBarrier& b) {
    asm volatile("s_waitcnt vmcnt(0)" ::: "memory");
    __syncthreads();
    if (threadIdx.x == 0) {
        unsigned* bar = b.bar;
        __builtin_amdgcn_s_waitcnt(0);
        unsigned nloc = b.st[0], nx = b.st[1];
        if (nloc == 0u) { xcd_barrier_complete(bar, b.x, nloc, nx); b.st[0] = nloc; b.st[1] = nx; }
        const unsigned old = xb_add(&bar[XB_XSUB(b.x)], 1u);
        const unsigned gen = old / nloc;
        if (old + 1u == (gen + 1u) * nloc) {
            __builtin_amdgcn_fence(__ATOMIC_RELEASE, "agent");
            asm volatile("s_waitcnt vmcnt(0)" ::: "memory");
            const unsigned og = xb_add(&bar[XB_TOP], 1u);
            const unsigned tg = og / nx;
            if (og + 1u == (tg + 1u) * nx) xb_add(&bar[XB_TOPGEN], 1u);
            else XB_SPIN(xb_ld(&bar[XB_TOPGEN]) == tg, bar);
            __builtin_amdgcn_fence(__ATOMIC_ACQUIRE, "agent");
            xb_add(&bar[XB_XGEN(b.x)], 1u);
            asm volatile("s_waitcnt vmcnt(0)" ::: "memory");
        } else {
            XB_SPIN(xb_ld(&bar[XB_XGEN(b.x)]) == gen, bar);
            __builtin_amdgcn_fence(__ATOMIC_ACQUIRE, "agent");
            asm volatile("s_waitcnt vmcnt(0)" ::: "memory");
        }
    }
    __syncthreads();
}
constexpr size_t WS_BAR = 253 * MiB;
constexpr int LDS_ST_OFF = LDS_BYTES - 16;
#define A (*(const volatile __attribute__((address_space(4))) Args*)__builtin_amdgcn_kernarg_segment_ptr())
__global__ void __launch_bounds__(512, 2) fwd_kernel(Args Aparam) {
    extern __shared__ __attribute__((aligned(16))) unsigned char lds_raw[];
    LAS unsigned char* lds = (LAS unsigned char*)lds_raw;
    const int tid = threadIdx.x, lane = tid & 63, wave = __builtin_amdgcn_readfirstlane(tid >> 6);
    const int G = gridDim.x, bx = blockIdx.x;
    const int gw = bx * 8 + wave, NGW = G * 8;
    const int lo = A.ph_lo, hi = A.ph_hi; (void)lo; (void)hi;
#ifndef PHMASK
#define PHMASK 0x1fff
#endif
#if ONE_LAUNCH
#define IN(k) (((PHMASK >> (k)) & 1) && (k) < 11)
#else
#define IN(k) (((PHMASK >> (k)) & 1) && lo <= (k) && (k) < hi)
#endif
#if ONE_LAUNCH
    XcdBarrier xbar; xbar.bar = nullptr; xbar.x = 0; xbar.st = (volatile LAS unsigned*)(lds + LDS_ST_OFF);
#define SEAM(k) do { xcd_barrier(xbar); } while (0)
    {
        unsigned* const barw = (unsigned*)(A.ws + WS_BAR);
        if (tid < 4) ((LAS unsigned*)(lds + LDS_ST_OFF))[tid] = 0u;
        if (bx == 0) for (int i = tid; i < XCD_BAR_WORDS; i += 512) barw[i] = 0u;
        cg::this_grid().sync();
        xbar = xcd_barrier_post(barw, (volatile LAS unsigned*)(lds + LDS_ST_OFF));
    }
#else
#define SEAM(k) do { } while (0)
#endif

    for (int rep_ = 0; rep_ < (((RPT_MASK >> 0) & 1) ? 2 : 1); ++rep_) { if (rep_) { if (0 == 0) cg::this_grid().sync(); else xcd_barrier(xbar); }
    if (IN(0)) {
        unsigned char* const wsb = A.ws; unsigned char* const dob = (unsigned char*)A.out; (void)wsb; (void)dob;
        LAS float* svec = (LAS float*)(lds + 131072);
        for (int task = bx; task < 192; task += G) {
            const int cb = task % 12, ks = task / 12, k0 = ks * 64;
            __syncthreads();
            for (int i = tid; i < 576; i += 512) { const int v = i >> 6, k = i & 63; const float cv = v < 8 ? A.c[v * 1024 + k0 + k] : A.c_ctx[k0 + k]; svec[i] = cv / (1.f + __expf(-cv)); }
            __syncthreads();
            gemv_task<9, 64, false>(A.w_mod, 6144, cb * 512, k0, svec, modp + (size_t)ks * 9 * 6144, 6144);
        }
        LAS float* scr = (LAS float*)(lds + wave * 16384);
        constexpr int NITEMS = 9088;
        for (int it = gw; it < NITEMS; it += NGW) {
            int r = it; const float* W; int ldw, col0, ncols, K; bf16_t* dst; int hp = 0;
            if (r < 512) { W = A.w_in; ldw = INW; col0 = 0; ncols = 1024; K = 1024; dst = W1T + (size_t)3 * 256 * 1024; hp = 1; }
            else if ((r -= 512) < 128) { W = A.w_in; ldw = INW; col0 = 1024; ncols = 256; K = 1024; dst = W1T; hp = 1; }
            else if ((r -= 128) < 128) { W = A.w_in; ldw = INW; col0 = 1280; ncols = 256; K = 1024; dst = W2T; }
            else if ((r -= 128) < 256) { W = A.w_in; ldw = INW; col0 = 1536; ncols = 512; K = 1024; dst = W1T + (size_t)7 * 256 * 1024; }
            else if ((r -= 256) < 256) { W = A.w_in; ldw = INW; col0 = 2048; ncols = 512; K = 1024; dst = W1T + (size_t)1 * 256 * 1024; }
            else if ((r -= 256) < 512) { W = A.w_in; ldw = INW; col0 = 2560; ncols = 1024; K = 1024; dst = W2T + (size_t)256 * 1024; }
            else if ((r -= 512) < 512) { W = A.w_in; ldw = INW; col0 = 3584; ncols = 1024; K = 1024; dst = W1T + (size_t)9 * 256 * 1024; }
            else if ((r -= 512) < 512) { W = A.w_in; ldw = INW; col0 = 4624; ncols = 1024; K = 1024; dst = W1T + (size_t)13 * 256 * 1024; }
            else if ((r -= 512) < 512) { W = A.w_in; ldw = INW; col0 = 5648; ncols = 1024; K = 1024; dst = W1T + (size_t)17 * 256 * 1024; }
            else if ((r -= 512) < 512) { W = A.w_branch_att; ldw = 1024; col0 = 0; ncols = 1024; K = 1024; dst = WBA; }
            else if ((r -= 512) < 512) { W = A.w_branch_ml; ldw = 1024; col0 = 0; ncols = 1024; K = 1024; dst = WBM; }
            else if ((r -= 512) < 512) { W = A.w_out; ldw = 1024; col0 = 0; ncols = 1024; K = 1024; dst = WO; }
            else if ((r -= 512) < 2816) { W = A.w_up; ldw = NUP; col0 = 0; ncols = NUP; K = 1024; dst = WUP; }
            else { r -= 2816; W = A.w_down; ldw = 1024; col0 = 0; ncols = 1024; K = DFF; dst = WDN; }
            const int nblk = ncols / 32, kb = r / nblk, nb = r % nblk, n0 = nb * 32;
            int drow = hp ? headperm(n0) : n0;
            if (W == A.w_up) drow = (n0 < DFF) ? 256 * (n0 >> 7) + (n0 & 127) : 256 * ((n0 - DFF) >> 7) + 128 + ((n0 - DFF) & 127);
            transpose_item(W, ldw, col0 + n0, kb * 64, dst, drow, K, scr, lane);
        }
        for (int i = bx * 512 + tid; i < 2048 * 32; i += G * 512) {
            const int t = i >> 5, j = i & 31; const float pos = (j < 16) ? (float)(t >> 6) : (float)(t & 63);
            const float invf = exp2f(-(float)(j & 15) * (13.287712379549449f / 16.f)); const float ang = pos * invf;
            cosT[i] = cosf(ang); sinT[i] = sinf(ang);
        }
    }
    }
    SEAM(0);

    for (int rep_ = 0; rep_ < (((RPT_MASK >> 1) & 1) ? 2 : 1); ++rep_) { if (rep_) { if (1 == 0) cg::this_grid().sync(); else xcd_barrier(xbar); }
    if (IN(1)) {
        unsigned char* const wsb = A.ws; unsigned char* const dob = (unsigned char*)A.out; (void)wsb; (void)dob;
        constexpr int GP = 1028;
        LAS float* sWg = (LAS float*)lds;
        LAS float* hT = (LAS float*)(lds + 65792);
        LAS float* svm = (LAS float*)(lds + 131584);
        LAS float* part = (LAS float*)(lds + 147968);
        LAS float* svec = part;
        for (int k = tid; k < 1024; k += 512) { const float* src = A.w_in + (size_t)k * INW + 4608;
#pragma unroll
            for (int q = 0; q < 4; ++q) { const f32x4 v = *(const f32x4*)(src + 4 * q); sWg[(4 * q + 0) * GP + k] = v[0]; sWg[(4 * q + 1) * GP + k] = v[1]; sWg[(4 * q + 2) * GP + k] = v[2]; sWg[(4 * q + 3) * GP + k] = v[3]; } }
        const int rpb = (MT + G - 1) / G, rbeg = bx * rpb, rend = (rbeg + rpb < MT) ? rbeg + rpb : MT;
        const int vlo = rbeg < ML ? (rbeg >> 11) : 8;
        for (int i = tid; i < 4096; i += 512) { const int slot = i >> 11, k = i & 2047; int v = vlo + slot; if (v > 8) v = 8; float a = A.b_mod[k];
#pragma unroll
            for (int ks = 0; ks < 16; ++ks) a += modp[((size_t)ks * 9 + v) * 6144 + k];
            svm[i] = a; }
        for (int i = bx * 512 + tid; i < 9 * 6144; i += G * 512) { float a = A.b_mod[i % 6144];
#pragma unroll
            for (int ks = 0; ks < 16; ++ks) a += modp[(size_t)ks * 9 * 6144 + i];
            mod[i] = a; }
        __syncthreads();
        {
            const float* xin = A.x; const float* cin = A.ctx; const float* n1w = A.norm1_w; const float* gbias = A.ml_gate_b;
            const int r16 = lane & 15, quad = lane >> 4;
            const int ntile = (rend - rbeg + 15) >> 4;
            f32x4 xn[2][4];
#pragma unroll
            for (int t = 0; t < 2; ++t) { const int row = rbeg + wave + 8 * t; if (row < rend) { const float* xr = row < ML ? xin + (size_t)row * 1024 : cin + (size_t)(row - ML) * 1024;
#pragma unroll
                for (int j = 0; j < 4; ++j) xn[t][j] = *(const f32x4*)(xr + 4 * lane + 256 * j); } }
            for (int tile = 0; tile < ntile; ++tile) {
                const int trow = rbeg + 16 * tile;
#pragma unroll
                for (int t = 0; t < 2; ++t) {
                    const int r = wave + 8 * t, row = trow + r;
                    f32x4 hv[4]; float ss = 0.f;
#pragma unroll
                    for (int j = 0; j < 4; ++j) { hv[j] = xn[t][j]; const f32x4 q = hv[j] * hv[j]; ss += (q[0] + q[1]) + (q[2] + q[3]); }
                    { const int rn = row + 16; if (rn < rend) { const float* xr = rn < ML ? xin + (size_t)rn * 1024 : cin + (size_t)(rn - ML) * 1024;
#pragma unroll
                        for (int j = 0; j < 4; ++j) xn[t][j] = *(const f32x4*)(xr + 4 * lane + 256 * j); } }
                    if (row < rend) {
                        const int v = row < ML ? (row >> 11) : 8;
                        const LAS float* sh = svm + (v - vlo) * 2048; const LAS float* sc = sh + 1024;
                        const float rstd = rsqrtf(wave_sum(ss) * (1.f / 1024.f) + EPS);
                        bf16_t* ho = H + (size_t)row * 1024;
#pragma unroll
                        for (int j = 0; j < 4; ++j) { const int k = 4 * lane + 256 * j;
                            hv[j] = hv[j] * rstd * (*(const f32x4*)(n1w + k)) * (*(const LAS f32x4*)(sc + k) + 1.f) + *(const LAS f32x4*)(sh + k);
                            u32x2 w; w.x = cvt_pk_bf16(hv[j][0], hv[j][1]); w.y = cvt_pk_bf16(hv[j][2], hv[j][3]); *(u32x2*)(ho + k) = w;
                            *(LAS f32x4*)(hT + r * GP + k) = hv[j]; }
                    }
                }
                __syncthreads();
                { f32x4 acc = (f32x4){0.f, 0.f, 0.f, 0.f};
#pragma unroll
                  for (int kk = 0; kk < 8; ++kk) { const f32x4 a4 = *(const LAS f32x4*)(hT + r16 * GP + wave * 128 + kk * 16 + quad * 4), b4 = *(const LAS f32x4*)(sWg + r16 * GP + wave * 128 + kk * 16 + quad * 4);
#pragma unroll
                    for (int i = 0; i < 4; ++i) acc = __builtin_amdgcn_mfma_f32_16x16x4f32(a4[i], b4[i], acc, 0, 0, 0); }
#pragma unroll
                  for (int j = 0; j < 4; ++j) part[wave * 256 + (quad * 4 + j) * 16 + r16] = acc[j]; }
                __syncthreads();
                if (tid < 256) { const int r = tid >> 4, gidx = tid & 15, row = trow + r; float gv = gbias[gidx];
#pragma unroll
                    for (int w = 0; w < 8; ++w) gv += part[w * 256 + tid];
                    if (gidx & 4) gv = fminf(gv, 0.f) - log1pf(expf(-fabsf(gv)));
                    if (row < rend) gates[(size_t)row * 16 + gidx] = gv; }
            }
        }
        for (int task = bx; task < 176; task += G) {
            const int cb = task % 11, ks = task / 11, k0 = ks * 64;
            __syncthreads();
            { const int v = tid >> 6, k = 3072 + k0 + (tid & 63); float a = A.b_mod[k];
#pragma unroll
                for (int q = 0; q < 16; ++q) a += modp[((size_t)q * 9 + v) * 6144 + k];
                svec[tid] = a; }
            __syncthreads();
            gemv_task<8, 64, false>(A.w_up, NUP, cb * 512, k0, svec, fbp + (size_t)ks * 8 * NUP, NUP);
        }
    }
    }
    SEAM(1);

    for (int rep_ = 0; rep_ < (((RPT_MASK >> 2) & 1) ? 2 : 1); ++rep_) { if (rep_) { if (2 == 0) cg::this_grid().sync(); else xcd_barrier(xbar); }
    if (IN(2)) {
        unsigned char* const wsb = A.ws; unsigned char* const dob = (unsigned char*)A.out; (void)wsb; (void)dob;
        for (int i = bx * 512 + tid; i < 8 * NUP; i += G * 512) { float a = 0.f;
#pragma unroll
            for (int ks = 0; ks < 16; ++ks) a += fbp[(size_t)ks * 8 * NUP + i];
            fbias[i] = a; }
        { pg8::Gemm g{H, W1T, 1024, 1024, 1024}; pg8::Order S; S.init(64, 21, G, bx, 24);
          EpiIn E{AK, MK, AQ, MQ, MO, GA, GM, A.q_norm_w, A.k_norm_w, cosT, sinT, (LAS float*)(lds + 131072)};
          pg8::gemm_phase<EpiIn, pg8::Order, true>(lds, g, S, E); }
        { pg8::Gemm g{W2T, H, 1024, 1024, 1024}; pg8::Order S; S.init(5, 72, G, (bx + G - (1368 % G)) % G, 0);
          EpiPlain E{XT, MT};
          pg8::gemm_phase<EpiPlain, pg8::Order, true>(lds, g, S, E); }
    }
    }
    SEAM(2);

    if (IN(3)) {
        unsigned char* const wsb = A.ws; unsigned char* const dob = (unsigned char*)A.out; (void)wsb; (void)dob;
        const int r16 = lane & 15, quad = lane >> 4;
        const int rt = wave & 3, hp = wave >> 2;
        LAS bf16_t* sK = (LAS bf16_t*)lds;
        LAS bf16_t* sVT = sK + 64 * 72;
        bf16x8 qn[2][2];
#define AT_QLOAD(un_) do { const int qb_ = (un_) & 31, kvh_ = ((un_) >> 5) & 3, b_ = (un_) >> 7; \
            _Pragma("unroll") for (int g = 0; g < 2; ++g) _Pragma("unroll") for (int ks = 0; ks < 2; ++ks) \
                qn[g][ks] = *(const bf16x8*)(AQ + (size_t)(b_ * SEQ + qb_ * 64 + rt * 16 + r16) * 1024 + (kvh_ * 4 + hp * 2 + g) * 64 + ks * 32 + quad * 8); } while (0)
        const int vcu3 = (G % 8 == 0) ? (bx % 8) * (G / 8) + bx / 8 : bx;
        if (vcu3 < 1024) AT_QLOAD(vcu3);
        for (int unit = vcu3; unit < 1024; unit += G) {
            const int qb = unit & 31, kvh = (unit >> 5) & 3, b = unit >> 7;
            const int rowbase = b * SEQ, t0 = qb * 64;
            bf16x8 qf[2][2];
#pragma unroll
            for (int g = 0; g < 2; ++g)
#pragma unroll
                for (int ks = 0; ks < 2; ++ks) qf[g][ks] = qn[g][ks];
            if (unit + G < 1024) AT_QLOAD(unit + G);
            f32x4 o[2][4]; float mrow[2], lrow[2];
#pragma unroll
            for (int g = 0; g < 2; ++g) { mrow[g] = A.attn_sink[kvh * 4 + hp * 2 + g]; lrow[g] = 1.f;
#pragma unroll
                for (int dt = 0; dt < 4; ++dt) o[g][dt] = (f32x4){0.f, 0.f, 0.f, 0.f}; }
            const int kb_lo = (qb < 2) ? 2 - qb : 0, kb_hi = (qb > 29) ? 33 - qb : 4;
            const bf16_t* const ak_ = AK; const bf16_t* const xt_ = XT; const int lr = tid >> 3, lc = tid & 7;
#define AT_KROW0(kb_) (((kb_) < 5) ? rowbase + (qb + (kb_) - 2) * 64 : ML + b * CTX + ((kb_) - 5) * 64)
            u32x4 pk, pv;
            { const int kr = AT_KROW0(kb_lo); pk = *(const u32x4*)(ak_ + (size_t)(kr + lr) * 256 + kvh * 64 + lc * 8); pv = *(const u32x4*)(xt_ + (size_t)(kvh * 64 + lr) * MT + kr + lc * 8); }
            for (int kb = kb_lo; kb < 9; kb = (kb == kb_hi) ? 5 : kb + 1) {
                const int mtype = (kb == 0) ? 1 : (kb == 4) ? 2 : 0;
                const int mlo = (mtype == 1) ? 0 : -4096, mhi = (mtype == 2) ? 0 : 4096, dl = quad * 4 - rt * 16 - r16;
                __syncthreads();
                *(LAS u32x4*)(sK + lr * 72 + lc * 8) = pk; *(LAS u32x4*)(sVT + lr * 72 + lc * 8) = pv;
                { const int kn = (kb == kb_hi) ? 5 : kb + 1;
                  if (kn < 9) { const int kr = AT_KROW0(kn); pk = *(const u32x4*)(ak_ + (size_t)(kr + lr) * 256 + kvh * 64 + lc * 8); pv = *(const u32x4*)(xt_ + (size_t)(kvh * 64 + lr) * MT + kr + lc * 8); } }
                __syncthreads();
                bf16x8 kf[4][2], vf[2][4];
#pragma unroll
                for (int tile = 0; tile < 4; ++tile)
#pragma unroll
                    for (int ks = 0; ks < 2; ++ks) kf[tile][ks] = *(const LAS bf16x8*)(sK + (tile * 16 + r16) * 72 + ks * 32 + quad * 8);
#pragma unroll
                for (int ks = 0; ks < 2; ++ks)
#pragma unroll
                    for (int dt = 0; dt < 4; ++dt) { const u32x2 lo = *(const LAS u32x2*)(sVT + (dt * 16 + r16) * 72 + ks * 32 + quad * 4), hi = *(const LAS u32x2*)(sVT + (dt * 16 + r16) * 72 + ks * 32 + 16 + quad * 4);
                        const u32x4 w = (u32x4){lo.x, lo.y, hi.x, hi.y}; vf[ks][dt] = __builtin_bit_cast(bf16x8, w); }
#pragma unroll
                for (int g = 0; g < 2; ++g) {
                    f32x4 s[4];
#pragma unroll
                    for (int tile = 0; tile < 4; ++tile) { s[tile] = (f32x4){0.f, 0.f, 0.f, 0.f};
#pragma unroll
                        for (int ks = 0; ks < 2; ++ks) s[tile] = mfma16(kf[tile][ks], qf[g][ks], s[tile]); }
                    float mx = -1e30f;
#pragma unroll
                    for (int tile = 0; tile < 4; ++tile)
#pragma unroll
                        for (int j = 0; j < 4; ++j) { const int dd = dl + (tile * 16 + j);
                            const int bad = ((dd - mlo) | (mhi - dd)) >> 31;
                            const float v = s[tile][j] * 0.125f + __int_as_float(bad & (int)0xF149F2CAu); s[tile][j] = v; mx = fmaxf(mx, v); }
                    mx = fmaxf(mx, __shfl_xor(mx, 16)); mx = fmaxf(mx, __shfl_xor(mx, 32));
                    const float mn = fmaxf(mrow[g], mx), alpha = __expf(mrow[g] - mn); mrow[g] = mn; float rs = 0.f;
                    unsigned pw[4][2];
#pragma unroll
                    for (int tile = 0; tile < 4; ++tile) { f32x4 pe;
#pragma unroll
                        for (int j = 0; j < 4; ++j) { pe[j] = __expf(s[tile][j] - mn); rs += pe[j]; }
                        pw[tile][0] = cvt_pk_bf16(pe[0], pe[1]); pw[tile][1] = cvt_pk_bf16(pe[2], pe[3]); }
                    rs += __shfl_xor(rs, 16); rs += __shfl_xor(rs, 32);
                    lrow[g] = lrow[g] * alpha + rs;
#pragma unroll
                    for (int dt = 0; dt < 4; ++dt) o[g][dt] = o[g][dt] * alpha;
#pragma unroll
                    for (int ks = 0; ks < 2; ++ks) { const u32x4 w = (u32x4){pw[2 * ks][0], pw[2 * ks][1], pw[2 * ks + 1][0], pw[2 * ks + 1][1]}; const bf16x8 pf = __builtin_bit_cast(bf16x8, w);
#pragma unroll
                        for (int dt = 0; dt < 4; ++dt) o[g][dt] = mfma16(vf[ks][dt], pf, o[g][dt]); }
                }
            }
#pragma unroll
            for (int g = 0; g < 2; ++g) { const float inv = 1.f / lrow[g];
                bf16_t* p = ATTO + (size_t)(rowbase + t0 + rt * 16 + r16) * 1024 + (kvh * 4 + hp * 2 + g) * 64 + quad * 4;
#pragma unroll
                for (int dt = 0; dt < 4; ++dt) { u32x2 w; w.x = cvt_pk_bf16(o[g][dt][0] * inv, o[g][dt][1] * inv); w.y = cvt_pk_bf16(o[g][dt][2] * inv, o[g][dt][3] * inv); *(u32x2*)(p + dt * 16) = w; } }
        }
    }
    __syncthreads();

    for (int rep_ = 0; rep_ < (((RPT_MASK >> 4) & 1) ? 2 : 1); ++rep_) { if (rep_) { if (4 == 0) cg::this_grid().sync(); else xcd_barrier(xbar); }
    if (IN(4)) {
        unsigned char* const wsb = A.ws; unsigned char* const dob = (unsigned char*)A.out; (void)wsb; (void)dob;
        const int r16 = lane & 15, quad = lane >> 4;
        LAS bf16_t* sK = (LAS bf16_t*)lds;
        LAS bf16_t* sVT = sK + 128 * 136;
        LAS bf16_t* sS = sVT + 64 * 136;
        LAS bf16_t* sC = sS + 128 * 136;
        LAS float* sgall = (LAS float*)(sC + 80 * 136);
        const float scale = 0.08838834764831845f;
        const int vcu4 = (G % 8 == 0) ? (bx % 8) * (G / 8) + bx / 8 : bx;
        for (int task = vcu4; task < 256; task += G) {
            const int vq = task & 3, dir = (task >> 2) & 1, hh = (task >> 3) & 3, b = task >> 5;
            __syncthreads();
            for (int i = tid; i < 80 * 136 / 2; i += 512) ((LAS unsigned*)sC)[i] = 0u;
            for (int st = wave; st < 18; st += 8) {
                const int t0g = ((st < 2) ? (ML + b * CTX + (dir ? 1 - st : st) * 128) : (b * SEQ + (dir ? 15 - (st - 2) : st - 2) * 128));
                const float* gp = gates + (size_t)(t0g + 2 * lane) * 16 + dir * 8 + hh;
                const float i0 = gp[0], f0 = gp[4], i1 = gp[16], f1 = gp[20];
                const float loc = f0 + f1; float v = loc;
#pragma unroll
                for (int off = 1; off < 64; off <<= 1) { const float t = __shfl_up(v, off); if (lane >= off) v += t; }
                const float total = __shfl(v, 63); const float p0 = v - loc + f0, p1 = p0 + f1;
                const float b0 = dir ? total - p0 + f0 : p0, b1 = dir ? total - p1 + f1 : p1;
                const float cmid = 0.5f * total; LAS float* g = sgall + st * 576;
                g[2 * lane] = __expf(fminf(b0 - cmid, 80.f)); g[2 * lane + 1] = __expf(fminf(b1 - cmid, 80.f));
                g[128 + 2 * lane] = __expf(fminf(i0 - b0 + cmid, 80.f)) * scale; g[128 + 2 * lane + 1] = __expf(fminf(i1 - b1 + cmid, 80.f)) * scale;
                g[256 + 2 * lane] = __expf(fminf(total - b0 + i0, 80.f)) * scale; g[256 + 2 * lane + 1] = __expf(fminf(total - b1 + i1, 80.f)) * scale;
                g[384 + 2 * lane] = __expf(b0); g[384 + 2 * lane + 1] = __expf(b1); if (lane == 0) g[512] = __expf(total);
            }
            f32x4 cacc[4], nacc = (f32x4){0.f, 0.f, 0.f, 0.f};
#pragma unroll
            for (int vt = 0; vt < 4; ++vt) cacc[vt] = (f32x4){0.f, 0.f, 0.f, 0.f};
            bf16_t* Hout = (bf16_t*)(dob + (dir ? DO_HB : DO_HF)); const int sgn = dir ? 1 : -1;
            const bf16_t* const mk_ = MK; const bf16_t* const xt_ = XT; const bf16_t* const mq_ = MQ;
            u32x4 pK[4], pVT[2]; bf16x8 pQ[4];
#define ML_TOK0(st) (((st) < 2) ? (ML + b * CTX + (dir ? 1 - (st) : (st)) * 128) : (b * SEQ + (dir ? 15 - ((st) - 2) : (st) - 2) * 128))
#define ML_PREFETCH(st) do { const int t0_ = ML_TOK0(st); \
                _Pragma("unroll") for (int q_ = 0; q_ < 4; ++q_) { const int i_ = tid + q_ * 512, r_ = i_ >> 4, c_ = i_ & 15; pK[q_] = *(const u32x4*)(mk_ + (size_t)(t0_ + r_) * 512 + hh * 128 + c_ * 8); } \
                if ((st) >= 2) { _Pragma("unroll") for (int ks_ = 0; ks_ < 4; ++ks_) pQ[ks_] = *(const bf16x8*)(mq_ + (size_t)(t0_ + wave * 16 + r16) * 512 + hh * 128 + ks_ * 32 + quad * 8); } \
                _Pragma("unroll") for (int q_ = 0; q_ < 2; ++q_) { const int i_ = tid + q_ * 512, r_ = i_ >> 4, c_ = i_ & 15; pVT[q_] = *(const u32x4*)(xt_ + (size_t)(256 + hh * 256 + vq * 64 + r_) * MT + t0_ + c_ * 8); } \
                } while (0)
            ML_PREFETCH(0);
            for (int step = 0; step < 18; ++step) {
                const bool isctx = step < 2; const int tok0 = ML_TOK0(step);
                const LAS float* sgb = sgall + step * 576; const LAS float *sga = sgb + 128, *sgw = sgb + 256, *sge = sgb + 384, *sgF = sgb + 512;
                __syncthreads();
#pragma unroll
                for (int q = 0; q < 4; ++q) { const int i = tid + q * 512, r = i >> 4, c = i & 15; *(LAS u32x4*)(sK + r * 136 + c * 8) = pK[q]; }
#pragma unroll
                for (int q = 0; q < 2; ++q) { const int i = tid + q * 512, r = i >> 4, c = i & 15; *(LAS u32x4*)(sVT + r * 136 + c * 8) = pVT[q]; }
                bf16x8 qf[4];
#pragma unroll
                for (int ks = 0; ks < 4; ++ks) qf[ks] = pQ[ks];
                if (step + 1 < 18) ML_PREFETCH(step + 1);
                __syncthreads();
                if (!isctx) {
                    const int prow = wave * 16 + r16;
                    f32x4 s[8];
#pragma unroll
                    for (int tile = 0; tile < 8; ++tile) { s[tile] = (f32x4){0.f, 0.f, 0.f, 0.f};
#pragma unroll
                        for (int ks = 0; ks < 4; ++ks) { const bf16x8 kf = *(const LAS bf16x8*)(sK + (tile * 16 + r16) * 136 + ks * 32 + quad * 8); s[tile] = mfma16(kf, qf[ks], s[tile]); } }
                    const float bp = sgb[prow]; float rs = 0.f;
#pragma unroll
                    for (int tile = 0; tile < 8; ++tile) { const f32x4 av = *(const LAS f32x4*)(sga + tile * 16 + quad * 4); f32x4 pe;
#pragma unroll
                        for (int j = 0; j < 4; ++j) { const int dd = (tile * 16 + quad * 4 + j - prow) * sgn;
                            pe[j] = __int_as_float(__float_as_int(s[tile][j] * (bp * av[j])) & ~(dd >> 31)); rs += pe[j]; }
                        u32x2 w; w.x = cvt_pk_bf16(pe[0], pe[1]); w.y = cvt_pk_bf16(pe[2], pe[3]);
                        *(LAS u32x2*)(sS + prow * 136 + tile * 16 + quad * 4) = w; }
                    rs += __shfl_xor(rs, 16); rs += __shfl_xor(rs, 32);
                    asm volatile("s_waitcnt lgkmcnt(0)" ::: "memory");
                    f32x4 a1[4], a2[5];
#pragma unroll
                    for (int vt = 0; vt < 4; ++vt) a1[vt] = (f32x4){0.f, 0.f, 0.f, 0.f};
#pragma unroll
                    for (int vt = 0; vt < 5; ++vt) a2[vt] = (f32x4){0.f, 0.f, 0.f, 0.f};
#pragma unroll
                    for (int ks = 0; ks < 4; ++ks) { const bf16x8 af = *(const LAS bf16x8*)(sS + prow * 136 + ks * 32 + quad * 8);
#pragma unroll
                        for (int vt = 0; vt < 4; ++vt) { const bf16x8 vf = *(const LAS bf16x8*)(sVT + (vt * 16 + r16) * 136 + ks * 32 + quad * 8); a1[vt] = mfma16(vf, af, a1[vt]); } }
#pragma unroll
                    for (int ks = 0; ks < 4; ++ks)
#pragma unroll
                        for (int vt = 0; vt < 5; ++vt) { const bf16x8 cf = *(const LAS bf16x8*)(sC + (vt * 16 + r16) * 136 + ks * 32 + quad * 8); a2[vt] = mfma16(cf, qf[ks], a2[vt]); }
                    const float e = sge[prow];
                    const float qn = __shfl(a2[4][0], r16); const float nq = rs + e * qn; const float inv = 1.f / fmaxf(fabsf(nq), 1.f);
                    bf16_t* hp = Hout + (size_t)(tok0 + prow) * 1024 + hh * 256 + vq * 64 + quad * 4;
#pragma unroll
                    for (int vt = 0; vt < 4; ++vt) { u32x2 w; w.x = cvt_pk_bf16((a1[vt][0] + e * a2[vt][0]) * inv, (a1[vt][1] + e * a2[vt][1]) * inv);
                        w.y = cvt_pk_bf16((a1[vt][2] + e * a2[vt][2]) * inv, (a1[vt][3] + e * a2[vt][3]) * inv); *(u32x2*)(hp + vt * 16) = w; }
                }
                __syncthreads();
                {
                    const float F = sgF[0];
#pragma unroll
                    for (int vt = 0; vt < 4; ++vt) cacc[vt] = cacc[vt] * F;
                    nacc = nacc * F;
                    bf16x8 ones; { const short o1 = (r16 == 0) ? (short)0x3F80 : (short)0;
#pragma unroll
                        for (int e = 0; e < 8; ++e) ones[e] = o1; }
#pragma unroll
                    for (int ks = 0; ks < 4; ++ks) {
                        const LAS bf16_t* kcol = sK + (ks * 32 + quad * 8) * 136 + wave * 16 + r16;
                        const f32x4 w0 = *(const LAS f32x4*)(sgw + ks * 32 + quad * 8), w1 = *(const LAS f32x4*)(sgw + ks * 32 + quad * 8 + 4);
                        f32x4 k0, k1;
#pragma unroll
                        for (int e = 0; e < 4; ++e) { k0[e] = bf2f(kcol[e * 136]) * w0[e]; k1[e] = bf2f(kcol[(4 + e) * 136]) * w1[e]; }
                        const u32x4 pk = pack8(k0, k1); const bf16x8 kts = __builtin_bit_cast(bf16x8, pk);
#pragma unroll
                        for (int vt = 0; vt < 4; ++vt) { const bf16x8 va = *(const LAS bf16x8*)(sVT + (vt * 16 + r16) * 136 + ks * 32 + quad * 8); cacc[vt] = mfma16(kts, va, cacc[vt]); }
                        nacc = mfma16(kts, ones, nacc);
                    }
#pragma unroll
                    for (int vt = 0; vt < 4; ++vt) { u32x2 w; w.x = cvt_pk_bf16(cacc[vt][0], cacc[vt][1]); w.y = cvt_pk_bf16(cacc[vt][2], cacc[vt][3]);
                        *(LAS u32x2*)(sC + (vt * 16 + r16) * 136 + wave * 16 + quad * 4) = w; }
                    if (r16 == 0) { u32x2 w; w.x = cvt_pk_bf16(nacc[0], nacc[1]); w.y = cvt_pk_bf16(nacc[2], nacc[3]); *(LAS u32x2*)(sC + 64 * 136 + wave * 16 + quad * 4) = w; }
                }
            }
        }
    }
    }
    SEAM(4);

    if (IN(5)) {
        unsigned char* const wsb = A.ws; unsigned char* const dob = (unsigned char*)A.out; (void)wsb; (void)dob;
        for (int row = gw; row < ML; row += NGW) {
            const size_t off = (size_t)row * 1024 + lane * 16;
            float ht[16], mo[16];
#pragma unroll
            for (int q = 0; q < 2; ++q) { const u32x4 a = *(const u32x4*)(HF + off + q * 8), c = *(const u32x4*)(HB + off + q * 8), d = *(const u32x4*)(MO + off + q * 8);
#pragma unroll
                for (int e = 0; e < 4; ++e) { ht[q * 8 + 2 * e] = __uint_as_float(a[e] << 16) + __uint_as_float(c[e] << 16); ht[q * 8 + 2 * e + 1] = __uint_as_float(a[e] & 0xffff0000u) + __uint_as_float(c[e] & 0xffff0000u);
                    mo[q * 8 + 2 * e] = __uint_as_float(d[e] << 16); mo[q * 8 + 2 * e + 1] = __uint_as_float(d[e] & 0xffff0000u); } }
            float ss = 0.f;
#pragma unroll
            for (int e = 0; e < 16; ++e) ss += ht[e] * ht[e];
            ss += __shfl_xor(ss, 1); ss += __shfl_xor(ss, 2); ss += __shfl_xor(ss, 4); ss += __shfl_xor(ss, 8);
            const float rs = rsqrtf(ss * (1.f / 256.f) + EPS);
            float r[16];
#pragma unroll
            for (int q = 0; q < 4; ++q) { const f32x4 w = *(const f32x4*)(A.ml_norm_w + lane * 16 + q * 4);
#pragma unroll
                for (int e = 0; e < 4; ++e) r[q * 4 + e] = ht[q * 4 + e] * rs * w[e] * sigmoidf_(mo[q * 4 + e]); }
#pragma unroll
            for (int q = 0; q < 2; ++q) { u32x4 w; w.x = cvt_pk_bf16(r[q * 8 + 0], r[q * 8 + 1]); w.y = cvt_pk_bf16(r[q * 8 + 2], r[q * 8 + 3]); w.z = cvt_pk_bf16(r[q * 8 + 4], r[q * 8 + 5]); w.w = cvt_pk_bf16(r[q * 8 + 6], r[q * 8 + 7]);
                *(u32x4*)(MO + off + q * 8) = w; }
        }
    }
    SEAM(5);

    for (int rep_ = 0; rep_ < (((RPT_MASK >> 6) & 1) ? 2 : 1); ++rep_) { if (rep_) { if (6 == 0) cg::this_grid().sync(); else xcd_barrier(xbar); }
    if (IN(6)) {
        unsigned char* const wsb = A.ws; unsigned char* const dob = (unsigned char*)A.out; (void)wsb; (void)dob;
        pg8::Order S; S.init(64, 4, G, bx, 0);
        { pg8::Gemm g{AQ, WBA, 1024, 1024, 1024, MO, WBM}; EpiMerge E{GA, GM, Y}; pg8::gemm_phase<EpiMerge, pg8::Order, false, true>(lds, g, S, E); }
    }
    }
    SEAM(6);

    for (int rep_ = 0; rep_ < (((RPT_MASK >> 7) & 1) ? 2 : 1); ++rep_) { if (rep_) { if (7 == 0) cg::this_grid().sync(); else xcd_barrier(xbar); }
    if (IN(7)) {
        unsigned char* const wsb = A.ws; unsigned char* const dob = (unsigned char*)A.out; (void)wsb; (void)dob;
        pg8::Order S; S.init(64, 4, G, bx, 0);
#ifdef DBG_P7PLAIN
        pg8::Gemm g{Y, WO, 1024, 1024, 1024}; EpiPlain E{T1, 1024};
        pg8::gemm_phase<EpiPlain, pg8::Order, false>(lds, g, S, E);
#else
        pg8::Gemm g{Y, WO, 1024, 1024, 1024}; EpiOut E{A.x, mod, A.norm2_w, (float*)dob, AQ, rowsq};
        pg8::gemm_phase<EpiOut, pg8::Order, false>(lds, g, S, E);
#endif
    }
    }
    SEAM(7);

    for (int rep_ = 0; rep_ < (((RPT_MASK >> 8) & 1) ? 2 : 1); ++rep_) { if (rep_) { if (8 == 0) cg::this_grid().sync(); else xcd_barrier(xbar); }
    if (IN(8)) {
        unsigned char* const wsb = A.ws; unsigned char* const dob = (unsigned char*)A.out; (void)wsb; (void)dob;
        pg8::Order S; S.init(64, 22, G, bx, 0);
        pg8::Gemm g{AQ, WUP, 1024, 1024, 1024}; EpiUp E{rowsq, fbias, A.conv_w, A.conv_b, ACT, RAWU, (LAS float*)(lds + 131072)};
        pg8::gemm_phase<EpiUp, pg8::Order, true>(lds, g, S, E);
    }
    }
    SEAM(8);

    if (IN(9)) {
        unsigned char* const wsb = A.ws; unsigned char* const dob = (unsigned char*)A.out; (void)wsb; (void)dob;
        const float* cw = A.conv_w; const float* cb = A.conv_b;
        for (int task = bx * 512 + tid; task < 1025 * 352; task += G * 512) {
            const int ch = task % 352, bd = task / 352, j0 = ch * 8;
            const int pc = 256 * (j0 >> 7) + (j0 & 127);
            const bool lo_ok = bd > 0, hi_ok = bd < 1024, seam = ((bd * 16) & 2047) == 0;
            const u32x4 zero = (u32x4){0u, 0u, 0u, 0u};
            u32x4 xa[4], xg[4];
#pragma unroll
            for (int k = 0; k < 4; ++k) { xa[k] = zero; xg[k] = zero; }
            if (lo_ok) { const bf16_t* rp = RAWU + ((size_t)(bd - 1) * 4 + 2) * NUP + pc; xa[0] = *(const u32x4*)rp; xg[0] = *(const u32x4*)(rp + 128); xa[1] = *(const u32x4*)(rp + NUP); xg[1] = *(const u32x4*)(rp + NUP + 128); }
            if (hi_ok) { const bf16_t* rp = RAWU + ((size_t)bd * 4) * NUP + pc; xa[2] = *(const u32x4*)rp; xg[2] = *(const u32x4*)(rp + 128); xa[3] = *(const u32x4*)(rp + NUP); xg[3] = *(const u32x4*)(rp + NUP + 128); }
            float wa[3][8], wg[3][8], ba[8], bg[8];
#pragma unroll
            for (int i = 0; i < 3; ++i)
#pragma unroll
                for (int q = 0; q < 2; ++q) { const f32x4 a = *(const f32x4*)(cw + i * NUP + j0 + 4 * q), g = *(const f32x4*)(cw + i * NUP + DFF + j0 + 4 * q);
#pragma unroll
                    for (int e = 0; e < 4; ++e) { wa[i][4 * q + e] = a[e]; wg[i][4 * q + e] = g[e]; } }
#pragma unroll
            for (int q = 0; q < 2; ++q) { const f32x4 a = *(const f32x4*)(cb + j0 + 4 * q), g = *(const f32x4*)(cb + DFF + j0 + 4 * q);
#pragma unroll
                for (int e = 0; e < 4; ++e) { ba[4 * q + e] = a[e]; bg[4 * q + e] = g[e]; } }
#pragma unroll
            for (int side = 0; side < 2; ++side) {
                if (side == 0 ? !lo_ok : !hi_ok) continue;
                float r[8];
#pragma unroll
                for (int e = 0; e < 8; ++e) { const int w = e >> 1; const bool hi16 = e & 1;
                    float va[3], vg[3];
#pragma unroll
                    for (int k = 0; k < 3; ++k) { const unsigned aw = xa[side + k][w], gw = xg[side + k][w];
                        va[k] = hi16 ? __uint_as_float(aw & 0xffff0000u) : __uint_as_float(aw << 16); vg[k] = hi16 ? __uint_as_float(gw & 0xffff0000u) : __uint_as_float(gw << 16); }
                    if (seam) { if (side == 0) { va[2] = 0.f; vg[2] = 0.f; } else { va[0] = 0.f; vg[0] = 0.f; } }
                    const float av = ba[e] + wa[0][e] * va[0] + wa[1][e] * va[1] + wa[2][e] * va[2];
                    const float gv = bg[e] + wg[0][e] * vg[0] + wg[1][e] * vg[1] + wg[2][e] * vg[2];
                    r[e] = gv * sigmoidf_(gv) * av; }
                u32x4 w; w.x = cvt_pk_bf16(r[0], r[1]); w.y = cvt_pk_bf16(r[2], r[3]); w.z = cvt_pk_bf16(r[4], r[5]); w.w = cvt_pk_bf16(r[6], r[7]);
                *(u32x4*)(ACT + (size_t)(bd * 16 - 1 + side) * DFF + j0) = w;
            }
        }
    }
    SEAM(9);

    if (IN(10)) {
        unsigned char* const wsb = A.ws; unsigned char* const dob = (unsigned char*)A.out; (void)wsb; (void)dob;
        pg8::Order S; S.init(64, 4, G, bx, 0);
        pg8::Gemm g{ACT, WDN, DFF, DFF, DFF}; EpiDown E{(float*)dob, mod, AQ, A.norm2_w};
        pg8::gemm_phase<EpiDown, pg8::Order, false>(lds, g, S, E);
    }
#undef IN
#undef SEAM
}
#undef A

extern "C" void kernel_launch(void* const* d_in, const int* in_sizes, int n_in, void* d_out, int out_size, void* d_ws, size_t ws_size, hipStream_t stream) {
    static int grid = 0;
    if (grid == 0) {
        if (n_in != 21 || out_size != ML * D || ws_size < WS_END) { fprintf(stderr, "kernel_launch: unexpected shapes (n_in %d out %d ws %zu)\n", n_in, out_size, ws_size); grid = -1; return; }
        int dev = 0, cus = 0, per_cu = 0;
        hipGetDevice(&dev); hipDeviceGetAttribute(&cus, hipDeviceAttributeMultiprocessorCount, dev);
        hipFuncSetAttribute((const void*)fwd_kernel, hipFuncAttributeMaxDynamicSharedMemorySize, LDS_BYTES);
        hipOccupancyMaxActiveBlocksPerMultiprocessor(&per_cu, (const void*)fwd_kernel, 512, LDS_BYTES);
        if (per_cu < 1) { fprintf(stderr, "kernel_launch: occupancy query says %d blocks per CU\n", per_cu); per_cu = 1; }
        grid = cus * per_cu;
        (void)hipGetLastError();
    }
    if (grid < 0) return;
    Args a{};
    const float** pp = (const float**)&a;
    for (int i = 0; i < 21; ++i) pp[i] = (const float*)d_in[i];
    a.out = (float*)d_out; a.ws = (unsigned char*)d_ws;
#if ONE_LAUNCH
    a.ph_lo = 0; a.ph_hi = 11;
    void* args[] = {&a};
    hipError_t e = hipLaunchCooperativeKernel((const void*)fwd_kernel, dim3(grid), dim3(512), args, LDS_BYTES, stream);
    if (e != hipSuccess) fprintf(stderr, "cooperative launch failed: %s (grid %d)\n", hipGetErrorString(e), grid);
#else
    for (int p = 0; p < 11; ++p) { a.ph_lo = p; a.ph_hi = p + 1; hipLaunchKernelGGL(fwd_kernel, dim3(grid), dim3(512), LDS_BYTES, stream, a); }

#endif
}
```

```cpp
#include <hip/hip_runtime.h>
#include <hip/hip_cooperative_groups.h>
#include <cstdio>
#include <cstdint>
namespace cg = cooperative_groups;

#ifndef RPT_MASK
#define RPT_MASK 0
#endif
#ifndef ONE_LAUNCH
#define ONE_LAUNCH 1
#endif

#define LAS __attribute__((address_space(3)))
typedef unsigned short bf16_t;
typedef short bf16x8 __attribute__((ext_vector_type(8)));
typedef float f32x4 __attribute__((ext_vector_type(4)));
typedef unsigned u32x4 __attribute__((ext_vector_type(4)));
typedef unsigned u32x2 __attribute__((ext_vector_type(2)));

constexpr int D = 1024, NB = 8, SEQ = 2048, CTX = 256;
constexpr int ML = NB * SEQ;
constexpr int MC = NB * CTX;
constexpr int MT = ML + MC;
constexpr int DFF = 2816, NUP = 2 * DFF, INW = 6672;
constexpr float EPS = 1e-6f;
constexpr size_t MiB = 1u << 20;
constexpr size_t WS_ZERO = 0;
constexpr size_t WS_MOD = 0, WS_FB = 256 * 1024, WS_RSQ = 512 * 1024;
constexpr size_t WS_MODP = 236 * MiB + 12 * MiB;
constexpr size_t WS_RSQP = 252 * MiB;
constexpr size_t DO_FBP = 60 * MiB;
constexpr size_t WS_ROPE = 1 * MiB;
constexpr size_t WS_GATES = 2 * MiB;
constexpr size_t WS_WBA = 4 * MiB, WS_WBM = 6 * MiB, WS_WO = 8 * MiB, WS_WUP = 10 * MiB, WS_WDN = 21 * MiB;
constexpr size_t WS_AQ = 27 * MiB;
constexpr size_t WS_MQ = 59 * MiB, WS_MK = 75 * MiB  , WS_MO = 93 * MiB, WS_GA = 125 * MiB, WS_GM = 157 * MiB, WS_XT = 189 * MiB  ;
constexpr size_t WS_T1 = 59 * MiB, WS_Y = 189 * MiB;
constexpr size_t WS_U = 59 * MiB;
constexpr size_t WS_HALO = 236 * MiB;
constexpr size_t WS_ACT = 59 * MiB;
constexpr size_t WS_RAW = 147 * MiB;
constexpr size_t WS_END = 256 * MiB;
constexpr size_t DO_H = 0, DO_W1T = 36 * MiB, DO_W2T = 47 * MiB, DO_AK = 51 * MiB;
constexpr size_t DO_HF = 0, DO_HB = 32 * MiB;
constexpr int LDS_BYTES = 157696;

typedef float f32x2_t __attribute__((ext_vector_type(2))); typedef __bf16 bf16x2_t __attribute__((ext_vector_type(2)));
__device__ __forceinline__ unsigned cvt_pk_bf16(float lo, float hi) { f32x2_t v = {lo, hi}; bf16x2_t b = __builtin_convertvector(v, bf16x2_t); return __builtin_bit_cast(unsigned, b); }
__device__ __forceinline__ float bf2f(unsigned short v) { return __uint_as_float((unsigned)v << 16); }
__device__ __forceinline__ bf16_t f2bf(float f) { return (bf16_t)(cvt_pk_bf16(f, 0.f) & 0xffffu); }
__device__ __forceinline__ u32x4 pack8(f32x4 a, f32x4 b) { u32x4 w; w.x = cvt_pk_bf16(a[0], a[1]); w.y = cvt_pk_bf16(a[2], a[3]); w.z = cvt_pk_bf16(b[0], b[1]); w.w = cvt_pk_bf16(b[2], b[3]); return w; }
__device__ __forceinline__ float sigmoidf_(float x) { return __builtin_amdgcn_rcpf(1.f + __expf(-x)); }
__device__ __forceinline__ float sigmoid_div(float x) { return 1.f / (1.f + __expf(-x)); }
__device__ __forceinline__ float wave_sum(float v) {
#pragma unroll
    for (int o = 1; o < 64; o <<= 1) v += __shfl_xor(v, o);
    return v;
}

namespace pg8 {
constexpr int BM = 256, BK = 64, HALF = 128, HTB = HALF * BK * 2, STAGE_BYTES = 8 * HTB, NXCD = 8, WGM = 8;
__host__ __device__ __forceinline__ int lds_byte(int r, int c) { const int st = (r >> 4) * 2 + (c >> 5), rr = r & 15, cc = c & 31, ob = rr * 64 + cc * 2; return st * 1024 + (ob ^ (((ob >> 9) & 1) << 5)); }
__host__ __device__ __forceinline__ void stage_rc(int b, int& R, int& C) { const int st = b / 1024, sb = b % 1024, swz = sb ^ (((sb >> 9) & 1) << 5); R = (st >> 1) * 16 + swz / 64; C = (st & 1) * 32 + (swz % 64) / 2; }
__host__ __device__ __forceinline__ int perm32(int rho) { const int n = rho >> 4, i = rho & 15; return 8 * (i >> 2) + 4 * n + (i & 3); }

struct Unit { int pm, pn; };
struct Gemm { const bf16_t* A; const bf16_t* Bt; int lda, ldb, K; const bf16_t* A2 = nullptr; const bf16_t* Bt2 = nullptr; };

struct Order {
    int nM, nN, nwg, G, c, extra;
    __device__ __forceinline__ void init(int nM_, int nN_, int G_, int c_, int extra_) { nM = nM_; nN = nN_; nwg = nM_ * nN_; G = G_; c = c_; extra = extra_; }
    __device__ __forceinline__ bool next(int i, Unit& u) const {
        const long Lq = (long)i * G + c; if (Lq >= nwg + extra) return false;
        if (Lq >= nwg) { const int e = (int)(Lq - nwg); u.pm = nM + e / 3; u.pn = e % 3; return true; }
        int wgid = (int)Lq; { const int q = nwg / NXCD, r = nwg % NXCD, xcd = wgid % NXCD, off = wgid / NXCD; wgid = (xcd < r ? xcd * (q + 1) : r * (q + 1) + (xcd - r) * q) + off; }
        const int nig = WGM * nN, gid = wgid / nig, fm = gid * WGM, gsz = (nM - fm) < WGM ? (nM - fm) : WGM;
        u.pm = fm + ((wgid % nig) % gsz); u.pn = (wgid % nig) / gsz; return true;
    }
};

template <class Epi, class Sched, bool ALIGN_EPI, bool DUAL = false>
__device__ __forceinline__ void gemm_phase(LAS unsigned char* lds, const Gemm g, const Sched& S, const Epi& E) {
    int tid_ = threadIdx.x; asm volatile("" : "+v"(tid_));
    const int tid = tid_, wid = __builtin_amdgcn_readfirstlane(tid >> 6), lane = tid & 63, wr = wid >> 2, wc = wid & 3, fr = lane & 15, fq = lane >> 4;
    const int K = g.K, nt1 = K / BK, nt = DUAL ? 2 * nt1 : nt1;
    unsigned voffA[2], voffB[2];
#pragma unroll
    for (int i = 0; i < 2; ++i) { int R, C; stage_rc(tid * 16 + i * 8192, R, C); const int Rb = ((R & ~31) + perm32(R & 31));
        voffA[i] = (unsigned)(R * g.lda + C) * 2u; voffB[i] = (unsigned)(Rb * g.ldb + C) * 2u; }
    const size_t kstep = (size_t)(BK * 2);
    const size_t hstepA = (size_t)HALF * g.lda * 2, hstepB = (size_t)HALF * g.ldb * 2;
    const size_t tstepA = 2 * hstepA, tstepB = 2 * hstepB;
    const unsigned ldsw = (unsigned)wid * 1024u;
    const int aoff = lds_byte(wr * 64 + fr, fq * 8), boff = lds_byte(wc * 32 + fr, fq * 8);
#define PG8_SA(b, h) (((b) * 2 + (h)) * HTB)
#define PG8_SB(b, h) ((4 + (b) * 2 + (h)) * HTB)
#define PG8_STAGE(bufoff, gbase, voff) do { _Pragma("unroll") for (int _i = 0; _i < 2; ++_i) \
        __builtin_amdgcn_global_load_lds((const unsigned*)((const char*)(gbase) + (voff)[_i]), (LAS unsigned*)(lds + (bufoff) + ldsw + _i * 8192), 16, 0, 0); } while (0)
#define PG8_LDA(dst, b, h) do { _Pragma("unroll") for (int m = 0; m < 4; ++m) _Pragma("unroll") for (int k = 0; k < 2; ++k) dst[m][k] = *(const LAS bf16x8*)(lds + PG8_SA(b, h) + aoff + m * 2048 + k * 1024); } while (0)
#define PG8_LDB(dst, b, h) do { _Pragma("unroll") for (int n = 0; n < 2; ++n) _Pragma("unroll") for (int k = 0; k < 2; ++k) dst[n][k] = *(const LAS bf16x8*)(lds + PG8_SB(b, h) + boff + n * 2048 + k * 1024); } while (0)
#define PG8_MMA(ai, bj, At, Bt) do { __builtin_amdgcn_s_setprio(1); _Pragma("unroll") for (int m = 0; m < 4; ++m) _Pragma("unroll") for (int n = 0; n < 2; ++n) _Pragma("unroll") for (int k = 0; k < 2; ++k) \
        acc[ai][bj][m][n] = __builtin_amdgcn_mfma_f32_16x16x32_bf16(Bt[n][k], At[m][k], acc[ai][bj][m][n], 0, 0, 0); __builtin_amdgcn_s_setprio(0); } while (0)
#define PG8_WAIT_V(n) asm volatile("s_waitcnt vmcnt(" #n ")" ::: "memory")
#define PG8_WAIT_L(n) asm volatile("s_waitcnt lgkmcnt(" #n ")" ::: "memory")
#define PG8_BAR __builtin_amdgcn_s_barrier()
#define PG8_SCHED __builtin_amdgcn_sched_barrier(0)
    Unit cur, nxt; int ui = 0;
    if (!S.next(0, cur)) return;
    f32x4 acc[2][2][4][2];
#pragma unroll
    for (int a = 0; a < 2; ++a)
#pragma unroll
        for (int b = 0; b < 2; ++b)
#pragma unroll
            for (int m = 0; m < 4; ++m)
#pragma unroll
                for (int n = 0; n < 2; ++n) acc[a][b][m][n] = (f32x4){0.f, 0.f, 0.f, 0.f};
    bf16x8 At[4][2], B0[2][2], B1[2][2];
    const char* cA = (const char*)g.A + (size_t)cur.pm * tstepA; const char* cB = (const char*)g.Bt + (size_t)cur.pn * tstepB;
    const char* cA2 = DUAL ? (const char*)g.A2 + (size_t)cur.pm * tstepA : cA; const char* cB2 = DUAL ? (const char*)g.Bt2 + (size_t)cur.pn * tstepB : cB;
    PG8_STAGE(PG8_SB(0, 0), cB, voffB); PG8_STAGE(PG8_SB(0, 1), cB + hstepB, voffB); PG8_STAGE(PG8_SA(0, 0), cA, voffA); PG8_STAGE(PG8_SA(0, 1), cA + hstepA, voffA);
    if (wr == 1) PG8_BAR;
    PG8_WAIT_V(2); PG8_BAR;
    PG8_STAGE(PG8_SB(1, 0), cB + kstep, voffB); PG8_STAGE(PG8_SA(1, 0), cA + kstep, voffA); PG8_STAGE(PG8_SB(1, 1), cB + hstepB + kstep, voffB);
    PG8_WAIT_V(6); PG8_BAR;
    for (;;) {
        const bool has_next = S.next(ui + 1, nxt);
        const char* nA = has_next ? (const char*)g.A + (size_t)nxt.pm * tstepA : cA; const char* nB = has_next ? (const char*)g.Bt + (size_t)nxt.pn * tstepB : cB;
        for (int t = 0; t < nt; t += 2) {
            const bool last = (t == nt - 2);
            const bool seg2 = DUAL && t >= nt1, seg2n = DUAL && t + 2 >= nt1;
            const char* a1 = seg2 ? cA2 + (size_t)(t + 1 - nt1) * kstep : cA + (size_t)(t + 1) * kstep;
            const char* a2 = last ? nA : (seg2n ? cA2 + (size_t)(t + 2 - nt1) * kstep : cA + (size_t)(t + 2) * kstep);
            const char* b2 = last ? nB : (seg2n ? cB2 + (size_t)(t + 2 - nt1) * kstep : cB + (size_t)(t + 2) * kstep);
            if constexpr (DUAL) { if (t == nt1) E.mid(acc, cur, wr, wc, fr, fq); }
            const char* a3 = a2 + kstep; const char* b3 = b2 + kstep;
            PG8_LDB(B0, 0, 0); PG8_LDB(B1, 0, 1); PG8_SCHED; PG8_LDA(At, 0, 0); PG8_STAGE(PG8_SA(1, 1), a1 + hstepA, voffA);
            PG8_WAIT_V(8); PG8_WAIT_L(0); PG8_BAR; PG8_MMA(0, 0, At, B0); PG8_MMA(0, 1, At, B1); PG8_BAR; PG8_SCHED;
            PG8_LDA(At, 0, 1); PG8_STAGE(PG8_SB(0, 0), b2, voffB); PG8_STAGE(PG8_SB(0, 1), b2 + hstepB, voffB); PG8_STAGE(PG8_SA(0, 0), a2, voffA);
            PG8_WAIT_V(8); PG8_WAIT_L(0); PG8_BAR; PG8_MMA(1, 0, At, B0); PG8_MMA(1, 1, At, B1); PG8_BAR; PG8_SCHED;
            PG8_LDB(B0, 1, 0); PG8_LDB(B1, 1, 1); PG8_SCHED; PG8_LDA(At, 1, 0); PG8_STAGE(PG8_SA(0, 1), a2 + hstepA, voffA);
            PG8_WAIT_V(8); PG8_WAIT_L(0); PG8_BAR; PG8_MMA(0, 0, At, B0); PG8_MMA(0, 1, At, B1); PG8_BAR; PG8_SCHED;
            PG8_LDA(At, 1, 1); PG8_STAGE(PG8_SB(1, 0), b3, voffB); PG8_STAGE(PG8_SB(1, 1), b3 + hstepB, voffB); PG8_STAGE(PG8_SA(1, 0), a3, voffA);
            PG8_WAIT_V(8); PG8_WAIT_L(0); PG8_BAR; PG8_MMA(1, 0, At, B0); PG8_MMA(1, 1, At, B1); PG8_BAR; PG8_SCHED;
        }
        if constexpr (ALIGN_EPI) { if (wr == 0) PG8_BAR; }
        E(acc, cur, wr, wc, fr, fq);
        if (!has_next) break;
#pragma unroll
        for (int a = 0; a < 2; ++a)
#pragma unroll
            for (int b = 0; b < 2; ++b)
#pragma unroll
                for (int m = 0; m < 4; ++m)
#pragma unroll
                    for (int n = 0; n < 2; ++n) acc[a][b][m][n] = (f32x4){0.f, 0.f, 0.f, 0.f};
        cur = nxt; cA = nA; cB = nB; ++ui;
        if constexpr (DUAL) { cA2 = (const char*)g.A2 + (size_t)cur.pm * tstepA; cB2 = (const char*)g.Bt2 + (size_t)cur.pn * tstepB; }
        if constexpr (ALIGN_EPI) { if (wr == 1) PG8_BAR; }
    }
    PG8_WAIT_V(0);
    if constexpr (!ALIGN_EPI) { if (wr == 0) PG8_BAR; }
    PG8_BAR;
#undef PG8_SA
#undef PG8_SB
#undef PG8_STAGE
#undef PG8_LDA
#undef PG8_LDB
#undef PG8_MMA
#undef PG8_WAIT_V
#undef PG8_WAIT_L
#undef PG8_BAR
#undef PG8_SCHED
}
}
using pg8::Unit;
typedef const f32x4 (&AccRef)[2][2][4][2];

struct EpiIn {
    bf16_t *AK_, *MK_, *AQ_, *MQ_, *MO_, *GA_, *GM_; const float *qnw, *knw, *cosT_, *sinT_; LAS float* sp;
    __device__ __forceinline__ void head_path(AccRef acc, const Unit& u, int wr, int wc, int fr, int fq_in, bf16_t* base, int ld, int coff, const float* nw) const {
        int fq = fq_in; asm volatile("" : "+v"(fq));
        const int row0 = u.pm * 256 + wr * 64 + fr;
        const bool rope = u.pm < 64;
        { int tx = threadIdx.x; asm volatile("" : "+v"(tx)); const int tt0 = (u.pm * 256) & 2047;
          for (int i = tx; i < (rope ? 2512 : 64); i += 512) { float v;
              if (i < 64) v = nw[i];
              else if (i < 208) { const int k = i - 64, gi = k / 36, e = k - gi * 36; const int t = tt0 + 64 * gi; v = e < 16 ? cosT_[t * 32 + e] : e < 32 ? sinT_[t * 32 + e - 16] : 0.f; }
              else { const int k = i - 208, c = k / 36, e = k - c * 36; const int t = tt0 + c; v = e < 16 ? cosT_[t * 32 + 16 + e] : e < 32 ? sinT_[t * 32 + e] : 0.f; }
              sp[i] = v; }
          asm volatile("s_waitcnt vmcnt(0) lgkmcnt(0)" ::: "memory"); __builtin_amdgcn_s_barrier(); asm volatile("" ::: "memory"); }
        const f32x4 w00 = *(const LAS f32x4*)(sp + 8 * fq), w01 = *(const LAS f32x4*)(sp + 8 * fq + 4), w10 = *(const LAS f32x4*)(sp + 32 + 8 * fq), w11 = *(const LAS f32x4*)(sp + 32 + 8 * fq + 4);
#pragma unroll
        for (int ai = 0; ai < 2; ++ai)
#pragma unroll
            for (int m = 0; m < 4; ++m) {
                const int row = row0 + ai * 128 + m * 16;
                f32x4 v00 = acc[ai][0][m][0], v01 = acc[ai][0][m][1], v10 = acc[ai][1][m][0], v11 = acc[ai][1][m][1];
                f32x4 q = v00 * v00 + v01 * v01 + v10 * v10 + v11 * v11;
                float ss = (q[0] + q[1]) + (q[2] + q[3]);
                ss += __shfl_xor(ss, 16); ss += __shfl_xor(ss, 32);
                const float rs = rsqrtf(ss * (1.f / 64.f) + EPS);
                v00 = v00 * rs * w00; v01 = v01 * rs * w01; v10 = v10 * rs * w10; v11 = v11 * rs * w11;
                f32x4 o00 = v00, o01 = v01, o10 = v10, o11 = v11;
                if (rope) {
                    const int r = ai * 128 + wr * 64 + m * 16 + fr;
                    const LAS float* cp = sp + ((fq < 2) ? 64 + (r >> 6) * 36 + 8 * fq : 208 + (r & 63) * 36 + 8 * (fq - 2));
                    const f32x4 c0 = *(const LAS f32x4*)cp, c1 = *(const LAS f32x4*)(cp + 4), s0 = *(const LAS f32x4*)(cp + 16), s1 = *(const LAS f32x4*)(cp + 20);
                    o00 = v00 * c0 - v10 * s0; o01 = v01 * c1 - v11 * s1; o10 = v00 * s0 + v10 * c0; o11 = v01 * s1 + v11 * c1;
                }
                bf16_t* p = base + (size_t)row * ld + coff + wc * 64 + 8 * fq;
                *(u32x4*)p = pack8(o00, o01); *(u32x4*)(p + 32) = pack8(o10, o11);
                asm volatile("" ::: "memory");
            }
    }
    template <bool SIG> __device__ __forceinline__ void plain_path(AccRef acc, const Unit& u, int wr, int wc, int fr, int fq, bf16_t* base, int ld, int coff) const {
        const int row0 = u.pm * 256 + wr * 64 + fr;
#pragma unroll
        for (int ai = 0; ai < 2; ++ai)
#pragma unroll
            for (int m = 0; m < 4; ++m) {
                bf16_t* p = base + (size_t)(row0 + ai * 128 + m * 16) * ld + coff + wc * 32 + 8 * fq;
#pragma unroll
                for (int bj = 0; bj < 2; ++bj) { f32x4 v0 = acc[ai][bj][m][0], v1 = acc[ai][bj][m][1];
                    if (SIG) {
#pragma unroll
                        for (int e = 0; e < 4; ++e) { v0[e] = sigmoid_div(v0[e]); v1[e] = sigmoid_div(v1[e]); } }
                    *(u32x4*)(p + bj * 128) = pack8(v0, v1); }
            }
    }
    __device__ __forceinline__ void operator()(AccRef acc, const Unit& u, int wr, int wc, int fr, int fq) const {
        const int pn = u.pn;
        if (pn == 0) head_path(acc, u, wr, wc, fr, fq, AK_, 256, 0, knw);
        else if (pn <= 2) plain_path<false>(acc, u, wr, wc, fr, fq, MK_, 512, (pn - 1) * 256);
        else if (pn <= 6) head_path(acc, u, wr, wc, fr, fq, AQ_, 1024, (pn - 3) * 256, qnw);
        else if (pn <= 8) plain_path<false>(acc, u, wr, wc, fr, fq, MQ_, 512, (pn - 7) * 256);
        else if (pn <= 12) plain_path<false>(acc, u, wr, wc, fr, fq, MO_, 1024, (pn - 9) * 256);
        else if (pn <= 16) plain_path<true>(acc, u, wr, wc, fr, fq, GA_, 1024, (pn - 13) * 256);
        else plain_path<true>(acc, u, wr, wc, fr, fq, GM_, 1024, (pn - 17) * 256);
    }
};
struct EpiPlain {
    bf16_t* O; int ldc;
    __device__ __forceinline__ void operator()(AccRef acc, const Unit& u, int wr, int wc, int fr, int fq) const {
        const int row0 = u.pm * 256 + wr * 64 + fr;
#pragma unroll
        for (int ai = 0; ai < 2; ++ai)
#pragma unroll
            for (int m = 0; m < 4; ++m) {
                bf16_t* p = O + (size_t)(row0 + ai * 128 + m * 16) * ldc + u.pn * 256 + wc * 32 + 8 * fq;
#pragma unroll
                for (int bj = 0; bj < 2; ++bj) *(u32x4*)(p + bj * 128) = pack8(acc[ai][bj][m][0], acc[ai][bj][m][1]);
            }
    }
};
template <bool ADD> struct EpiGate {
    const bf16_t* Gt; const bf16_t* T; bf16_t* O;
    __device__ __forceinline__ void operator()(AccRef acc, const Unit& u, int wr, int wc, int fr, int fq) const {
        const int row0 = u.pm * 256 + wr * 64 + fr;
        const size_t off0 = (size_t)row0 * 1024 + u.pn * 256 + wc * 32 + 8 * fq;
        u32x4 gv[2][2], tv[2][2];
#pragma unroll
        for (int bj = 0; bj < 2; ++bj) { gv[0][bj] = *(const u32x4*)(Gt + off0 + bj * 128); tv[0][bj] = (u32x4){0u, 0u, 0u, 0u}; if (ADD) tv[0][bj] = *(const u32x4*)(T + off0 + bj * 128); }
#pragma unroll
        for (int it = 0; it < 8; ++it) {
            const int ai = it >> 2, m = it & 3, cur = it & 1, nx = cur ^ 1;
            const size_t off = off0 + (size_t)(ai * 128 + m * 16) * 1024;
            if (it < 7) { const size_t offn = off0 + (size_t)(((it + 1) >> 2) * 128 + ((it + 1) & 3) * 16) * 1024;
#pragma unroll
                for (int bj = 0; bj < 2; ++bj) { gv[nx][bj] = *(const u32x4*)(Gt + offn + bj * 128); tv[nx][bj] = (u32x4){0u, 0u, 0u, 0u}; if (ADD) tv[nx][bj] = *(const u32x4*)(T + offn + bj * 128); } }
#pragma unroll
            for (int bj = 0; bj < 2; ++bj) {
                float r[8];
#pragma unroll
                for (int e = 0; e < 8; ++e) {
                    const unsigned gw = gv[cur][bj][e >> 1], tw = tv[cur][bj][e >> 1];
                    const float gg = (e & 1) ? __uint_as_float(gw & 0xffff0000u) : __uint_as_float(gw << 16);
                    const float tt = (e & 1) ? __uint_as_float(tw & 0xffff0000u) : __uint_as_float(tw << 16);
                    r[e] = tt + sigmoidf_(gg) * acc[ai][bj][m][e >> 2][e & 3];
                }
                u32x4 w; w.x = cvt_pk_bf16(r[0], r[1]); w.y = cvt_pk_bf16(r[2], r[3]); w.z = cvt_pk_bf16(r[4], r[5]); w.w = cvt_pk_bf16(r[6], r[7]);
                *(u32x4*)(O + off + bj * 128) = w;
            }
        }
    }
};
struct EpiMerge {
    const bf16_t* Sa; const bf16_t* Sm; bf16_t* O;
    __device__ __forceinline__ void mid(f32x4 (&acc)[2][2][4][2], const Unit& u, int wr, int wc, int fr, int fq) const {
        const size_t off0 = (size_t)(u.pm * 256 + wr * 64 + fr) * 1024 + u.pn * 256 + wc * 32 + 8 * fq;
        u32x4 av[2][2], mv[2][2];
#pragma unroll
        for (int bj = 0; bj < 2; ++bj) { av[0][bj] = *(const u32x4*)(Sa + off0 + bj * 128); mv[0][bj] = *(const u32x4*)(Sm + off0 + bj * 128); }
#pragma unroll
        for (int it = 0; it < 8; ++it) {
            const int ai = it >> 2, m = it & 3, cur = it & 1, nx = cur ^ 1;
            if (it < 7) { const size_t offn = off0 + (size_t)(((it + 1) >> 2) * 128 + ((it + 1) & 3) * 16) * 1024;
#pragma unroll
                for (int bj = 0; bj < 2; ++bj) { av[nx][bj] = *(const u32x4*)(Sa + offn + bj * 128); mv[nx][bj] = *(const u32x4*)(Sm + offn + bj * 128); } }
#pragma unroll
            for (int bj = 0; bj < 2; ++bj)
#pragma unroll
                for (int e = 0; e < 8; ++e) {
                    const unsigned aw = av[cur][bj][e >> 1], mw = mv[cur][bj][e >> 1];
                    const float sa = (e & 1) ? __uint_as_float(aw & 0xffff0000u) : __uint_as_float(aw << 16);
                    const float sm = (e & 1) ? __uint_as_float(mw & 0xffff0000u) : __uint_as_float(mw << 16);
                    acc[ai][bj][m][e >> 2][e & 3] *= sa * __builtin_amdgcn_rcpf(fmaxf(sm, 1e-30f));
                }
        }
    }
    __device__ __forceinline__ void operator()(AccRef acc, const Unit& u, int wr, int wc, int fr, int fq) const {
        const size_t off0 = (size_t)(u.pm * 256 + wr * 64 + fr) * 1024 + u.pn * 256 + wc * 32 + 8 * fq;
        u32x4 mv[2][2];
#pragma unroll
        for (int bj = 0; bj < 2; ++bj) mv[0][bj] = *(const u32x4*)(Sm + off0 + bj * 128);
#pragma unroll
        for (int it = 0; it < 8; ++it) {
            const int ai = it >> 2, m = it & 3, cur = it & 1, nx = cur ^ 1;
            const size_t off = off0 + (size_t)(ai * 128 + m * 16) * 1024;
            if (it < 7) { const size_t offn = off0 + (size_t)(((it + 1) >> 2) * 128 + ((it + 1) & 3) * 16) * 1024;
#pragma unroll
                for (int bj = 0; bj < 2; ++bj) mv[nx][bj] = *(const u32x4*)(Sm + offn + bj * 128); }
#pragma unroll
            for (int bj = 0; bj < 2; ++bj) { float r[8];
#pragma unroll
                for (int e = 0; e < 8; ++e) { const unsigned mw = mv[cur][bj][e >> 1];
                    const float sm = (e & 1) ? __uint_as_float(mw & 0xffff0000u) : __uint_as_float(mw << 16);
                    r[e] = fmaxf(sm, 1e-30f) * acc[ai][bj][m][e >> 2][e & 3]; }
                u32x4 w; w.x = cvt_pk_bf16(r[0], r[1]); w.y = cvt_pk_bf16(r[2], r[3]); w.z = cvt_pk_bf16(r[4], r[5]); w.w = cvt_pk_bf16(r[6], r[7]);
                *(u32x4*)(O + off + bj * 128) = w; }
        }
    }
};
struct EpiOut {
    const float* x; const float* mod; const float* nw2; float* xmid; bf16_t* AP; float* rowsq;
    __device__ __forceinline__ void operator()(AccRef acc, const Unit& u, int wr, int wc, int fr, int fq) const {
        const int b = u.pm >> 3; const float* mb = mod + b * 6144;
        const int row0 = u.pm * 256 + wr * 64 + fr, col0 = u.pn * 256 + wc * 32 + 8 * fq;
        f32x4 g1[2][2], sw[2][2];
#pragma unroll
        for (int bj = 0; bj < 2; ++bj)
#pragma unroll
            for (int n = 0; n < 2; ++n) { const int c = col0 + bj * 128 + 4 * n; g1[bj][n] = *(const f32x4*)(mb + 2048 + c);
                sw[bj][n] = *(const f32x4*)(nw2 + c) * (*(const f32x4*)(mb + 4096 + c) + 1.f); }
        f32x4 xv[2][2][2];
#pragma unroll
        for (int bj = 0; bj < 2; ++bj)
#pragma unroll
            for (int n = 0; n < 2; ++n) xv[0][bj][n] = *(const f32x4*)(x + (size_t)row0 * 1024 + col0 + bj * 128 + 4 * n);
#pragma unroll
        for (int it = 0; it < 8; ++it) {
            const int ai = it >> 2, m = it & 3, cur = it & 1, nx = cur ^ 1;
            const int row = row0 + ai * 128 + m * 16; const size_t off = (size_t)row * 1024 + col0; float ss = 0.f;
            if (it < 7) { const size_t offn = (size_t)(row0 + ((it + 1) >> 2) * 128 + ((it + 1) & 3) * 16) * 1024 + col0;
#pragma unroll
                for (int bj = 0; bj < 2; ++bj)
#pragma unroll
                    for (int n = 0; n < 2; ++n) xv[nx][bj][n] = *(const f32x4*)(x + offn + bj * 128 + 4 * n); }
#pragma unroll
            for (int bj = 0; bj < 2; ++bj) {
                f32x4 v[2];
#pragma unroll
                for (int n = 0; n < 2; ++n) { v[n] = xv[cur][bj][n] + g1[bj][n] * acc[ai][bj][m][n];
                    const f32x4 q = v[n] * v[n]; ss += (q[0] + q[1]) + (q[2] + q[3]); }
                *(u32x4*)(AP + off + bj * 128) = pack8(v[0] * sw[bj][0], v[1] * sw[bj][1]);
            }
            ss += __shfl_xor(ss, 16); ss += __shfl_xor(ss, 32);
            if (fq == 0) rowsq[(size_t)row * 16 + u.pn * 4 + wc] = ss;
        }
    }
};
__device__ __forceinline__ float dpp_prev(float v) { return __int_as_float(__builtin_amdgcn_update_dpp(0, __float_as_int(v), 0x111, 0xf, 0xf, true)); }
__device__ __forceinline__ float dpp_next(float v) { return __int_as_float(__builtin_amdgcn_update_dpp(0, __float_as_int(v), 0x101, 0xf, 0xf, true)); }
struct EpiUp {
    const float* rowsq; const float* fb; const float* cw; const float* cb; bf16_t* ACT_; bf16_t* RAW_; LAS float* sp;
    __device__ __forceinline__ void operator()(AccRef acc, const Unit& u, int wr, int wc, int fr, int fq) const {
        const int b = u.pm >> 3; const int row0 = u.pm * 256 + wr * 64 + fr;
        int tx = threadIdx.x; asm volatile("" : "+v"(tx));
        if (tx < 256) {
            const float* qp = rowsq + (size_t)(u.pm * 256 + tx) * 16; const f32x4 q0 = *(const f32x4*)qp, q1 = *(const f32x4*)(qp + 4), q2 = *(const f32x4*)(qp + 8), q3 = *(const f32x4*)(qp + 12);
            const f32x4 qs = (q0 + q1) + (q2 + q3); sp[1280 + tx] = rsqrtf(((qs[0] + qs[1]) + (qs[2] + qs[3])) * (1.f / 1024.f) + EPS);
        } else {
            for (int i = tx - 256; i < 1280; i += 256) { const int vec = i >> 7, j = u.pn * 128 + (i & 127);
                const float* src = vec == 0 ? fb + b * NUP + j : vec == 1 ? fb + b * NUP + DFF + j : vec < 5 ? cw + (vec - 2) * NUP + j : vec < 8 ? cw + (vec - 5) * NUP + DFF + j : vec == 8 ? cb + j : cb + DFF + j;
                sp[i] = *src; } }
        asm volatile("s_waitcnt vmcnt(0) lgkmcnt(0)" ::: "memory"); __builtin_amdgcn_s_barrier(); asm volatile("" ::: "memory");
        const LAS float* spc = sp + wc * 32 + 8 * fq;
        const int jb = u.pn * 128 + wc * 32 + 8 * fq;
        const int pcol = u.pn * 256 + wc * 32 + 8 * fq;
        const bool interior = (fr >= 1) && (fr <= 14), rawrow = !((fr >= 2) && (fr <= 13));
        const int slot = fr < 2 ? fr : fr - 12;
#pragma unroll
        for (int ai = 0; ai < 2; ++ai)
#pragma unroll
            for (int m = 0; m < 4; ++m) {
                const int row = row0 + ai * 128 + m * 16; const float rstd = sp[1280 + ai * 128 + wr * 64 + m * 16 + fr];
                float r[8]; f32x4 ua[2], ug[2];
#pragma unroll
                for (int n = 0; n < 2; ++n) {
                    ua[n] = acc[ai][0][m][n] * rstd + *(const LAS f32x4*)(spc + 0 * 128 + 4 * n);
                    ug[n] = acc[ai][1][m][n] * rstd + *(const LAS f32x4*)(spc + 1 * 128 + 4 * n);
                    const f32x4 wa0 = *(const LAS f32x4*)(spc + 2 * 128 + 4 * n), wa1 = *(const LAS f32x4*)(spc + 3 * 128 + 4 * n), wa2 = *(const LAS f32x4*)(spc + 4 * 128 + 4 * n);
                    const f32x4 wg0 = *(const LAS f32x4*)(spc + 5 * 128 + 4 * n), wg1 = *(const LAS f32x4*)(spc + 6 * 128 + 4 * n), wg2 = *(const LAS f32x4*)(spc + 7 * 128 + 4 * n);
                    const f32x4 ba = *(const LAS f32x4*)(spc + 8 * 128 + 4 * n), bg = *(const LAS f32x4*)(spc + 9 * 128 + 4 * n);
#pragma unroll
                    for (int e = 0; e < 4; ++e) {
                        const float av = ba[e] + wa0[e] * dpp_prev(ua[n][e]) + wa1[e] * ua[n][e] + wa2[e] * dpp_next(ua[n][e]);
                        const float gv = bg[e] + wg0[e] * dpp_prev(ug[n][e]) + wg1[e] * ug[n][e] + wg2[e] * dpp_next(ug[n][e]);
                        r[4 * n + e] = gv * sigmoidf_(gv) * av;
                    }
                }
                if (interior) { u32x4 w; w.x = cvt_pk_bf16(r[0], r[1]); w.y = cvt_pk_bf16(r[2], r[3]); w.z = cvt_pk_bf16(r[4], r[5]); w.w = cvt_pk_bf16(r[6], r[7]);
                    *(u32x4*)(ACT_ + (size_t)row * DFF + jb) = w; }
                if (rawrow) { bf16_t* rp = RAW_ + ((size_t)(row >> 4) * 4 + slot) * NUP + pcol;
                    *(u32x4*)rp = pack8(ua[0], ua[1]); *(u32x4*)(rp + 128) = pack8(ug[0], ug[1]); }
                asm volatile("" ::: "memory");
            }
    }
};
struct EpiDown {
    float* out; const float* mod; const bf16_t* AP; const float* nw2;
    __device__ __forceinline__ void operator()(AccRef acc, const Unit& u, int wr, int wc, int fr, int fq) const {
        const int b = u.pm >> 3; const float* mb = mod + b * 6144;
        const int row0 = u.pm * 256 + wr * 64 + fr, col0 = u.pn * 256 + wc * 32 + 8 * fq;
        f32x4 g2[2][2], rsw[2][2];
#pragma unroll
        for (int bj = 0; bj < 2; ++bj)
#pragma unroll
            for (int n = 0; n < 2; ++n) { const int c = col0 + bj * 128 + 4 * n; g2[bj][n] = *(const f32x4*)(mb + 5120 + c);
                const f32x4 sw = *(const f32x4*)(nw2 + c) * (*(const f32x4*)(mb + 4096 + c) + 1.f);
#pragma unroll
                for (int e = 0; e < 4; ++e) rsw[bj][n][e] = 1.f / sw[e]; }
        u32x4 av[2][2];
#pragma unroll
        for (int bj = 0; bj < 2; ++bj) av[0][bj] = *(const u32x4*)(AP + (size_t)row0 * 1024 + col0 + bj * 128);
#pragma unroll
        for (int it = 0; it < 8; ++it) {
            const int ai = it >> 2, m = it & 3, cur = it & 1, nx = cur ^ 1;
            const size_t off = (size_t)(row0 + ai * 128 + m * 16) * 1024 + col0;
            if (it < 7) { const size_t offn = (size_t)(row0 + ((it + 1) >> 2) * 128 + ((it + 1) & 3) * 16) * 1024 + col0;
#pragma unroll
                for (int bj = 0; bj < 2; ++bj) av[nx][bj] = *(const u32x4*)(AP + offn + bj * 128); }
#pragma unroll
            for (int bj = 0; bj < 2; ++bj)
#pragma unroll
                for (int n = 0; n < 2; ++n) { const unsigned w0 = av[cur][bj][2 * n], w1 = av[cur][bj][2 * n + 1];
                    const f32x4 ap = (f32x4){__uint_as_float(w0 << 16), __uint_as_float(w0 & 0xffff0000u), __uint_as_float(w1 << 16), __uint_as_float(w1 & 0xffff0000u)};
                    *(f32x4*)(out + off + bj * 128 + 4 * n) = ap * rsw[bj][n] + g2[bj][n] * acc[ai][bj][m][n]; }
        }
    }
};

__device__ __forceinline__ f32x4 mfma16(bf16x8 a, bf16x8 b, f32x4 c) { return __builtin_amdgcn_mfma_f32_16x16x32_bf16(a, b, c, 0, 0, 0); }

__device__ __forceinline__ void transpose_item(const float* W, int ldw, int col, int k0, bf16_t* WT, int dst_row, int dld, LAS float* scr, int lane) {
#pragma unroll 8
    for (int i = 0; i < 32; ++i) { const int kk = 2 * i + (lane >> 5); scr[kk * 33 + (lane & 31)] = W[(size_t)(k0 + kk) * ldw + col + (lane & 31)]; }
    asm volatile("s_waitcnt lgkmcnt(0)" ::: "memory");
    const int c = lane & 7;
#pragma unroll
    for (int j = 0; j < 4; ++j) { const int n = (lane >> 3) + 8 * j; const LAS float* s = scr + (8 * c) * 33 + n;
        u32x4 o; o.x = cvt_pk_bf16(s[0 * 33], s[1 * 33]); o.y = cvt_pk_bf16(s[2 * 33], s[3 * 33]); o.z = cvt_pk_bf16(s[4 * 33], s[5 * 33]); o.w = cvt_pk_bf16(s[6 * 33], s[7 * 33]);
        *(u32x4*)(WT + (size_t)(dst_row + n) * dld + k0 + 8 * c) = o; }
    asm volatile("s_waitcnt lgkmcnt(0)" ::: "memory");
}
__device__ __forceinline__ int headperm(int n0) { const int tile = n0 >> 8, l = n0 & 255; return tile * 256 + 128 * ((l >> 5) & 1) + 32 * (l >> 6); }

struct Args {
    const float *x, *c, *ctx, *c_ctx, *w_mod, *b_mod, *norm1_w, *w_in, *q_norm_w, *k_norm_w, *attn_sink, *ml_gate_b, *ml_norm_w,
        *w_branch_att, *w_branch_ml, *w_out, *norm2_w, *w_up, *conv_w, *conv_b, *w_down;
    float* out; unsigned char* ws; int ph_lo, ph_hi;
};

template <int NV, int KS, bool ATOMIC> __device__ __forceinline__ void gemv_task(const float* W, int ldw, int n0, int k0, const LAS float* svec, float* out, int ldo) {
    const int n = n0 + threadIdx.x; float a[NV];
#pragma unroll
    for (int v = 0; v < NV; ++v) a[v] = 0.f;
#pragma unroll 16
    for (int k = 0; k < KS; ++k) { const float w = W[(size_t)(k0 + k) * ldw + n];
#pragma unroll
        for (int v = 0; v < NV; ++v) a[v] += svec[v * KS + k] * w; }
#pragma unroll
    for (int v = 0; v < NV; ++v) { if (ATOMIC) atomicAdd(out + (size_t)v * ldo + n, a[v]); else out[(size_t)v * ldo + n] = a[v]; }
}

#define mod   ((float*)(wsb + WS_MOD))
#define modp  ((float*)(wsb + WS_MODP))
#define fbias ((float*)(wsb + WS_FB))
#define rowsq ((float*)(wsb + WS_RSQP))
#define fbp ((float*)(dob + DO_FBP))
#define cosT  ((float*)(wsb + WS_ROPE))
#define sinT  ((float*)(wsb + WS_ROPE) + 2048 * 32)
#define gates ((float*)(wsb + WS_GATES))
#define WBA ((bf16_t*)(wsb + WS_WBA))
#define WBM ((bf16_t*)(wsb + WS_WBM))
#define WO  ((bf16_t*)(wsb + WS_WO))
#define WUP ((bf16_t*)(wsb + WS_WUP))
#define WDN ((bf16_t*)(wsb + WS_WDN))
#define AQ  ((bf16_t*)(wsb + WS_AQ))
#ifdef DBG_ATTO
#define ATTO GA
#else
#define ATTO AQ
#endif
#define MQ  ((bf16_t*)(wsb + WS_MQ))
#define MK  ((bf16_t*)(wsb + WS_MK))
#define MO  ((bf16_t*)(wsb + WS_MO))
#define GA  ((bf16_t*)(wsb + WS_GA))
#define GM  ((bf16_t*)(wsb + WS_GM))
#define XT  ((bf16_t*)(wsb + WS_XT))
#define T1  ((bf16_t*)(wsb + WS_T1))
#define Y   ((bf16_t*)(wsb + WS_Y))
#define U   ((bf16_t*)(wsb + WS_U))
#define HALO ((bf16_t*)(wsb + WS_HALO))
#define ACT ((bf16_t*)(wsb + WS_ACT))
#define RAWU ((bf16_t*)(wsb + WS_RAW))
#define H   ((bf16_t*)(dob + DO_H))
#define W1T ((bf16_t*)(dob + DO_W1T))
#define W2T ((bf16_t*)(dob + DO_W2T))
#define AK  ((bf16_t*)(wsb + WS_HALO))
#define HF  ((bf16_t*)(dob + DO_HF))
#define HB  ((bf16_t*)(dob + DO_HB))

#define XB_TMO      128
#define XB_XCNT(j)  (256  + 64 * (j))
#define XB_XSUB(j)  (1280 + 64 * (j))
#define XB_XGEN(j)  (2304 + 64 * (j))
#define XB_TOP      3328
#define XB_TOPGEN   3392
#define XCD_BAR_WORDS 3456
#define XB_SPIN_CAP (1u << 18)
__device__ __forceinline__ unsigned xb_ld(unsigned* p)              { return __hip_atomic_load(p, __ATOMIC_RELAXED, __HIP_MEMORY_SCOPE_AGENT); }
__device__ __forceinline__ unsigned xb_add(unsigned* p, unsigned v) { return __hip_atomic_fetch_add(p, v, __ATOMIC_RELAXED, __HIP_MEMORY_SCOPE_AGENT); }
__device__ __forceinline__ unsigned xb_xcc_id() { return (unsigned)__builtin_amdgcn_s_getreg((3 << 11) | 20) & 0xFu; }
#define XB_SPIN(cond, bar) do { unsigned _sp = 0; while (cond) { __builtin_amdgcn_s_sleep(1); \
    if ((++_sp & 255u) == 0u) { if (xb_ld(&(bar)[XB_TMO])) break; if (_sp > XB_SPIN_CAP) { atomicAdd(&(bar)[XB_TMO], 1u); break; } } } } while (0)
struct XcdBarrier { unsigned* bar; unsigned x; volatile LAS unsigned* st; };
__device__ __forceinline__ XcdBarrier xcd_barrier_post(unsigned* bar, volatile LAS unsigned* st) {
    XcdBarrier b; b.bar = bar; b.x = xb_xcc_id(); b.st = st;
    if (threadIdx.x == 0) (void)xb_add(&bar[XB_XCNT(b.x)], 1u);
    return b;
}
__device__ __forceinline__ void xcd_barrier_complete(unsigned* bar, unsigned x, unsigned& nloc, unsigned& nx) {
    const unsigned G = gridDim.x * gridDim.y * gridDim.z;
    unsigned sum, cnt, mine, sp = 0u;
    for (;;) {
        sum = 0u; cnt = 0u; mine = 0u;
#pragma unroll
        for (unsigned j = 0; j < 16; ++j) { const unsigned c = xb_ld(&bar[XB_XCNT(j)]); sum += c; cnt += (c > 0u) ? 1u : 0u; mine = (j == x) ? c : mine; }
        if (sum == G) break;
        __builtin_amdgcn_s_sleep(1);
        if ((++sp & 255u) == 0u) { if (xb_ld(&bar[XB_TMO])) break; if (sp > XB_SPIN_CAP) { atomicAdd(&bar[XB_TMO], 1u); break; } }
    }
    nloc = mine > 0u ? mine : 1u; nx = cnt > 0u ? cnt : 1u;
}
__device__ __forceinline__ void xcd_barrier(const XcdBarrier& b) {
    asm volatile("s_waitcnt vmcnt(0)" ::: "memory");
    __syncthreads();
    if (threadIdx.x == 0) {
        unsigned* bar = b.bar;
        __builtin_amdgcn_s_waitcnt(0);
        unsigned nloc = b.st[0], nx = b.st[1];
        if (nloc == 0u) { xcd_barrier_complete(bar, b.x, nloc, nx); b.st[0] = nloc; b.st[1] = nx; }
        const unsigned old = xb_add(&bar[XB_XSUB(b.x)], 1u);
        const unsigned gen = old / nloc;
        if (old + 1u == (gen + 1u) * nloc) {
            __builtin_amdgcn_fence(__ATOMIC_RELEASE, "agent");
            asm volatile("s_waitcnt vmcnt(0)" ::: "memory");
            const unsigned og = xb_add(&bar[XB_TOP], 1u);
            const unsigned tg = og / nx;
            if (og + 1u == (tg + 1u) * nx) xb_add(&bar[XB_TOPGEN], 1u);
            else XB_SPIN(xb_ld(&bar[XB_TOPGEN]) == tg, bar);
            __builtin_amdgcn_fence(__ATOMIC_ACQUIRE, "agent");
            xb_add(&bar[XB_XGEN(b.x)], 1u);
            asm volatile("s_waitcnt vmcnt(0)" ::: "memory");
        } else {
            XB_SPIN(xb_ld(&bar[XB_XGEN(b.x)]) == gen, bar);
            __builtin_amdgcn_fence(__ATOMIC_ACQUIRE, "agent");
            asm volatile("s_waitcnt vmcnt(0)" ::: "memory");
        }
    }
    __syncthreads();
}
constexpr size_t WS_BAR = 253 * MiB;
constexpr int LDS_ST_OFF = LDS_BYTES - 16;
#define A (*(const volatile __attribute__((address_space(4))) Args*)__builtin_amdgcn_kernarg_segment_ptr())
__global__ void __launch_bounds__(512, 2) fwd_kernel(Args Aparam) {
    extern __shared__ __attribute__((aligned(16))) unsigned char lds_raw[];
    LAS unsigned char* lds = (LAS unsigned char*)lds_raw;
    const int tid = threadIdx.x, lane = tid & 63, wave = __builtin_amdgcn_readfirstlane(tid >> 6);
    const int G = gridDim.x, bx = blockIdx.x;
    const int gw = bx * 8 + wave, NGW = G * 8;
    const int lo = A.ph_lo, hi = A.ph_hi; (void)lo; (void)hi;
#ifndef PHMASK
#define PHMASK 0x1fff
#endif
#if ONE_LAUNCH
#define IN(k) (((PHMASK >> (k)) & 1) && (k) < 11)
#else
#define IN(k) (((PHMASK >> (k)) & 1) && lo <= (k) && (k) < hi)
#endif
#if ONE_LAUNCH
    XcdBarrier xbar; xbar.bar = nullptr; xbar.x = 0; xbar.st = (volatile LAS unsigned*)(lds + LDS_ST_OFF);
#define SEAM(k) do { xcd_barrier(xbar); } while (0)
    {
        unsigned* const barw = (unsigned*)(A.ws + WS_BAR);
        if (tid < 4) ((LAS unsigned*)(lds + LDS_ST_OFF))[tid] = 0u;
        if (bx == 0) for (int i = tid; i < XCD_BAR_WORDS; i += 512) barw[i] = 0u;
        cg::this_grid().sync();
        xbar = xcd_barrier_post(barw, (volatile LAS unsigned*)(lds + LDS_ST_OFF));
    }
#else
#define SEAM(k) do { } while (0)
#endif

    for (int rep_ = 0; rep_ < (((RPT_MASK >> 0) & 1) ? 2 : 1); ++rep_) { if (rep_) { if (0 == 0) cg::this_grid().sync(); else xcd_barrier(xbar); }
    if (IN(0)) {
        unsigned char* const wsb = A.ws; unsigned char* const dob = (unsigned char*)A.out; (void)wsb; (void)dob;
        LAS float* svec = (LAS float*)(lds + 131072);
        for (int task = bx; task < 192; task += G) {
            const int cb = task % 12, ks = task / 12, k0 = ks * 64;
            __syncthreads();
            for (int i = tid; i < 576; i += 512) { const int v = i >> 6, k = i & 63; const float cv = v < 8 ? A.c[v * 1024 + k0 + k] : A.c_ctx[k0 + k]; svec[i] = cv / (1.f + __expf(-cv)); }
            __syncthreads();
            gemv_task<9, 64, false>(A.w_mod, 6144, cb * 512, k0, svec, modp + (size_t)ks * 9 * 6144, 6144);
        }
        LAS float* scr = (LAS float*)(lds + wave * 16384);
        constexpr int NITEMS = 9088;
        for (int it = gw; it < NITEMS; it += NGW) {
            int r = it; const float* W; int ldw, col0, ncols, K; bf16_t* dst; int hp = 0;
            if (r < 512) { W = A.w_in; ldw = INW; col0 = 0; ncols = 1024; K = 1024; dst = W1T + (size_t)3 * 256 * 1024; hp = 1; }
            else if ((r -= 512) < 128) { W = A.w_in; ldw = INW; col0 = 1024; ncols = 256; K = 1024; dst = W1T; hp = 1; }
            else if ((r -= 128) < 128) { W = A.w_in; ldw = INW; col0 = 1280; ncols = 256; K = 1024; dst = W2T; }
            else if ((r -= 128) < 256) { W = A.w_in; ldw = INW; col0 = 1536; ncols = 512; K = 1024; dst = W1T + (size_t)7 * 256 * 1024; }
            else if ((r -= 256) < 256) { W = A.w_in; ldw = INW; col0 = 2048; ncols = 512; K = 1024; dst = W1T + (size_t)1 * 256 * 1024; }
            else if ((r -= 256) < 512) { W = A.w_in; ldw = INW; col0 = 2560; ncols = 1024; K = 1024; dst = W2T + (size_t)256 * 1024; }
            else if ((r -= 512) < 512) { W = A.w_in; ldw = INW; col0 = 3584; ncols = 1024; K = 1024; dst = W1T + (size_t)9 * 256 * 1024; }
            else if ((r -= 512) < 512) { W = A.w_in; ldw = INW; col0 = 4624; ncols = 1024; K = 1024; dst = W1T + (size_t)13 * 256 * 1024; }
            else if ((r -= 512) < 512) { W = A.w_in; ldw = INW; col0 = 5648; ncols = 1024; K = 1024; dst = W1T + (size_t)17 * 256 * 1024; }
            else if ((r -= 512) < 512) { W = A.w_branch_att; ldw = 1024; col0 = 0; ncols = 1024; K = 1024; dst = WBA; }
            else if ((r -= 512) < 512) { W = A.w_branch_ml; ldw = 1024; col0 = 0; ncols = 1024; K = 1024; dst = WBM; }
            else if ((r -= 512) < 512) { W = A.w_out; ldw = 1024; col0 = 0; ncols = 1024; K = 1024; dst = WO; }
            else if ((r -= 512) < 2816) { W = A.w_up; ldw = NUP; col0 = 0; ncols = NUP; K = 1024; dst = WUP; }
            else { r -= 2816; W = A.w_down; ldw = 1024; col0 = 0; ncols = 1024; K = DFF; dst = WDN; }
            const int nblk = ncols / 32, kb = r / nblk, nb = r % nblk, n0 = nb * 32;
            int drow = hp ? headperm(n0) : n0;
            if (W == A.w_up) drow = (n0 < DFF) ? 256 * (n0 >> 7) + (n0 & 127) : 256 * ((n0 - DFF) >> 7) + 128 + ((n0 - DFF) & 127);
            transpose_item(W, ldw, col0 + n0, kb * 64, dst, drow, K, scr, lane);
        }
        for (int i = bx * 512 + tid; i < 2048 * 32; i += G * 512) {
            const int t = i >> 5, j = i & 31; const float pos = (j < 16) ? (float)(t >> 6) : (float)(t & 63);
            const float invf = exp2f(-(float)(j & 15) * (13.287712379549449f / 16.f)); const float ang = pos * invf;
            cosT[i] = cosf(ang); sinT[i] = sinf(ang);
        }
    }
    }
    SEAM(0);

    for (int rep_ = 0; rep_ < (((RPT_MASK >> 1) & 1) ? 2 : 1); ++rep_) { if (rep_) { if (1 == 0) cg::this_grid().sync(); else xcd_barrier(xbar); }
    if (IN(1)) {
        unsigned char* const wsb = A.ws; unsigned char* const dob = (unsigned char*)A.out; (void)wsb; (void)dob;
        constexpr int GP = 1028;
        LAS float* sWg = (LAS float*)lds;
        LAS float* hT = (LAS float*)(lds + 65792);
        LAS float* svm = (LAS float*)(lds + 131584);
        LAS float* part = (LAS float*)(lds + 147968);
        LAS float* svec = part;
        for (int k = tid; k < 1024; k += 512) { const float* src = A.w_in + (size_t)k * INW + 4608;
#pragma unroll
            for (int q = 0; q < 4; ++q) { const f32x4 v = *(const f32x4*)(src + 4 * q); sWg[(4 * q + 0) * GP + k] = v[0]; sWg[(4 * q + 1) * GP + k] = v[1]; sWg[(4 * q + 2) * GP + k] = v[2]; sWg[(4 * q + 3) * GP + k] = v[3]; } }
        const int rpb = (MT + G - 1) / G, rbeg = bx * rpb, rend = (rbeg + rpb < MT) ? rbeg + rpb : MT;
        const int vlo = rbeg < ML ? (rbeg >> 11) : 8;
        for (int i = tid; i < 4096; i += 512) { const int slot = i >> 11, k = i & 2047; int v = vlo + slot; if (v > 8) v = 8; float a = A.b_mod[k];
#pragma unroll
            for (int ks = 0; ks < 16; ++ks) a += modp[((size_t)ks * 9 + v) * 6144 + k];
            svm[i] = a; }
        for (int i = bx * 512 + tid; i < 9 * 6144; i += G * 512) { float a = A.b_mod[i % 6144];
#pragma unroll
            for (int ks = 0; ks < 16; ++ks) a += modp[(size_t)ks * 9 * 6144 + i];
            mod[i] = a; }
        __syncthreads();
        {
            const float* xin = A.x; const float* cin = A.ctx; const float* n1w = A.norm1_w; const float* gbias = A.ml_gate_b;
            const int r16 = lane & 15, quad = lane >> 4;
            const int ntile = (rend - rbeg + 15) >> 4;
            f32x4 xn[2][4];
#pragma unroll
            for (int t = 0; t < 2; ++t) { const int row = rbeg + wave + 8 * t; if (row < rend) { const float* xr = row < ML ? xin + (size_t)row * 1024 : cin + (size_t)(row - ML) * 1024;
#pragma unroll
                for (int j = 0; j < 4; ++j) xn[t][j] = *(const f32x4*)(xr + 4 * lane + 256 * j); } }
            for (int tile = 0; tile < ntile; ++tile) {
                const int trow = rbeg + 16 * tile;
#pragma unroll
                for (int t = 0; t < 2; ++t) {
                    const int r = wave + 8 * t, row = trow + r;
                    f32x4 hv[4]; float ss = 0.f;
#pragma unroll
                    for (int j = 0; j < 4; ++j) { hv[j] = xn[t][j]; const f32x4 q = hv[j] * hv[j]; ss += (q[0] + q[1]) + (q[2] + q[3]); }
                    { const int rn = row + 16; if (rn < rend) { const float* xr = rn < ML ? xin + (size_t)rn * 1024 : cin + (size_t)(rn - ML) * 1024;
#pragma unroll
                        for (int j = 0; j < 4; ++j) xn[t][j] = *(const f32x4*)(xr + 4 * lane + 256 * j); } }
                    if (row < rend) {
                        const int v = row < ML ? (row >> 11) : 8;
                        const LAS float* sh = svm + (v - vlo) * 2048; const LAS float* sc = sh + 1024;
                        const float rstd = rsqrtf(wave_sum(ss) * (1.f / 1024.f) + EPS);
                        bf16_t* ho = H + (size_t)row * 1024;
#pragma unroll
                        for (int j = 0; j < 4; ++j) { const int k = 4 * lane + 256 * j;
                            hv[j] = hv[j] * rstd * (*(const f32x4*)(n1w + k)) * (*(const LAS f32x4*)(sc + k) + 1.f) + *(const LAS f32x4*)(sh + k);
                            u32x2 w; w.x = cvt_pk_bf16(hv[j][0], hv[j][1]); w.y = cvt_pk_bf16(hv[j][2], hv[j][3]); *(u32x2*)(ho + k) = w;
                            *(LAS f32x4*)(hT + r * GP + k) = hv[j]; }
                    }
                }
                __syncthreads();
                { f32x4 acc = (f32x4){0.f, 0.f, 0.f, 0.f};
#pragma unroll
                  for (int kk = 0; kk < 8; ++kk) { const f32x4 a4 = *(const LAS f32x4*)(hT + r16 * GP + wave * 128 + kk * 16 + quad * 4), b4 = *(const LAS f32x4*)(sWg + r16 * GP + wave * 128 + kk * 16 + quad * 4);
#pragma unroll
                    for (int i = 0; i < 4; ++i) acc = __builtin_amdgcn_mfma_f32_16x16x4f32(a4[i], b4[i], acc, 0, 0, 0); }
#pragma unroll
                  for (int j = 0; j < 4; ++j) part[wave * 256 + (quad * 4 + j) * 16 + r16] = acc[j]; }
                __syncthreads();
                if (tid < 256) { const int r = tid >> 4, gidx = tid & 15, row = trow + r; float gv = gbias[gidx];
#pragma unroll
                    for (int w = 0; w < 8; ++w) gv += part[w * 256 + tid];
                    if (gidx & 4) gv = fminf(gv, 0.f) - log1pf(expf(-fabsf(gv)));
                    if (row < rend) gates[(size_t)row * 16 + gidx] = gv; }
            }
        }
        for (int task = bx; task < 176; task += G) {
            const int cb = task % 11, ks = task / 11, k0 = ks * 64;
            __syncthreads();
            { const int v = tid >> 6, k = 3072 + k0 + (tid & 63); float a = A.b_mod[k];
#pragma unroll
                for (int q = 0; q < 16; ++q) a += modp[((size_t)q * 9 + v) * 6144 + k];
                svec[tid] = a; }
            __syncthreads();
            gemv_task<8, 64, false>(A.w_up, NUP, cb * 512, k0, svec, fbp + (size_t)ks * 8 * NUP, NUP);
        }
    }
    }
    SEAM(1);

    for (int rep_ = 0; rep_ < (((RPT_MASK >> 2) & 1) ? 2 : 1); ++rep_) { if (rep_) { if (2 == 0) cg::this_grid().sync(); else xcd_barrier(xbar); }
    if (IN(2)) {
        unsigned char* const wsb = A.ws; unsigned char* const dob = (unsigned char*)A.out; (void)wsb; (void)dob;
        for (int i = bx * 512 + tid; i < 8 * NUP; i += G * 512) { float a = 0.f;
#pragma unroll
            for (int ks = 0; ks < 16; ++ks) a += fbp[(size_t)ks * 8 * NUP + i];
            fbias[i] = a; }
        { pg8::Gemm g{H, W1T, 1024, 1024, 1024}; pg8::Order S; S.init(64, 21, G, bx, 24);
          EpiIn E{AK, MK, AQ, MQ, MO, GA, GM, A.q_norm_w, A.k_norm_w, cosT, sinT, (LAS float*)(lds + 131072)};
          pg8::gemm_phase<EpiIn, pg8::Order, true>(lds, g, S, E); }
        { pg8::Gemm g{W2T, H, 1024, 1024, 1024}; pg8::Order S; S.init(5, 72, G, (bx + G - (1368 % G)) % G, 0);
          EpiPlain E{XT, MT};
          pg8::gemm_phase<EpiPlain, pg8::Order, true>(lds, g, S, E); }
    }
    }
    SEAM(2);

    if (IN(3)) {
        unsigned char* const wsb = A.ws; unsigned char* const dob = (unsigned char*)A.out; (void)wsb; (void)dob;
        const int r16 = lane & 15, quad = lane >> 4;
        const int rt = wave & 3, hp = wave >> 2;
        LAS bf16_t* sK = (LAS bf16_t*)lds;
        LAS bf16_t* sVT = sK + 64 * 72;
        bf16x8 qn[2][2];
#define AT_QLOAD(un_) do { const int qb_ = (un_) & 31, kvh_ = ((un_) >> 5) & 3, b_ = (un_) >> 7; \
            _Pragma("unroll") for (int g = 0; g < 2; ++g) _Pragma("unroll") for (int ks = 0; ks < 2; ++ks) \
                qn[g][ks] = *(const bf16x8*)(AQ + (size_t)(b_ * SEQ + qb_ * 64 + rt * 16 + r16) * 1024 + (kvh_ * 4 + hp * 2 + g) * 64 + ks * 32 + quad * 8); } while (0)
        const int vcu3 = (G % 8 == 0) ? (bx % 8) * (G / 8) + bx / 8 : bx;
        if (vcu3 < 1024) AT_QLOAD(vcu3);
        for (int unit = vcu3; unit < 1024; unit += G) {
            const int qb = unit & 31, kvh = (unit >> 5) & 3, b = unit >> 7;
            const int rowbase = b * SEQ, t0 = qb * 64;
            bf16x8 qf[2][2];
#pragma unroll
            for (int g = 0; g < 2; ++g)
#pragma unroll
                for (int ks = 0; ks < 2; ++ks) qf[g][ks] = qn[g][ks];
            if (unit + G < 1024) AT_QLOAD(unit + G);
            f32x4 o[2][4]; float mrow[2], lrow[2];
#pragma unroll
            for (int g = 0; g < 2; ++g) { mrow[g] = A.attn_sink[kvh * 4 + hp * 2 + g]; lrow[g] = 1.f;
#pragma unroll
                for (int dt = 0; dt < 4; ++dt) o[g][dt] = (f32x4){0.f, 0.f, 0.f, 0.f}; }
            const int kb_lo = (qb < 2) ? 2 - qb : 0, kb_hi = (qb > 29) ? 33 - qb : 4;
            const bf16_t* const ak_ = AK; const bf16_t* const xt_ = XT; const int lr = tid >> 3, lc = tid & 7;
#define AT_KROW0(kb_) (((kb_) < 5) ? rowbase + (qb + (kb_) - 2) * 64 : ML + b * CTX + ((kb_) - 5) * 64)
            u32x4 pk, pv;
            { const int kr = AT_KROW0(kb_lo); pk = *(const u32x4*)(ak_ + (size_t)(kr + lr) * 256 + kvh * 64 + lc * 8); pv = *(const u32x4*)(xt_ + (size_t)(kvh * 64 + lr) * MT + kr + lc * 8); }
            for (int kb = kb_lo; kb < 9; kb = (kb == kb_hi) ? 5 : kb + 1) {
                const int mtype = (kb == 0) ? 1 : (kb == 4) ? 2 : 0;
                const int mlo = (mtype == 1) ? 0 : -4096, mhi = (mtype == 2) ? 0 : 4096, dl = quad * 4 - rt * 16 - r16;
                __syncthreads();
                *(LAS u32x4*)(sK + lr * 72 + lc * 8) = pk; *(LAS u32x4*)(sVT + lr * 72 + lc * 8) = pv;
                { const int kn = (kb == kb_hi) ? 5 : kb + 1;
                  if (kn < 9) { const int kr = AT_KROW0(kn); pk = *(const u32x4*)(ak_ + (size_t)(kr + lr) * 256 + kvh * 64 + lc * 8); pv = *(const u32x4*)(xt_ + (size_t)(kvh * 64 + lr) * MT + kr + lc * 8); } }
                __syncthreads();
                bf16x8 kf[4][2], vf[2][4];
#pragma unroll
                for (int tile = 0; tile < 4; ++tile)
#pragma unroll
                    for (int ks = 0; ks < 2; ++ks) kf[tile][ks] = *(const LAS bf16x8*)(sK + (tile * 16 + r16) * 72 + ks * 32 + quad * 8);
#pragma unroll
                for (int ks = 0; ks < 2; ++ks)
#pragma unroll
                    for (int dt = 0; dt < 4; ++dt) { const u32x2 lo = *(const LAS u32x2*)(sVT + (dt * 16 + r16) * 72 + ks * 32 + quad * 4), hi = *(const LAS u32x2*)(sVT + (dt * 16 + r16) * 72 + ks * 32 + 16 + quad * 4);
                        const u32x4 w = (u32x4){lo.x, lo.y, hi.x, hi.y}; vf[ks][dt] = __builtin_bit_cast(bf16x8, w); }
#pragma unroll
                for (int g = 0; g < 2; ++g) {
                    f32x4 s[4];
#pragma unroll
                    for (int tile = 0; tile < 4; ++tile) { s[tile] = (f32x4){0.f, 0.f, 0.f, 0.f};
#pragma unroll
                        for (int ks = 0; ks < 2; ++ks) s[tile] = mfma16(kf[tile][ks], qf[g][ks], s[tile]); }
                    float mx = -1e30f;
#pragma unroll
                    for (int tile = 0; tile < 4; ++tile)
#pragma unroll
                        for (int j = 0; j < 4; ++j) { const int dd = dl + (tile * 16 + j);
                            const int bad = ((dd - mlo) | (mhi - dd)) >> 31;
                            const float v = s[tile][j] * 0.125f + __int_as_float(bad & (int)0xF149F2CAu); s[tile][j] = v; mx = fmaxf(mx, v); }
                    mx = fmaxf(mx, __shfl_xor(mx, 16)); mx = fmaxf(mx, __shfl_xor(mx, 32));
                    const float mn = fmaxf(mrow[g], mx), alpha = __expf(mrow[g] - mn); mrow[g] = mn; float rs = 0.f;
                    unsigned pw[4][2];
#pragma unroll
                    for (int tile = 0; tile < 4; ++tile) { f32x4 pe;
#pragma unroll
                        for (int j = 0; j < 4; ++j) { pe[j] = __expf(s[tile][j] - mn); rs += pe[j]; }
                        pw[tile][0] = cvt_pk_bf16(pe[0], pe[1]); pw[tile][1] = cvt_pk_bf16(pe[2], pe[3]); }
                    rs += __shfl_xor(rs, 16); rs += __shfl_xor(rs, 32);
                    lrow[g] = lrow[g] * alpha + rs;
#pragma unroll
                    for (int dt = 0; dt < 4; ++dt) o[g][dt] = o[g][dt] * alpha;
#pragma unroll
                    for (int ks = 0; ks < 2; ++ks) { const u32x4 w = (u32x4){pw[2 * ks][0], pw[2 * ks][1], pw[2 * ks + 1][0], pw[2 * ks + 1][1]}; const bf16x8 pf = __builtin_bit_cast(bf16x8, w);
#pragma unroll
                        for (int dt = 0; dt < 4; ++dt) o[g][dt] = mfma16(vf[ks][dt], pf, o[g][dt]); }
                }
            }
#pragma unroll
            for (int g = 0; g < 2; ++g) { const float inv = 1.f / lrow[g];
                bf16_t* p = ATTO + (size_t)(rowbase + t0 + rt * 16 + r16) * 1024 + (kvh * 4 + hp * 2 + g) * 64 + quad * 4;
#pragma unroll
                for (int dt = 0; dt < 4; ++dt) { u32x2 w; w.x = cvt_pk_bf16(o[g][dt][0] * inv, o[g][dt][1] * inv); w.y = cvt_pk_bf16(o[g][dt][2] * inv, o[g][dt][3] * inv); *(u32x2*)(p + dt * 16) = w; } }
        }
    }
    __syncthreads();

    for (int rep_ = 0; rep_ < (((RPT_MASK >> 4) & 1) ? 2 : 1); ++rep_) { if (rep_) { if (4 == 0) cg::this_grid().sync(); else xcd_barrier(xbar); }
    if (IN(4)) {
        unsigned char* const wsb = A.ws; unsigned char* const dob = (unsigned char*)A.out; (void)wsb; (void)dob;
        const int r16 = lane & 15, quad = lane >> 4;
        LAS bf16_t* sK = (LAS bf16_t*)lds;
        LAS bf16_t* sVT = sK + 128 * 136;
        LAS bf16_t* sS = sVT + 64 * 136;
        LAS bf16_t* sC = sS + 128 * 136;
        LAS float* sgall = (LAS float*)(sC + 80 * 136);
        const float scale = 0.08838834764831845f;
        const int vcu4 = (G % 8 == 0) ? (bx % 8) * (G / 8) + bx / 8 : bx;
        for (int task = vcu4; task < 256; task += G) {
            const int vq = task & 3, dir = (task >> 2) & 1, hh = (task >> 3) & 3, b = task >> 5;
            __syncthreads();
            for (int i = tid; i < 80 * 136 / 2; i += 512) ((LAS unsigned*)sC)[i] = 0u;
            for (int st = wave; st < 18; st += 8) {
                const int t0g = ((st < 2) ? (ML + b * CTX + (dir ? 1 - st : st) * 128) : (b * SEQ + (dir ? 15 - (st - 2) : st - 2) * 128));
                const float* gp = gates + (size_t)(t0g + 2 * lane) * 16 + dir * 8 + hh;
                const float i0 = gp[0], f0 = gp[4], i1 = gp[16], f1 = gp[20];
                const float loc = f0 + f1; float v = loc;
#pragma unroll
                for (int off = 1; off < 64; off <<= 1) { const float t = __shfl_up(v, off); if (lane >= off) v += t; }
                const float total = __shfl(v, 63); const float p0 = v - loc + f0, p1 = p0 + f1;
                const float b0 = dir ? total - p0 + f0 : p0, b1 = dir ? total - p1 + f1 : p1;
                const float cmid = 0.5f * total; LAS float* g = sgall + st * 576;
                g[2 * lane] = __expf(fminf(b0 - cmid, 80.f)); g[2 * lane + 1] = __expf(fminf(b1 - cmid, 80.f));
                g[128 + 2 * lane] = __expf(fminf(i0 - b0 + cmid, 80.f)) * scale; g[128 + 2 * lane + 1] = __expf(fminf(i1 - b1 + cmid, 80.f)) * scale;
                g[256 + 2 * lane] = __expf(fminf(total - b0 + i0, 80.f)) * scale; g[256 + 2 * lane + 1] = __expf(fminf(total - b1 + i1, 80.f)) * scale;
                g[384 + 2 * lane] = __expf(b0); g[384 + 2 * lane + 1] = __expf(b1); if (lane == 0) g[512] = __expf(total);
            }
            f32x4 cacc[4], nacc = (f32x4){0.f, 0.f, 0.f, 0.f};
#pragma unroll
            for (int vt = 0; vt < 4; ++vt) cacc[vt] = (f32x4){0.f, 0.f, 0.f, 0.f};
            bf16_t* Hout = (bf16_t*)(dob + (dir ? DO_HB : DO_HF)); const int sgn = dir ? 1 : -1;
            const bf16_t* const mk_ = MK; const bf16_t* const xt_ = XT; const bf16_t* const mq_ = MQ;
            u32x4 pK[4], pVT[2]; bf16x8 pQ[4];
#define ML_TOK0(st) (((st) < 2) ? (ML + b * CTX + (dir ? 1 - (st) : (st)) * 128) : (b * SEQ + (dir ? 15 - ((st) - 2) : (st) - 2) * 128))
#define ML_PREFETCH(st) do { const int t0_ = ML_TOK0(st); \
                _Pragma("unroll") for (int q_ = 0; q_ < 4; ++q_) { const int i_ = tid + q_ * 512, r_ = i_ >> 4, c_ = i_ & 15; pK[q_] = *(const u32x4*)(mk_ + (size_t)(t0_ + r_) * 512 + hh * 128 + c_ * 8); } \
                if ((st) >= 2) { _Pragma("unroll") for (int ks_ = 0; ks_ < 4; ++ks_) pQ[ks_] = *(const bf16x8*)(mq_ + (size_t)(t0_ + wave * 16 + r16) * 512 + hh * 128 + ks_ * 32 + quad * 8); } \
                _Pragma("unroll") for (int q_ = 0; q_ < 2; ++q_) { const int i_ = tid + q_ * 512, r_ = i_ >> 4, c_ = i_ & 15; pVT[q_] = *(const u32x4*)(xt_ + (size_t)(256 + hh * 256 + vq * 64 + r_) * MT + t0_ + c_ * 8); } \
                } while (0)
            ML_PREFETCH(0);
            for (int step = 0; step < 18; ++step) {
                const bool isctx = step < 2; const int tok0 = ML_TOK0(step);
                const LAS float* sgb = sgall + step * 576; const LAS float *sga = sgb + 128, *sgw = sgb + 256, *sge = sgb + 384, *sgF = sgb + 512;
                __syncthreads();
#pragma unroll
                for (int q = 0; q < 4; ++q) { const int i = tid + q * 512, r = i >> 4, c = i & 15; *(LAS u32x4*)(sK + r * 136 + c * 8) = pK[q]; }
#pragma unroll
                for (int q = 0; q < 2; ++q) { const int i = tid + q * 512, r = i >> 4, c = i & 15; *(LAS u32x4*)(sVT + r * 136 + c * 8) = pVT[q]; }
                bf16x8 qf[4];
#pragma unroll
                for (int ks = 0; ks < 4; ++ks) qf[ks] = pQ[ks];
                if (step + 1 < 18) ML_PREFETCH(step + 1);
                __syncthreads();
                if (!isctx) {
                    const int prow = wave * 16 + r16;
                    f32x4 s[8];
#pragma unroll
                    for (int tile = 0; tile < 8; ++tile) { s[tile] = (f32x4){0.f, 0.f, 0.f, 0.f};
#pragma unroll
                        for (int ks = 0; ks < 4; ++ks) { const bf16x8 kf = *(const LAS bf16x8*)(sK + (tile * 16 + r16) * 136 + ks * 32 + quad * 8); s[tile] = mfma16(kf, qf[ks], s[tile]); } }
                    const float bp = sgb[prow]; float rs = 0.f;
#pragma unroll
                    for (int tile = 0; tile < 8; ++tile) { const f32x4 av = *(const LAS f32x4*)(sga + tile * 16 + quad * 4); f32x4 pe;
#pragma unroll
                        for (int j = 0; j < 4; ++j) { const int dd = (tile * 16 + quad * 4 + j - prow) * sgn;
                            pe[j] = __int_as_float(__float_as_int(s[tile][j] * (bp * av[j])) & ~(dd >> 31)); rs += pe[j]; }
                        u32x2 w; w.x = cvt_pk_bf16(pe[0], pe[1]); w.y = cvt_pk_bf16(pe[2], pe[3]);
                        *(LAS u32x2*)(sS + prow * 136 + tile * 16 + quad * 4) = w; }
                    rs += __shfl_xor(rs, 16); rs += __shfl_xor(rs, 32);
                    asm volatile("s_waitcnt lgkmcnt(0)" ::: "memory");
                    f32x4 a1[4], a2[5];
#pragma unroll
                    for (int vt = 0; vt < 4; ++vt) a1[vt] = (f32x4){0.f, 0.f, 0.f, 0.f};
#pragma unroll
                    for (int vt = 0; vt < 5; ++vt) a2[vt] = (f32x4){0.f, 0.f, 0.f, 0.f};
#pragma unroll
                    for (int ks = 0; ks < 4; ++ks) { const bf16x8 af = *(const LAS bf16x8*)(sS + prow * 136 + ks * 32 + quad * 8);
#pragma unroll
                        for (int vt = 0; vt < 4; ++vt) { const bf16x8 vf = *(const LAS bf16x8*)(sVT + (vt * 16 + r16) * 136 + ks * 32 + quad * 8); a1[vt] = mfma16(vf, af, a1[vt]); } }
#pragma unroll
                    for (int ks = 0; ks < 4; ++ks)
#pragma unroll
                        for (int vt = 0; vt < 5; ++vt) { const bf16x8 cf = *(const LAS bf16x8*)(sC + (vt * 16 + r16) * 136 + ks * 32 + quad * 8); a2[vt] = mfma16(cf, qf[ks], a2[vt]); }
                    const float e = sge[prow];
                    const float qn = __shfl(a2[4][0], r16); const float nq = rs + e * qn; const float inv = 1.f / fmaxf(fabsf(nq), 1.f);
                    bf16_t* hp = Hout + (size_t)(tok0 + prow) * 1024 + hh * 256 + vq * 64 + quad * 4;
#pragma unroll
                    for (int vt = 0; vt < 4; ++vt) { u32x2 w; w.x = cvt_pk_bf16((a1[vt][0] + e * a2[vt][0]) * inv, (a1[vt][1] + e * a2[vt][1]) * inv);
                        w.y = cvt_pk_bf16((a1[vt][2] + e * a2[vt][2]) * inv, (a1[vt][3] + e * a2[vt][3]) * inv); *(u32x2*)(hp + vt * 16) = w; }
                }
                __syncthreads();
                {
                    const float F = sgF[0];
#pragma unroll
                    for (int vt = 0; vt < 4; ++vt) cacc[vt] = cacc[vt] * F;
                    nacc = nacc * F;
                    bf16x8 ones; { const short o1 = (r16 == 0) ? (short)0x3F80 : (short)0;
#pragma unroll
                        for (int e = 0; e < 8; ++e) ones[e] = o1; }
#pragma unroll
                    for (int ks = 0; ks < 4; ++ks) {
                        const LAS bf16_t* kcol = sK + (ks * 32 + quad * 8) * 136 + wave * 16 + r16;
                        const f32x4 w0 = *(const LAS f32x4*)(sgw + ks * 32 + quad * 8), w1 = *(const LAS f32x4*)(sgw + ks * 32 + quad * 8 + 4);
                        f32x4 k0, k1;
#pragma unroll
                        for (int e = 0; e < 4; ++e) { k0[e] = bf2f(kcol[e * 136]) * w0[e]; k1[e] = bf2f(kcol[(4 + e) * 136]) * w1[e]; }
                        const u32x4 pk = pack8(k0, k1); const bf16x8 kts = __builtin_bit_cast(bf16x8, pk);
#pragma unroll
                        for (int vt = 0; vt < 4; ++vt) { const bf16x8 va = *(const LAS bf16x8*)(sVT + (vt * 16 + r16) * 136 + ks * 32 + quad * 8); cacc[vt] = mfma16(kts, va, cacc[vt]); }
                        nacc = mfma16(kts, ones, nacc);
                    }
#pragma unroll
                    for (int vt = 0; vt < 4; ++vt) { u32x2 w; w.x = cvt_pk_bf16(cacc[vt][0], cacc[vt][1]); w.y = cvt_pk_bf16(cacc[vt][2], cacc[vt][3]);
                        *(LAS u32x2*)(sC + (vt * 16 + r16) * 136 + wave * 16 + quad * 4) = w; }
                    if (r16 == 0) { u32x2 w; w.x = cvt_pk_bf16(nacc[0], nacc[1]); w.y = cvt_pk_bf16(nacc[2], nacc[3]); *(LAS u32x2*)(sC + 64 * 136 + wave * 16 + quad * 4) = w; }
                }
            }
        }
    }
    }
    SEAM(4);

    if (IN(5)) {
        unsigned char* const wsb = A.ws; unsigned char* const dob = (unsigned char*)A.out; (void)wsb; (void)dob;
        {
            const float* mnw = A.ml_norm_w; f32x4 wn[4];
#pragma unroll
            for (int q = 0; q < 4; ++q) wn[q] = *(const f32x4*)(mnw + lane * 16 + q * 4);
            u32x4 na[2], nc[2], nd[2];
            if (gw < ML) { const size_t off = (size_t)gw * 1024 + lane * 16;
#pragma unroll
                for (int q = 0; q < 2; ++q) { na[q] = *(const u32x4*)(HF + off + q * 8); nc[q] = *(const u32x4*)(HB + off + q * 8); nd[q] = *(const u32x4*)(MO + off + q * 8); } }
            for (int row = gw; row < ML; row += NGW) {
                const size_t off = (size_t)row * 1024 + lane * 16;
                float ht[16], mo[16];
#pragma unroll
                for (int q = 0; q < 2; ++q) { const u32x4 a = na[q], c = nc[q], d = nd[q];
#pragma unroll
                    for (int e = 0; e < 4; ++e) { ht[q * 8 + 2 * e] = __uint_as_float(a[e] << 16) + __uint_as_float(c[e] << 16); ht[q * 8 + 2 * e + 1] = __uint_as_float(a[e] & 0xffff0000u) + __uint_as_float(c[e] & 0xffff0000u);
                        mo[q * 8 + 2 * e] = __uint_as_float(d[e] << 16); mo[q * 8 + 2 * e + 1] = __uint_as_float(d[e] & 0xffff0000u); } }
                if (row + NGW < ML) { const size_t offn = (size_t)(row + NGW) * 1024 + lane * 16;
#pragma unroll
                    for (int q = 0; q < 2; ++q) { na[q] = *(const u32x4*)(HF + offn + q * 8); nc[q] = *(const u32x4*)(HB + offn + q * 8); nd[q] = *(const u32x4*)(MO + offn + q * 8); } }
                float ss = 0.f;
#pragma unroll
                for (int e = 0; e < 16; ++e) ss += ht[e] * ht[e];
                ss += __shfl_xor(ss, 1); ss += __shfl_xor(ss, 2); ss += __shfl_xor(ss, 4); ss += __shfl_xor(ss, 8);
                const float rs = rsqrtf(ss * (1.f / 256.f) + EPS);
                float r[16];
#pragma unroll
                for (int q = 0; q < 4; ++q)
#pragma unroll
                    for (int e = 0; e < 4; ++e) r[q * 4 + e] = ht[q * 4 + e] * rs * wn[q][e] * sigmoidf_(mo[q * 4 + e]);
#pragma unroll
                for (int q = 0; q < 2; ++q) { u32x4 w; w.x = cvt_pk_bf16(r[q * 8 + 0], r[q * 8 + 1]); w.y = cvt_pk_bf16(r[q * 8 + 2], r[q * 8 + 3]); w.z = cvt_pk_bf16(r[q * 8 + 4], r[q * 8 + 5]); w.w = cvt_pk_bf16(r[q * 8 + 6], r[q * 8 + 7]);
                    *(u32x4*)(MO + off + q * 8) = w; }
            }
        }
    }
    SEAM(5);

    for (int rep_ = 0; rep_ < (((RPT_MASK >> 6) & 1) ? 2 : 1); ++rep_) { if (rep_) { if (6 == 0) cg::this_grid().sync(); else xcd_barrier(xbar); }
    if (IN(6)) {
        unsigned char* const wsb = A.ws; unsigned char* const dob = (unsigned char*)A.out; (void)wsb; (void)dob;
        pg8::Order S; S.init(64, 4, G, bx, 0);
        { pg8::Gemm g{AQ, WBA, 1024, 1024, 1024, MO, WBM}; EpiMerge E{GA, GM, Y}; pg8::gemm_phase<EpiMerge, pg8::Order, false, true>(lds, g, S, E); }
    }
    }
    SEAM(6);

    for (int rep_ = 0; rep_ < (((RPT_MASK >> 7) & 1) ? 2 : 1); ++rep_) { if (rep_) { if (7 == 0) cg::this_grid().sync(); else xcd_barrier(xbar); }
    if (IN(7)) {
        unsigned char* const wsb = A.ws; unsigned char* const dob = (unsigned char*)A.out; (void)wsb; (void)dob;
        pg8::Order S; S.init(64, 4, G, bx, 0);
#ifdef DBG_P7PLAIN
        pg8::Gemm g{Y, WO, 1024, 1024, 1024}; EpiPlain E{T1, 1024};
        pg8::gemm_phase<EpiPlain, pg8::Order, false>(lds, g, S, E);
#else
        pg8::Gemm g{Y, WO, 1024, 1024, 1024}; EpiOut E{A.x, mod, A.norm2_w, (float*)dob, AQ, rowsq};
        pg8::gemm_phase<EpiOut, pg8::Order, false>(lds, g, S, E);
#endif
    }
    }
    SEAM(7);

    for (int rep_ = 0; rep_ < (((RPT_MASK >> 8) & 1) ? 2 : 1); ++rep_) { if (rep_) { if (8 == 0) cg::this_grid().sync(); else xcd_barrier(xbar); }
    if (IN(8)) {
        unsigned char* const wsb = A.ws; unsigned char* const dob = (unsigned char*)A.out; (void)wsb; (void)dob;
        pg8::Order S; S.init(64, 22, G, bx, 0);
        pg8::Gemm g{AQ, WUP, 1024, 1024, 1024}; EpiUp E{rowsq, fbias, A.conv_w, A.conv_b, ACT, RAWU, (LAS float*)(lds + 131072)};
        pg8::gemm_phase<EpiUp, pg8::Order, true>(lds, g, S, E);
    }
    }
    SEAM(8);

    if (IN(9)) {
        unsigned char* const wsb = A.ws; unsigned char* const dob = (unsigned char*)A.out; (void)wsb; (void)dob;
        const float* cw = A.conv_w; const float* cb = A.conv_b;
        for (int task = bx * 512 + tid; task < 1025 * 352; task += G * 512) {
            const int ch = task % 352, bd = task / 352, j0 = ch * 8;
            const int pc = 256 * (j0 >> 7) + (j0 & 127);
            const bool lo_ok = bd > 0, hi_ok = bd < 1024, seam = ((bd * 16) & 2047) == 0;
            const u32x4 zero = (u32x4){0u, 0u, 0u, 0u};
            u32x4 xa[4], xg[4];
#pragma unroll
            for (int k = 0; k < 4; ++k) { xa[k] = zero; xg[k] = zero; }
            if (lo_ok) { const bf16_t* rp = RAWU + ((size_t)(bd - 1) * 4 + 2) * NUP + pc; xa[0] = *(const u32x4*)rp; xg[0] = *(const u32x4*)(rp + 128); xa[1] = *(const u32x4*)(rp + NUP); xg[1] = *(const u32x4*)(rp + NUP + 128); }
            if (hi_ok) { const bf16_t* rp = RAWU + ((size_t)bd * 4) * NUP + pc; xa[2] = *(const u32x4*)rp; xg[2] = *(const u32x4*)(rp + 128); xa[3] = *(const u32x4*)(rp + NUP); xg[3] = *(const u32x4*)(rp + NUP + 128); }
            float wa[3][8], wg[3][8], ba[8], bg[8];
#pragma unroll
            for (int i = 0; i < 3; ++i)
#pragma unroll
                for (int q = 0; q < 2; ++q) { const f32x4 a = *(const f32x4*)(cw + i * NUP + j0 + 4 * q), g = *(const f32x4*)(cw + i * NUP + DFF + j0 + 4 * q);
#pragma unroll
                    for (int e = 0; e < 4; ++e) { wa[i][4 * q + e] = a[e]; wg[i][4 * q + e] = g[e]; } }
#pragma unroll
            for (int q = 0; q < 2; ++q) { const f32x4 a = *(const f32x4*)(cb + j0 + 4 * q), g = *(const f32x4*)(cb + DFF + j0 + 4 * q);
#pragma unroll
                for (int e = 0; e < 4; ++e) { ba[4 * q + e] = a[e]; bg[4 * q + e] = g[e]; } }
#pragma unroll
            for (int side = 0; side < 2; ++side) {
                if (side == 0 ? !lo_ok : !hi_ok) continue;
                float r[8];
#pragma unroll
                for (int e = 0; e < 8; ++e) { const int w = e >> 1; const bool hi16 = e & 1;
                    float va[3], vg[3];
#pragma unroll
                    for (int k = 0; k < 3; ++k) { const unsigned aw = xa[side + k][w], gw = xg[side + k][w];
                        va[k] = hi16 ? __uint_as_float(aw & 0xffff0000u) : __uint_as_float(aw << 16); vg[k] = hi16 ? __uint_as_float(gw & 0xffff0000u) : __uint_as_float(gw << 16); }
                    if (seam) { if (side == 0) { va[2] = 0.f; vg[2] = 0.f; } else { va[0] = 0.f; vg[0] = 0.f; } }
                    const float av = ba[e] + wa[0][e] * va[0] + wa[1][e] * va[1] + wa[2][e] * va[2];
                    const float gv = bg[e] + wg[0][e] * vg[0] + wg[1][e] * vg[1] + wg[2][e] * vg[2];
                    r[e] = gv * sigmoidf_(gv) * av; }
                u32x4 w; w.x = cvt_pk_bf16(r[0], r[1]); w.y = cvt_pk_bf16(r[2], r[3]); w.z = cvt_pk_bf16(r[4], r[5]); w.w = cvt_pk_bf16(r[6], r[7]);
                *(u32x4*)(ACT + (size_t)(bd * 16 - 1 + side) * DFF + j0) = w;
            }
        }
    }
    SEAM(9);

    if (IN(10)) {
        unsigned char* const wsb = A.ws; unsigned char* const dob = (unsigned char*)A.out; (void)wsb; (void)dob;
        pg8::Order S; S.init(64, 4, G, bx, 0);
        pg8::Gemm g{ACT, WDN, DFF, DFF, DFF}; EpiDown E{(float*)dob, mod, AQ, A.norm2_w};
        pg8::gemm_phase<EpiDown, pg8::Order, false>(lds, g, S, E);
    }
#undef IN
#undef SEAM
}
#undef A

extern "C" void kernel_launch(void* const* d_in, const int* in_sizes, int n_in, void* d_out, int out_size, void* d_ws, size_t ws_size, hipStream_t stream) {
    static int grid = 0;
    if (grid == 0) {
        if (n_in != 21 || out_size != ML * D || ws_size < WS_END) { fprintf(stderr, "kernel_launch: unexpected shapes (n_in %d out %d ws %zu)\n", n_in, out_size, ws_size); grid = -1; return; }
        int dev = 0, cus = 0, per_cu = 0;
        hipGetDevice(&dev); hipDeviceGetAttribute(&cus, hipDeviceAttributeMultiprocessorCount, dev);
        hipFuncSetAttribute((const void*)fwd_kernel, hipFuncAttributeMaxDynamicSharedMemorySize, LDS_BYTES);
        hipOccupancyMaxActiveBlocksPerMultiprocessor(&per_cu, (const void*)fwd_kernel, 512, LDS_BYTES);
        if (per_cu < 1) { fprintf(stderr, "kernel_launch: occupancy query says %d blocks per CU\n", per_cu); per_cu = 1; }
        grid = cus * per_cu;
        (void)hipGetLastError();
    }
    if (grid < 0) return;
    Args a{};
    const float** pp = (const float**)&a;
    for (int i = 0; i < 21; ++i) pp[i] = (const float*)d_in[i];
    a.out = (float*)d_out; a.ws = (unsigned char*)d_ws;
#if ONE_LAUNCH
    a.ph_lo = 0; a.ph_hi = 11;
    void* args[] = {&a};
    hipError_t e = hipLaunchCooperativeKernel((const void*)fwd_kernel, dim3(grid), dim3(512), args, LDS_BYTES, stream);
    if (e != hipSuccess) fprintf(stderr, "cooperative launch failed: %s (grid %d)\n", hipGetErrorString(e), grid);
#else
    for (int p = 0; p < 11; ++p) { a.ph_lo = p; a.ph_hi = p + 1; hipLaunchKernelGGL(fwd_kernel, dim3(grid), dim3(512), LDS_BYTES, stream, a); }

#endif
}
```

```cpp
#include <hip/hip_runtime.h>
#include <hip/hip_cooperative_groups.h>
#include <cstdio>
#include <cstdint>
namespace cg = cooperative_groups;

#ifndef RPT_MASK
#define RPT_MASK 0
#endif
#ifndef ONE_LAUNCH
#define ONE_LAUNCH 1
#endif

#define LAS __attribute__((address_space(3)))
typedef unsigned short bf16_t;
typedef short bf16x8 __attribute__((ext_vector_type(8)));
typedef float f32x4 __attribute__((ext_vector_type(4)));
typedef unsigned u32x4 __attribute__((ext_vector_type(4)));
typedef unsigned u32x2 __attribute__((ext_vector_type(2)));

constexpr int D = 1024, NB = 8, SEQ = 2048, CTX = 256;
constexpr int ML = NB * SEQ;
constexpr int MC = NB * CTX;
constexpr int MT = ML + MC;
constexpr int DFF = 2816, NUP = 2 * DFF, INW = 6672;
constexpr float EPS = 1e-6f;
constexpr size_t MiB = 1u << 20;
constexpr size_t WS_ZERO = 0;
constexpr size_t WS_MOD = 0, WS_FB = 256 * 1024, WS_RSQ = 512 * 1024;
constexpr size_t WS_MODP = 236 * MiB + 12 * MiB;
constexpr size_t WS_RSQP = 252 * MiB;
constexpr size_t DO_FBP = 60 * MiB;
constexpr size_t WS_ROPE = 1 * MiB;
constexpr size_t WS_GATES = 2 * MiB;
constexpr size_t WS_WBA = 4 * MiB, WS_WBM = 6 * MiB, WS_WO = 8 * MiB, WS_WUP = 10 * MiB, WS_WDN = 21 * MiB;
constexpr size_t WS_AQ = 27 * MiB;
constexpr size_t WS_MQ = 59 * MiB, WS_MK = 75 * MiB  , WS_MO = 93 * MiB, WS_GA = 125 * MiB, WS_GM = 157 * MiB, WS_XT = 189 * MiB  ;
constexpr size_t WS_T1 = 59 * MiB, WS_Y = 189 * MiB;
constexpr size_t WS_U = 59 * MiB;
constexpr size_t WS_HALO = 236 * MiB;
constexpr size_t WS_ACT = 59 * MiB;
constexpr size_t WS_RAW = 147 * MiB;
constexpr size_t WS_END = 256 * MiB;
constexpr size_t DO_H = 0, DO_W1T = 36 * MiB, DO_W2T = 47 * MiB, DO_AK = 51 * MiB;
constexpr size_t DO_HF = 0, DO_HB = 32 * MiB;
constexpr int LDS_BYTES = 157696;

typedef float f32x2_t __attribute__((ext_vector_type(2))); typedef __bf16 bf16x2_t __attribute__((ext_vector_type(2)));
__device__ __forceinline__ unsigned cvt_pk_bf16(float lo, float hi) { f32x2_t v = {lo, hi}; bf16x2_t b = __builtin_convertvector(v, bf16x2_t); return __builtin_bit_cast(unsigned, b); }
__device__ __forceinline__ float bf2f(unsigned short v) { return __uint_as_float((unsigned)v << 16); }
__device__ __forceinline__ bf16_t f2bf(float f) { return (bf16_t)(cvt_pk_bf16(f, 0.f) & 0xffffu); }
__device__ __forceinline__ u32x4 pack8(f32x4 a, f32x4 b) { u32x4 w; w.x = cvt_pk_bf16(a[0], a[1]); w.y = cvt_pk_bf16(a[2], a[3]); w.z = cvt_pk_bf16(b[0], b[1]); w.w = cvt_pk_bf16(b[2], b[3]); return w; }
__device__ __forceinline__ float sigmoidf_(float x) { return __builtin_amdgcn_rcpf(1.f + __expf(-x)); }
__device__ __forceinline__ float sigmoid_div(float x) { return 1.f / (1.f + __expf(-x)); }
__device__ __forceinline__ float wave_sum(float v) {
#pragma unroll
    for (int o = 1; o < 64; o <<= 1) v += __shfl_xor(v, o);
    return v;
}

namespace pg8 {
constexpr int BM = 256, BK = 64, HALF = 128, HTB = HALF * BK * 2, STAGE_BYTES = 8 * HTB, NXCD = 8, WGM = 8;
__host__ __device__ __forceinline__ int lds_byte(int r, int c) { const int st = (r >> 4) * 2 + (c >> 5), rr = r & 15, cc = c & 31, ob = rr * 64 + cc * 2; return st * 1024 + (ob ^ (((ob >> 9) & 1) << 5)); }
__host__ __device__ __forceinline__ void stage_rc(int b, int& R, int& C) { const int st = b / 1024, sb = b % 1024, swz = sb ^ (((sb >> 9) & 1) << 5); R = (st >> 1) * 16 + swz / 64; C = (st & 1) * 32 + (swz % 64) / 2; }
__host__ __device__ __forceinline__ int perm32(int rho) { const int n = rho >> 4, i = rho & 15; return 8 * (i >> 2) + 4 * n + (i & 3); }

struct Unit { int pm, pn; };
struct Gemm { const bf16_t* A; const bf16_t* Bt; int lda, ldb, K; const bf16_t* A2 = nullptr; const bf16_t* Bt2 = nullptr; };

struct Order {
    int nM, nN, nwg, G, c, extra;
    __device__ __forceinline__ void init(int nM_, int nN_, int G_, int c_, int extra_) { nM = nM_; nN = nN_; nwg = nM_ * nN_; G = G_; c = c_; extra = extra_; }
    __device__ __forceinline__ bool next(int i, Unit& u) const {
        const long Lq = (long)i * G + c; if (Lq >= nwg + extra) return false;
        if (Lq >= nwg) { const int e = (int)(Lq - nwg); u.pm = nM + e / 3; u.pn = e % 3; return true; }
        int wgid = (int)Lq; { const int q = nwg / NXCD, r = nwg % NXCD, xcd = wgid % NXCD, off = wgid / NXCD; wgid = (xcd < r ? xcd * (q + 1) : r * (q + 1) + (xcd - r) * q) + off; }
        const int nig = WGM * nN, gid = wgid / nig, fm = gid * WGM, gsz = (nM - fm) < WGM ? (nM - fm) : WGM;
        u.pm = fm + ((wgid % nig) % gsz); u.pn = (wgid % nig) / gsz; return true;
    }
};

template <class Epi, class Sched, bool ALIGN_EPI, bool DUAL = false>
__device__ __forceinline__ void gemm_phase(LAS unsigned char* lds, const Gemm g, const Sched& S, const Epi& E) {
    int tid_ = threadIdx.x; asm volatile("" : "+v"(tid_));
    const int tid = tid_, wid = __builtin_amdgcn_readfirstlane(tid >> 6), lane = tid & 63, wr = wid >> 2, wc = wid & 3, fr = lane & 15, fq = lane >> 4;
    const int K = g.K, nt1 = K / BK, nt = DUAL ? 2 * nt1 : nt1;
    unsigned voffA[2], voffB[2];
#pragma unroll
    for (int i = 0; i < 2; ++i) { int R, C; stage_rc(tid * 16 + i * 8192, R, C); const int Rb = ((R & ~31) + perm32(R & 31));
        voffA[i] = (unsigned)(R * g.lda + C) * 2u; voffB[i] = (unsigned)(Rb * g.ldb + C) * 2u; }
    const size_t kstep = (size_t)(BK * 2);
    const size_t hstepA = (size_t)HALF * g.lda * 2, hstepB = (size_t)HALF * g.ldb * 2;
    const size_t tstepA = 2 * hstepA, tstepB = 2 * hstepB;
    const unsigned ldsw = (unsigned)wid * 1024u;
    const int aoff = lds_byte(wr * 64 + fr, fq * 8), boff = lds_byte(wc * 32 + fr, fq * 8);
#define PG8_SA(b, h) (((b) * 2 + (h)) * HTB)
#define PG8_SB(b, h) ((4 + (b) * 2 + (h)) * HTB)
#define PG8_STAGE(bufoff, gbase, voff) do { _Pragma("unroll") for (int _i = 0; _i < 2; ++_i) \
        __builtin_amdgcn_global_load_lds((const unsigned*)((const char*)(gbase) + (voff)[_i]), (LAS unsigned*)(lds + (bufoff) + ldsw + _i * 8192), 16, 0, 0); } while (0)
#define PG8_LDA(dst, b, h) do { _Pragma("unroll") for (int m = 0; m < 4; ++m) _Pragma("unroll") for (int k = 0; k < 2; ++k) dst[m][k] = *(const LAS bf16x8*)(lds + PG8_SA(b, h) + aoff + m * 2048 + k * 1024); } while (0)
#define PG8_LDB(dst, b, h) do { _Pragma("unroll") for (int n = 0; n < 2; ++n) _Pragma("unroll") for (int k = 0; k < 2; ++k) dst[n][k] = *(const LAS bf16x8*)(lds + PG8_SB(b, h) + boff + n * 2048 + k * 1024); } while (0)
#define PG8_MMA(ai, bj, At, Bt) do { __builtin_amdgcn_s_setprio(1); _Pragma("unroll") for (int m = 0; m < 4; ++m) _Pragma("unroll") for (int n = 0; n < 2; ++n) _Pragma("unroll") for (int k = 0; k < 2; ++k) \
        acc[ai][bj][m][n] = __builtin_amdgcn_mfma_f32_16x16x32_bf16(Bt[n][k], At[m][k], acc[ai][bj][m][n], 0, 0, 0); __builtin_amdgcn_s_setprio(0); } while (0)
#define PG8_WAIT_V(n) asm volatile("s_waitcnt vmcnt(" #n ")" ::: "memory")
#define PG8_WAIT_L(n) asm volatile("s_waitcnt lgkmcnt(" #n ")" ::: "memory")
#define PG8_BAR __builtin_amdgcn_s_barrier()
#define PG8_SCHED __builtin_amdgcn_sched_barrier(0)
    Unit cur, nxt; int ui = 0;
    if (!S.next(0, cur)) return;
    f32x4 acc[2][2][4][2];
#pragma unroll
    for (int a = 0; a < 2; ++a)
#pragma unroll
        for (int b = 0; b < 2; ++b)
#pragma unroll
            for (int m = 0; m < 4; ++m)
#pragma unroll
                for (int n = 0; n < 2; ++n) acc[a][b][m][n] = (f32x4){0.f, 0.f, 0.f, 0.f};
    bf16x8 At[4][2], B0[2][2], B1[2][2];
    const char* cA = (const char*)g.A + (size_t)cur.pm * tstepA; const char* cB = (const char*)g.Bt + (size_t)cur.pn * tstepB;
    const char* cA2 = DUAL ? (const char*)g.A2 + (size_t)cur.pm * tstepA : cA; const char* cB2 = DUAL ? (const char*)g.Bt2 + (size_t)cur.pn * tstepB : cB;
    PG8_STAGE(PG8_SB(0, 0), cB, voffB); PG8_STAGE(PG8_SB(0, 1), cB + hstepB, voffB); PG8_STAGE(PG8_SA(0, 0), cA, voffA); PG8_STAGE(PG8_SA(0, 1), cA + hstepA, voffA);
    if (wr == 1) PG8_BAR;
    PG8_WAIT_V(2); PG8_BAR;
    PG8_STAGE(PG8_SB(1, 0), cB + kstep, voffB); PG8_STAGE(PG8_SA(1, 0), cA + kstep, voffA); PG8_STAGE(PG8_SB(1, 1), cB + hstepB + kstep, voffB);
    PG8_WAIT_V(6); PG8_BAR;
    for (;;) {
        const bool has_next = S.next(ui + 1, nxt);
        const char* nA = has_next ? (const char*)g.A + (size_t)nxt.pm * tstepA : cA; const char* nB = has_next ? (const char*)g.Bt + (size_t)nxt.pn * tstepB : cB;
        for (int t = 0; t < nt; t += 2) {
            const bool last = (t == nt - 2);
            const bool seg2 = DUAL && t >= nt1, seg2n = DUAL && t + 2 >= nt1;
            const char* a1 = seg2 ? cA2 + (size_t)(t + 1 - nt1) * kstep : cA + (size_t)(t + 1) * kstep;
            const char* a2 = last ? nA : (seg2n ? cA2 + (size_t)(t + 2 - nt1) * kstep : cA + (size_t)(t + 2) * kstep);
            const char* b2 = last ? nB : (seg2n ? cB2 + (size_t)(t + 2 - nt1) * kstep : cB + (size_t)(t + 2) * kstep);
            if constexpr (DUAL) { if (t == nt1) E.mid(acc, cur, wr, wc, fr, fq); }
            const char* a3 = a2 + kstep; const char* b3 = b2 + kstep;
            PG8_LDB(B0, 0, 0); PG8_LDB(B1, 0, 1); PG8_SCHED; PG8_LDA(At, 0, 0); PG8_STAGE(PG8_SA(1, 1), a1 + hstepA, voffA);
            PG8_WAIT_V(8); PG8_WAIT_L(0); PG8_BAR; PG8_MMA(0, 0, At, B0); PG8_MMA(0, 1, At, B1); PG8_BAR; PG8_SCHED;
            PG8_LDA(At, 0, 1); PG8_STAGE(PG8_SB(0, 0), b2, voffB); PG8_STAGE(PG8_SB(0, 1), b2 + hstepB, voffB); PG8_STAGE(PG8_SA(0, 0), a2, voffA);
            PG8_WAIT_V(8); PG8_WAIT_L(0); PG8_BAR; PG8_MMA(1, 0, At, B0); PG8_MMA(1, 1, At, B1); PG8_BAR; PG8_SCHED;
            PG8_LDB(B0, 1, 0); PG8_LDB(B1, 1, 1); PG8_SCHED; PG8_LDA(At, 1, 0); PG8_STAGE(PG8_SA(0, 1), a2 + hstepA, voffA);
            PG8_WAIT_V(8); PG8_WAIT_L(0); PG8_BAR; PG8_MMA(0, 0, At, B0); PG8_MMA(0, 1, At, B1); PG8_BAR; PG8_SCHED;
            PG8_LDA(At, 1, 1); PG8_STAGE(PG8_SB(1, 0), b3, voffB); PG8_STAGE(PG8_SB(1, 1), b3 + hstepB, voffB); PG8_STAGE(PG8_SA(1, 0), a3, voffA);
            PG8_WAIT_V(8); PG8_WAIT_L(0); PG8_BAR; PG8_MMA(1, 0, At, B0); PG8_MMA(1, 1, At, B1); PG8_BAR; PG8_SCHED;
        }
        if constexpr (ALIGN_EPI) { if (wr == 0) PG8_BAR; }
        E(acc, cur, wr, wc, fr, fq);
        if (!has_next) break;
#pragma unroll
        for (int a = 0; a < 2; ++a)
#pragma unroll
            for (int b = 0; b < 2; ++b)
#pragma unroll
                for (int m = 0; m < 4; ++m)
#pragma unroll
                    for (int n = 0; n < 2; ++n) acc[a][b][m][n] = (f32x4){0.f, 0.f, 0.f, 0.f};
        cur = nxt; cA = nA; cB = nB; ++ui;
        if constexpr (DUAL) { cA2 = (const char*)g.A2 + (size_t)cur.pm * tstepA; cB2 = (const char*)g.Bt2 + (size_t)cur.pn * tstepB; }
        if constexpr (ALIGN_EPI) { if (wr == 1) PG8_BAR; }
    }
    PG8_WAIT_V(0);
    if constexpr (!ALIGN_EPI) { if (wr == 0) PG8_BAR; }
    PG8_BAR;
#undef PG8_SA
#undef PG8_SB
#undef PG8_STAGE
#undef PG8_LDA
#undef PG8_LDB
#undef PG8_MMA
#undef PG8_WAIT_V
#undef PG8_WAIT_L
#undef PG8_BAR
#undef PG8_SCHED
}
}
using pg8::Unit;
typedef const f32x4 (&AccRef)[2][2][4][2];

struct EpiIn {
    bf16_t *AK_, *MK_, *AQ_, *MQ_, *MO_, *GA_, *GM_; const float *qnw, *knw, *cosT_, *sinT_; LAS float* sp;
    __device__ __forceinline__ void head_path(AccRef acc, const Unit& u, int wr, int wc, int fr, int fq_in, bf16_t* base, int ld, int coff, const float* nw) const {
        int fq = fq_in; asm volatile("" : "+v"(fq));
        const int row0 = u.pm * 256 + wr * 64 + fr;
        const bool rope = u.pm < 64;
        { int tx = threadIdx.x; asm volatile("" : "+v"(tx)); const int tt0 = (u.pm * 256) & 2047;
          for (int i = tx; i < (rope ? 2512 : 64); i += 512) { float v;
              if (i < 64) v = nw[i];
              else if (i < 208) { const int k = i - 64, gi = k / 36, e = k - gi * 36; const int t = tt0 + 64 * gi; v = e < 16 ? cosT_[t * 32 + e] : e < 32 ? sinT_[t * 32 + e - 16] : 0.f; }
              else { const int k = i - 208, c = k / 36, e = k - c * 36; const int t = tt0 + c; v = e < 16 ? cosT_[t * 32 + 16 + e] : e < 32 ? sinT_[t * 32 + e] : 0.f; }
              sp[i] = v; }
          asm volatile("s_waitcnt vmcnt(0) lgkmcnt(0)" ::: "memory"); __builtin_amdgcn_s_barrier(); asm volatile("" ::: "memory"); }
        const f32x4 w00 = *(const LAS f32x4*)(sp + 8 * fq), w01 = *(const LAS f32x4*)(sp + 8 * fq + 4), w10 = *(const LAS f32x4*)(sp + 32 + 8 * fq), w11 = *(const LAS f32x4*)(sp + 32 + 8 * fq + 4);
#pragma unroll
        for (int ai = 0; ai < 2; ++ai)
#pragma unroll
            for (int m = 0; m < 4; ++m) {
                const int row = row0 + ai * 128 + m * 16;
                f32x4 v00 = acc[ai][0][m][0], v01 = acc[ai][0][m][1], v10 = acc[ai][1][m][0], v11 = acc[ai][1][m][1];
                f32x4 q = v00 * v00 + v01 * v01 + v10 * v10 + v11 * v11;
                float ss = (q[0] + q[1]) + (q[2] + q[3]);
                ss += __shfl_xor(ss, 16); ss += __shfl_xor(ss, 32);
                const float rs = rsqrtf(ss * (1.f / 64.f) + EPS);
                v00 = v00 * rs * w00; v01 = v01 * rs * w01; v10 = v10 * rs * w10; v11 = v11 * rs * w11;
                f32x4 o00 = v00, o01 = v01, o10 = v10, o11 = v11;
                if (rope) {
                    const int r = ai * 128 + wr * 64 + m * 16 + fr;
                    const LAS float* cp = sp + ((fq < 2) ? 64 + (r >> 6) * 36 + 8 * fq : 208 + (r & 63) * 36 + 8 * (fq - 2));
                    const f32x4 c0 = *(const LAS f32x4*)cp, c1 = *(const LAS f32x4*)(cp + 4), s0 = *(const LAS f32x4*)(cp + 16), s1 = *(const LAS f32x4*)(cp + 20);
                    o00 = v00 * c0 - v10 * s0; o01 = v01 * c1 - v11 * s1; o10 = v00 * s0 + v10 * c0; o11 = v01 * s1 + v11 * c1;
                }
                bf16_t* p = base + (size_t)row * ld + coff + wc * 64 + 8 * fq;
                *(u32x4*)p = pack8(o00, o01); *(u32x4*)(p + 32) = pack8(o10, o11);
                asm volatile("" ::: "memory");
            }
    }
    template <bool SIG> __device__ __forceinline__ void plain_path(AccRef acc, const Unit& u, int wr, int wc, int fr, int fq, bf16_t* base, int ld, int coff) const {
        const int row0 = u.pm * 256 + wr * 64 + fr;
#pragma unroll
        for (int ai = 0; ai < 2; ++ai)
#pragma unroll
            for (int m = 0; m < 4; ++m) {
                bf16_t* p = base + (size_t)(row0 + ai * 128 + m * 16) * ld + coff + wc * 32 + 8 * fq;
#pragma unroll
                for (int bj = 0; bj < 2; ++bj) { f32x4 v0 = acc[ai][bj][m][0], v1 = acc[ai][bj][m][1];
                    if (SIG) {
#pragma unroll
                        for (int e = 0; e < 4; ++e) { v0[e] = sigmoid_div(v0[e]); v1[e] = sigmoid_div(v1[e]); } }
                    *(u32x4*)(p + bj * 128) = pack8(v0, v1); }
            }
    }
    __device__ __forceinline__ void operator()(AccRef acc, const Unit& u, int wr, int wc, int fr, int fq) const {
        const int pn = u.pn;
        if (pn == 0) head_path(acc, u, wr, wc, fr, fq, AK_, 256, 0, knw);
        else if (pn <= 2) plain_path<false>(acc, u, wr, wc, fr, fq, MK_, 512, (pn - 1) * 256);
        else if (pn <= 6) head_path(acc, u, wr, wc, fr, fq, AQ_, 1024, (pn - 3) * 256, qnw);
        else if (pn <= 8) plain_path<false>(acc, u, wr, wc, fr, fq, MQ_, 512, (pn - 7) * 256);
        else if (pn <= 12) plain_path<false>(acc, u, wr, wc, fr, fq, MO_, 1024, (pn - 9) * 256);
        else if (pn <= 16) plain_path<true>(acc, u, wr, wc, fr, fq, GA_, 1024, (pn - 13) * 256);
        else plain_path<true>(acc, u, wr, wc, fr, fq, GM_, 1024, (pn - 17) * 256);
    }
};
struct EpiPlain {
    bf16_t* O; int ldc;
    __device__ __forceinline__ void operator()(AccRef acc, const Unit& u, int wr, int wc, int fr, int fq) const {
        const int row0 = u.pm * 256 + wr * 64 + fr;
#pragma unroll
        for (int ai = 0; ai < 2; ++ai)
#pragma unroll
            for (int m = 0; m < 4; ++m) {
                bf16_t* p = O + (size_t)(row0 + ai * 128 + m * 16) * ldc + u.pn * 256 + wc * 32 + 8 * fq;
#pragma unroll
                for (int bj = 0; bj < 2; ++bj) *(u32x4*)(p + bj * 128) = pack8(acc[ai][bj][m][0], acc[ai][bj][m][1]);
            }
    }
};
template <bool ADD> struct EpiGate {
    const bf16_t* Gt; const bf16_t* T; bf16_t* O;
    __device__ __forceinline__ void operator()(AccRef acc, const Unit& u, int wr, int wc, int fr, int fq) const {
        const int row0 = u.pm * 256 + wr * 64 + fr;
        const size_t off0 = (size_t)row0 * 1024 + u.pn * 256 + wc * 32 + 8 * fq;
        u32x4 gv[2][2], tv[2][2];
#pragma unroll
        for (int bj = 0; bj < 2; ++bj) { gv[0][bj] = *(const u32x4*)(Gt + off0 + bj * 128); tv[0][bj] = (u32x4){0u, 0u, 0u, 0u}; if (ADD) tv[0][bj] = *(const u32x4*)(T + off0 + bj * 128); }
#pragma unroll
        for (int it = 0; it < 8; ++it) {
            const int ai = it >> 2, m = it & 3, cur = it & 1, nx = cur ^ 1;
            const size_t off = off0 + (size_t)(ai * 128 + m * 16) * 1024;
            if (it < 7) { const size_t offn = off0 + (size_t)(((it + 1) >> 2) * 128 + ((it + 1) & 3) * 16) * 1024;
#pragma unroll
                for (int bj = 0; bj < 2; ++bj) { gv[nx][bj] = *(const u32x4*)(Gt + offn + bj * 128); tv[nx][bj] = (u32x4){0u, 0u, 0u, 0u}; if (ADD) tv[nx][bj] = *(const u32x4*)(T + offn + bj * 128); } }
#pragma unroll
            for (int bj = 0; bj < 2; ++bj) {
                float r[8];
#pragma unroll
                for (int e = 0; e < 8; ++e) {
                    const unsigned gw = gv[cur][bj][e >> 1], tw = tv[cur][bj][e >> 1];
                    const float gg = (e & 1) ? __uint_as_float(gw & 0xffff0000u) : __uint_as_float(gw << 16);
                    const float tt = (e & 1) ? __uint_as_float(tw & 0xffff0000u) : __uint_as_float(tw << 16);
                    r[e] = tt + sigmoidf_(gg) * acc[ai][bj][m][e >> 2][e & 3];
                }
                u32x4 w; w.x = cvt_pk_bf16(r[0], r[1]); w.y = cvt_pk_bf16(r[2], r[3]); w.z = cvt_pk_bf16(r[4], r[5]); w.w = cvt_pk_bf16(r[6], r[7]);
                *(u32x4*)(O + off + bj * 128) = w;
            }
        }
    }
};
struct EpiMerge {
    const bf16_t* Sa; const bf16_t* Sm; bf16_t* O;
    __device__ __forceinline__ void mid(f32x4 (&acc)[2][2][4][2], const Unit& u, int wr, int wc, int fr, int fq) const {
        const size_t off0 = (size_t)(u.pm * 256 + wr * 64 + fr) * 1024 + u.pn * 256 + wc * 32 + 8 * fq;
        u32x4 av[2][2], mv[2][2];
#pragma unroll
        for (int bj = 0; bj < 2; ++bj) { av[0][bj] = *(const u32x4*)(Sa + off0 + bj * 128); mv[0][bj] = *(const u32x4*)(Sm + off0 + bj * 128); }
#pragma unroll
        for (int it = 0; it < 8; ++it) {
            const int ai = it >> 2, m = it & 3, cur = it & 1, nx = cur ^ 1;
            if (it < 7) { const size_t offn = off0 + (size_t)(((it + 1) >> 2) * 128 + ((it + 1) & 3) * 16) * 1024;
#pragma unroll
                for (int bj = 0; bj < 2; ++bj) { av[nx][bj] = *(const u32x4*)(Sa + offn + bj * 128); mv[nx][bj] = *(const u32x4*)(Sm + offn + bj * 128); } }
#pragma unroll
            for (int bj = 0; bj < 2; ++bj)
#pragma unroll
                for (int e = 0; e < 8; ++e) {
                    const unsigned aw = av[cur][bj][e >> 1], mw = mv[cur][bj][e >> 1];
                    const float sa = (e & 1) ? __uint_as_float(aw & 0xffff0000u) : __uint_as_float(aw << 16);
                    const float sm = (e & 1) ? __uint_as_float(mw & 0xffff0000u) : __uint_as_float(mw << 16);
                    acc[ai][bj][m][e >> 2][e & 3] *= sa * __builtin_amdgcn_rcpf(fmaxf(sm, 1e-30f));
                }
        }
    }
    __device__ __forceinline__ void operator()(AccRef acc, const Unit& u, int wr, int wc, int fr, int fq) const {
        const size_t off0 = (size_t)(u.pm * 256 + wr * 64 + fr) * 1024 + u.pn * 256 + wc * 32 + 8 * fq;
        u32x4 mv[2][2];
#pragma unroll
        for (int bj = 0; bj < 2; ++bj) mv[0][bj] = *(const u32x4*)(Sm + off0 + bj * 128);
#pragma unroll
        for (int it = 0; it < 8; ++it) {
            const int ai = it >> 2, m = it & 3, cur = it & 1, nx = cur ^ 1;
            const size_t off = off0 + (size_t)(ai * 128 + m * 16) * 1024;
            if (it < 7) { const size_t offn = off0 + (size_t)(((it + 1) >> 2) * 128 + ((it + 1) & 3) * 16) * 1024;
#pragma unroll
                for (int bj = 0; bj < 2; ++bj) mv[nx][bj] = *(const u32x4*)(Sm + offn + bj * 128); }
#pragma unroll
            for (int bj = 0; bj < 2; ++bj) { float r[8];
#pragma unroll
                for (int e = 0; e < 8; ++e) { const unsigned mw = mv[cur][bj][e >> 1];
                    const float sm = (e & 1) ? __uint_as_float(mw & 0xffff0000u) : __uint_as_float(mw << 16);
                    r[e] = fmaxf(sm, 1e-30f) * acc[ai][bj][m][e >> 2][e & 3]; }
                u32x4 w; w.x = cvt_pk_bf16(r[0], r[1]); w.y = cvt_pk_bf16(r[2], r[3]); w.z = cvt_pk_bf16(r[4], r[5]); w.w = cvt_pk_bf16(r[6], r[7]);
                *(u32x4*)(O + off + bj * 128) = w; }
        }
    }
};
struct EpiOut {
    const float* x; const float* mod; const float* nw2; float* xmid; bf16_t* AP; float* rowsq;
    __device__ __forceinline__ void operator()(AccRef acc, const Unit& u, int wr, int wc, int fr, int fq) const {
        const int b = u.pm >> 3; const float* mb = mod + b * 6144;
        const int row0 = u.pm * 256 + wr * 64 + fr, col0 = u.pn * 256 + wc * 32 + 8 * fq;
        f32x4 g1[2][2], sw[2][2];
#pragma unroll
        for (int bj = 0; bj < 2; ++bj)
#pragma unroll
            for (int n = 0; n < 2; ++n) { const int c = col0 + bj * 128 + 4 * n; g1[bj][n] = *(const f32x4*)(mb + 2048 + c);
                sw[bj][n] = *(const f32x4*)(nw2 + c) * (*(const f32x4*)(mb + 4096 + c) + 1.f); }
        f32x4 xv[2][2][2];
#pragma unroll
        for (int bj = 0; bj < 2; ++bj)
#pragma unroll
            for (int n = 0; n < 2; ++n) xv[0][bj][n] = __builtin_nontemporal_load((const f32x4*)(x + (size_t)row0 * 1024 + col0 + bj * 128 + 4 * n));
#pragma unroll
        for (int it = 0; it < 8; ++it) {
            const int ai = it >> 2, m = it & 3, cur = it & 1, nx = cur ^ 1;
            const int row = row0 + ai * 128 + m * 16; const size_t off = (size_t)row * 1024 + col0; float ss = 0.f;
            if (it < 7) { const size_t offn = (size_t)(row0 + ((it + 1) >> 2) * 128 + ((it + 1) & 3) * 16) * 1024 + col0;
#pragma unroll
                for (int bj = 0; bj < 2; ++bj)
#pragma unroll
                    for (int n = 0; n < 2; ++n) xv[nx][bj][n] = __builtin_nontemporal_load((const f32x4*)(x + offn + bj * 128 + 4 * n)); }
#pragma unroll
            for (int bj = 0; bj < 2; ++bj) {
                f32x4 v[2];
#pragma unroll
                for (int n = 0; n < 2; ++n) { v[n] = xv[cur][bj][n] + g1[bj][n] * acc[ai][bj][m][n];
                    const f32x4 q = v[n] * v[n]; ss += (q[0] + q[1]) + (q[2] + q[3]); }
                *(u32x4*)(AP + off + bj * 128) = pack8(v[0] * sw[bj][0], v[1] * sw[bj][1]);
            }
            ss += __shfl_xor(ss, 16); ss += __shfl_xor(ss, 32);
            if (fq == 0) rowsq[(size_t)row * 16 + u.pn * 4 + wc] = ss;
        }
    }
};
__device__ __forceinline__ float dpp_prev(float v) { return __int_as_float(__builtin_amdgcn_update_dpp(0, __float_as_int(v), 0x111, 0xf, 0xf, true)); }
__device__ __forceinline__ float dpp_next(float v) { return __int_as_float(__builtin_amdgcn_update_dpp(0, __float_as_int(v), 0x101, 0xf, 0xf, true)); }
struct EpiUp {
    const float* rowsq; const float* fb; const float* cw; const float* cb; bf16_t* ACT_; bf16_t* RAW_; LAS float* sp;
    __device__ __forceinline__ void operator()(AccRef acc, const Unit& u, int wr, int wc, int fr, int fq) const {
        const int b = u.pm >> 3; const int row0 = u.pm * 256 + wr * 64 + fr;
        int tx = threadIdx.x; asm volatile("" : "+v"(tx));
        if (tx < 256) {
            const float* qp = rowsq + (size_t)(u.pm * 256 + tx) * 16; const f32x4 q0 = *(const f32x4*)qp, q1 = *(const f32x4*)(qp + 4), q2 = *(const f32x4*)(qp + 8), q3 = *(const f32x4*)(qp + 12);
            const f32x4 qs = (q0 + q1) + (q2 + q3); sp[1280 + tx] = rsqrtf(((qs[0] + qs[1]) + (qs[2] + qs[3])) * (1.f / 1024.f) + EPS);
        } else {
            for (int i = tx - 256; i < 1280; i += 256) { const int vec = i >> 7, j = u.pn * 128 + (i & 127);
                const float* src = vec == 0 ? fb + b * NUP + j : vec == 1 ? fb + b * NUP + DFF + j : vec < 5 ? cw + (vec - 2) * NUP + j : vec < 8 ? cw + (vec - 5) * NUP + DFF + j : vec == 8 ? cb + j : cb + DFF + j;
                sp[i] = *src; } }
        asm volatile("s_waitcnt vmcnt(0) lgkmcnt(0)" ::: "memory"); __builtin_amdgcn_s_barrier(); asm volatile("" ::: "memory");
        const LAS float* spc = sp + wc * 32 + 8 * fq;
        const int jb = u.pn * 128 + wc * 32 + 8 * fq;
        const int pcol = u.pn * 256 + wc * 32 + 8 * fq;
        const bool interior = (fr >= 1) && (fr <= 14), rawrow = !((fr >= 2) && (fr <= 13));
        const int slot = fr < 2 ? fr : fr - 12;
#pragma unroll
        for (int ai = 0; ai < 2; ++ai)
#pragma unroll
            for (int m = 0; m < 4; ++m) {
                const int row = row0 + ai * 128 + m * 16; const float rstd = sp[1280 + ai * 128 + wr * 64 + m * 16 + fr];
                float r[8]; f32x4 ua[2], ug[2];
#pragma unroll
                for (int n = 0; n < 2; ++n) {
                    ua[n] = acc[ai][0][m][n] * rstd + *(const LAS f32x4*)(spc + 0 * 128 + 4 * n);
                    ug[n] = acc[ai][1][m][n] * rstd + *(const LAS f32x4*)(spc + 1 * 128 + 4 * n);
                    const f32x4 wa0 = *(const LAS f32x4*)(spc + 2 * 128 + 4 * n), wa1 = *(const LAS f32x4*)(spc + 3 * 128 + 4 * n), wa2 = *(const LAS f32x4*)(spc + 4 * 128 + 4 * n);
                    const f32x4 wg0 = *(const LAS f32x4*)(spc + 5 * 128 + 4 * n), wg1 = *(const LAS f32x4*)(spc + 6 * 128 + 4 * n), wg2 = *(const LAS f32x4*)(spc + 7 * 128 + 4 * n);
                    const f32x4 ba = *(const LAS f32x4*)(spc + 8 * 128 + 4 * n), bg = *(const LAS f32x4*)(spc + 9 * 128 + 4 * n);
#pragma unroll
                    for (int e = 0; e < 4; ++e) {
                        const float av = ba[e] + wa0[e] * dpp_prev(ua[n][e]) + wa1[e] * ua[n][e] + wa2[e] * dpp_next(ua[n][e]);
                        const float gv = bg[e] + wg0[e] * dpp_prev(ug[n][e]) + wg1[e] * ug[n][e] + wg2[e] * dpp_next(ug[n][e]);
                        r[4 * n + e] = gv * sigmoidf_(gv) * av;
                    }
                }
                if (interior) { u32x4 w; w.x = cvt_pk_bf16(r[0], r[1]); w.y = cvt_pk_bf16(r[2], r[3]); w.z = cvt_pk_bf16(r[4], r[5]); w.w = cvt_pk_bf16(r[6], r[7]);
                    *(u32x4*)(ACT_ + (size_t)row * DFF + jb) = w; }
                if (rawrow) { bf16_t* rp = RAW_ + ((size_t)(row >> 4) * 4 + slot) * NUP + pcol;
                    *(u32x4*)rp = pack8(ua[0], ua[1]); *(u32x4*)(rp + 128) = pack8(ug[0], ug[1]); }
                asm volatile("" ::: "memory");
            }
    }
};
struct EpiDown {
    float* out; const float* mod; const bf16_t* AP; const float* nw2;
    __device__ __forceinline__ void operator()(AccRef acc, const Unit& u, int wr, int wc, int fr, int fq) const {
        const int b = u.pm >> 3; const float* mb = mod + b * 6144;
        const int row0 = u.pm * 256 + wr * 64 + fr, col0 = u.pn * 256 + wc * 32 + 8 * fq;
        f32x4 g2[2][2], rsw[2][2];
#pragma unroll
        for (int bj = 0; bj < 2; ++bj)
#pragma unroll
            for (int n = 0; n < 2; ++n) { const int c = col0 + bj * 128 + 4 * n; g2[bj][n] = *(const f32x4*)(mb + 5120 + c);
                const f32x4 sw = *(const f32x4*)(nw2 + c) * (*(const f32x4*)(mb + 4096 + c) + 1.f);
#pragma unroll
                for (int e = 0; e < 4; ++e) rsw[bj][n][e] = 1.f / sw[e]; }
        u32x4 av[2][2];
#pragma unroll
        for (int bj = 0; bj < 2; ++bj) av[0][bj] = *(const u32x4*)(AP + (size_t)row0 * 1024 + col0 + bj * 128);
#pragma unroll
        for (int it = 0; it < 8; ++it) {
            const int ai = it >> 2, m = it & 3, cur = it & 1, nx = cur ^ 1;
            const size_t off = (size_t)(row0 + ai * 128 + m * 16) * 1024 + col0;
            if (it < 7) { const size_t offn = (size_t)(row0 + ((it + 1) >> 2) * 128 + ((it + 1) & 3) * 16) * 1024 + col0;
#pragma unroll
                for (int bj = 0; bj < 2; ++bj) av[nx][bj] = *(const u32x4*)(AP + offn + bj * 128); }
#pragma unroll
            for (int bj = 0; bj < 2; ++bj)
#pragma unroll
                for (int n = 0; n < 2; ++n) { const unsigned w0 = av[cur][bj][2 * n], w1 = av[cur][bj][2 * n + 1];
                    const f32x4 ap = (f32x4){__uint_as_float(w0 << 16), __uint_as_float(w0 & 0xffff0000u), __uint_as_float(w1 << 16), __uint_as_float(w1 & 0xffff0000u)};
                    *(f32x4*)(out + off + bj * 128 + 4 * n) = ap * rsw[bj][n] + g2[bj][n] * acc[ai][bj][m][n]; }
        }
    }
};

__device__ __forceinline__ f32x4 mfma16(bf16x8 a, bf16x8 b, f32x4 c) { return __builtin_amdgcn_mfma_f32_16x16x32_bf16(a, b, c, 0, 0, 0); }

__device__ __forceinline__ void transpose_item(const float* W, int ldw, int col, int k0, bf16_t* WT, int dst_row, int dld, LAS float* scr, int lane) {
#pragma unroll 8
    for (int i = 0; i < 32; ++i) { const int kk = 2 * i + (lane >> 5); scr[kk * 33 + (lane & 31)] = W[(size_t)(k0 + kk) * ldw + col + (lane & 31)]; }
    asm volatile("s_waitcnt lgkmcnt(0)" ::: "memory");
    const int c = lane & 7;
#pragma unroll
    for (int j = 0; j < 4; ++j) { const int n = (lane >> 3) + 8 * j; const LAS float* s = scr + (8 * c) * 33 + n;
        u32x4 o; o.x = cvt_pk_bf16(s[0 * 33], s[1 * 33]); o.y = cvt_pk_bf16(s[2 * 33], s[3 * 33]); o.z = cvt_pk_bf16(s[4 * 33], s[5 * 33]); o.w = cvt_pk_bf16(s[6 * 33], s[7 * 33]);
        *(u32x4*)(WT + (size_t)(dst_row + n) * dld + k0 + 8 * c) = o; }
    asm volatile("s_waitcnt lgkmcnt(0)" ::: "memory");
}
__device__ __forceinline__ int headperm(int n0) { const int tile = n0 >> 8, l = n0 & 255; return tile * 256 + 128 * ((l >> 5) & 1) + 32 * (l >> 6); }

struct Args {
    const float *x, *c, *ctx, *c_ctx, *w_mod, *b_mod, *norm1_w, *w_in, *q_norm_w, *k_norm_w, *attn_sink, *ml_gate_b, *ml_norm_w,
        *w_branch_att, *w_branch_ml, *w_out, *norm2_w, *w_up, *conv_w, *conv_b, *w_down;
    float* out; unsigned char* ws; int ph_lo, ph_hi;
};

template <int NV, int KS, bool ATOMIC> __device__ __forceinline__ void gemv_task(const float* W, int ldw, int n0, int k0, const LAS float* svec, float* out, int ldo) {
    const int n = n0 + threadIdx.x; float a[NV];
#pragma unroll
    for (int v = 0; v < NV; ++v) a[v] = 0.f;
#pragma unroll 16
    for (int k = 0; k < KS; ++k) { const float w = W[(size_t)(k0 + k) * ldw + n];
#pragma unroll
        for (int v = 0; v < NV; ++v) a[v] += svec[v * KS + k] * w; }
#pragma unroll
    for (int v = 0; v < NV; ++v) { if (ATOMIC) atomicAdd(out + (size_t)v * ldo + n, a[v]); else out[(size_t)v * ldo + n] = a[v]; }
}

#define mod   ((float*)(wsb + WS_MOD))
#define modp  ((float*)(wsb + WS_MODP))
#define fbias ((float*)(wsb + WS_FB))
#define rowsq ((float*)(wsb + WS_RSQP))
#define fbp ((float*)(dob + DO_FBP))
#define cosT  ((float*)(wsb + WS_ROPE))
#define sinT  ((float*)(wsb + WS_ROPE) + 2048 * 32)
#define gates ((float*)(wsb + WS_GATES))
#define WBA ((bf16_t*)(wsb + WS_WBA))
#define WBM ((bf16_t*)(wsb + WS_WBM))
#define WO  ((bf16_t*)(wsb + WS_WO))
#define WUP ((bf16_t*)(wsb + WS_WUP))
#define WDN ((bf16_t*)(wsb + WS_WDN))
#define AQ  ((bf16_t*)(wsb + WS_AQ))
#ifdef DBG_ATTO
#define ATTO GA
#else
#define ATTO AQ
#endif
#define MQ  ((bf16_t*)(wsb + WS_MQ))
#define MK  ((bf16_t*)(wsb + WS_MK))
#define MO  ((bf16_t*)(wsb + WS_MO))
#define GA  ((bf16_t*)(wsb + WS_GA))
#define GM  ((bf16_t*)(wsb + WS_GM))
#define XT  ((bf16_t*)(wsb + WS_XT))
#define T1  ((bf16_t*)(wsb + WS_T1))
#define Y   ((bf16_t*)(wsb + WS_Y))
#define U   ((bf16_t*)(wsb + WS_U))
#define HALO ((bf16_t*)(wsb + WS_HALO))
#define ACT ((bf16_t*)(wsb + WS_ACT))
#define RAWU ((bf16_t*)(wsb + WS_RAW))
#define H   ((bf16_t*)(dob + DO_H))
#define W1T ((bf16_t*)(dob + DO_W1T))
#define W2T ((bf16_t*)(dob + DO_W2T))
#define AK  ((bf16_t*)(wsb + WS_HALO))
#define HF  ((bf16_t*)(dob + DO_HF))
#define HB  ((bf16_t*)(dob + DO_HB))

#define XB_TMO      128
#define XB_XCNT(j)  (256  + 64 * (j))
#define XB_XSUB(j)  (1280 + 64 * (j))
#define XB_XGEN(j)  (2304 + 64 * (j))
#define XB_TOP      3328
#define XB_TOPGEN   3392
#define XCD_BAR_WORDS 3456
#define XB_SPIN_CAP (1u << 18)
__device__ __forceinline__ unsigned xb_ld(unsigned* p)              { return __hip_atomic_load(p, __ATOMIC_RELAXED, __HIP_MEMORY_SCOPE_AGENT); }
__device__ __forceinline__ unsigned xb_add(unsigned* p, unsigned v) { return __hip_atomic_fetch_add(p, v, __ATOMIC_RELAXED, __HIP_MEMORY_SCOPE_AGENT); }
__device__ __forceinline__ unsigned xb_xcc_id() { return (unsigned)__builtin_amdgcn_s_getreg((3 << 11) | 20) & 0xFu; }
#define XB_SPIN(cond, bar) do { unsigned _sp = 0; while (cond) { __builtin_amdgcn_s_sleep(1); \
    if ((++_sp & 255u) == 0u) { if (xb_ld(&(bar)[XB_TMO])) break; if (_sp > XB_SPIN_CAP) { atomicAdd(&(bar)[XB_TMO], 1u); break; } } } } while (0)
struct XcdBarrier { unsigned* bar; unsigned x; volatile LAS unsigned* st; };
__device__ __forceinline__ XcdBarrier xcd_barrier_post(unsigned* bar, volatile LAS unsigned* st) {
    XcdBarrier b; b.bar = bar; b.x = xb_xcc_id(); b.st = st;
    if (threadIdx.x == 0) (void)xb_add(&bar[XB_XCNT(b.x)], 1u);
    return b;
}
__device__ __forceinline__ void xcd_barrier_complete(unsigned* bar, unsigned x, unsigned& nloc, unsigned& nx) {
    const unsigned G = gridDim.x * gridDim.y * gridDim.z;
    unsigned sum, cnt, mine, sp = 0u;
    for (;;) {
        sum = 0u; cnt = 0u; mine = 0u;
#pragma unroll
        for (unsigned j = 0; j < 16; ++j) { const unsigned c = xb_ld(&bar[XB_XCNT(j)]); sum += c; cnt += (c > 0u) ? 1u : 0u; mine = (j == x) ? c : mine; }
        if (sum == G) break;
        __builtin_amdgcn_s_sleep(1);
        if ((++sp & 255u) == 0u) { if (xb_ld(&bar[XB_TMO])) break; if (sp > XB_SPIN_CAP) { atomicAdd(&bar[XB_TMO], 1u); break; } }
    }
    nloc = mine > 0u ? mine : 1u; nx = cnt > 0u ? cnt : 1u;
}
__device__ __forceinline__ void xcd_barrier(const XcdBarrier& b) {
    asm volatile("s_waitcnt vmcnt(0)" ::: "memory");
    __syncthreads();
    if (threadIdx.x == 0) {
        unsigned* bar = b.bar;
        __builtin_amdgcn_s_waitcnt(0);
        unsigned nloc = b.st[0], nx = b.st[1];
        if (nloc == 0u) { xcd_barrier_complete(bar, b.x, nloc, nx); b.st[0] = nloc; b.st[1] = nx; }
        const unsigned old = xb_add(&bar[XB_XSUB(b.x)], 1u);
        const unsigned gen = old / nloc;
        if (old + 1u == (gen + 1u) * nloc) {
            __builtin_amdgcn_fence(__ATOMIC_RELEASE, "agent");
            asm volatile("s_waitcnt vmcnt(0)" ::: "memory");
            const unsigned og = xb_add(&bar[XB_TOP], 1u);
            const unsigned tg = og / nx;
            if (og + 1u == (tg + 1u) * nx) xb_add(&bar[XB_TOPGEN], 1u);
            else XB_SPIN(xb_ld(&bar[XB_TOPGEN]) == tg, bar);
            __builtin_amdgcn_fence(__ATOMIC_ACQUIRE, "agent");
            xb_add(&bar[XB_XGEN(b.x)], 1u);
            asm volatile("s_waitcnt vmcnt(0)" ::: "memory");
        } else {
            XB_SPIN(xb_ld(&bar[XB_XGEN(b.x)]) == gen, bar);
            __builtin_amdgcn_fence(__ATOMIC_ACQUIRE, "agent");
            asm volatile("s_waitcnt vmcnt(0)" ::: "memory");
        }
    }
    __syncthreads();
}
constexpr size_t WS_BAR = 253 * MiB;
constexpr int LDS_ST_OFF = LDS_BYTES - 16;
#define A (*(const volatile __attribute__((address_space(4))) Args*)__builtin_amdgcn_kernarg_segment_ptr())
__global__ void __launch_bounds__(512, 2) fwd_kernel(Args Aparam) {
    extern __shared__ __attribute__((aligned(16))) unsigned char lds_raw[];
    LAS unsigned char* lds = (LAS unsigned char*)lds_raw;
    const int tid = threadIdx.x, lane = tid & 63, wave = __builtin_amdgcn_readfirstlane(tid >> 6);
    const int G = gridDim.x, bx = blockIdx.x;
    const int gw = bx * 8 + wave, NGW = G * 8;
    const int lo = A.ph_lo, hi = A.ph_hi; (void)lo; (void)hi;
#ifndef PHMASK
#define PHMASK 0x1fff
#endif
#if ONE_LAUNCH
#define IN(k) (((PHMASK >> (k)) & 1) && (k) < 11)
#else
#define IN(k) (((PHMASK >> (k)) & 1) && lo <= (k) && (k) < hi)
#endif
#if ONE_LAUNCH
    XcdBarrier xbar; xbar.bar = nullptr; xbar.x = 0; xbar.st = (volatile LAS unsigned*)(lds + LDS_ST_OFF);
#define SEAM(k) do { xcd_barrier(xbar); } while (0)
    {
        unsigned* const barw = (unsigned*)(A.ws + WS_BAR);
        if (tid < 4) ((LAS unsigned*)(lds + LDS_ST_OFF))[tid] = 0u;
        if (bx == 0) for (int i = tid; i < XCD_BAR_WORDS; i += 512) barw[i] = 0u;
        cg::this_grid().sync();
        xbar = xcd_barrier_post(barw, (volatile LAS unsigned*)(lds + LDS_ST_OFF));
    }
#else
#define SEAM(k) do { } while (0)
#endif

    for (int rep_ = 0; rep_ < (((RPT_MASK >> 0) & 1) ? 2 : 1); ++rep_) { if (rep_) { if (0 == 0) cg::this_grid().sync(); else xcd_barrier(xbar); }
    if (IN(0)) {
        unsigned char* const wsb = A.ws; unsigned char* const dob = (unsigned char*)A.out; (void)wsb; (void)dob;
        LAS float* svec = (LAS float*)(lds + 131072);
        for (int task = bx; task < 192; task += G) {
            const int cb = task % 12, ks = task / 12, k0 = ks * 64;
            __syncthreads();
            for (int i = tid; i < 576; i += 512) { const int v = i >> 6, k = i & 63; const float cv = v < 8 ? A.c[v * 1024 + k0 + k] : A.c_ctx[k0 + k]; svec[i] = cv / (1.f + __expf(-cv)); }
            __syncthreads();
            gemv_task<9, 64, false>(A.w_mod, 6144, cb * 512, k0, svec, modp + (size_t)ks * 9 * 6144, 6144);
        }
        LAS float* scr = (LAS float*)(lds + wave * 16384);
        constexpr int NITEMS = 9088;
        for (int it = gw; it < NITEMS; it += NGW) {
            int r = it; const float* W; int ldw, col0, ncols, K; bf16_t* dst; int hp = 0;
            if (r < 512) { W = A.w_in; ldw = INW; col0 = 0; ncols = 1024; K = 1024; dst = W1T + (size_t)3 * 256 * 1024; hp = 1; }
            else if ((r -= 512) < 128) { W = A.w_in; ldw = INW; col0 = 1024; ncols = 256; K = 1024; dst = W1T; hp = 1; }
            else if ((r -= 128) < 128) { W = A.w_in; ldw = INW; col0 = 1280; ncols = 256; K = 1024; dst = W2T; }
            else if ((r -= 128) < 256) { W = A.w_in; ldw = INW; col0 = 1536; ncols = 512; K = 1024; dst = W1T + (size_t)7 * 256 * 1024; }
            else if ((r -= 256) < 256) { W = A.w_in; ldw = INW; col0 = 2048; ncols = 512; K = 1024; dst = W1T + (size_t)1 * 256 * 1024; }
            else if ((r -= 256) < 512) { W = A.w_in; ldw = INW; col0 = 2560; ncols = 1024; K = 1024; dst = W2T + (size_t)256 * 1024; }
            else if ((r -= 512) < 512) { W = A.w_in; ldw = INW; col0 = 3584; ncols = 1024; K = 1024; dst = W1T + (size_t)9 * 256 * 1024; }
            else if ((r -= 512) < 512) { W = A.w_in; ldw = INW; col0 = 4624; ncols = 1024; K = 1024; dst = W1T + (size_t)13 * 256 * 1024; }
            else if ((r -= 512) < 512) { W = A.w_in; ldw = INW; col0 = 5648; ncols = 1024; K = 1024; dst = W1T + (size_t)17 * 256 * 1024; }
            else if ((r -= 512) < 512) { W = A.w_branch_att; ldw = 1024; col0 = 0; ncols = 1024; K = 1024; dst = WBA; }
            else if ((r -= 512) < 512) { W = A.w_branch_ml; ldw = 1024; col0 = 0; ncols = 1024; K = 1024; dst = WBM; }
            else if ((r -= 512) < 512) { W = A.w_out; ldw = 1024; col0 = 0; ncols = 1024; K = 1024; dst = WO; }
            else if ((r -= 512) < 2816) { W = A.w_up; ldw = NUP; col0 = 0; ncols = NUP; K = 1024; dst = WUP; }
            else { r -= 2816; W = A.w_down; ldw = 1024; col0 = 0; ncols = 1024; K = DFF; dst = WDN; }
            const int nblk = ncols / 32, kb = r / nblk, nb = r % nblk, n0 = nb * 32;
            int drow = hp ? headperm(n0) : n0;
            if (W == A.w_up) drow = (n0 < DFF) ? 256 * (n0 >> 7) + (n0 & 127) : 256 * ((n0 - DFF) >> 7) + 128 + ((n0 - DFF) & 127);
            transpose_item(W, ldw, col0 + n0, kb * 64, dst, drow, K, scr, lane);
        }
        for (int i = bx * 512 + tid; i < 2048 * 32; i += G * 512) {
            const int t = i >> 5, j = i & 31; const float pos = (j < 16) ? (float)(t >> 6) : (float)(t & 63);
            const float invf = exp2f(-(float)(j & 15) * (13.287712379549449f / 16.f)); const float ang = pos * invf;
            cosT[i] = cosf(ang); sinT[i] = sinf(ang);
        }
    }
    }
    SEAM(0);

    for (int rep_ = 0; rep_ < (((RPT_MASK >> 1) & 1) ? 2 : 1); ++rep_) { if (rep_) { if (1 == 0) cg::this_grid().sync(); else xcd_barrier(xbar); }
    if (IN(1)) {
        unsigned char* const wsb = A.ws; unsigned char* const dob = (unsigned char*)A.out; (void)wsb; (void)dob;
        constexpr int GP = 1028;
        LAS float* sWg = (LAS float*)lds;
        LAS float* hT = (LAS float*)(lds + 65792);
        LAS float* svm = (LAS float*)(lds + 131584);
        LAS float* part = (LAS float*)(lds + 147968);
        LAS float* svec = part;
        for (int k = tid; k < 1024; k += 512) { const float* src = A.w_in + (size_t)k * INW + 4608;
#pragma unroll
            for (int q = 0; q < 4; ++q) { const f32x4 v = *(const f32x4*)(src + 4 * q); sWg[(4 * q + 0) * GP + k] = v[0]; sWg[(4 * q + 1) * GP + k] = v[1]; sWg[(4 * q + 2) * GP + k] = v[2]; sWg[(4 * q + 3) * GP + k] = v[3]; } }
        const int rpb = (MT + G - 1) / G, rbeg = bx * rpb, rend = (rbeg + rpb < MT) ? rbeg + rpb : MT;
        const int vlo = rbeg < ML ? (rbeg >> 11) : 8;
        for (int i = tid; i < 4096; i += 512) { const int slot = i >> 11, k = i & 2047; int v = vlo + slot; if (v > 8) v = 8; float a = A.b_mod[k];
#pragma unroll
            for (int ks = 0; ks < 16; ++ks) a += modp[((size_t)ks * 9 + v) * 6144 + k];
            svm[i] = a; }
        for (int i = bx * 512 + tid; i < 9 * 6144; i += G * 512) { float a = A.b_mod[i % 6144];
#pragma unroll
            for (int ks = 0; ks < 16; ++ks) a += modp[(size_t)ks * 9 * 6144 + i];
            mod[i] = a; }
        __syncthreads();
        {
            const float* xin = A.x; const float* cin = A.ctx; const float* n1w = A.norm1_w; const float* gbias = A.ml_gate_b;
            const int r16 = lane & 15, quad = lane >> 4;
            const int ntile = (rend - rbeg + 15) >> 4;
            f32x4 xn[2][4];
#pragma unroll
            for (int t = 0; t < 2; ++t) { const int row = rbeg + wave + 8 * t; if (row < rend) { const float* xr = row < ML ? xin + (size_t)row * 1024 : cin + (size_t)(row - ML) * 1024;
#pragma unroll
                for (int j = 0; j < 4; ++j) xn[t][j] = __builtin_nontemporal_load((const f32x4*)(xr + 4 * lane + 256 * j)); } }
            for (int tile = 0; tile < ntile; ++tile) {
                const int trow = rbeg + 16 * tile;
#pragma unroll
                for (int t = 0; t < 2; ++t) {
                    const int r = wave + 8 * t, row = trow + r;
                    f32x4 hv[4]; float ss = 0.f;
#pragma unroll
                    for (int j = 0; j < 4; ++j) { hv[j] = xn[t][j]; const f32x4 q = hv[j] * hv[j]; ss += (q[0] + q[1]) + (q[2] + q[3]); }
                    { const int rn = row + 16; if (rn < rend) { const float* xr = rn < ML ? xin + (size_t)rn * 1024 : cin + (size_t)(rn - ML) * 1024;
#pragma unroll
                        for (int j = 0; j < 4; ++j) xn[t][j] = __builtin_nontemporal_load((const f32x4*)(xr + 4 * lane + 256 * j)); } }
                    if (row < rend) {
                        const int v = row < ML ? (row >> 11) : 8;
                        const LAS float* sh = svm + (v - vlo) * 2048; const LAS float* sc = sh + 1024;
                        const float rstd = rsqrtf(wave_sum(ss) * (1.f / 1024.f) + EPS);
                        bf16_t* ho = H + (size_t)row * 1024;
#pragma unroll
                        for (int j = 0; j < 4; ++j) { const int k = 4 * lane + 256 * j;
                            hv[j] = hv[j] * rstd * (*(const f32x4*)(n1w + k)) * (*(const LAS f32x4*)(sc + k) + 1.f) + *(const LAS f32x4*)(sh + k);
                            u32x2 w; w.x = cvt_pk_bf16(hv[j][0], hv[j][1]); w.y = cvt_pk_bf16(hv[j][2], hv[j][3]); *(u32x2*)(ho + k) = w;
                            *(LAS f32x4*)(hT + r * GP + k) = hv[j]; }
                    }
                }
                __syncthreads();
                { f32x4 acc = (f32x4){0.f, 0.f, 0.f, 0.f};
#pragma unroll
                  for (int kk = 0; kk < 8; ++kk) { const f32x4 a4 = *(const LAS f32x4*)(hT + r16 * GP + wave * 128 + kk * 16 + quad * 4), b4 = *(const LAS f32x4*)(sWg + r16 * GP + wave * 128 + kk * 16 + quad * 4);
#pragma unroll
                    for (int i = 0; i < 4; ++i) acc = __builtin_amdgcn_mfma_f32_16x16x4f32(a4[i], b4[i], acc, 0, 0, 0); }
#pragma unroll
                  for (int j = 0; j < 4; ++j) part[wave * 256 + (quad * 4 + j) * 16 + r16] = acc[j]; }
                __syncthreads();
                if (tid < 256) { const int r = tid >> 4, gidx = tid & 15, row = trow + r; float gv = gbias[gidx];
#pragma unroll
                    for (int w = 0; w < 8; ++w) gv += part[w * 256 + tid];
                    if (gidx & 4) gv = fminf(gv, 0.f) - log1pf(expf(-fabsf(gv)));
                    if (row < rend) gates[(size_t)row * 16 + gidx] = gv; }
            }
        }
        for (int task = bx; task < 176; task += G) {
            const int cb = task % 11, ks = task / 11, k0 = ks * 64;
            __syncthreads();
            { const int v = tid >> 6, k = 3072 + k0 + (tid & 63); float a = A.b_mod[k];
#pragma unroll
                for (int q = 0; q < 16; ++q) a += modp[((size_t)q * 9 + v) * 6144 + k];
                svec[tid] = a; }
            __syncthreads();
            gemv_task<8, 64, false>(A.w_up, NUP, cb * 512, k0, svec, fbp + (size_t)ks * 8 * NUP, NUP);
        }
    }
    }
    SEAM(1);

    for (int rep_ = 0; rep_ < (((RPT_MASK >> 2) & 1) ? 2 : 1); ++rep_) { if (rep_) { if (2 == 0) cg::this_grid().sync(); else xcd_barrier(xbar); }
    if (IN(2)) {
        unsigned char* const wsb = A.ws; unsigned char* const dob = (unsigned char*)A.out; (void)wsb; (void)dob;
        for (int i = bx * 512 + tid; i < 8 * NUP; i += G * 512) { float a = 0.f;
#pragma unroll
            for (int ks = 0; ks < 16; ++ks) a += fbp[(size_t)ks * 8 * NUP + i];
            fbias[i] = a; }
        { pg8::Gemm g{H, W1T, 1024, 1024, 1024}; pg8::Order S; S.init(64, 21, G, bx, 24);
          EpiIn E{AK, MK, AQ, MQ, MO, GA, GM, A.q_norm_w, A.k_norm_w, cosT, sinT, (LAS float*)(lds + 131072)};
          pg8::gemm_phase<EpiIn, pg8::Order, true>(lds, g, S, E); }
        { pg8::Gemm g{W2T, H, 1024, 1024, 1024}; pg8::Order S; S.init(5, 72, G, (bx + G - (1368 % G)) % G, 0);
          EpiPlain E{XT, MT};
          pg8::gemm_phase<EpiPlain, pg8::Order, true>(lds, g, S, E); }
    }
    }
    SEAM(2);

    if (IN(3)) {
        unsigned char* const wsb = A.ws; unsigned char* const dob = (unsigned char*)A.out; (void)wsb; (void)dob;
        const int r16 = lane & 15, quad = lane >> 4;
        const int rt = wave & 3, hp = wave >> 2;
        LAS bf16_t* sK = (LAS bf16_t*)lds;
        LAS bf16_t* sVT = sK + 64 * 72;
        bf16x8 qn[2][2];
#define AT_QLOAD(un_) do { const int qb_ = (un_) & 31, kvh_ = ((un_) >> 5) & 3, b_ = (un_) >> 7; \
            _Pragma("unroll") for (int g = 0; g < 2; ++g) _Pragma("unroll") for (int ks = 0; ks < 2; ++ks) \
                qn[g][ks] = *(const bf16x8*)(AQ + (size_t)(b_ * SEQ + qb_ * 64 + rt * 16 + r16) * 1024 + (kvh_ * 4 + hp * 2 + g) * 64 + ks * 32 + quad * 8); } while (0)
        const int vcu3 = (G % 8 == 0) ? (bx % 8) * (G / 8) + bx / 8 : bx;
        if (vcu3 < 1024) AT_QLOAD(vcu3);
        for (int unit = vcu3; unit < 1024; unit += G) {
            const int qb = unit & 31, kvh = (unit >> 5) & 3, b = unit >> 7;
            const int rowbase = b * SEQ, t0 = qb * 64;
            bf16x8 qf[2][2];
#pragma unroll
            for (int g = 0; g < 2; ++g)
#pragma unroll
                for (int ks = 0; ks < 2; ++ks) qf[g][ks] = qn[g][ks];
            if (unit + G < 1024) AT_QLOAD(unit + G);
            f32x4 o[2][4]; float mrow[2], lrow[2];
#pragma unroll
            for (int g = 0; g < 2; ++g) { mrow[g] = A.attn_sink[kvh * 4 + hp * 2 + g]; lrow[g] = 1.f;
#pragma unroll
                for (int dt = 0; dt < 4; ++dt) o[g][dt] = (f32x4){0.f, 0.f, 0.f, 0.f}; }
            const int kb_lo = (qb < 2) ? 2 - qb : 0, kb_hi = (qb > 29) ? 33 - qb : 4;
            const bf16_t* const ak_ = AK; const bf16_t* const xt_ = XT; const int lr = tid >> 3, lc = tid & 7;
#define AT_KROW0(kb_) (((kb_) < 5) ? rowbase + (qb + (kb_) - 2) * 64 : ML + b * CTX + ((kb_) - 5) * 64)
            u32x4 pk, pv;
            { const int kr = AT_KROW0(kb_lo); pk = *(const u32x4*)(ak_ + (size_t)(kr + lr) * 256 + kvh * 64 + lc * 8); pv = *(const u32x4*)(xt_ + (size_t)(kvh * 64 + lr) * MT + kr + lc * 8); }
            for (int kb = kb_lo; kb < 9; kb = (kb == kb_hi) ? 5 : kb + 1) {
                const int mtype = (kb == 0) ? 1 : (kb == 4) ? 2 : 0;
                const int mlo = (mtype == 1) ? 0 : -4096, mhi = (mtype == 2) ? 0 : 4096, dl = quad * 4 - rt * 16 - r16;
                __syncthreads();
                *(LAS u32x4*)(sK + lr * 72 + lc * 8) = pk; *(LAS u32x4*)(sVT + lr * 72 + lc * 8) = pv;
                { const int kn = (kb == kb_hi) ? 5 : kb + 1;
                  if (kn < 9) { const int kr = AT_KROW0(kn); pk = *(const u32x4*)(ak_ + (size_t)(kr + lr) * 256 + kvh * 64 + lc * 8); pv = *(const u32x4*)(xt_ + (size_t)(kvh * 64 + lr) * MT + kr + lc * 8); } }
                __syncthreads();
                bf16x8 kf[4][2], vf[2][4];
#pragma unroll
                for (int tile = 0; tile < 4; ++tile)
#pragma unroll
                    for (int ks = 0; ks < 2; ++ks) kf[tile][ks] = *(const LAS bf16x8*)(sK + (tile * 16 + r16) * 72 + ks * 32 + quad * 8);
#pragma unroll
                for (int ks = 0; ks < 2; ++ks)
#pragma unroll
                    for (int dt = 0; dt < 4; ++dt) { const u32x2 lo = *(const LAS u32x2*)(sVT + (dt * 16 + r16) * 72 + ks * 32 + quad * 4), hi = *(const LAS u32x2*)(sVT + (dt * 16 + r16) * 72 + ks * 32 + 16 + quad * 4);
                        const u32x4 w = (u32x4){lo.x, lo.y, hi.x, hi.y}; vf[ks][dt] = __builtin_bit_cast(bf16x8, w); }
#pragma unroll
                for (int g = 0; g < 2; ++g) {
                    f32x4 s[4];
#pragma unroll
                    for (int tile = 0; tile < 4; ++tile) { s[tile] = (f32x4){0.f, 0.f, 0.f, 0.f};
#pragma unroll
                        for (int ks = 0; ks < 2; ++ks) s[tile] = mfma16(kf[tile][ks], qf[g][ks], s[tile]); }
                    float mx = -1e30f;
#pragma unroll
                    for (int tile = 0; tile < 4; ++tile)
#pragma unroll
                        for (int j = 0; j < 4; ++j) { const int dd = dl + (tile * 16 + j);
                            const int bad = ((dd - mlo) | (mhi - dd)) >> 31;
                            const float v = s[tile][j] * 0.125f + __int_as_float(bad & (int)0xF149F2CAu); s[tile][j] = v; mx = fmaxf(mx, v); }
                    mx = fmaxf(mx, __shfl_xor(mx, 16)); mx = fmaxf(mx, __shfl_xor(mx, 32));
                    const float mn = fmaxf(mrow[g], mx), alpha = __expf(mrow[g] - mn); mrow[g] = mn; float rs = 0.f;
                    unsigned pw[4][2];
#pragma unroll
                    for (int tile = 0; tile < 4; ++tile) { f32x4 pe;
#pragma unroll
                        for (int j = 0; j < 4; ++j) { pe[j] = __expf(s[tile][j] - mn); rs += pe[j]; }
                        pw[tile][0] = cvt_pk_bf16(pe[0], pe[1]); pw[tile][1] = cvt_pk_bf16(pe[2], pe[3]); }
                    rs += __shfl_xor(rs, 16); rs += __shfl_xor(rs, 32);
                    lrow[g] = lrow[g] * alpha + rs;
#pragma unroll
                    for (int dt = 0; dt < 4; ++dt) o[g][dt] = o[g][dt] * alpha;
#pragma unroll
                    for (int ks = 0; ks < 2; ++ks) { const u32x4 w = (u32x4){pw[2 * ks][0], pw[2 * ks][1], pw[2 * ks + 1][0], pw[2 * ks + 1][1]}; const bf16x8 pf = __builtin_bit_cast(bf16x8, w);
#pragma unroll
                        for (int dt = 0; dt < 4; ++dt) o[g][dt] = mfma16(vf[ks][dt], pf, o[g][dt]); }
                }
            }
#pragma unroll
            for (int g = 0; g < 2; ++g) { const float inv = 1.f / lrow[g];
                bf16_t* p = ATTO + (size_t)(rowbase + t0 + rt * 16 + r16) * 1024 + (kvh * 4 + hp * 2 + g) * 64 + quad * 4;
#pragma unroll
                for (int dt = 0; dt < 4; ++dt) { u32x2 w; w.x = cvt_pk_bf16(o[g][dt][0] * inv, o[g][dt][1] * inv); w.y = cvt_pk_bf16(o[g][dt][2] * inv, o[g][dt][3] * inv); *(u32x2*)(p + dt * 16) = w; } }
        }
    }
    __syncthreads();

    for (int rep_ = 0; rep_ < (((RPT_MASK >> 4) & 1) ? 2 : 1); ++rep_) { if (rep_) { if (4 == 0) cg::this_grid().sync(); else xcd_barrier(xbar); }
    if (IN(4)) {
        unsigned char* const wsb = A.ws; unsigned char* const dob = (unsigned char*)A.out; (void)wsb; (void)dob;
        const int r16 = lane & 15, quad = lane >> 4;
        LAS bf16_t* sK = (LAS bf16_t*)lds;
        LAS bf16_t* sVT = sK + 128 * 136;
        LAS bf16_t* sS = sVT + 64 * 136;
        LAS bf16_t* sC = sS + 128 * 136;
        LAS float* sgall = (LAS float*)(sC + 80 * 136);
        const float scale = 0.08838834764831845f;
        const int vcu4 = (G % 8 == 0) ? (bx % 8) * (G / 8) + bx / 8 : bx;
        for (int task = vcu4; task < 256; task += G) {
            const int vq = task & 3, dir = (task >> 2) & 1, hh = (task >> 3) & 3, b = task >> 5;
            __syncthreads();
            for (int i = tid; i < 80 * 136 / 2; i += 512) ((LAS unsigned*)sC)[i] = 0u;
            for (int st = wave; st < 18; st += 8) {
                const int t0g = ((st < 2) ? (ML + b * CTX + (dir ? 1 - st : st) * 128) : (b * SEQ + (dir ? 15 - (st - 2) : st - 2) * 128));
                const float* gp = gates + (size_t)(t0g + 2 * lane) * 16 + dir * 8 + hh;
                const float i0 = gp[0], f0 = gp[4], i1 = gp[16], f1 = gp[20];
                const float loc = f0 + f1; float v = loc;
#pragma unroll
                for (int off = 1; off < 64; off <<= 1) { const float t = __shfl_up(v, off); if (lane >= off) v += t; }
                const float total = __shfl(v, 63); const float p0 = v - loc + f0, p1 = p0 + f1;
                const float b0 = dir ? total - p0 + f0 : p0, b1 = dir ? total - p1 + f1 : p1;
                const float cmid = 0.5f * total; LAS float* g = sgall + st * 576;
                g[2 * lane] = __expf(fminf(b0 - cmid, 80.f)); g[2 * lane + 1] = __expf(fminf(b1 - cmid, 80.f));
                g[128 + 2 * lane] = __expf(fminf(i0 - b0 + cmid, 80.f)) * scale; g[128 + 2 * lane + 1] = __expf(fminf(i1 - b1 + cmid, 80.f)) * scale;
                g[256 + 2 * lane] = __expf(fminf(total - b0 + i0, 80.f)) * scale; g[256 + 2 * lane + 1] = __expf(fminf(total - b1 + i1, 80.f)) * scale;
                g[384 + 2 * lane] = __expf(b0); g[384 + 2 * lane + 1] = __expf(b1); if (lane == 0) g[512] = __expf(total);
            }
            f32x4 cacc[4], nacc = (f32x4){0.f, 0.f, 0.f, 0.f};
#pragma unroll
            for (int vt = 0; vt < 4; ++vt) cacc[vt] = (f32x4){0.f, 0.f, 0.f, 0.f};
            bf16_t* Hout = (bf16_t*)(dob + (dir ? DO_HB : DO_HF)); const int sgn = dir ? 1 : -1;
            const bf16_t* const mk_ = MK; const bf16_t* const xt_ = XT; const bf16_t* const mq_ = MQ;
            u32x4 pK[4], pVT[2]; bf16x8 pQ[4];
#define ML_TOK0(st) (((st) < 2) ? (ML + b * CTX + (dir ? 1 - (st) : (st)) * 128) : (b * SEQ + (dir ? 15 - ((st) - 2) : (st) - 2) * 128))
#define ML_PREFETCH(st) do { const int t0_ = ML_TOK0(st); \
                _Pragma("unroll") for (int q_ = 0; q_ < 4; ++q_) { const int i_ = tid + q_ * 512, r_ = i_ >> 4, c_ = i_ & 15; pK[q_] = *(const u32x4*)(mk_ + (size_t)(t0_ + r_) * 512 + hh * 128 + c_ * 8); } \
                if ((st) >= 2) { _Pragma("unroll") for (int ks_ = 0; ks_ < 4; ++ks_) pQ[ks_] = *(const bf16x8*)(mq_ + (size_t)(t0_ + wave * 16 + r16) * 512 + hh * 128 + ks_ * 32 + quad * 8); } \
                _Pragma("unroll") for (int q_ = 0; q_ < 2; ++q_) { const int i_ = tid + q_ * 512, r_ = i_ >> 4, c_ = i_ & 15; pVT[q_] = *(const u32x4*)(xt_ + (size_t)(256 + hh * 256 + vq * 64 + r_) * MT + t0_ + c_ * 8); } \
                } while (0)
            ML_PREFETCH(0);
            for (int step = 0; step < 18; ++step) {
                const bool isctx = step < 2; const int tok0 = ML_TOK0(step);
                const LAS float* sgb = sgall + step * 576; const LAS float *sga = sgb + 128, *sgw = sgb + 256, *sge = sgb + 384, *sgF = sgb + 512;
                __syncthreads();
#pragma unroll
                for (int q = 0; q < 4; ++q) { const int i = tid + q * 512, r = i >> 4, c = i & 15; *(LAS u32x4*)(sK + r * 136 + c * 8) = pK[q]; }
#pragma unroll
                for (int q = 0; q < 2; ++q) { const int i = tid + q * 512, r = i >> 4, c = i & 15; *(LAS u32x4*)(sVT + r * 136 + c * 8) = pVT[q]; }
                bf16x8 qf[4];
#pragma unroll
                for (int ks = 0; ks < 4; ++ks) qf[ks] = pQ[ks];
                if (step + 1 < 18) ML_PREFETCH(step + 1);
                __syncthreads();
                if (!isctx) {
                    const int prow = wave * 16 + r16;
                    f32x4 s[8];
#pragma unroll
                    for (int tile = 0; tile < 8; ++tile) { s[tile] = (f32x4){0.f, 0.f, 0.f, 0.f};
#pragma unroll
                        for (int ks = 0; ks < 4; ++ks) { const bf16x8 kf = *(const LAS bf16x8*)(sK + (tile * 16 + r16) * 136 + ks * 32 + quad * 8); s[tile] = mfma16(kf, qf[ks], s[tile]); } }
                    const float bp = sgb[prow]; float rs = 0.f;
#pragma unroll
                    for (int tile = 0; tile < 8; ++tile) { const f32x4 av = *(const LAS f32x4*)(sga + tile * 16 + quad * 4); f32x4 pe;
#pragma unroll
                        for (int j = 0; j < 4; ++j) { const int dd = (tile * 16 + quad * 4 + j - prow) * sgn;
                            pe[j] = __int_as_float(__float_as_int(s[tile][j] * (bp * av[j])) & ~(dd >> 31)); rs += pe[j]; }
                        u32x2 w; w.x = cvt_pk_bf16(pe[0], pe[1]); w.y = cvt_pk_bf16(pe[2], pe[3]);
                        *(LAS u32x2*)(sS + prow * 136 + tile * 16 + quad * 4) = w; }
                    rs += __shfl_xor(rs, 16); rs += __shfl_xor(rs, 32);
                    asm volatile("s_waitcnt lgkmcnt(0)" ::: "memory");
                    f32x4 a1[4], a2[5];
#pragma unroll
                    for (int vt = 0; vt < 4; ++vt) a1[vt] = (f32x4){0.f, 0.f, 0.f, 0.f};
#pragma unroll
                    for (int vt = 0; vt < 5; ++vt) a2[vt] = (f32x4){0.f, 0.f, 0.f, 0.f};
#pragma unroll
                    for (int ks = 0; ks < 4; ++ks) { const bf16x8 af = *(const LAS bf16x8*)(sS + prow * 136 + ks * 32 + quad * 8);
#pragma unroll
                        for (int vt = 0; vt < 4; ++vt) { const bf16x8 vf = *(const LAS bf16x8*)(sVT + (vt * 16 + r16) * 136 + ks * 32 + quad * 8); a1[vt] = mfma16(vf, af, a1[vt]); } }
#pragma unroll
                    for (int ks = 0; ks < 4; ++ks)
#pragma unroll
                        for (int vt = 0; vt < 5; ++vt) { const bf16x8 cf = *(const LAS bf16x8*)(sC + (vt * 16 + r16) * 136 + ks * 32 + quad * 8); a2[vt] = mfma16(cf, qf[ks], a2[vt]); }
                    const float e = sge[prow];
                    const float qn = __shfl(a2[4][0], r16); const float nq = rs + e * qn; const float inv = 1.f / fmaxf(fabsf(nq), 1.f);
                    bf16_t* hp = Hout + (size_t)(tok0 + prow) * 1024 + hh * 256 + vq * 64 + quad * 4;
#pragma unroll
                    for (int vt = 0; vt < 4; ++vt) { u32x2 w; w.x = cvt_pk_bf16((a1[vt][0] + e * a2[vt][0]) * inv, (a1[vt][1] + e * a2[vt][1]) * inv);
                        w.y = cvt_pk_bf16((a1[vt][2] + e * a2[vt][2]) * inv, (a1[vt][3] + e * a2[vt][3]) * inv); *(u32x2*)(hp + vt * 16) = w; }
                }
                __syncthreads();
                {
                    const float F = sgF[0];
#pragma unroll
                    for (int vt = 0; vt < 4; ++vt) cacc[vt] = cacc[vt] * F;
                    nacc = nacc * F;
                    bf16x8 ones; { const short o1 = (r16 == 0) ? (short)0x3F80 : (short)0;
#pragma unroll
                        for (int e = 0; e < 8; ++e) ones[e] = o1; }
#pragma unroll
                    for (int ks = 0; ks < 4; ++ks) {
                        const LAS bf16_t* kcol = sK + (ks * 32 + quad * 8) * 136 + wave * 16 + r16;
                        const f32x4 w0 = *(const LAS f32x4*)(sgw + ks * 32 + quad * 8), w1 = *(const LAS f32x4*)(sgw + ks * 32 + quad * 8 + 4);
                        f32x4 k0, k1;
#pragma unroll
                        for (int e = 0; e < 4; ++e) { k0[e] = bf2f(kcol[e * 136]) * w0[e]; k1[e] = bf2f(kcol[(4 + e) * 136]) * w1[e]; }
                        const u32x4 pk = pack8(k0, k1); const bf16x8 kts = __builtin_bit_cast(bf16x8, pk);
#pragma unroll
                        for (int vt = 0; vt < 4; ++vt) { const bf16x8 va = *(const LAS bf16x8*)(sVT + (vt * 16 + r16) * 136 + ks * 32 + quad * 8); cacc[vt] = mfma16(kts, va, cacc[vt]); }
                        nacc = mfma16(kts, ones, nacc);
                    }
#pragma unroll
                    for (int vt = 0; vt < 4; ++vt) { u32x2 w; w.x = cvt_pk_bf16(cacc[vt][0], cacc[vt][1]); w.y = cvt_pk_bf16(cacc[vt][2], cacc[vt][3]);
                        *(LAS u32x2*)(sC + (vt * 16 + r16) * 136 + wave * 16 + quad * 4) = w; }
                    if (r16 == 0) { u32x2 w; w.x = cvt_pk_bf16(nacc[0], nacc[1]); w.y = cvt_pk_bf16(nacc[2], nacc[3]); *(LAS u32x2*)(sC + 64 * 136 + wave * 16 + quad * 4) = w; }
                }
            }
        }
    }
    }
    SEAM(4);

    if (IN(5)) {
        unsigned char* const wsb = A.ws; unsigned char* const dob = (unsigned char*)A.out; (void)wsb; (void)dob;
        {
            const float* mnw = A.ml_norm_w; f32x4 wn[4];
#pragma unroll
            for (int q = 0; q < 4; ++q) wn[q] = *(const f32x4*)(mnw + lane * 16 + q * 4);
            u32x4 na[2], nc[2], nd[2];
            if (gw < ML) { const size_t off = (size_t)gw * 1024 + lane * 16;
#pragma unroll
                for (int q = 0; q < 2; ++q) { na[q] = *(const u32x4*)(HF + off + q * 8); nc[q] = *(const u32x4*)(HB + off + q * 8); nd[q] = *(const u32x4*)(MO + off + q * 8); } }
            for (int row = gw; row < ML; row += NGW) {
                const size_t off = (size_t)row * 1024 + lane * 16;
                float ht[16], mo[16];
#pragma unroll
                for (int q = 0; q < 2; ++q) { const u32x4 a = na[q], c = nc[q], d = nd[q];
#pragma unroll
                    for (int e = 0; e < 4; ++e) { ht[q * 8 + 2 * e] = __uint_as_float(a[e] << 16) + __uint_as_float(c[e] << 16); ht[q * 8 + 2 * e + 1] = __uint_as_float(a[e] & 0xffff0000u) + __uint_as_float(c[e] & 0xffff0000u);
                        mo[q * 8 + 2 * e] = __uint_as_float(d[e] << 16); mo[q * 8 + 2 * e + 1] = __uint_as_float(d[e] & 0xffff0000u); } }
                if (row + NGW < ML) { const size_t offn = (size_t)(row + NGW) * 1024 + lane * 16;
#pragma unroll
                    for (int q = 0; q < 2; ++q) { na[q] = *(const u32x4*)(HF + offn + q * 8); nc[q] = *(const u32x4*)(HB + offn + q * 8); nd[q] = *(const u32x4*)(MO + offn + q * 8); } }
                float ss = 0.f;
#pragma unroll
                for (int e = 0; e < 16; ++e) ss += ht[e] * ht[e];
                ss += __shfl_xor(ss, 1); ss += __shfl_xor(ss, 2); ss += __shfl_xor(ss, 4); ss += __shfl_xor(ss, 8);
                const float rs = rsqrtf(ss * (1.f / 256.f) + EPS);
                float r[16];
#pragma unroll
                for (int q = 0; q < 4; ++q)
#pragma unroll
                    for (int e = 0; e < 4; ++e) r[q * 4 + e] = ht[q * 4 + e] * rs * wn[q][e] * sigmoidf_(mo[q * 4 + e]);
#pragma unroll
                for (int q = 0; q < 2; ++q) { u32x4 w; w.x = cvt_pk_bf16(r[q * 8 + 0], r[q * 8 + 1]); w.y = cvt_pk_bf16(r[q * 8 + 2], r[q * 8 + 3]); w.z = cvt_pk_bf16(r[q * 8 + 4], r[q * 8 + 5]); w.w = cvt_pk_bf16(r[q * 8 + 6], r[q * 8 + 7]);
                    *(u32x4*)(MO + off + q * 8) = w; }
            }
        }
    }
    SEAM(5);

    for (int rep_ = 0; rep_ < (((RPT_MASK >> 6) & 1) ? 2 : 1); ++rep_) { if (rep_) { if (6 == 0) cg::this_grid().sync(); else xcd_barrier(xbar); }
    if (IN(6)) {
        unsigned char* const wsb = A.ws; unsigned char* const dob = (unsigned char*)A.out; (void)wsb; (void)dob;
        pg8::Order S; S.init(64, 4, G, bx, 0);
        { pg8::Gemm g{AQ, WBA, 1024, 1024, 1024, MO, WBM}; EpiMerge E{GA, GM, Y}; pg8::gemm_phase<EpiMerge, pg8::Order, false, true>(lds, g, S, E); }
    }
    }
    SEAM(6);

    for (int rep_ = 0; rep_ < (((RPT_MASK >> 7) & 1) ? 2 : 1); ++rep_) { if (rep_) { if (7 == 0) cg::this_grid().sync(); else xcd_barrier(xbar); }
    if (IN(7)) {
        unsigned char* const wsb = A.ws; unsigned char* const dob = (unsigned char*)A.out; (void)wsb; (void)dob;
        pg8::Order S; S.init(64, 4, G, bx, 0);
#ifdef DBG_P7PLAIN
        pg8::Gemm g{Y, WO, 1024, 1024, 1024}; EpiPlain E{T1, 1024};
        pg8::gemm_phase<EpiPlain, pg8::Order, false>(lds, g, S, E);
#else
        pg8::Gemm g{Y, WO, 1024, 1024, 1024}; EpiOut E{A.x, mod, A.norm2_w, (float*)dob, AQ, rowsq};
        pg8::gemm_phase<EpiOut, pg8::Order, false>(lds, g, S, E);
#endif
    }
    }
    SEAM(7);

    for (int rep_ = 0; rep_ < (((RPT_MASK >> 8) & 1) ? 2 : 1); ++rep_) { if (rep_) { if (8 == 0) cg::this_grid().sync(); else xcd_barrier(xbar); }
    if (IN(8)) {
        unsigned char* const wsb = A.ws; unsigned char* const dob = (unsigned char*)A.out; (void)wsb; (void)dob;
        pg8::Order S; S.init(64, 22, G, bx, 0);
        pg8::Gemm g{AQ, WUP, 1024, 1024, 1024}; EpiUp E{rowsq, fbias, A.conv_w, A.conv_b, ACT, RAWU, (LAS float*)(lds + 131072)};
        pg8::gemm_phase<EpiUp, pg8::Order, true>(lds, g, S, E);
    }
    }
    SEAM(8);

    if (IN(9)) {
        unsigned char* const wsb = A.ws; unsigned char* const dob = (unsigned char*)A.out; (void)wsb; (void)dob;
        const float* cw = A.conv_w; const float* cb = A.conv_b;
        for (int task = bx * 512 + tid; task < 1025 * 352; task += G * 512) {
            const int ch = task % 352, bd = task / 352, j0 = ch * 8;
            const int pc = 256 * (j0 >> 7) + (j0 & 127);
            const bool lo_ok = bd > 0, hi_ok = bd < 1024, seam = ((bd * 16) & 2047) == 0;
            const u32x4 zero = (u32x4){0u, 0u, 0u, 0u};
            u32x4 xa[4], xg[4];
#pragma unroll
            for (int k = 0; k < 4; ++k) { xa[k] = zero; xg[k] = zero; }
            if (lo_ok) { const bf16_t* rp = RAWU + ((size_t)(bd - 1) * 4 + 2) * NUP + pc; xa[0] = *(const u32x4*)rp; xg[0] = *(const u32x4*)(rp + 128); xa[1] = *(const u32x4*)(rp + NUP); xg[1] = *(const u32x4*)(rp + NUP + 128); }
            if (hi_ok) { const bf16_t* rp = RAWU + ((size_t)bd * 4) * NUP + pc; xa[2] = *(const u32x4*)rp; xg[2] = *(const u32x4*)(rp + 128); xa[3] = *(const u32x4*)(rp + NUP); xg[3] = *(const u32x4*)(rp + NUP + 128); }
            float wa[3][8], wg[3][8], ba[8], bg[8];
#pragma unroll
            for (int i = 0; i < 3; ++i)
#pragma unroll
                for (int q = 0; q < 2; ++q) { const f32x4 a = *(const f32x4*)(cw + i * NUP + j0 + 4 * q), g = *(const f32x4*)(cw + i * NUP + DFF + j0 + 4 * q);
#pragma unroll
                    for (int e = 0; e < 4; ++e) { wa[i][4 * q + e] = a[e]; wg[i][4 * q + e] = g[e]; } }
#pragma unroll
            for (int q = 0; q < 2; ++q) { const f32x4 a = *(const f32x4*)(cb + j0 + 4 * q), g = *(const f32x4*)(cb + DFF + j0 + 4 * q);
#pragma unroll
                for (int e = 0; e < 4; ++e) { ba[4 * q + e] = a[e]; bg[4 * q + e] = g[e]; } }
#pragma unroll
            for (int side = 0; side < 2; ++side) {
                if (side == 0 ? !lo_ok : !hi_ok) continue;
                float r[8];
#pragma unroll
                for (int e = 0; e < 8; ++e) { const int w = e >> 1; const bool hi16 = e & 1;
                    float va[3], vg[3];
#pragma unroll
                    for (int k = 0; k < 3; ++k) { const unsigned aw = xa[side + k][w], gw = xg[side + k][w];
                        va[k] = hi16 ? __uint_as_float(aw & 0xffff0000u) : __uint_as_float(aw << 16); vg[k] = hi16 ? __uint_as_float(gw & 0xffff0000u) : __uint_as_float(gw << 16); }
                    if (seam) { if (side == 0) { va[2] = 0.f; vg[2] = 0.f; } else { va[0] = 0.f; vg[0] = 0.f; } }
                    const float av = ba[e] + wa[0][e] * va[0] + wa[1][e] * va[1] + wa[2][e] * va[2];
                    const float gv = bg[e] + wg[0][e] * vg[0] + wg[1][e] * vg[1] + wg[2][e] * vg[2];
                    r[e] = gv * sigmoidf_(gv) * av; }
                u32x4 w; w.x = cvt_pk_bf16(r[0], r[1]); w.y = cvt_pk_bf16(r[2], r[3]); w.z = cvt_pk_bf16(r[4], r[5]); w.w = cvt_pk_bf16(r[6], r[7]);
                *(u32x4*)(ACT + (size_t)(bd * 16 - 1 + side) * DFF + j0) = w;
            }
        }
    }
    SEAM(9);

    if (IN(10)) {
        unsigned char* const wsb = A.ws; unsigned char* const dob = (unsigned char*)A.out; (void)wsb; (void)dob;
        pg8::Order S; S.init(64, 4, G, bx, 0);
        pg8::Gemm g{ACT, WDN, DFF, DFF, DFF}; EpiDown E{(float*)dob, mod, AQ, A.norm2_w};
        pg8::gemm_phase<EpiDown, pg8::Order, false>(lds, g, S, E);
    }
#undef IN
#undef SEAM
}
#undef A

extern "C" void kernel_launch(void* const* d_in, const int* in_sizes, int n_in, void* d_out, int out_size, void* d_ws, size_t ws_size, hipStream_t stream) {
    static int grid = 0;
    if (grid == 0) {
        if (n_in != 21 || out_size != ML * D || ws_size < WS_END) { fprintf(stderr, "kernel_launch: unexpected shapes (n_in %d out %d ws %zu)\n", n_in, out_size, ws_size); grid = -1; return; }
        int dev = 0, cus = 0, per_cu = 0;
        hipGetDevice(&dev); hipDeviceGetAttribute(&cus, hipDeviceAttributeMultiprocessorCount, dev);
        hipFuncSetAttribute((const void*)fwd_kernel, hipFuncAttributeMaxDynamicSharedMemorySize, LDS_BYTES);
        hipOccupancyMaxActiveBlocksPerMultiprocessor(&per_cu, (const void*)fwd_kernel, 512, LDS_BYTES);
        if (per_cu < 1) { fprintf(stderr, "kernel_launch: occupancy query says %d blocks per CU\n", per_cu); per_cu = 1; }
        grid = cus * per_cu;
        (void)hipGetLastError();
    }
    if (grid < 0) return;
    Args a{};
    const float** pp = (const float**)&a;
    for (int i = 0; i < 21; ++i) pp[i] = (const float*)d_in[i];
    a.out = (float*)d_out; a.ws = (unsigned char*)d_ws;
#if ONE_LAUNCH
    a.ph_lo = 0; a.ph_hi = 11;
    void* args[] = {&a};
    hipError_t e = hipLaunchCooperativeKernel((const void*)fwd_kernel, dim3(grid), dim3(512), args, LDS_BYTES, stream);
    if (e != hipSuccess) fprintf(stderr, "cooperative launch failed: %s (grid %d)\n", hipGetErrorString(e), grid);
#else
    for (int p = 0; p < 11; ++p) { a.ph_lo = p; a.ph_hi = p + 1; hipLaunchKernelGGL(fwd_kernel, dim3(grid), dim3(512), LDS_BYTES, stream, a); }

#endif
}
```
